# Optimizing an MI355X kernel written in HIP

```python
import jax, jax.numpy as jnp
from jax import lax
import numpy as np

D_MODEL = 1024
BATCH = 8
SEQ = 2048
DEPTH = 4
DEC_BATCH = 1
DEC_SEQ = 16384
PAST_LEN = 128

N_MEM = 256
D_FF = 2816
FOURIER_GROUPS = 4
FOURIER_GROUP_DIM = 128
FOURIER_WIDTH = FOURIER_GROUPS * FOURIER_GROUP_DIM
RET_HEADS = 4
RET_DK = 128
RET_DV = 256
RET_QK_WIDTH = RET_HEADS * RET_DK
RET_V_WIDTH = RET_HEADS * RET_DV
RET_CHUNK = 128
N_BRANCHES = 2
IN_WIDTH = FOURIER_WIDTH + 2 * RET_QK_WIDTH + 2 * RET_V_WIDTH + N_BRANCHES * D_MODEL
IN_SPLITS = (FOURIER_WIDTH,
             FOURIER_WIDTH + RET_QK_WIDTH,
             FOURIER_WIDTH + 2 * RET_QK_WIDTH,
             FOURIER_WIDTH + 2 * RET_QK_WIDTH + RET_V_WIDTH,
             FOURIER_WIDTH + 2 * RET_QK_WIDTH + 2 * RET_V_WIDTH)
XA_HEADS = 4
XA_HEAD_DIM = D_MODEL // XA_HEADS
ROPE_BASE = 10000.0
EPS = 1e-6

kernel_name = "hybrid_fnet_retention_encoder"


def rmsnorm(x, g):
    xf = x.astype(jnp.float32)
    y = xf * lax.rsqrt(jnp.mean(xf * xf, axis=-1, keepdims=True) + EPS)
    return (y * g.astype(jnp.float32)).astype(x.dtype)


def swiglu(h, w_in, w_out):
    gate, up = jnp.split(h @ w_in, 2, axis=-1)
    return (jax.nn.silu(gate) * up) @ w_out


def rotary(x, pos):
    d = x.shape[-1]
    half = d // 2
    inv = 1.0 / (ROPE_BASE ** (jnp.arange(half, dtype=jnp.float32) * 2.0 / d))
    ang = pos[:, None] * inv[None, :]
    cos = jnp.cos(ang)[None, :, None, :]
    sin = jnp.sin(ang)[None, :, None, :]
    x1, x2 = x[..., :half], x[..., half:]
    return jnp.concatenate([x1 * cos - x2 * sin, x2 * cos + x1 * sin], axis=-1)


def fourier_mix(hf):
    B, S, _ = hf.shape
    a = hf.astype(jnp.float32).reshape(B, S, FOURIER_GROUPS, FOURIER_GROUP_DIM)
    y = jnp.fft.fft2(a, axes=(1, 3), norm="ortho").real
    return y.reshape(B, S, FOURIER_WIDTH).astype(hf.dtype)


def retention_dir(q, k, v, log_gamma, strict):
    B, S, H, DK = q.shape
    DV = v.shape[-1]
    C = RET_CHUNK
    N = S // C
    qc = q.reshape(B, N, C, H, DK)
    kc = k.reshape(B, N, C, H, DK)
    vc = v.reshape(B, N, C, H, DV)
    idx = jnp.arange(C, dtype=jnp.float32)
    diff = idx[:, None] - idx[None, :]
    mask = (diff > 0) if strict else (diff >= 0)
    decay = jnp.where(mask[None], jnp.exp(log_gamma[:, None, None] * jnp.where(mask, diff, 0.0)[None]), 0.0)
    scores = jnp.einsum('bnchd,bnmhd->bnhcm', qc, kc) * decay[None, None]
    intra = jnp.einsum('bnhcm,bnmhe->bnche', scores, vc)
    xi = jnp.exp(log_gamma[None, :] * (idx[:, None] + 1.0))
    zeta = jnp.exp(log_gamma[None, :] * (C - 1.0 - idx[:, None]))
    g_chunk = jnp.exp(log_gamma * C)[None, :, None, None]
    upd = jnp.einsum('bnmhd,bnmhe->nbhde', kc * zeta[None, None, :, :, None], vc)

    def step(state, u):
        return g_chunk * state + u, state

    _, r_prev = lax.scan(step, jnp.zeros((B, H, DK, DV), jnp.float32), upd)
    cross = jnp.einsum('bnchd,nbhde->bnche', qc * xi[None, None, :, :, None], r_prev)
    return (intra + cross).reshape(B, S, H, DV)


def retention(hq, hk, hv, hg, decay_fwd, decay_bwd):
    B, S, _ = hq.shape
    pos = jnp.arange(S, dtype=jnp.float32)
    q = rotary(hq.astype(jnp.float32).reshape(B, S, RET_HEADS, RET_DK), pos)
    k = rotary(hk.astype(jnp.float32).reshape(B, S, RET_HEADS, RET_DK), pos) * (RET_DK ** -0.5)
    v = hv.astype(jnp.float32).reshape(B, S, RET_HEADS, RET_DV)
    lg_f = jax.nn.log_sigmoid(decay_fwd.astype(jnp.float32))
    lg_b = jax.nn.log_sigmoid(decay_bwd.astype(jnp.float32))
    y_f = retention_dir(q, k, v, lg_f, False)
    y_b = jnp.flip(retention_dir(jnp.flip(q, 1), jnp.flip(k, 1), jnp.flip(v, 1), lg_b, True), 1)
    y = y_f + y_b
    y = y * lax.rsqrt(jnp.mean(y * y, axis=-1, keepdims=True) + EPS)
    y = y.reshape(B, S, RET_V_WIDTH).astype(hg.dtype)
    return jax.nn.silu(hg) * y


def cross_attention(h, mem_n, wq, wkv, wo):
    B, S, _ = h.shape
    M = mem_n.shape[1]
    q = (h @ wq).reshape(B, S, XA_HEADS, XA_HEAD_DIM)
    k, v = jnp.split(mem_n @ wkv, 2, axis=-1)
    k = k.reshape(B, M, XA_HEADS, XA_HEAD_DIM)
    v = v.reshape(B, M, XA_HEADS, XA_HEAD_DIM)
    s = jnp.einsum('bshd,bmhd->bhsm', q, k).astype(jnp.float32) * (XA_HEAD_DIM ** -0.5)
    p = jax.nn.softmax(s, axis=-1).astype(v.dtype)
    o = jnp.einsum('bhsm,bmhd->bshd', p, v).reshape(B, S, D_MODEL)
    return o @ wo


def trunk(x, mem, ffn1_norm, ffn1_w_in, ffn1_w_out, mix_norm, mix_w_in, fourier_w, ret_decay_fwd,
          ret_decay_bwd, ret_w_out, mix_w_out, xa_norm, mem_norm, xa_wq, xa_wkv, xa_wo,
          ffn2_norm, ffn2_w_in, ffn2_w_out, final_norm):
    for l in range(DEPTH):
        x = x + 0.5 * swiglu(rmsnorm(x, ffn1_norm[l]), ffn1_w_in[l], ffn1_w_out[l])
        h = rmsnorm(x, mix_norm[l])
        hf, hq, hk, hv, hg, gates = jnp.split(h @ mix_w_in[l], IN_SPLITS, axis=-1)
        y_a = fourier_mix(hf) @ fourier_w[l]
        y_b = retention(hq, hk, hv, hg, ret_decay_fwd[l], ret_decay_bwd[l]) @ ret_w_out[l]
        g_a, g_b = jnp.split(jax.nn.sigmoid(gates), 2, axis=-1)
        x = x + (g_a * y_a + g_b * y_b) @ mix_w_out[l]
        x = x + cross_attention(rmsnorm(x, xa_norm[l]), rmsnorm(mem, mem_norm[l]), xa_wq[l], xa_wkv[l], xa_wo[l])
        x = x + 0.5 * swiglu(rmsnorm(x, ffn2_norm[l]), ffn2_w_in[l], ffn2_w_out[l])
    return rmsnorm(x, final_norm)


def setup_inputs(seed: int = 0) -> dict:
    key = jax.random.key(seed)
    ks = jax.random.split(key, 32)
    f32 = jnp.float32

    def w(k, shape, fan_in):
        return jax.random.normal(k, shape, f32) * (fan_in ** -0.5)

    def gain(k, shape):
        return 1.0 + 0.01 * jax.random.normal(k, shape, f32)

    base_logit = jnp.log(2.0 ** (5.0 + jnp.arange(RET_HEADS, dtype=f32)) - 1.0)
    return {
        "x_prompt": jax.random.normal(ks[0], (BATCH, SEQ, D_MODEL), f32),
        "x_sample": jax.random.normal(ks[1], (DEC_BATCH, DEC_SEQ, D_MODEL), f32),
        "mem_prompt": jax.random.normal(ks[2], (BATCH, N_MEM, D_MODEL), f32),
        "mem_sample": jax.random.normal(ks[3], (DEC_BATCH, N_MEM, D_MODEL), f32),
        "ffn1_norm": gain(ks[4], (DEPTH, D_MODEL)),
        "ffn1_w_in": w(ks[5], (DEPTH, D_MODEL, 2 * D_FF), D_MODEL),
        "ffn1_w_out": w(ks[6], (DEPTH, D_FF, D_MODEL), D_FF),
        "mix_norm": gain(ks[7], (DEPTH, D_MODEL)),
        "mix_w_in": w(ks[8], (DEPTH, D_MODEL, IN_WIDTH), D_MODEL),
        "fourier_w": w(ks[9], (DEPTH, FOURIER_WIDTH, D_MODEL), FOURIER_WIDTH),
        "ret_decay_fwd": base_logit[None, :] + 0.05 * jax.random.normal(ks[10], (DEPTH, RET_HEADS), f32),
        "ret_decay_bwd": base_logit[None, :] + 0.05 * jax.random.normal(ks[11], (DEPTH, RET_HEADS), f32),
        "ret_w_out": w(ks[12], (DEPTH, RET_V_WIDTH, D_MODEL), RET_V_WIDTH),
        "mix_w_out": w(ks[13], (DEPTH, D_MODEL, D_MODEL), D_MODEL),
        "xa_norm": gain(ks[14], (DEPTH, D_MODEL)),
        "mem_norm": gain(ks[15], (DEPTH, D_MODEL)),
        "xa_wq": w(ks[16], (DEPTH, D_MODEL, D_MODEL), D_MODEL),
        "xa_wkv": w(ks[17], (DEPTH, D_MODEL, 2 * D_MODEL), D_MODEL),
        "xa_wo": w(ks[18], (DEPTH, D_MODEL, D_MODEL), D_MODEL),
        "ffn2_norm": gain(ks[19], (DEPTH, D_MODEL)),
        "ffn2_w_in": w(ks[20], (DEPTH, D_MODEL, 2 * D_FF), D_MODEL),
        "ffn2_w_out": w(ks[21], (DEPTH, D_FF, D_MODEL), D_FF),
        "final_norm": gain(ks[22], (D_MODEL,)),
    }


def reference(x_prompt, x_sample, mem_prompt, mem_sample, ffn1_norm, ffn1_w_in, ffn1_w_out, mix_norm,
              mix_w_in, fourier_w, ret_decay_fwd, ret_decay_bwd, ret_w_out, mix_w_out, xa_norm, mem_norm,
              xa_wq, xa_wkv, xa_wo, ffn2_norm, ffn2_w_in, ffn2_w_out, final_norm):
    y_prompt = trunk(x_prompt, mem_prompt, ffn1_norm, ffn1_w_in, ffn1_w_out, mix_norm, mix_w_in, fourier_w,
                     ret_decay_fwd, ret_decay_bwd, ret_w_out, mix_w_out, xa_norm, mem_norm, xa_wq, xa_wkv,
                     xa_wo, ffn2_norm, ffn2_w_in, ffn2_w_out, final_norm)
    y_sample = trunk(x_sample, mem_sample, ffn1_norm, ffn1_w_in, ffn1_w_out, mix_norm, mix_w_in, fourier_w,
                     ret_decay_fwd, ret_decay_bwd, ret_w_out, mix_w_out, xa_norm, mem_norm, xa_wq, xa_wkv,
                     xa_wo, ffn2_norm, ffn2_w_in, ffn2_w_out, final_norm)
    return (y_prompt, y_sample)
```

```cpp
#include <hip/hip_runtime.h>
#include <hip/hip_cooperative_groups.h>
#include <cstdio>
namespace cg = cooperative_groups;

#define LAS __attribute__((address_space(3)))
typedef unsigned short bf16_t;
typedef short bf16x8 __attribute__((ext_vector_type(8)));
typedef short s16x4 __attribute__((ext_vector_type(4)));
typedef float f32x4 __attribute__((ext_vector_type(4)));
typedef float f32x16 __attribute__((ext_vector_type(16)));
typedef unsigned u32x4 __attribute__((ext_vector_type(4)));
typedef unsigned u32x2 __attribute__((ext_vector_type(2)));

constexpr int T_TOK = 32768, DM = 1024, DFF = 2816, NMEMROWS = 2304;
constexpr size_t MiB = 1048576;
constexpr size_t OFF_TAB = 0;
constexpr size_t OFF_DFT = 8 * MiB;
constexpr size_t OFF_MEMB = OFF_DFT + 256 * 1024;
constexpr size_t OFF_RSS = OFF_MEMB + 4718592;
constexpr size_t OFF_XB = OFF_RSS + 2 * MiB;
constexpr size_t OFF_WB = OFF_XB + 64 * MiB;
constexpr size_t OFF_A = OFF_WB + 58 * MiB;
constexpr size_t OFF_S = OFF_A + 128 * MiB;
constexpr size_t OFF_B = OFF_S + 128 * MiB;
constexpr size_t WS_NEED = OFF_B + 160 * MiB;
constexpr size_t W_1I = 0, W_1O = 5767168, W_M1 = 8650752, W_M2 = 11796480, W_F = 14942208, W_R = 15466496, W_MO = 16515072,
                 W_Q = 17563648, W_KV = 18612224, W_O = 20709376, W_2I = 21757952, W_2O = 27525120;
constexpr int DT_C128 = 0, DT_S128 = 16384, DT_C64 = 32768, DT_S64 = 36864, DT_C32 = 40960, DT_S32 = 41984;

struct Params {
  const float* in[23];
  float* X;
  unsigned char* ws;
};

__device__ __forceinline__ int opaque_tid() { int t = threadIdx.x; asm volatile("" : "+v"(t)); return t; }
typedef __bf16 bf16x2_t __attribute__((ext_vector_type(2)));
typedef float f32x2 __attribute__((ext_vector_type(2)));
__device__ __forceinline__ unsigned cvt_pk_bf16(float lo, float hi) { f32x2 v = {lo, hi}; bf16x2_t b = __builtin_convertvector(v, bf16x2_t); return __builtin_bit_cast(unsigned, b); }
__device__ __forceinline__ float bf_lo(unsigned u) { return __uint_as_float(u << 16); }
__device__ __forceinline__ float bf_hi(unsigned u) { return __uint_as_float(u & 0xffff0000u); }
__device__ __forceinline__ u32x4 pack8(f32x4 a, f32x4 b) { u32x4 o; o[0] = cvt_pk_bf16(a[0], a[1]); o[1] = cvt_pk_bf16(a[2], a[3]); o[2] = cvt_pk_bf16(b[0], b[1]); o[3] = cvt_pk_bf16(b[2], b[3]); return o; }
__device__ __forceinline__ u32x2 pack4(float a, float b, float c, float d) { u32x2 o; o[0] = cvt_pk_bf16(a, b); o[1] = cvt_pk_bf16(c, d); return o; }
__device__ __forceinline__ float fsigmoid(float x) { return __builtin_amdgcn_rcpf(1.f + __expf(-x)); }
__device__ __forceinline__ float fsilu(float x) { return x * fsigmoid(x); }
__device__ __forceinline__ float row_rstd(const float* RSS, int row) {
  const f32x4* p = (const f32x4*)(RSS + (size_t)row * 16); f32x4 a = p[0], b = p[1], c = p[2], d = p[3];
  float s = ((a[0] + a[1]) + (a[2] + a[3])) + ((b[0] + b[1]) + (b[2] + b[3])) + ((c[0] + c[1]) + (c[2] + c[3])) + ((d[0] + d[1]) + (d[2] + d[3]));
  return rsqrtf(s * (1.f / 1024.f) + 1e-6f);
}
__device__ __forceinline__ bf16x8 tr_frag(const LAS unsigned char* lds, unsigned off_lo, unsigned off_hi) {
  s16x4 a = __builtin_amdgcn_ds_read_tr16_b64_v4i16((LAS s16x4*)(lds + off_lo));
  s16x4 b = __builtin_amdgcn_ds_read_tr16_b64_v4i16((LAS s16x4*)(lds + off_hi));
  return __builtin_shufflevector(a, b, 0, 1, 2, 3, 4, 5, 6, 7);
}
__device__ __forceinline__ f32x16 mfma32(bf16x8 a, bf16x8 b, f32x16 c) { return __builtin_amdgcn_mfma_f32_32x32x16_bf16(a, b, c, 0, 0, 0); }
__device__ __forceinline__ float log_sigmoid(float x) { return fminf(x, 0.f) - log1pf(expf(-fabsf(x))); }
__device__ __forceinline__ bf16x8 scale_frag(bf16x8 q, float s) {
  u32x4 u = (u32x4)q; u32x4 o;
#pragma unroll
  for (int i = 0; i < 4; ++i) o[i] = cvt_pk_bf16(bf_lo(u[i]) * s, bf_hi(u[i]) * s);
  return (bf16x8)o;
}

namespace pg8 {
constexpr int BM = 256, BK = 64, HALF = 128, HTB = HALF * BK * 2, STAGE_BYTES = 8 * HTB, NXCD = 8, WGM = 8;
__device__ __forceinline__ int lds_byte(int r, int c) { const int st = (r >> 4) * 2 + (c >> 5), rr = r & 15, cc = c & 31, ob = rr * 64 + cc * 2; return st * 1024 + (ob ^ (((ob >> 9) & 1) << 5)); }
__device__ __forceinline__ void stage_rc(int b, int& R, int& C) { const int st = b / 1024, sb = b % 1024, swz = sb ^ (((sb >> 9) & 1) << 5); R = (st >> 1) * 16 + swz / 64; C = (st & 1) * 32 + (swz % 64) / 2; }
__device__ __forceinline__ int perm32(int rho) { const int n = rho >> 4, i = rho & 15; return 8 * (i >> 2) + 4 * n + (i & 3); }
struct Unit { int pm, pn; };
struct Gemm { const bf16_t* A; const bf16_t* Bt; int M, N, K; };
struct StaticOrder {
  int nM, nN, nwg, G, c;
  __device__ void init(int M, int N, int G_, int c_) { nM = M / BM; nN = N / BM; nwg = nM * nN; G = G_; c = c_; }
  __device__ bool next(int i, Unit& u) const {
    const long L = (long)i * G + c; if (L >= nwg) return false;
    int wgid = (int)L; { const int q = nwg / NXCD, r = nwg % NXCD, xcd = wgid % NXCD, off = wgid / NXCD; wgid = (xcd < r ? xcd * (q + 1) : r * (q + 1) + (xcd - r) * q) + off; }
    const int nig = WGM * nN, gid = wgid / nig, fm = gid * WGM, gsz = (nM - fm) < WGM ? (nM - fm) : WGM;
    u.pm = fm + ((wgid % nig) % gsz); u.pn = (wgid % nig) / gsz; return true;
  }
  __device__ __forceinline__ void a_ready(const Unit&) const {}
  __device__ __forceinline__ void done(const Unit&) const {}
};

template <class Epi, class Sched>
__device__ __forceinline__ void gemm_phase(LAS unsigned char* lds, const Gemm g, const Sched& S, const Epi& E) {
  const int tid = opaque_tid(), wid = __builtin_amdgcn_readfirstlane(tid >> 6), lane = tid & 63, wr = wid >> 2, wc = wid & 3, fr = lane & 15, fq = lane >> 4;
  const int K = g.K, nt = K / BK;
  unsigned voffA[2], voffB[2];
#pragma unroll
  for (int i = 0; i < 2; ++i) { int R, C; stage_rc(tid * 16 + i * 8192, R, C); const int Rb = Epi::PERM ? ((R & ~31) + perm32(R & 31)) : R;
    voffA[i] = (unsigned)(R * K + C) * 2u; voffB[i] = (unsigned)(Rb * K + C) * 2u; }
  const size_t kstep = (size_t)(BK * 2);
  const size_t hstep = (size_t)HALF * K * 2;
  const size_t tstep = 2 * hstep;
  const unsigned ldsw = (unsigned)wid * 1024u;
  const int aoff = lds_byte(wr * 64 + fr, fq * 8), boff = lds_byte(wc * 32 + fr, fq * 8);
#define PG8_SA(b, h) (((b) * 2 + (h)) * HTB)
#define PG8_SB(b, h) ((4 + (b) * 2 + (h)) * HTB)
#define PG8_STAGE(bufoff, gbase, voff) do { _Pragma("unroll") for (int _i = 0; _i < 2; ++_i) \
    __builtin_amdgcn_global_load_lds((const unsigned*)((const char*)(gbase) + (voff)[_i]), (LAS unsigned*)(lds + (bufoff) + ldsw + _i * 8192), 16, 0, 0); } while (0)
#define PG8_LDA(dst, b, h) do { _Pragma("unroll") for (int m = 0; m < 4; ++m) _Pragma("unroll") for (int k = 0; k < 2; ++k) dst[m][k] = *(const LAS bf16x8*)(lds + PG8_SA(b, h) + aoff + m * 2048 + k * 1024); } while (0)
#define PG8_LDB(dst, b, h) do { _Pragma("unroll") for (int n = 0; n < 2; ++n) _Pragma("unroll") for (int k = 0; k < 2; ++k) dst[n][k] = *(const LAS bf16x8*)(lds + PG8_SB(b, h) + boff + n * 2048 + k * 1024); } while (0)
#define PG8_MMA(ai, bj, At, Bt) do { __builtin_amdgcn_s_setprio(1); _Pragma("unroll") for (int m = 0; m < 4; ++m) _Pragma("unroll") for (int n = 0; n < 2; ++n) _Pragma("unroll") for (int k = 0; k < 2; ++k) \
    acc[ai][bj][m][n] = __builtin_amdgcn_mfma_f32_16x16x32_bf16(Bt[n][k], At[m][k], acc[ai][bj][m][n], 0, 0, 0); __builtin_amdgcn_s_setprio(0); } while (0)
#define PG8_WAIT_V(n) asm volatile("s_waitcnt vmcnt(" #n ")" ::: "memory")
#define PG8_WAIT_L(n) asm volatile("s_waitcnt lgkmcnt(" #n ")" ::: "memory")
#define PG8_BAR __builtin_amdgcn_s_barrier()
#define PG8_SCHED __builtin_amdgcn_sched_barrier(0)
  Unit cur, nxt; int ui = 0;
  if (!S.next(0, cur)) return;
  f32x4 acc[2][2][4][2];
#pragma unroll
  for (int a = 0; a < 2; ++a)
#pragma unroll
    for (int b = 0; b < 2; ++b)
#pragma unroll
      for (int m = 0; m < 4; ++m)
#pragma unroll
        for (int n = 0; n < 2; ++n) acc[a][b][m][n] = (f32x4){0.f, 0.f, 0.f, 0.f};
  bf16x8 At[4][2], B0[2][2], B1[2][2];
  const char* cA = (const char*)g.A + (size_t)cur.pm * tstep; const char* cB = (const char*)g.Bt + (size_t)cur.pn * tstep;
  S.a_ready(cur);
  PG8_STAGE(PG8_SB(0, 0), cB, voffB); PG8_STAGE(PG8_SA(0, 0), cA, voffA); PG8_STAGE(PG8_SB(0, 1), cB + hstep, voffB); PG8_STAGE(PG8_SA(0, 1), cA + hstep, voffA);
  if (wr == 1) PG8_BAR;
  PG8_WAIT_V(4); PG8_BAR;
  PG8_STAGE(PG8_SB(1, 0), cB + kstep, voffB); PG8_STAGE(PG8_SA(1, 0), cA + kstep, voffA); PG8_STAGE(PG8_SB(1, 1), cB + hstep + kstep, voffB);
  PG8_WAIT_V(6); PG8_BAR;
  for (;;) {
    const bool has_next = S.next(ui + 1, nxt);
    const char* nA = has_next ? (const char*)g.A + (size_t)nxt.pm * tstep : cA; const char* nB = has_next ? (const char*)g.Bt + (size_t)nxt.pn * tstep : cB;
    for (int t = 0; t < nt; t += 2) {
      const bool last = (t == nt - 2);
      const char* a1 = cA + (size_t)(t + 1) * kstep;
      const char* a2 = last ? nA : cA + (size_t)(t + 2) * kstep; const char* b2 = last ? nB : cB + (size_t)(t + 2) * kstep;
      const char* a3 = a2 + kstep; const char* b3 = b2 + kstep;
      if (last && has_next) S.a_ready(nxt);
      PG8_LDB(B0, 0, 0); PG8_SCHED; PG8_LDA(At, 0, 0); PG8_STAGE(PG8_SA(1, 1), a1 + hstep, voffA);
      PG8_WAIT_L(8); PG8_BAR; PG8_WAIT_L(0); PG8_MMA(0, 0, At, B0); PG8_BAR; PG8_SCHED;
      PG8_LDB(B1, 0, 1); PG8_STAGE(PG8_SB(0, 0), b2, voffB);
      PG8_BAR; PG8_WAIT_L(0); PG8_MMA(0, 1, At, B1); PG8_BAR;
      PG8_LDA(At, 0, 1); PG8_STAGE(PG8_SA(0, 0), a2, voffA);
      PG8_BAR; PG8_WAIT_L(0); PG8_MMA(1, 0, At, B0); PG8_BAR; PG8_SCHED;
      PG8_STAGE(PG8_SB(0, 1), b2 + hstep, voffB);
      PG8_WAIT_V(6); PG8_BAR; PG8_MMA(1, 1, At, B1); PG8_BAR;
      PG8_LDB(B0, 1, 0); PG8_SCHED; PG8_LDA(At, 1, 0); PG8_STAGE(PG8_SA(0, 1), a2 + hstep, voffA);
      PG8_WAIT_L(8); PG8_BAR; PG8_WAIT_L(0); PG8_MMA(0, 0, At, B0); PG8_BAR; PG8_SCHED;
      PG8_LDB(B1, 1, 1); PG8_STAGE(PG8_SB(1, 0), b3, voffB);
      PG8_BAR; PG8_WAIT_L(0); PG8_MMA(0, 1, At, B1); PG8_BAR;
      PG8_LDA(At, 1, 1); PG8_STAGE(PG8_SA(1, 0), a3, voffA);
      PG8_BAR; PG8_WAIT_L(0); PG8_MMA(1, 0, At, B0); PG8_BAR; PG8_SCHED;
      PG8_STAGE(PG8_SB(1, 1), b3 + hstep, voffB);
      PG8_WAIT_V(6); PG8_BAR; PG8_MMA(1, 1, At, B1); PG8_BAR;
    }
    E(acc, cur, wr, wc, fr, fq); S.done(cur);
    if (!has_next) break;
#pragma unroll
    for (int a = 0; a < 2; ++a)
#pragma unroll
      for (int b = 0; b < 2; ++b)
#pragma unroll
        for (int m = 0; m < 4; ++m)
#pragma unroll
          for (int n = 0; n < 2; ++n) acc[a][b][m][n] = (f32x4){0.f, 0.f, 0.f, 0.f};
    cur = nxt; cA = nA; cB = nB; ++ui;
  }
  PG8_WAIT_V(0);
  if (wr == 0) PG8_BAR;
  PG8_BAR;
#undef PG8_SA
#undef PG8_SB
#undef PG8_STAGE
#undef PG8_LDA
#undef PG8_LDB
#undef PG8_MMA
#undef PG8_WAIT_V
#undef PG8_WAIT_L
#undef PG8_BAR
#undef PG8_SCHED
}
}
using pg8::Unit;
typedef f32x4 AccT[2][2][4][2];

struct EpiFfnIn {
  static constexpr bool PERM = true;
  const float* RSS; bf16_t* H;
  __device__ __forceinline__ void operator()(const AccT& acc, const Unit& u, int wr, int wc, int fr, int fq) const {
#pragma unroll
    for (int ai = 0; ai < 2; ++ai)
#pragma unroll
      for (int m = 0; m < 4; ++m) {
        const int row = u.pm * 256 + ai * 128 + wr * 64 + m * 16 + fr; const float rs = row_rstd(RSS, row);
        f32x4 h0, h1;
#pragma unroll
        for (int i = 0; i < 4; ++i) { h0[i] = fsilu(acc[ai][0][m][0][i] * rs) * (acc[ai][1][m][0][i] * rs); h1[i] = fsilu(acc[ai][0][m][1][i] * rs) * (acc[ai][1][m][1][i] * rs); }
        *(u32x4*)(H + (size_t)row * DFF + u.pn * 128 + wc * 32 + fq * 8) = pack8(h0, h1);
      }
  }
};
struct EpiRes {
  static constexpr bool PERM = true;
  float* X; bf16_t* XB; float* RSS; float s;
  __device__ __forceinline__ void operator()(const AccT& acc, const Unit& u, int wr, int wc, int fr, int fq) const {
#pragma unroll
    for (int ai = 0; ai < 2; ++ai)
#pragma unroll
      for (int m = 0; m < 4; ++m) {
        const int row = u.pm * 256 + ai * 128 + wr * 64 + m * 16 + fr; float ss = 0.f;
#pragma unroll
        for (int bj = 0; bj < 2; ++bj) {
          const int col = u.pn * 256 + bj * 128 + wc * 32 + fq * 8;
          float* xp = X + (size_t)row * DM + col;
          f32x4 y0 = *(const f32x4*)xp + acc[ai][bj][m][0] * s, y1 = *(const f32x4*)(xp + 4) + acc[ai][bj][m][1] * s;
          *(f32x4*)xp = y0; *(f32x4*)(xp + 4) = y1;
          *(u32x4*)(XB + (size_t)row * DM + col) = pack8(y0, y1);
#pragma unroll
          for (int i = 0; i < 4; ++i) ss += y0[i] * y0[i] + y1[i] * y1[i];
        }
        ss += __shfl_xor(ss, 16); ss += __shfl_xor(ss, 32);
        if (fq == 0) RSS[(size_t)row * 16 + u.pn * 4 + wc] = ss;
      }
  }
};
struct EpiM1 {
  static constexpr bool PERM = true;
  const float* RSS; const float2* TAB; bf16_t* Z; bf16_t* Q; bf16_t* Kb; bf16_t* V;
  __device__ __forceinline__ void operator()(const AccT& acc, const Unit& u, int wr, int wc, int fr, int fq) const {
    const int pn = u.pn;
    if (pn < 4 || pn >= 8) {
      bf16_t* dst = pn < 4 ? Z : V; const int cb = (pn < 4 ? pn : pn - 8) * 256;
#pragma unroll
      for (int ai = 0; ai < 2; ++ai)
#pragma unroll
        for (int m = 0; m < 4; ++m) {
          const int row = u.pm * 256 + ai * 128 + wr * 64 + m * 16 + fr; const float rs = row_rstd(RSS, row);
#pragma unroll
          for (int bj = 0; bj < 2; ++bj)
            *(u32x4*)(dst + (size_t)row * 1024 + cb + bj * 128 + wc * 32 + fq * 8) = pack8(acc[ai][bj][m][0] * rs, acc[ai][bj][m][1] * rs);
        }
    } else {
      bf16_t* dst = pn < 6 ? Q : Kb; const int head = 2 * (pn < 6 ? pn - 4 : pn - 6) + (wc >> 1); const int d0 = 32 * (wc & 1) + 8 * fq;
#pragma unroll
      for (int ai = 0; ai < 2; ++ai)
#pragma unroll
        for (int m = 0; m < 4; ++m) {
          const int row = u.pm * 256 + ai * 128 + wr * 64 + m * 16 + fr; const float rs = row_rstd(RSS, row);
          const int spos = row < 16384 ? (row & 2047) : row - 16384;
          const f32x4* tp = (const f32x4*)(TAB + (size_t)spos * 64 + d0);
          f32x4 t0 = tp[0], t1 = tp[1], t2 = tp[2], t3 = tp[3];
          f32x4 x1a = acc[ai][0][m][0] * rs, x1b = acc[ai][0][m][1] * rs, x2a = acc[ai][1][m][0] * rs, x2b = acc[ai][1][m][1] * rs;
          f32x4 ca = {t0[0], t0[2], t1[0], t1[2]}, sa = {t0[1], t0[3], t1[1], t1[3]}, cb2 = {t2[0], t2[2], t3[0], t3[2]}, sb = {t2[1], t2[3], t3[1], t3[3]};
          f32x4 o1a = x1a * ca - x2a * sa, o1b = x1b * cb2 - x2b * sb, o2a = x2a * ca + x1a * sa, o2b = x2b * cb2 + x1b * sb;
          bf16_t* op = dst + (size_t)row * 512 + head * 128 + d0;
          *(u32x4*)op = pack8(o1a, o1b); *(u32x4*)(op + 64) = pack8(o2a, o2b);
        }
    }
  }
};
struct EpiM2 {
  static constexpr bool PERM = true;
  const float* RSS; bf16_t* YN; bf16_t* GATES;
  __device__ __forceinline__ void operator()(const AccT& acc, const Unit& u, int wr, int wc, int fr, int fq) const {
    const int pn = u.pn;
#pragma unroll
    for (int ai = 0; ai < 2; ++ai)
#pragma unroll
      for (int m = 0; m < 4; ++m) {
        const int row = u.pm * 256 + ai * 128 + wr * 64 + m * 16 + fr; const float rs = row_rstd(RSS, row);
#pragma unroll
        for (int bj = 0; bj < 2; ++bj) {
          f32x4 a = acc[ai][bj][m][0] * rs, b = acc[ai][bj][m][1] * rs;
          if (pn < 4) {
            bf16_t* p = YN + (size_t)row * 1024 + pn * 256 + bj * 128 + wc * 32 + fq * 8; u32x4 y = *(const u32x4*)p;
#pragma unroll
            for (int i = 0; i < 2; ++i) { a[2 * i] = fsilu(a[2 * i]) * bf_lo(y[i]); a[2 * i + 1] = fsilu(a[2 * i + 1]) * bf_hi(y[i]); b[2 * i] = fsilu(b[2 * i]) * bf_lo(y[2 + i]); b[2 * i + 1] = fsilu(b[2 * i + 1]) * bf_hi(y[2 + i]); }
            *(u32x4*)p = pack8(a, b);
          } else {
#pragma unroll
            for (int i = 0; i < 4; ++i) { a[i] = fsigmoid(a[i]); b[i] = fsigmoid(b[i]); }
            *(u32x4*)(GATES + (size_t)row * 2048 + (pn - 4) * 256 + bj * 128 + wc * 32 + fq * 8) = pack8(a, b);
          }
        }
      }
  }
};
template <int MODE> struct EpiComb {
  static constexpr bool PERM = true;
  const bf16_t* GATES; bf16_t* U;
  __device__ __forceinline__ void operator()(const AccT& acc, const Unit& u, int wr, int wc, int fr, int fq) const {
#pragma unroll
    for (int ai = 0; ai < 2; ++ai)
#pragma unroll
      for (int m = 0; m < 4; ++m) {
        const int row = u.pm * 256 + ai * 128 + wr * 64 + m * 16 + fr;
#pragma unroll
        for (int bj = 0; bj < 2; ++bj) {
          const int col = u.pn * 256 + bj * 128 + wc * 32 + fq * 8;
          u32x4 gg = *(const u32x4*)(GATES + (size_t)row * 2048 + MODE * 1024 + col);
          f32x4 a = acc[ai][bj][m][0], b = acc[ai][bj][m][1];
#pragma unroll
          for (int i = 0; i < 2; ++i) { a[2 * i] *= bf_lo(gg[i]); a[2 * i + 1] *= bf_hi(gg[i]); b[2 * i] *= bf_lo(gg[2 + i]); b[2 * i + 1] *= bf_hi(gg[2 + i]); }
          bf16_t* p = U + (size_t)row * 1024 + col;
          if (MODE == 1) { u32x4 y = *(const u32x4*)p;
#pragma unroll
            for (int i = 0; i < 2; ++i) { a[2 * i] += bf_lo(y[i]); a[2 * i + 1] += bf_hi(y[i]); b[2 * i] += bf_lo(y[2 + i]); b[2 * i + 1] += bf_hi(y[2 + i]); } }
          *(u32x4*)p = pack8(a, b);
        }
      }
  }
};
template <bool USE_RS> struct EpiPlain {
  static constexpr bool PERM = true;
  const float* RSS; bf16_t* O; int ldo; float s;
  __device__ __forceinline__ void operator()(const AccT& acc, const Unit& u, int wr, int wc, int fr, int fq) const {
#pragma unroll
    for (int ai = 0; ai < 2; ++ai)
#pragma unroll
      for (int m = 0; m < 4; ++m) {
        const int row = u.pm * 256 + ai * 128 + wr * 64 + m * 16 + fr; const float rs = USE_RS ? row_rstd(RSS, row) * s : s;
#pragma unroll
        for (int bj = 0; bj < 2; ++bj)
          *(u32x4*)(O + (size_t)row * ldo + u.pn * 256 + bj * 128 + wc * 32 + fq * 8) = pack8(acc[ai][bj][m][0] * rs, acc[ai][bj][m][1] * rs);
      }
  }
};

template <class Epi> __device__ __forceinline__ void run_gemm(LAS unsigned char* lds, const bf16_t* A, const bf16_t* Bt, int M, int N, int K, const Epi& E) {
  pg8::Gemm g{A, Bt, M, N, K}; pg8::StaticOrder S; S.init(M, N, gridDim.x, blockIdx.x);
  pg8::gemm_phase<Epi, pg8::StaticOrder>(lds, g, S, E);
  __syncthreads();
}

__device__ void prep_tiles(const float* __restrict__ src, int ld, bf16_t* __restrict__ dst, int K, int Ndst, const float* __restrict__ gain, float scale,
                           int maptype, int mapbase, int& tbase, float* lt) {
  const int tid = opaque_tid(), G = gridDim.x;
  const int nkt = K >> 6, ntiles = (Ndst >> 6) * nkt;
  int start = (int)blockIdx.x - (tbase % G); if (start < 0) start += G;
  for (int t = start; t < ntiles; t += G) {
    const int nt = t / nkt, kt = t - nt * nkt, n0 = nt << 6, k0 = kt << 6;
    int sc0;
    if (maptype == 0) sc0 = mapbase + n0;
    else if (maptype == 1) { const int pn = n0 >> 8, h = (n0 >> 7) & 1, j = n0 & 127; sc0 = h * DFF + pn * 128 + j; }
    else { const int tt = n0 >> 8, c = n0 & 255, bj = c >> 7, cc = c & 127; sc0 = mapbase + (2 * tt + (cc >> 6)) * 128 + bj * 64 + (cc & 63); }
#pragma unroll
    for (int it = 0; it < 2; ++it) {
      const int idx = tid + it * 512, k = idx >> 4, n4 = idx & 15;
      const f32x4 v = *(const f32x4*)(src + (size_t)(k0 + k) * ld + sc0 + n4 * 4);
      const float g = scale * (gain ? gain[k0 + k] : 1.f);
      float* p = lt + k * 65 + n4 * 4; p[0] = v[0] * g; p[1] = v[1] * g; p[2] = v[2] * g; p[3] = v[3] * g;
    }
    __syncthreads();
    { const int n = tid >> 3, kc = (tid & 7) << 3; f32x4 a, b;
#pragma unroll
      for (int j = 0; j < 4; ++j) { a[j] = lt[(kc + j) * 65 + n]; b[j] = lt[(kc + 4 + j) * 65 + n]; }
      *(u32x4*)(dst + (size_t)(n0 + n) * K + k0 + kc) = pack8(a, b); }
    __syncthreads();
  }
  tbase += ntiles;
}
__device__ void prep_zfold(const float* __restrict__ wmix  , const float* __restrict__ gain, bf16_t* __restrict__ WM1, int& tbase, float* lt) {
  const int tid = opaque_tid(), G = gridDim.x;
  float* cosT = lt + 16 * 129; float* sinT = cosT + 128;
  int start = (int)blockIdx.x - (tbase % G); if (start < 0) start += G;
  for (int t = start; t < 256; t += G) {
    const int grp = t >> 6, k0 = (t & 63) << 4;
    { const int k = tid >> 5, c4 = tid & 31; const f32x4 v = *(const f32x4*)(wmix + (size_t)(k0 + k) * 5632 + grp * 128 + c4 * 4);
      float* p = lt + k * 129 + c4 * 4; p[0] = v[0]; p[1] = v[1]; p[2] = v[2]; p[3] = v[3]; }
    if (tid < 128) { cosT[tid] = __builtin_amdgcn_cosf((float)tid * (1.f / 128.f)); sinT[tid] = __builtin_amdgcn_sinf((float)tid * (1.f / 128.f)); }
    __syncthreads();
    { const int nl = tid >> 1, ri = nl >> 7, cc = nl & 127, kh = (tid & 1) << 3;
      float a0 = 0.f, a1 = 0.f, a2 = 0.f, a3 = 0.f, a4 = 0.f, a5 = 0.f, a6 = 0.f, a7 = 0.f;
      const float* lp = lt + kh * 129;
      for (int c = 0; c < 128; ++c) {
        const int idx = (c * cc) & 127; const float w = ri ? -sinT[idx] : cosT[idx];
        a0 += lp[c] * w; a1 += lp[129 + c] * w; a2 += lp[2 * 129 + c] * w; a3 += lp[3 * 129 + c] * w;
        a4 += lp[4 * 129 + c] * w; a5 += lp[5 * 129 + c] * w; a6 += lp[6 * 129 + c] * w; a7 += lp[7 * 129 + c] * w;
      }
      const float sc = 0.08838834764831845f; const float* gp = gain + k0 + kh;
      f32x4 o0 = {a0 * sc * gp[0], a1 * sc * gp[1], a2 * sc * gp[2], a3 * sc * gp[3]}, o1 = {a4 * sc * gp[4], a5 * sc * gp[5], a6 * sc * gp[6], a7 * sc * gp[7]};
      *(u32x4*)(WM1 + (size_t)(ri * 512 + grp * 128 + cc) * 1024 + k0 + kh) = pack8(o0, o1); }
    __syncthreads();
  }
  tbase += 256;
}

template <int STAGE>
__device__ void dft_item(const bf16_t* __restrict__ src, bf16_t* __restrict__ dst, const bf16_t* __restrict__ Ct, const bf16_t* __restrict__ St,
                         int N, int lgN, int rowbase, int j, int chblk, int S, int N1, int N2, LAS unsigned char* lds) {
  const int tid = opaque_tid(), w = tid >> 6, l = tid & 63;
  const int CB = 8192 >> lgN, stride = CB * 4 + 64;
  const int lgcpr = 11 - lgN, cpr = 1 << lgcpr;
#pragma unroll
  for (int it = 0; it < 4; ++it) {
    const int q = tid + it * 512, n = q >> lgcpr, cq = q & (cpr - 1), part = cq >> (lgcpr - 1), cc = cq & ((cpr >> 1) - 1);
    const int irow = STAGE == 1 ? rowbase + N2 * n + j : rowbase + j * N2 + n;
    const u32x4 v = *(const u32x4*)(src + (size_t)irow * 1024 + part * 512 + chblk * CB + cc * 8);
    *(LAS u32x4*)(lds + n * stride + (part * CB + cc * 8) * 2) = v;
  }
  __syncthreads();
  const int kts = N >> 5, kt = w & (kts - 1), chsub = w >> (lgN - 5);
  const int i16 = l & 15, q4 = i16 >> 2, p4 = i16 & 3, G1 = (l >> 4) & 1, h = l >> 5;
  const unsigned colre = (unsigned)(chsub * 32 + 16 * G1 + 4 * p4) * 2u, colim = colre + (unsigned)CB * 2u;
  const int kout = kt * 32 + (l & 31);
  f32x16 a0 = {}, a1 = {}, a2 = {};
  const int nks = N >> 4;
  for (int ks = 0; ks < nks; ++ks) {
    const unsigned rlo = (unsigned)(16 * ks + 8 * h + q4) * stride, rhi = rlo + 4u * stride;
    const bf16x8 Ar = tr_frag(lds, rlo + colre, rhi + colre), Ai = tr_frag(lds, rlo + colim, rhi + colim);
    const bf16x8 Bc = *(const bf16x8*)(Ct + kout * N + 16 * ks + 8 * h), Bs = *(const bf16x8*)(St + kout * N + 16 * ks + 8 * h);
    a0 = mfma32(Ar, Bc, a0); a0 = mfma32(Ai, Bs, a0);
    if (STAGE == 1) { a1 = mfma32(Ai, Bc, a1); a2 = mfma32(Ar, Bs, a2); }
  }
  const int chb = chblk * CB + chsub * 32 + 4 * h;
  if (STAGE == 1) {
    const int mm = (j * kout) & (S - 1); const float fr = (float)mm / (float)S;
    const float c = __builtin_amdgcn_cosf(fr), s = __builtin_amdgcn_sinf(fr);
    const size_t orow = (size_t)(rowbase + kout * N2 + j) * 1024;
#pragma unroll
    for (int g = 0; g < 4; ++g) {
      float re[4], im[4];
#pragma unroll
      for (int i = 0; i < 4; ++i) { const float yr = a0[4 * g + i], yi = a1[4 * g + i] - a2[4 * g + i]; re[i] = yr * c + yi * s; im[i] = yi * c - yr * s; }
      *(u32x2*)(dst + orow + chb + 8 * g) = pack4(re[0], re[1], re[2], re[3]);
      *(u32x2*)(dst + orow + 512 + chb + 8 * g) = pack4(im[0], im[1], im[2], im[3]);
    }
  } else {
    const size_t orow = (size_t)(rowbase + j + N1 * kout) * 512;
#pragma unroll
    for (int g = 0; g < 4; ++g) *(u32x2*)(dst + orow + chb + 8 * g) = pack4(a0[4 * g], a0[4 * g + 1], a0[4 * g + 2], a0[4 * g + 3]);
  }
  __syncthreads();
}
template <int STAGE>
__device__ void dft_phase(const bf16_t* src, bf16_t* dst, const bf16_t* DT, LAS unsigned char* lds) {
  for (int it = blockIdx.x; it < 2048; it += gridDim.x) {
    if (it < 1024) dft_item<STAGE>(src, dst, DT + DT_C128, DT + DT_S128, 128, 7, 16384, it >> 3, it & 7, 16384, 128, 128, lds);
    else {
      const int r = it - 1024, b = r >> 7, rr = r & 127;
      if (STAGE == 1) dft_item<STAGE>(src, dst, DT + DT_C32, DT + DT_S32, 32, 5, b * 2048, rr >> 1, rr & 1, 2048, 32, 64, lds);
      else dft_item<STAGE>(src, dst, DT + DT_C64, DT + DT_S64, 64, 6, b * 2048, rr >> 2, rr & 3, 2048, 32, 64, lds);
    }
  }
}

__device__ void ret_state_item(const bf16_t* __restrict__ Kb, const bf16_t* __restrict__ Vb, bf16_t* __restrict__ STf, bf16_t* __restrict__ STb,
                               int cidx, int head, float lgf2, float lgb2, LAS unsigned char* lds) {
  const int tid = opaque_tid(), w = tid >> 6, l = tid & 63; const int row0 = cidx * 128;
  constexpr unsigned VS = 576, KS = 320, OKF = 73728, OKB = 114688;
#pragma unroll
  for (int it = 0; it < 8; ++it) { const int q = tid + it * 512, j = q >> 5, c = q & 31;
    *(LAS u32x4*)(lds + j * VS + c * 16) = *(const u32x4*)(Vb + (size_t)(row0 + j) * 1024 + head * 256 + c * 8); }
#pragma unroll
  for (int it = 0; it < 4; ++it) { const int q = tid + it * 512, j = q >> 4, c = q & 15;
    const u32x4 v = *(const u32x4*)(Kb + (size_t)(row0 + j) * 512 + head * 128 + c * 8);
    const float zf = __builtin_amdgcn_exp2f(lgf2 * (float)(127 - j)), zb = __builtin_amdgcn_exp2f(lgb2 * (float)j);
    u32x4 of, ob;
#pragma unroll
    for (int i = 0; i < 4; ++i) { const float a = bf_lo(v[i]), b = bf_hi(v[i]); of[i] = cvt_pk_bf16(a * zf, b * zf); ob[i] = cvt_pk_bf16(a * zb, b * zb); }
    *(LAS u32x4*)(lds + OKF + j * KS + c * 16) = of; *(LAS u32x4*)(lds + OKB + j * KS + c * 16) = ob; }
  __syncthreads();
  const int i16 = l & 15, q4 = i16 >> 2, p4 = i16 & 3, G1 = (l >> 4) & 1, h = l >> 5;
  const unsigned cofs = (unsigned)(16 * G1 + 4 * p4) * 2u;
  f32x16 af[4], ab[4];
#pragma unroll
  for (int i = 0; i < 4; ++i) { af[i] = (f32x16){}; ab[i] = (f32x16){}; }
  for (int ks = 0; ks < 8; ++ks) {
    const unsigned r = (unsigned)(16 * ks + 8 * h + q4);
    const bf16x8 Bv = tr_frag(lds, r * VS + w * 64 + cofs, (r + 4) * VS + w * 64 + cofs);
#pragma unroll
    for (int dt = 0; dt < 4; ++dt) {
      const bf16x8 Af = tr_frag(lds, OKF + r * KS + dt * 64 + cofs, OKF + (r + 4) * KS + dt * 64 + cofs);
      const bf16x8 Ab = tr_frag(lds, OKB + r * KS + dt * 64 + cofs, OKB + (r + 4) * KS + dt * 64 + cofs);
      af[dt] = mfma32(Af, Bv, af[dt]); ab[dt] = mfma32(Ab, Bv, ab[dt]);
    }
  }
  const size_t ob = ((size_t)(cidx * 4 + head) * 256 + w * 32 + (l & 31)) * 128 + 4 * h;
#pragma unroll
  for (int dt = 0; dt < 4; ++dt)
#pragma unroll
    for (int g = 0; g < 4; ++g) {
      *(u32x2*)(STf + ob + dt * 32 + 8 * g) = pack4(af[dt][4 * g], af[dt][4 * g + 1], af[dt][4 * g + 2], af[dt][4 * g + 3]);
      *(u32x2*)(STb + ob + dt * 32 + 8 * g) = pack4(ab[dt][4 * g], ab[dt][4 * g + 1], ab[dt][4 * g + 2], ab[dt][4 * g + 3]);
    }
  __syncthreads();
}
__device__ void ret_scan_seq(bf16_t* __restrict__ ST, int c0, int nch, int sub  , float lg, bool bwd) {
  const float g = expf(lg * 128.f);
  bf16_t* base = ST + (size_t)c0 * 131072 + (size_t)sub * 2048 + opaque_tid() * 4;
  float s0 = 0.f, s1 = 0.f, s2 = 0.f, s3 = 0.f;
  for (int cb = 0; cb < nch; cb += 8) {
    u32x2 u[8];
#pragma unroll
    for (int i = 0; i < 8; ++i) { const int c = bwd ? nch - 1 - (cb + i) : cb + i; u[i] = *(const u32x2*)(base + (size_t)c * 131072); }
#pragma unroll
    for (int i = 0; i < 8; ++i) { const int c = bwd ? nch - 1 - (cb + i) : cb + i;
      *(u32x2*)(base + (size_t)c * 131072) = pack4(s0, s1, s2, s3);
      s0 = g * s0 + bf_lo(u[i][0]); s1 = g * s1 + bf_hi(u[i][0]); s2 = g * s2 + bf_lo(u[i][1]); s3 = g * s3 + bf_hi(u[i][1]); }
  }
}
__device__ void ret_out_item(const bf16_t* __restrict__ Qb, const bf16_t* __restrict__ Kb, bf16_t* Vb, const bf16_t* __restrict__ STf, const bf16_t* __restrict__ STb,
                             int cidx, int head, float lgf2, float lgb2, LAS unsigned char* lds) {
  const int tid = opaque_tid(), w = tid >> 6, l = tid & 63; const int row0 = cidx * 128;
  constexpr unsigned VS = 576, ORED = 73728;
#pragma unroll
  for (int it = 0; it < 8; ++it) { const int q = tid + it * 512, j = q >> 5, c = q & 31;
    *(LAS u32x4*)(lds + j * VS + c * 16) = *(const u32x4*)(Vb + (size_t)(row0 + j) * 1024 + head * 256 + c * 8); }
  __syncthreads();
  const int ib = w & 3, eh = w >> 2, il = l & 31, h = l >> 5;
  const int i16 = l & 15, q4 = i16 >> 2, p4 = i16 & 3, G1 = (l >> 4) & 1;
  const int iloc = ib * 32 + il;
  bf16x8 qf[8];
  { const bf16_t* qp = Qb + (size_t)(row0 + iloc) * 512 + head * 128 + 8 * h;
#pragma unroll
    for (int ks = 0; ks < 8; ++ks) qf[ks] = *(const bf16x8*)(qp + 16 * ks); }
  bf16x8 pf[4][2];
#pragma unroll
  for (int jt = 0; jt < 4; ++jt) {
    f32x16 a = {};
    const bf16_t* kp = Kb + (size_t)(row0 + jt * 32 + il) * 512 + head * 128 + 8 * h;
#pragma unroll
    for (int ks = 0; ks < 8; ++ks) a = mfma32(*(const bf16x8*)(kp + 16 * ks), qf[ks], a);
    u32x4 p0, p1;
#pragma unroll
    for (int r = 0; r < 16; r += 2) {
      float v[2];
#pragma unroll
      for (int e = 0; e < 2; ++e) { const int jl = jt * 32 + ((r + e) & 3) + 8 * ((r + e) >> 2) + 4 * h; const int dd = iloc - jl;
        const float dec = dd >= 0 ? __builtin_amdgcn_exp2f(lgf2 * (float)dd) : __builtin_amdgcn_exp2f(lgb2 * (float)(-dd)); v[e] = a[r + e] * dec; }
      const unsigned pk = cvt_pk_bf16(v[0], v[1]);
      if (r < 8) p0[r >> 1] = pk; else p1[(r - 8) >> 1] = pk;
    }
    pf[jt][0] = (bf16x8)p0; pf[jt][1] = (bf16x8)p1;
  }
  f32x16 acc[4];
#pragma unroll
  for (int i = 0; i < 4; ++i) acc[i] = (f32x16){};
  const unsigned cofs = (unsigned)(eh * 128 + 16 * G1 + 4 * p4) * 2u;
#pragma unroll
  for (int jt = 0; jt < 4; ++jt)
#pragma unroll
    for (int s = 0; s < 2; ++s) {
      const unsigned r = (unsigned)(jt * 32 + 16 * s + 4 * h + q4);
#pragma unroll
      for (int et = 0; et < 4; ++et) acc[et] = mfma32(tr_frag(lds, r * VS + et * 64 + cofs, (r + 8) * VS + et * 64 + cofs), pf[jt][s], acc[et]);
    }
#pragma unroll
  for (int dir = 0; dir < 2; ++dir) {
    const float xi = dir ? __builtin_amdgcn_exp2f(lgb2 * (float)(128 - iloc)) : __builtin_amdgcn_exp2f(lgf2 * (float)(iloc + 1));
    const bf16_t* sp = (dir ? STb : STf) + ((size_t)(cidx * 4 + head) * 256 + eh * 128 + il) * 128 + 8 * h;
#pragma unroll
    for (int ks = 0; ks < 8; ++ks) {
      const bf16x8 sq = scale_frag(qf[ks], xi);
#pragma unroll
      for (int et = 0; et < 4; ++et) acc[et] = mfma32(*(const bf16x8*)(sp + (size_t)et * 32 * 128 + 16 * ks), sq, acc[et]);
    }
  }
  float ss = 0.f;
#pragma unroll
  for (int et = 0; et < 4; ++et)
#pragma unroll
    for (int r = 0; r < 16; ++r) ss += acc[et][r] * acc[et][r];
  ss += __shfl_xor(ss, 32);
  LAS float* red = (LAS float*)(lds + ORED);
  if (h == 0) red[eh * 128 + iloc] = ss;
  __syncthreads();
  const float rn = rsqrtf((red[iloc] + red[128 + iloc]) * (1.f / 256.f) + 1e-6f);
  bf16_t* op = Vb + (size_t)(row0 + iloc) * 1024 + head * 256 + eh * 128 + 4 * h;
#pragma unroll
  for (int et = 0; et < 4; ++et)
#pragma unroll
    for (int g = 0; g < 4; ++g)
      *(u32x2*)(op + et * 32 + 8 * g) = pack4(acc[et][4 * g] * rn, acc[et][4 * g + 1] * rn, acc[et][4 * g + 2] * rn, acc[et][4 * g + 3] * rn);
  __syncthreads();
}

__device__ void attn_item(const bf16_t* __restrict__ QX, const bf16_t* __restrict__ KV, bf16_t* __restrict__ O, int tt, int head, LAS unsigned char* lds) {
  const int tid = opaque_tid(), w = tid >> 6, l = tid & 63; const int row0 = tt * 256; const int b = tt < 64 ? (tt >> 3) : 8; const int mrow0 = b * 256;
  constexpr unsigned KS = 528, VS = 576;
#pragma unroll 4
  for (int it = 0; it < 16; ++it) { const int q = tid + it * 512, m = q >> 5, c = q & 31;
    *(LAS u32x4*)(lds + m * KS + c * 16) = *(const u32x4*)(KV + (size_t)(mrow0 + m) * 2048 + head * 256 + c * 8); }
  __syncthreads();
  const int il = l & 31, h = l >> 5, i16 = l & 15, q4 = i16 >> 2, p4 = i16 & 3, G1 = (l >> 4) & 1;
  const int row = row0 + w * 32 + il;
  bf16x8 pf[8][2];
  float mxp = -3.0e38f, sum = 0.f;
  const bf16_t* qp = QX + (size_t)row * 1024 + head * 256 + 8 * h;
#pragma unroll
  for (int hf = 0; hf < 2; ++hf) {
    f32x16 sc[4];
#pragma unroll
    for (int i = 0; i < 4; ++i) sc[i] = (f32x16){};
#pragma unroll 2
    for (int ks = 0; ks < 16; ++ks) {
      const bf16x8 B = *(const bf16x8*)(qp + 16 * ks);
#pragma unroll
      for (int mt = 0; mt < 4; ++mt) sc[mt] = mfma32(*(const LAS bf16x8*)(lds + ((hf * 4 + mt) * 32 + il) * KS + (16 * ks + 8 * h) * 2), B, sc[mt]);
    }
    float mx = mxp;
#pragma unroll
    for (int mt = 0; mt < 4; ++mt)
#pragma unroll
      for (int r = 0; r < 16; ++r) mx = fmaxf(mx, sc[mt][r]);
    mx = fmaxf(mx, __shfl_xor(mx, 32));
    if (hf == 1) { const float f = __builtin_amdgcn_exp2f((mxp - mx) * 1.4426950408889634f); sum *= f;
#pragma unroll
      for (int mt = 0; mt < 4; ++mt) { pf[mt][0] = scale_frag(pf[mt][0], f); pf[mt][1] = scale_frag(pf[mt][1], f); } }
#pragma unroll
    for (int mt = 0; mt < 4; ++mt) {
      u32x4 p0, p1;
#pragma unroll
      for (int r = 0; r < 16; r += 2) {
        const float e0 = __builtin_amdgcn_exp2f((sc[mt][r] - mx) * 1.4426950408889634f), e1 = __builtin_amdgcn_exp2f((sc[mt][r + 1] - mx) * 1.4426950408889634f);
        sum += e0 + e1; const unsigned pk = cvt_pk_bf16(e0, e1);
        if (r < 8) p0[r >> 1] = pk; else p1[(r - 8) >> 1] = pk;
      }
      pf[hf * 4 + mt][0] = (bf16x8)p0; pf[hf * 4 + mt][1] = (bf16x8)p1;
    }
    mxp = mx;
  }
  sum += __shfl_xor(sum, 32);
  const float inv = __builtin_amdgcn_rcpf(sum);
  __builtin_amdgcn_sched_barrier(0);
  __syncthreads();
  __builtin_amdgcn_sched_barrier(0);
#pragma unroll 4
  for (int it = 0; it < 16; ++it) { const int q = tid + it * 512, m = q >> 5, c = q & 31;
    *(LAS u32x4*)(lds + m * VS + c * 16) = *(const u32x4*)(KV + (size_t)(mrow0 + m) * 2048 + 1024 + head * 256 + c * 8); }
  __syncthreads();
  __builtin_amdgcn_sched_barrier(0);
#pragma unroll 1
  for (int half = 0; half < 2; ++half) {
    f32x16 acc[4];
#pragma unroll
    for (int i = 0; i < 4; ++i) acc[i] = (f32x16){};
    const unsigned cofs = (unsigned)(half * 128 + 16 * G1 + 4 * p4) * 2u;
#pragma unroll
    for (int mt = 0; mt < 8; ++mt)
#pragma unroll
      for (int s = 0; s < 2; ++s) {
        const unsigned r = (unsigned)(mt * 32 + 16 * s + 4 * h + q4);
#pragma unroll
        for (int et = 0; et < 4; ++et) acc[et] = mfma32(tr_frag(lds, r * VS + et * 64 + cofs, (r + 8) * VS + et * 64 + cofs), pf[mt][s], acc[et]);
      }
    bf16_t* op = O + (size_t)row * 1024 + head * 256 + half * 128 + 4 * h;
#pragma unroll
    for (int et = 0; et < 4; ++et)
#pragma unroll
      for (int g = 0; g < 4; ++g)
        *(u32x2*)(op + et * 32 + 8 * g) = pack4(acc[et][4 * g] * inv, acc[et][4 * g + 1] * inv, acc[et][4 * g + 2] * inv, acc[et][4 * g + 3] * inv);
  }
  __syncthreads();
}

__device__ __forceinline__ float sel4(const float (&a)[4], int i) { return i == 0 ? a[0] : i == 1 ? a[1] : i == 2 ? a[2] : a[3]; }

__global__ void __launch_bounds__(512, 2) mega(Params p) {
  cg::grid_group grid = cg::this_grid();
  extern __shared__ __attribute__((aligned(16))) unsigned char smem_raw[];
  LAS unsigned char* lds = (LAS unsigned char*)smem_raw;
  float* ltf = (float*)smem_raw;
  const int tid = opaque_tid(), G = gridDim.x, wv = tid >> 6, lane = tid & 63;
  unsigned char* ws = p.ws;
  float2* TAB = (float2*)(ws + OFF_TAB); bf16_t* DT = (bf16_t*)(ws + OFF_DFT); bf16_t* MEMB = (bf16_t*)(ws + OFF_MEMB);
  float* RSS = (float*)(ws + OFF_RSS); bf16_t* XB = (bf16_t*)(ws + OFF_XB); bf16_t* WB = (bf16_t*)(ws + OFF_WB);
  bf16_t* RA = (bf16_t*)(ws + OFF_A); bf16_t* RS = (bf16_t*)(ws + OFF_S); bf16_t* RB = (bf16_t*)(ws + OFF_B);
  bf16_t* Zb = RA; bf16_t* Y1 = RA + 32 * MiB; bf16_t* GATES = RA; bf16_t* HID = RA; bf16_t* QX = RA; bf16_t* Ob = RA + 32 * MiB;
  bf16_t* STf = RS; bf16_t* STb = RS + 32 * MiB;
  bf16_t* Qb = RB; bf16_t* Kb = RB + 16 * MiB; bf16_t* Vb = RB + 32 * MiB; bf16_t* Fb = RB + 64 * MiB; bf16_t* Ub = RB; bf16_t* KVb = RB + 32 * MiB;
  float* X = p.X;

  for (int r = blockIdx.x * 8 + wv; r < T_TOK; r += G * 8) {
    const float* src = r < 16384 ? p.in[0] + (size_t)r * DM : p.in[1] + (size_t)(r - 16384) * DM;
    float ss = 0.f;
#pragma unroll
    for (int k = 0; k < 4; ++k) { const f32x4 v = *(const f32x4*)(src + k * 256 + lane * 4);
      *(f32x4*)(X + (size_t)r * DM + k * 256 + lane * 4) = v; *(u32x2*)(XB + (size_t)r * DM + k * 256 + lane * 4) = pack4(v[0], v[1], v[2], v[3]);
      ss += v[0] * v[0] + v[1] * v[1] + v[2] * v[2] + v[3] * v[3]; }
#pragma unroll
    for (int o = 32; o; o >>= 1) ss += __shfl_xor(ss, o);
    if (lane < 16) RSS[(size_t)r * 16 + lane] = lane == 0 ? ss : 0.f;
  }
  for (int r = blockIdx.x * 8 + wv; r < NMEMROWS; r += G * 8) {
    const float* src = r < 2048 ? p.in[2] + (size_t)r * DM : p.in[3] + (size_t)(r - 2048) * DM;
    f32x4 v0 = *(const f32x4*)(src + lane * 4), v1 = *(const f32x4*)(src + 256 + lane * 4), v2 = *(const f32x4*)(src + 512 + lane * 4), v3 = *(const f32x4*)(src + 768 + lane * 4);
    float ss = 0.f;
#pragma unroll
    for (int i = 0; i < 4; ++i) ss += v0[i] * v0[i] + v1[i] * v1[i] + v2[i] * v2[i] + v3[i] * v3[i];
#pragma unroll
    for (int o = 32; o; o >>= 1) ss += __shfl_xor(ss, o);
    const float rs = rsqrtf(ss * (1.f / 1024.f) + 1e-6f);
    bf16_t* mp = MEMB + (size_t)r * DM + lane * 4;
    *(u32x2*)(mp) = pack4(v0[0] * rs, v0[1] * rs, v0[2] * rs, v0[3] * rs); *(u32x2*)(mp + 256) = pack4(v1[0] * rs, v1[1] * rs, v1[2] * rs, v1[3] * rs);
    *(u32x2*)(mp + 512) = pack4(v2[0] * rs, v2[1] * rs, v2[2] * rs, v2[3] * rs); *(u32x2*)(mp + 768) = pack4(v3[0] * rs, v3[1] * rs, v3[2] * rs, v3[3] * rs);
  }
  for (int i = blockIdx.x * 512 + tid; i < 16384 * 64; i += G * 512) {
    const int s = i >> 6, d = i & 63;
    const float e = (float)d * 2.0f / 128.0f; const float inv = 1.0f / powf(10000.0f, e); const float ang = (float)s * inv;
    const double a = (double)ang * 0.15915494309189535; const double fr = a - rint(a);
    const float f = (float)fr;
    TAB[i] = make_float2(__builtin_amdgcn_cosf(f), __builtin_amdgcn_sinf(f));
  }
  for (int i = blockIdx.x * 512 + tid; i < 16384 + 4096 + 1024; i += G * 512) {
    int N, k, n, oc, os;
    if (i < 16384) { N = 128; k = i >> 7; n = i & 127; oc = DT_C128 + i; os = DT_S128 + i; }
    else if (i < 20480) { const int q = i - 16384; N = 64; k = q >> 6; n = q & 63; oc = DT_C64 + q; os = DT_S64 + q; }
    else { const int q = i - 20480; N = 32; k = q >> 5; n = q & 31; oc = DT_C32 + q; os = DT_S32 + q; }
    const float fr = (float)((k * n) & (N - 1)) / (float)N; const float sc = rsqrtf((float)N);
    const unsigned pk = cvt_pk_bf16(__builtin_amdgcn_cosf(fr) * sc, __builtin_amdgcn_sinf(fr) * sc);
    DT[oc] = (bf16_t)(pk & 0xffffu); DT[os] = (bf16_t)(pk >> 16);
  }

  for (int layer = 0; layer < 4; ++layer) {
    {
      int tb = 0;
      const float* g1 = p.in[4] + layer * DM; const float* gm = p.in[7] + layer * DM; const float* gx = p.in[14] + layer * DM;
      const float* gmem = p.in[15] + layer * DM; const float* g2 = p.in[19] + layer * DM;
      const float* wmix = p.in[8] + (size_t)layer * 1024 * 5632;
      prep_tiles(p.in[5] + (size_t)layer * 1024 * 5632, 5632, WB + W_1I, 1024, 5632, g1, 1.f, 1, 0, tb, ltf);
      prep_tiles(p.in[6] + (size_t)layer * DFF * 1024, 1024, WB + W_1O, DFF, 1024, nullptr, 1.f, 0, 0, tb, ltf);
      prep_zfold(wmix, gm, WB + W_M1, tb, ltf);
      prep_tiles(wmix, 5632, WB + W_M1 + (size_t)1024 * 1024, 1024, 512, gm, 1.f, 2, 512, tb, ltf);
      prep_tiles(wmix, 5632, WB + W_M1 + (size_t)1536 * 1024, 1024, 512, gm, 0.08838834764831845f, 2, 1024, tb, ltf);
      prep_tiles(wmix, 5632, WB + W_M1 + (size_t)2048 * 1024, 1024, 1024, gm, 1.f, 0, 1536, tb, ltf);
      prep_tiles(wmix, 5632, WB + W_M2, 1024, 3072, gm, 1.f, 0, 2560, tb, ltf);
      prep_tiles(p.in[9] + (size_t)layer * 512 * 1024, 1024, WB + W_F, 512, 1024, nullptr, 1.f, 0, 0, tb, ltf);
      prep_tiles(p.in[12] + (size_t)layer * 1024 * 1024, 1024, WB + W_R, 1024, 1024, nullptr, 1.f, 0, 0, tb, ltf);
      prep_tiles(p.in[13] + (size_t)layer * 1024 * 1024, 1024, WB + W_MO, 1024, 1024, nullptr, 1.f, 0, 0, tb, ltf);
      prep_tiles(p.in[16] + (size_t)layer * 1024 * 1024, 1024, WB + W_Q, 1024, 1024, gx, 1.f, 0, 0, tb, ltf);
      prep_tiles(p.in[17] + (size_t)layer * 1024 * 2048, 2048, WB + W_KV, 1024, 2048, gmem, 1.f, 0, 0, tb, ltf);
      prep_tiles(p.in[18] + (size_t)layer * 1024 * 1024, 1024, WB + W_O, 1024, 1024, nullptr, 1.f, 0, 0, tb, ltf);
      prep_tiles(p.in[20] + (size_t)layer * 1024 * 5632, 5632, WB + W_2I, 1024, 5632, g2, 1.f, 1, 0, tb, ltf);
      prep_tiles(p.in[21] + (size_t)layer * DFF * 1024, 1024, WB + W_2O, DFF, 1024, nullptr, 1.f, 0, 0, tb, ltf);
    }
    grid.sync();
    run_gemm(lds, XB, WB + W_1I, T_TOK, 5632, 1024, EpiFfnIn{RSS, HID});
    grid.sync();
    run_gemm(lds, HID, WB + W_1O, T_TOK, 1024, DFF, EpiRes{X, XB, RSS, 0.5f});
    grid.sync();
    run_gemm(lds, XB, WB + W_M1, T_TOK, 3072, 1024, EpiM1{RSS, TAB, Zb, Qb, Kb, Vb});
    grid.sync();
    float lgf2[4], lgb2[4], lgf[4], lgb[4];
#pragma unroll
    for (int hh = 0; hh < 4; ++hh) { lgf[hh] = log_sigmoid(p.in[10][layer * 4 + hh]); lgb[hh] = log_sigmoid(p.in[11][layer * 4 + hh]);
      lgf2[hh] = lgf[hh] * 1.4426950408889634f; lgb2[hh] = lgb[hh] * 1.4426950408889634f; }
    dft_phase<1>(Zb, Y1, DT, lds);
    for (int it = blockIdx.x; it < 1024; it += G) { const int hh = it & 3; ret_state_item(Kb, Vb, STf, STb, it >> 2, hh, sel4(lgf2, hh), sel4(lgb2, hh), lds); }
    grid.sync();
    dft_phase<2>(Y1, Fb, DT, lds);
    for (int it = blockIdx.x; it < 256; it += G) {
      if (it < 128) { const int dir = it >> 6, sub = it & 63, hh = sub >> 4; ret_scan_seq(dir ? STb : STf, 128, 128, sub, dir ? sel4(lgb, hh) : sel4(lgf, hh), dir); }
      else for (int k = 0; k < 8; ++k) { const int r = (it - 128) * 8 + k, b = r >> 7, dir = (r >> 6) & 1, sub = r & 63, hh = sub >> 4;
        ret_scan_seq(dir ? STb : STf, b * 16, 16, sub, dir ? sel4(lgb, hh) : sel4(lgf, hh), dir); }
    }
    grid.sync();
    for (int it = blockIdx.x; it < 1024; it += G) { const int hh = it & 3; ret_out_item(Qb, Kb, Vb, STf, STb, it >> 2, hh, sel4(lgf2, hh), sel4(lgb2, hh), lds); }
    grid.sync();
    run_gemm(lds, XB, WB + W_M2, T_TOK, 3072, 1024, EpiM2{RSS, Vb, GATES});
    grid.sync();
    run_gemm(lds, Fb, WB + W_F, T_TOK, 1024, 512, EpiComb<0>{GATES, Ub});
    run_gemm(lds, Vb, WB + W_R, T_TOK, 1024, 1024, EpiComb<1>{GATES, Ub});
    grid.sync();
    run_gemm(lds, Ub, WB + W_MO, T_TOK, 1024, 1024, EpiRes{X, XB, RSS, 1.0f});
    grid.sync();
    run_gemm(lds, XB, WB + W_Q, T_TOK, 1024, 1024, EpiPlain<true>{RSS, QX, 1024, 0.0625f});
    run_gemm(lds, MEMB, WB + W_KV, NMEMROWS, 2048, 1024, EpiPlain<false>{RSS, KVb, 2048, 1.0f});
    grid.sync();
    for (int it = blockIdx.x; it < 512; it += G) attn_item(QX, KVb, Ob, it >> 2, it & 3, lds);
    grid.sync();
    run_gemm(lds, Ob, WB + W_O, T_TOK, 1024, 1024, EpiRes{X, XB, RSS, 1.0f});
    grid.sync();
    run_gemm(lds, XB, WB + W_2I, T_TOK, 5632, 1024, EpiFfnIn{RSS, HID});
    grid.sync();
    run_gemm(lds, HID, WB + W_2O, T_TOK, 1024, DFF, EpiRes{X, XB, RSS, 0.5f});
    grid.sync();
  }
  const int tidf = opaque_tid(), wvf = tidf >> 6, lanef = tidf & 63;
  for (int r = blockIdx.x * 8 + wvf; r < T_TOK; r += G * 8) {
    const float rs = row_rstd(RSS, r);
#pragma unroll
    for (int k = 0; k < 4; ++k) { float* xp = X + (size_t)r * DM + k * 256 + lanef * 4; const f32x4 g = *(const f32x4*)(p.in[22] + k * 256 + lanef * 4);
      *(f32x4*)xp = *(const f32x4*)xp * rs * g; }
  }
}

extern "C" void kernel_launch(void* const* d_in, const int* in_sizes, int n_in, void* d_out, int out_size, void* d_ws, size_t ws_size, hipStream_t stream) {
  constexpr size_t kDynLds = 163840;
  static int grid_blocks = 0;
  if (!grid_blocks) {
    (void)hipFuncSetAttribute((const void*)mega, hipFuncAttributeMaxDynamicSharedMemorySize, (int)kDynLds);
    int dev = 0, cus = 0, per_cu = 0;
    (void)hipGetDevice(&dev);
    (void)hipDeviceGetAttribute(&cus, hipDeviceAttributeMultiprocessorCount, dev);
    (void)hipOccupancyMaxActiveBlocksPerMultiprocessor(&per_cu, mega, 512, kDynLds);
    grid_blocks = cus > 0 ? cus : 256;
    if (per_cu < 1) fprintf(stderr, "occupancy query returned %d\n", per_cu);
  }
  if (ws_size < WS_NEED) { fprintf(stderr, "workspace too small: %zu < %zu\n", ws_size, (size_t)WS_NEED); return; }
  Params p{};
  for (int i = 0; i < 23; ++i) p.in[i] = (const float*)d_in[i];
  p.X = (float*)d_out; p.ws = (unsigned char*)d_ws;
  void* args[] = {&p};
  hipError_t e = hipLaunchCooperativeKernel((void*)mega, dim3(grid_blocks), dim3(512), args, kDynLds, stream);
  if (e != hipSuccess) fprintf(stderr, "cooperative launch failed: %s (grid %d)\n", hipGetErrorString(e), grid_blocks);
}
```

```cpp
#include <hip/hip_runtime.h>
#include <hip/hip_cooperative_groups.h>
#include <cstdio>
namespace cg = cooperative_groups;

#define LAS __attribute__((address_space(3)))
typedef unsigned short bf16_t;
typedef short bf16x8 __attribute__((ext_vector_type(8)));
typedef short s16x4 __attribute__((ext_vector_type(4)));
typedef float f32x4 __attribute__((ext_vector_type(4)));
typedef float f32x16 __attribute__((ext_vector_type(16)));
typedef unsigned u32x4 __attribute__((ext_vector_type(4)));
typedef unsigned u32x2 __attribute__((ext_vector_type(2)));

constexpr int T_TOK = 32768, DM = 1024, DFF = 2816, NMEMROWS = 2304;
constexpr size_t MiB = 1048576;
constexpr size_t OFF_TAB = 0;
constexpr size_t OFF_DFT = 8 * MiB;
constexpr size_t OFF_MEMB = OFF_DFT + 256 * 1024;
constexpr size_t OFF_RSS = OFF_MEMB + 4718592;
constexpr size_t OFF_XB = OFF_RSS + 2 * MiB;
constexpr size_t OFF_WB = OFF_XB + 64 * MiB;
constexpr size_t OFF_A = OFF_WB + 58 * MiB;
constexpr size_t OFF_S = OFF_A + 128 * MiB;
constexpr size_t OFF_B = OFF_S + 128 * MiB;
constexpr size_t WS_NEED = OFF_B + 160 * MiB;
constexpr size_t W_1I = 0, W_1O = 5767168, W_M1 = 8650752, W_M2 = 11796480, W_F = 14942208, W_R = 15466496, W_MO = 16515072,
                 W_Q = 17563648, W_KV = 18612224, W_O = 20709376, W_2I = 21757952, W_2O = 27525120;
constexpr int DT_C128 = 0, DT_S128 = 16384, DT_C64 = 32768, DT_S64 = 36864, DT_C32 = 40960, DT_S32 = 41984;

struct Params {
  const float* in[23];
  float* X;
  unsigned char* ws;
};

__device__ __forceinline__ int opaque_tid() { int t = threadIdx.x; asm volatile("" : "+v"(t)); return t; }
typedef __bf16 bf16x2_t __attribute__((ext_vector_type(2)));
typedef float f32x2 __attribute__((ext_vector_type(2)));
__device__ __forceinline__ unsigned cvt_pk_bf16(float lo, float hi) { f32x2 v = {lo, hi}; bf16x2_t b = __builtin_convertvector(v, bf16x2_t); return __builtin_bit_cast(unsigned, b); }
__device__ __forceinline__ float bf_lo(unsigned u) { return __uint_as_float(u << 16); }
__device__ __forceinline__ float bf_hi(unsigned u) { return __uint_as_float(u & 0xffff0000u); }
__device__ __forceinline__ u32x4 pack8(f32x4 a, f32x4 b) { u32x4 o; o[0] = cvt_pk_bf16(a[0], a[1]); o[1] = cvt_pk_bf16(a[2], a[3]); o[2] = cvt_pk_bf16(b[0], b[1]); o[3] = cvt_pk_bf16(b[2], b[3]); return o; }
__device__ __forceinline__ u32x2 pack4(float a, float b, float c, float d) { u32x2 o; o[0] = cvt_pk_bf16(a, b); o[1] = cvt_pk_bf16(c, d); return o; }
__device__ __forceinline__ float fsigmoid(float x) { return __builtin_amdgcn_rcpf(1.f + __expf(-x)); }
__device__ __forceinline__ float fsilu(float x) { return x * fsigmoid(x); }
__device__ __forceinline__ float row_rstd(const float* RSS, int row) {
  const f32x4* p = (const f32x4*)(RSS + (size_t)row * 16); f32x4 a = p[0], b = p[1], c = p[2], d = p[3];
  float s = ((a[0] + a[1]) + (a[2] + a[3])) + ((b[0] + b[1]) + (b[2] + b[3])) + ((c[0] + c[1]) + (c[2] + c[3])) + ((d[0] + d[1]) + (d[2] + d[3]));
  return rsqrtf(s * (1.f / 1024.f) + 1e-6f);
}
__device__ __forceinline__ bf16x8 tr_frag(const LAS unsigned char* lds, unsigned off_lo, unsigned off_hi) {
  s16x4 a = __builtin_amdgcn_ds_read_tr16_b64_v4i16((LAS s16x4*)(lds + off_lo));
  s16x4 b = __builtin_amdgcn_ds_read_tr16_b64_v4i16((LAS s16x4*)(lds + off_hi));
  return __builtin_shufflevector(a, b, 0, 1, 2, 3, 4, 5, 6, 7);
}
__device__ __forceinline__ f32x16 mfma32(bf16x8 a, bf16x8 b, f32x16 c) { return __builtin_amdgcn_mfma_f32_32x32x16_bf16(a, b, c, 0, 0, 0); }
__device__ __forceinline__ float log_sigmoid(float x) { return fminf(x, 0.f) - log1pf(expf(-fabsf(x))); }
__device__ __forceinline__ bf16x8 scale_frag(bf16x8 q, float s) {
  u32x4 u = (u32x4)q; u32x4 o;
#pragma unroll
  for (int i = 0; i < 4; ++i) o[i] = cvt_pk_bf16(bf_lo(u[i]) * s, bf_hi(u[i]) * s);
  return (bf16x8)o;
}

namespace pg8 {
constexpr int BM = 256, BK = 64, HALF = 128, HTB = HALF * BK * 2, STAGE_BYTES = 8 * HTB, NXCD = 8, WGM = 8;
__device__ __forceinline__ int lds_byte(int r, int c) { const int st = (r >> 4) * 2 + (c >> 5), rr = r & 15, cc = c & 31, ob = rr * 64 + cc * 2; return st * 1024 + (ob ^ (((ob >> 9) & 1) << 5)); }
__device__ __forceinline__ void stage_rc(int b, int& R, int& C) { const int st = b / 1024, sb = b % 1024, swz = sb ^ (((sb >> 9) & 1) << 5); R = (st >> 1) * 16 + swz / 64; C = (st & 1) * 32 + (swz % 64) / 2; }
__device__ __forceinline__ int perm32(int rho) { const int n = rho >> 4, i = rho & 15; return 8 * (i >> 2) + 4 * n + (i & 3); }
struct Unit { int pm, pn; };
struct Gemm { const bf16_t* A; const bf16_t* Bt; int M, N, K; };
struct StaticOrder {
  int nM, nN, nwg, G, c;
  __device__ void init(int M, int N, int G_, int c_) { nM = M / BM; nN = N / BM; nwg = nM * nN; G = G_; c = c_; }
  __device__ bool next(int i, Unit& u) const {
    const long L = (long)i * G + c; if (L >= nwg) return false;
    int wgid = (int)L; { const int q = nwg / NXCD, r = nwg % NXCD, xcd = wgid % NXCD, off = wgid / NXCD; wgid = (xcd < r ? xcd * (q + 1) : r * (q + 1) + (xcd - r) * q) + off; }
    const int nig = WGM * nN, gid = wgid / nig, fm = gid * WGM, gsz = (nM - fm) < WGM ? (nM - fm) : WGM;
    u.pm = fm + ((wgid % nig) % gsz); u.pn = (wgid % nig) / gsz; return true;
  }
  __device__ __forceinline__ void a_ready(const Unit&) const {}
  __device__ __forceinline__ void done(const Unit&) const {}
};

template <class Epi, class Sched>
__device__ __forceinline__ void gemm_phase(LAS unsigned char* lds, const Gemm g, const Sched& S, const Epi& E) {
  const int tid = opaque_tid(), wid = __builtin_amdgcn_readfirstlane(tid >> 6), lane = tid & 63, wr = wid >> 2, wc = wid & 3, fr = lane & 15, fq = lane >> 4;
  const int K = g.K, nt = K / BK;
  unsigned voffA[2], voffB[2];
#pragma unroll
  for (int i = 0; i < 2; ++i) { int R, C; stage_rc(tid * 16 + i * 8192, R, C); const int Rb = Epi::PERM ? ((R & ~31) + perm32(R & 31)) : R;
    voffA[i] = (unsigned)(R * K + C) * 2u; voffB[i] = (unsigned)(Rb * K + C) * 2u; }
  const size_t kstep = (size_t)(BK * 2);
  const size_t hstep = (size_t)HALF * K * 2;
  const size_t tstep = 2 * hstep;
  const unsigned ldsw = (unsigned)wid * 1024u;
  const int aoff = lds_byte(wr * 64 + fr, fq * 8), boff = lds_byte(wc * 32 + fr, fq * 8);
#define PG8_SA(b, h) (((b) * 2 + (h)) * HTB)
#define PG8_SB(b, h) ((4 + (b) * 2 + (h)) * HTB)
#define PG8_STAGE(bufoff, gbase, voff) do { _Pragma("unroll") for (int _i = 0; _i < 2; ++_i) \
    __builtin_amdgcn_global_load_lds((const unsigned*)((const char*)(gbase) + (voff)[_i]), (LAS unsigned*)(lds + (bufoff) + ldsw + _i * 8192), 16, 0, 0); } while (0)
#define PG8_LDA(dst, b, h) do { _Pragma("unroll") for (int m = 0; m < 4; ++m) _Pragma("unroll") for (int k = 0; k < 2; ++k) dst[m][k] = *(const LAS bf16x8*)(lds + PG8_SA(b, h) + aoff + m * 2048 + k * 1024); } while (0)
#define PG8_LDB(dst, b, h) do { _Pragma("unroll") for (int n = 0; n < 2; ++n) _Pragma("unroll") for (int k = 0; k < 2; ++k) dst[n][k] = *(const LAS bf16x8*)(lds + PG8_SB(b, h) + boff + n * 2048 + k * 1024); } while (0)
#define PG8_MMA(ai, bj, At, Bt) do { __builtin_amdgcn_s_setprio(1); _Pragma("unroll") for (int m = 0; m < 4; ++m) _Pragma("unroll") for (int n = 0; n < 2; ++n) _Pragma("unroll") for (int k = 0; k < 2; ++k) \
    acc[ai][bj][m][n] = __builtin_amdgcn_mfma_f32_16x16x32_bf16(Bt[n][k], At[m][k], acc[ai][bj][m][n], 0, 0, 0); __builtin_amdgcn_s_setprio(0); } while (0)
#define PG8_WAIT_V(n) asm volatile("s_waitcnt vmcnt(" #n ")" ::: "memory")
#define PG8_WAIT_L(n) asm volatile("s_waitcnt lgkmcnt(" #n ")" ::: "memory")
#define PG8_BAR __builtin_amdgcn_s_barrier()
#define PG8_SCHED __builtin_amdgcn_sched_barrier(0)
  Unit cur, nxt; int ui = 0;
  if (!S.next(0, cur)) return;
  f32x4 acc[2][2][4][2];
#pragma unroll
  for (int a = 0; a < 2; ++a)
#pragma unroll
    for (int b = 0; b < 2; ++b)
#pragma unroll
      for (int m = 0; m < 4; ++m)
#pragma unroll
        for (int n = 0; n < 2; ++n) acc[a][b][m][n] = (f32x4){0.f, 0.f, 0.f, 0.f};
  bf16x8 At[4][2], B0[2][2], B1[2][2];
  const char* cA = (const char*)g.A + (size_t)cur.pm * tstep; const char* cB = (const char*)g.Bt + (size_t)cur.pn * tstep;
  S.a_ready(cur);
  PG8_STAGE(PG8_SB(0, 0), cB, voffB); PG8_STAGE(PG8_SA(0, 0), cA, voffA); PG8_STAGE(PG8_SB(0, 1), cB + hstep, voffB); PG8_STAGE(PG8_SA(0, 1), cA + hstep, voffA);
  if (wr == 1) PG8_BAR;
  PG8_WAIT_V(4); PG8_BAR;
  PG8_STAGE(PG8_SB(1, 0), cB + kstep, voffB); PG8_STAGE(PG8_SA(1, 0), cA + kstep, voffA); PG8_STAGE(PG8_SB(1, 1), cB + hstep + kstep, voffB);
  PG8_WAIT_V(6); PG8_BAR;
  for (;;) {
    const bool has_next = S.next(ui + 1, nxt);
    const char* nA = has_next ? (const char*)g.A + (size_t)nxt.pm * tstep : cA; const char* nB = has_next ? (const char*)g.Bt + (size_t)nxt.pn * tstep : cB;
    for (int t = 0; t < nt; t += 2) {
      const bool last = (t == nt - 2);
      const char* a1 = cA + (size_t)(t + 1) * kstep;
      const char* a2 = last ? nA : cA + (size_t)(t + 2) * kstep; const char* b2 = last ? nB : cB + (size_t)(t + 2) * kstep;
      const char* a3 = a2 + kstep; const char* b3 = b2 + kstep;
      if (last && has_next) S.a_ready(nxt);
      PG8_LDB(B0, 0, 0); PG8_SCHED; PG8_LDA(At, 0, 0); PG8_STAGE(PG8_SA(1, 1), a1 + hstep, voffA);
      PG8_WAIT_L(8); PG8_BAR; PG8_WAIT_L(0); PG8_MMA(0, 0, At, B0); PG8_BAR; PG8_SCHED;
      PG8_LDB(B1, 0, 1); PG8_STAGE(PG8_SB(0, 0), b2, voffB);
      PG8_BAR; PG8_WAIT_L(0); PG8_MMA(0, 1, At, B1); PG8_BAR;
      PG8_LDA(At, 0, 1); PG8_STAGE(PG8_SA(0, 0), a2, voffA);
      PG8_BAR; PG8_WAIT_L(0); PG8_MMA(1, 0, At, B0); PG8_BAR; PG8_SCHED;
      PG8_STAGE(PG8_SB(0, 1), b2 + hstep, voffB);
      PG8_WAIT_V(6); PG8_BAR; PG8_MMA(1, 1, At, B1); PG8_BAR;
      PG8_LDB(B0, 1, 0); PG8_SCHED; PG8_LDA(At, 1, 0); PG8_STAGE(PG8_SA(0, 1), a2 + hstep, voffA);
      PG8_WAIT_L(8); PG8_BAR; PG8_WAIT_L(0); PG8_MMA(0, 0, At, B0); PG8_BAR; PG8_SCHED;
      PG8_LDB(B1, 1, 1); PG8_STAGE(PG8_SB(1, 0), b3, voffB);
      PG8_BAR; PG8_WAIT_L(0); PG8_MMA(0, 1, At, B1); PG8_BAR;
      PG8_LDA(At, 1, 1); PG8_STAGE(PG8_SA(1, 0), a3, voffA);
      PG8_BAR; PG8_WAIT_L(0); PG8_MMA(1, 0, At, B0); PG8_BAR; PG8_SCHED;
      PG8_STAGE(PG8_SB(1, 1), b3 + hstep, voffB);
      PG8_WAIT_V(6); PG8_BAR; PG8_MMA(1, 1, At, B1); PG8_BAR;
    }
    E(acc, cur, wr, wc, fr, fq); S.done(cur);
    if (!has_next) break;
#pragma unroll
    for (int a = 0; a < 2; ++a)
#pragma unroll
      for (int b = 0; b < 2; ++b)
#pragma unroll
        for (int m = 0; m < 4; ++m)
#pragma unroll
          for (int n = 0; n < 2; ++n) acc[a][b][m][n] = (f32x4){0.f, 0.f, 0.f, 0.f};
    cur = nxt; cA = nA; cB = nB; ++ui;
  }
  PG8_WAIT_V(0);
  if (wr == 0) PG8_BAR;
  PG8_BAR;
#undef PG8_SA
#undef PG8_SB
#undef PG8_STAGE
#undef PG8_LDA
#undef PG8_LDB
#undef PG8_MMA
#undef PG8_WAIT_V
#undef PG8_WAIT_L
#undef PG8_BAR
#undef PG8_SCHED
}
}
using pg8::Unit;
typedef f32x4 AccT[2][2][4][2];

struct EpiFfnIn {
  static constexpr bool PERM = true;
  const float* RSS; bf16_t* H;
  __device__ __forceinline__ void operator()(const AccT& acc, const Unit& u, int wr, int wc, int fr, int fq) const {
#pragma unroll
    for (int ai = 0; ai < 2; ++ai)
#pragma unroll
      for (int m = 0; m < 4; ++m) {
        const int row = u.pm * 256 + ai * 128 + wr * 64 + m * 16 + fr; const float rs = row_rstd(RSS, row);
        f32x4 h0, h1;
#pragma unroll
        for (int i = 0; i < 4; ++i) { h0[i] = fsilu(acc[ai][0][m][0][i] * rs) * (acc[ai][1][m][0][i] * rs); h1[i] = fsilu(acc[ai][0][m][1][i] * rs) * (acc[ai][1][m][1][i] * rs); }
        *(u32x4*)(H + (size_t)row * DFF + u.pn * 128 + wc * 32 + fq * 8) = pack8(h0, h1);
      }
  }
};
struct EpiRes {
  static constexpr bool PERM = true;
  float* X; bf16_t* XB; float* RSS; float s;
  __device__ __forceinline__ void operator()(const AccT& acc, const Unit& u, int wr, int wc, int fr, int fq) const {
#pragma unroll
    for (int ai = 0; ai < 2; ++ai)
#pragma unroll
      for (int m = 0; m < 4; ++m) {
        const int row = u.pm * 256 + ai * 128 + wr * 64 + m * 16 + fr; float ss = 0.f;
#pragma unroll
        for (int bj = 0; bj < 2; ++bj) {
          const int col = u.pn * 256 + bj * 128 + wc * 32 + fq * 8;
          float* xp = X + (size_t)row * DM + col;
          f32x4 y0 = *(const f32x4*)xp + acc[ai][bj][m][0] * s, y1 = *(const f32x4*)(xp + 4) + acc[ai][bj][m][1] * s;
          *(f32x4*)xp = y0; *(f32x4*)(xp + 4) = y1;
          *(u32x4*)(XB + (size_t)row * DM + col) = pack8(y0, y1);
#pragma unroll
          for (int i = 0; i < 4; ++i) ss += y0[i] * y0[i] + y1[i] * y1[i];
        }
        ss += __shfl_xor(ss, 16); ss += __shfl_xor(ss, 32);
        if (fq == 0) RSS[(size_t)row * 16 + u.pn * 4 + wc] = ss;
      }
  }
};
struct EpiM1 {
  static constexpr bool PERM = true;
  const float* RSS; const float2* TAB; bf16_t* Z; bf16_t* Q; bf16_t* Kb; bf16_t* V;
  __device__ __forceinline__ void operator()(const AccT& acc, const Unit& u, int wr, int wc, int fr, int fq) const {
    const int pn = u.pn;
    if (pn < 4 || pn >= 8) {
      bf16_t* dst = pn < 4 ? Z : V; const int cb = (pn < 4 ? pn : pn - 8) * 256;
#pragma unroll
      for (int ai = 0; ai < 2; ++ai)
#pragma unroll
        for (int m = 0; m < 4; ++m) {
          const int row = u.pm * 256 + ai * 128 + wr * 64 + m * 16 + fr; const float rs = row_rstd(RSS, row);
#pragma unroll
          for (int bj = 0; bj < 2; ++bj)
            *(u32x4*)(dst + (size_t)row * 1024 + cb + bj * 128 + wc * 32 + fq * 8) = pack8(acc[ai][bj][m][0] * rs, acc[ai][bj][m][1] * rs);
        }
    } else {
      bf16_t* dst = pn < 6 ? Q : Kb; const int head = 2 * (pn < 6 ? pn - 4 : pn - 6) + (wc >> 1); const int d0 = 32 * (wc & 1) + 8 * fq;
#pragma unroll
      for (int ai = 0; ai < 2; ++ai)
#pragma unroll
        for (int m = 0; m < 4; ++m) {
          const int row = u.pm * 256 + ai * 128 + wr * 64 + m * 16 + fr; const float rs = row_rstd(RSS, row);
          const int spos = row < 16384 ? (row & 2047) : row - 16384;
          const f32x4* tp = (const f32x4*)(TAB + (size_t)spos * 64 + d0);
          f32x4 t0 = tp[0], t1 = tp[1], t2 = tp[2], t3 = tp[3];
          f32x4 x1a = acc[ai][0][m][0] * rs, x1b = acc[ai][0][m][1] * rs, x2a = acc[ai][1][m][0] * rs, x2b = acc[ai][1][m][1] * rs;
          f32x4 ca = {t0[0], t0[2], t1[0], t1[2]}, sa = {t0[1], t0[3], t1[1], t1[3]}, cb2 = {t2[0], t2[2], t3[0], t3[2]}, sb = {t2[1], t2[3], t3[1], t3[3]};
          f32x4 o1a = x1a * ca - x2a * sa, o1b = x1b * cb2 - x2b * sb, o2a = x2a * ca + x1a * sa, o2b = x2b * cb2 + x1b * sb;
          bf16_t* op = dst + (size_t)row * 512 + head * 128 + d0;
          *(u32x4*)op = pack8(o1a, o1b); *(u32x4*)(op + 64) = pack8(o2a, o2b);
        }
    }
  }
};
struct EpiM2 {
  static constexpr bool PERM = true;
  const float* RSS; bf16_t* YN; bf16_t* GATES;
  __device__ __forceinline__ void operator()(const AccT& acc, const Unit& u, int wr, int wc, int fr, int fq) const {
    const int pn = u.pn;
#pragma unroll
    for (int ai = 0; ai < 2; ++ai)
#pragma unroll
      for (int m = 0; m < 4; ++m) {
        const int row = u.pm * 256 + ai * 128 + wr * 64 + m * 16 + fr; const float rs = row_rstd(RSS, row);
#pragma unroll
        for (int bj = 0; bj < 2; ++bj) {
          f32x4 a = acc[ai][bj][m][0] * rs, b = acc[ai][bj][m][1] * rs;
          if (pn < 4) {
            bf16_t* p = YN + (size_t)row * 1024 + pn * 256 + bj * 128 + wc * 32 + fq * 8; u32x4 y = *(const u32x4*)p;
#pragma unroll
            for (int i = 0; i < 2; ++i) { a[2 * i] = fsilu(a[2 * i]) * bf_lo(y[i]); a[2 * i + 1] = fsilu(a[2 * i + 1]) * bf_hi(y[i]); b[2 * i] = fsilu(b[2 * i]) * bf_lo(y[2 + i]); b[2 * i + 1] = fsilu(b[2 * i + 1]) * bf_hi(y[2 + i]); }
            *(u32x4*)p = pack8(a, b);
          } else {
#pragma unroll
            for (int i = 0; i < 4; ++i) { a[i] = fsigmoid(a[i]); b[i] = fsigmoid(b[i]); }
            *(u32x4*)(GATES + (size_t)row * 2048 + (pn - 4) * 256 + bj * 128 + wc * 32 + fq * 8) = pack8(a, b);
          }
        }
      }
  }
};
template <int MODE> struct EpiComb {
  static constexpr bool PERM = true;
  const bf16_t* GATES; bf16_t* U;
  __device__ __forceinline__ void operator()(const AccT& acc, const Unit& u, int wr, int wc, int fr, int fq) const {
#pragma unroll
    for (int ai = 0; ai < 2; ++ai)
#pragma unroll
      for (int m = 0; m < 4; ++m) {
        const int row = u.pm * 256 + ai * 128 + wr * 64 + m * 16 + fr;
#pragma unroll
        for (int bj = 0; bj < 2; ++bj) {
          const int col = u.pn * 256 + bj * 128 + wc * 32 + fq * 8;
          u32x4 gg = *(const u32x4*)(GATES + (size_t)row * 2048 + MODE * 1024 + col);
          f32x4 a = acc[ai][bj][m][0], b = acc[ai][bj][m][1];
#pragma unroll
          for (int i = 0; i < 2; ++i) { a[2 * i] *= bf_lo(gg[i]); a[2 * i + 1] *= bf_hi(gg[i]); b[2 * i] *= bf_lo(gg[2 + i]); b[2 * i + 1] *= bf_hi(gg[2 + i]); }
          bf16_t* p = U + (size_t)row * 1024 + col;
          if (MODE == 1) { u32x4 y = *(const u32x4*)p;
#pragma unroll
            for (int i = 0; i < 2; ++i) { a[2 * i] += bf_lo(y[i]); a[2 * i + 1] += bf_hi(y[i]); b[2 * i] += bf_lo(y[2 + i]); b[2 * i + 1] += bf_hi(y[2 + i]); } }
          *(u32x4*)p = pack8(a, b);
        }
      }
  }
};
template <bool USE_RS> struct EpiPlain {
  static constexpr bool PERM = true;
  const float* RSS; bf16_t* O; int ldo; float s;
  __device__ __forceinline__ void operator()(const AccT& acc, const Unit& u, int wr, int wc, int fr, int fq) const {
#pragma unroll
    for (int ai = 0; ai < 2; ++ai)
#pragma unroll
      for (int m = 0; m < 4; ++m) {
        const int row = u.pm * 256 + ai * 128 + wr * 64 + m * 16 + fr; const float rs = USE_RS ? row_rstd(RSS, row) * s : s;
#pragma unroll
        for (int bj = 0; bj < 2; ++bj)
          *(u32x4*)(O + (size_t)row * ldo + u.pn * 256 + bj * 128 + wc * 32 + fq * 8) = pack8(acc[ai][bj][m][0] * rs, acc[ai][bj][m][1] * rs);
      }
  }
};

template <class Epi> __device__ __forceinline__ void run_gemm(LAS unsigned char* lds, const bf16_t* A, const bf16_t* Bt, int M, int N, int K, const Epi& E) {
  pg8::Gemm g{A, Bt, M, N, K}; pg8::StaticOrder S; S.init(M, N, gridDim.x, blockIdx.x);
  pg8::gemm_phase<Epi, pg8::StaticOrder>(lds, g, S, E);
  __syncthreads();
}

__device__ void prep_tiles(const float* __restrict__ src, int ld, bf16_t* __restrict__ dst, int K, int Ndst, const float* __restrict__ gain, float scale,
                           int maptype, int mapbase, int& tbase, float* lt) {
  const int tid = opaque_tid(), G = gridDim.x;
  const int nkt = K >> 6, ntiles = (Ndst >> 6) * nkt;
  int start = (int)blockIdx.x - (tbase % G); if (start < 0) start += G;
  for (int t = start; t < ntiles; t += G) {
    const int nt = t / nkt, kt = t - nt * nkt, n0 = nt << 6, k0 = kt << 6;
    int sc0;
    if (maptype == 0) sc0 = mapbase + n0;
    else if (maptype == 1) { const int pn = n0 >> 8, h = (n0 >> 7) & 1, j = n0 & 127; sc0 = h * DFF + pn * 128 + j; }
    else { const int tt = n0 >> 8, c = n0 & 255, bj = c >> 7, cc = c & 127; sc0 = mapbase + (2 * tt + (cc >> 6)) * 128 + bj * 64 + (cc & 63); }
#pragma unroll
    for (int it = 0; it < 2; ++it) {
      const int idx = tid + it * 512, k = idx >> 4, n4 = idx & 15;
      const f32x4 v = *(const f32x4*)(src + (size_t)(k0 + k) * ld + sc0 + n4 * 4);
      const float g = scale * (gain ? gain[k0 + k] : 1.f);
      float* p = lt + k * 65 + n4 * 4; p[0] = v[0] * g; p[1] = v[1] * g; p[2] = v[2] * g; p[3] = v[3] * g;
    }
    __syncthreads();
    { const int n = tid >> 3, kc = (tid & 7) << 3; f32x4 a, b;
#pragma unroll
      for (int j = 0; j < 4; ++j) { a[j] = lt[(kc + j) * 65 + n]; b[j] = lt[(kc + 4 + j) * 65 + n]; }
      *(u32x4*)(dst + (size_t)(n0 + n) * K + k0 + kc) = pack8(a, b); }
    __syncthreads();
  }
  tbase += ntiles;
}
__device__ void prep_zfold(const float* __restrict__ wmix  , const float* __restrict__ gain, bf16_t* __restrict__ WM1, int& tbase, float* lt) {
  const int tid = opaque_tid(), G = gridDim.x;
  float* cosT = lt + 16 * 129; float* sinT = cosT + 128;
  int start = (int)blockIdx.x - (tbase % G); if (start < 0) start += G;
  for (int t = start; t < 256; t += G) {
    const int grp = t >> 6, k0 = (t & 63) << 4;
    { const int k = tid >> 5, c4 = tid & 31; const f32x4 v = *(const f32x4*)(wmix + (size_t)(k0 + k) * 5632 + grp * 128 + c4 * 4);
      float* p = lt + k * 129 + c4 * 4; p[0] = v[0]; p[1] = v[1]; p[2] = v[2]; p[3] = v[3]; }
    if (tid < 128) { cosT[tid] = __builtin_amdgcn_cosf((float)tid * (1.f / 128.f)); sinT[tid] = __builtin_amdgcn_sinf((float)tid * (1.f / 128.f)); }
    __syncthreads();
    { const int nl = tid >> 1, ri = nl >> 7, cc = nl & 127, kh = (tid & 1) << 3;
      float a0 = 0.f, a1 = 0.f, a2 = 0.f, a3 = 0.f, a4 = 0.f, a5 = 0.f, a6 = 0.f, a7 = 0.f;
      const float* lp = lt + kh * 129;
      for (int c = 0; c < 128; ++c) {
        const int idx = (c * cc) & 127; const float w = ri ? -sinT[idx] : cosT[idx];
        a0 += lp[c] * w; a1 += lp[129 + c] * w; a2 += lp[2 * 129 + c] * w; a3 += lp[3 * 129 + c] * w;
        a4 += lp[4 * 129 + c] * w; a5 += lp[5 * 129 + c] * w; a6 += lp[6 * 129 + c] * w; a7 += lp[7 * 129 + c] * w;
      }
      const float sc = 0.08838834764831845f; const float* gp = gain + k0 + kh;
      f32x4 o0 = {a0 * sc * gp[0], a1 * sc * gp[1], a2 * sc * gp[2], a3 * sc * gp[3]}, o1 = {a4 * sc * gp[4], a5 * sc * gp[5], a6 * sc * gp[6], a7 * sc * gp[7]};
      *(u32x4*)(WM1 + (size_t)(ri * 512 + grp * 128 + cc) * 1024 + k0 + kh) = pack8(o0, o1); }
    __syncthreads();
  }
  tbase += 256;
}

template <int STAGE>
__device__ void dft_item(const bf16_t* __restrict__ src, bf16_t* __restrict__ dst, const bf16_t* __restrict__ Ct, const bf16_t* __restrict__ St,
                         int N, int lgN, int rowbase, int j, int chblk, int S, int N1, int N2, LAS unsigned char* lds) {
  const int tid = opaque_tid(), w = tid >> 6, l = tid & 63;
  const int CB = 8192 >> lgN, stride = CB * 4 + 64;
  const int lgcpr = 11 - lgN, cpr = 1 << lgcpr;
#pragma unroll
  for (int it = 0; it < 4; ++it) {
    const int q = tid + it * 512, n = q >> lgcpr, cq = q & (cpr - 1), part = cq >> (lgcpr - 1), cc = cq & ((cpr >> 1) - 1);
    const int irow = STAGE == 1 ? rowbase + N2 * n + j : rowbase + j * N2 + n;
    const u32x4 v = *(const u32x4*)(src + (size_t)irow * 1024 + part * 512 + chblk * CB + cc * 8);
    *(LAS u32x4*)(lds + n * stride + (part * CB + cc * 8) * 2) = v;
  }
  __syncthreads();
  const int kts = N >> 5, kt = w & (kts - 1), chsub = w >> (lgN - 5);
  const int i16 = l & 15, q4 = i16 >> 2, p4 = i16 & 3, G1 = (l >> 4) & 1, h = l >> 5;
  const unsigned colre = (unsigned)(chsub * 32 + 16 * G1 + 4 * p4) * 2u, colim = colre + (unsigned)CB * 2u;
  const int kout = kt * 32 + (l & 31);
  f32x16 a0 = {}, a1 = {}, a2 = {};
  const int nks = N >> 4;
  for (int ks = 0; ks < nks; ++ks) {
    const unsigned rlo = (unsigned)(16 * ks + 8 * h + q4) * stride, rhi = rlo + 4u * stride;
    const bf16x8 Ar = tr_frag(lds, rlo + colre, rhi + colre), Ai = tr_frag(lds, rlo + colim, rhi + colim);
    const bf16x8 Bc = *(const bf16x8*)(Ct + kout * N + 16 * ks + 8 * h), Bs = *(const bf16x8*)(St + kout * N + 16 * ks + 8 * h);
    a0 = mfma32(Ar, Bc, a0); a0 = mfma32(Ai, Bs, a0);
    if (STAGE == 1) { a1 = mfma32(Ai, Bc, a1); a2 = mfma32(Ar, Bs, a2); }
  }
  const int chb = chblk * CB + chsub * 32 + 4 * h;
  if (STAGE == 1) {
    const int mm = (j * kout) & (S - 1); const float fr = (float)mm / (float)S;
    const float c = __builtin_amdgcn_cosf(fr), s = __builtin_amdgcn_sinf(fr);
    const size_t orow = (size_t)(rowbase + kout * N2 + j) * 1024;
#pragma unroll
    for (int g = 0; g < 4; ++g) {
      float re[4], im[4];
#pragma unroll
      for (int i = 0; i < 4; ++i) { const float yr = a0[4 * g + i], yi = a1[4 * g + i] - a2[4 * g + i]; re[i] = yr * c + yi * s; im[i] = yi * c - yr * s; }
      *(u32x2*)(dst + orow + chb + 8 * g) = pack4(re[0], re[1], re[2], re[3]);
      *(u32x2*)(dst + orow + 512 + chb + 8 * g) = pack4(im[0], im[1], im[2], im[3]);
    }
  } else {
    const size_t orow = (size_t)(rowbase + j + N1 * kout) * 512;
#pragma unroll
    for (int g = 0; g < 4; ++g) *(u32x2*)(dst + orow + chb + 8 * g) = pack4(a0[4 * g], a0[4 * g + 1], a0[4 * g + 2], a0[4 * g + 3]);
  }
  __syncthreads();
}
template <int STAGE>
__device__ void dft_phase(const bf16_t* src, bf16_t* dst, const bf16_t* DT, LAS unsigned char* lds) {
  for (int it = blockIdx.x; it < 2048; it += gridDim.x) {
    if (it < 1024) dft_item<STAGE>(src, dst, DT + DT_C128, DT + DT_S128, 128, 7, 16384, it >> 3, it & 7, 16384, 128, 128, lds);
    else {
      const int r = it - 1024, b = r >> 7, rr = r & 127;
      if (STAGE == 1) dft_item<STAGE>(src, dst, DT + DT_C32, DT + DT_S32, 32, 5, b * 2048, rr >> 1, rr & 1, 2048, 32, 64, lds);
      else dft_item<STAGE>(src, dst, DT + DT_C64, DT + DT_S64, 64, 6, b * 2048, rr >> 2, rr & 3, 2048, 32, 64, lds);
    }
  }
}

__device__ void ret_state_item(const bf16_t* __restrict__ Kb, const bf16_t* __restrict__ Vb, bf16_t* __restrict__ STf, bf16_t* __restrict__ STb,
                               int cidx, int head, float lgf2, float lgb2, LAS unsigned char* lds) {
  const int tid = opaque_tid(), w = tid >> 6, l = tid & 63; const int row0 = cidx * 128;
  constexpr unsigned VS = 576, KS = 320, OKF = 73728, OKB = 114688;
#pragma unroll
  for (int it = 0; it < 8; ++it) { const int q = tid + it * 512, j = q >> 5, c = q & 31;
    *(LAS u32x4*)(lds + j * VS + c * 16) = *(const u32x4*)(Vb + (size_t)(row0 + j) * 1024 + head * 256 + c * 8); }
#pragma unroll
  for (int it = 0; it < 4; ++it) { const int q = tid + it * 512, j = q >> 4, c = q & 15;
    const u32x4 v = *(const u32x4*)(Kb + (size_t)(row0 + j) * 512 + head * 128 + c * 8);
    const float zf = __builtin_amdgcn_exp2f(lgf2 * (float)(127 - j)), zb = __builtin_amdgcn_exp2f(lgb2 * (float)j);
    u32x4 of, ob;
#pragma unroll
    for (int i = 0; i < 4; ++i) { const float a = bf_lo(v[i]), b = bf_hi(v[i]); of[i] = cvt_pk_bf16(a * zf, b * zf); ob[i] = cvt_pk_bf16(a * zb, b * zb); }
    *(LAS u32x4*)(lds + OKF + j * KS + c * 16) = of; *(LAS u32x4*)(lds + OKB + j * KS + c * 16) = ob; }
  __syncthreads();
  const int i16 = l & 15, q4 = i16 >> 2, p4 = i16 & 3, G1 = (l >> 4) & 1, h = l >> 5;
  const unsigned cofs = (unsigned)(16 * G1 + 4 * p4) * 2u;
  f32x16 af[4], ab[4];
#pragma unroll
  for (int i = 0; i < 4; ++i) { af[i] = (f32x16){}; ab[i] = (f32x16){}; }
  for (int ks = 0; ks < 8; ++ks) {
    const unsigned r = (unsigned)(16 * ks + 8 * h + q4);
    const bf16x8 Bv = tr_frag(lds, r * VS + w * 64 + cofs, (r + 4) * VS + w * 64 + cofs);
#pragma unroll
    for (int dt = 0; dt < 4; ++dt) {
      const bf16x8 Af = tr_frag(lds, OKF + r * KS + dt * 64 + cofs, OKF + (r + 4) * KS + dt * 64 + cofs);
      const bf16x8 Ab = tr_frag(lds, OKB + r * KS + dt * 64 + cofs, OKB + (r + 4) * KS + dt * 64 + cofs);
      af[dt] = mfma32(Af, Bv, af[dt]); ab[dt] = mfma32(Ab, Bv, ab[dt]);
    }
  }
  const size_t ob = ((size_t)(cidx * 4 + head) * 256 + w * 32 + (l & 31)) * 128 + 4 * h;
#pragma unroll
  for (int dt = 0; dt < 4; ++dt)
#pragma unroll
    for (int g = 0; g < 4; ++g) {
      *(u32x2*)(STf + ob + dt * 32 + 8 * g) = pack4(af[dt][4 * g], af[dt][4 * g + 1], af[dt][4 * g + 2], af[dt][4 * g + 3]);
      *(u32x2*)(STb + ob + dt * 32 + 8 * g) = pack4(ab[dt][4 * g], ab[dt][4 * g + 1], ab[dt][4 * g + 2], ab[dt][4 * g + 3]);
    }
  __syncthreads();
}
__device__ void ret_scan_seq(bf16_t* __restrict__ ST, int c0, int nch, int sub  , float lg, bool bwd) {
  const float g = expf(lg * 128.f);
  bf16_t* base = ST + (size_t)c0 * 131072 + (size_t)sub * 2048 + opaque_tid() * 4;
  float s0 = 0.f, s1 = 0.f, s2 = 0.f, s3 = 0.f;
  for (int cb = 0; cb < nch; cb += 8) {
    u32x2 u[8];
#pragma unroll
    for (int i = 0; i < 8; ++i) { const int c = bwd ? nch - 1 - (cb + i) : cb + i; u[i] = *(const u32x2*)(base + (size_t)c * 131072); }
#pragma unroll
    for (int i = 0; i < 8; ++i) { const int c = bwd ? nch - 1 - (cb + i) : cb + i;
      *(u32x2*)(base + (size_t)c * 131072) = pack4(s0, s1, s2, s3);
      s0 = g * s0 + bf_lo(u[i][0]); s1 = g * s1 + bf_hi(u[i][0]); s2 = g * s2 + bf_lo(u[i][1]); s3 = g * s3 + bf_hi(u[i][1]); }
  }
}
__device__ void ret_out_item(const bf16_t* __restrict__ Qb, const bf16_t* __restrict__ Kb, bf16_t* Vb, const bf16_t* __restrict__ STf, const bf16_t* __restrict__ STb,
                             int cidx, int head, float lgf2, float lgb2, LAS unsigned char* lds) {
  const int tid = opaque_tid(), w = tid >> 6, l = tid & 63; const int row0 = cidx * 128;
  constexpr unsigned VS = 576, ORED = 73728;
#pragma unroll
  for (int it = 0; it < 8; ++it) { const int q = tid + it * 512, j = q >> 5, c = q & 31;
    *(LAS u32x4*)(lds + j * VS + c * 16) = *(const u32x4*)(Vb + (size_t)(row0 + j) * 1024 + head * 256 + c * 8); }
  __syncthreads();
  const int ib = w & 3, eh = w >> 2, il = l & 31, h = l >> 5;
  const int i16 = l & 15, q4 = i16 >> 2, p4 = i16 & 3, G1 = (l >> 4) & 1;
  const int iloc = ib * 32 + il;
  bf16x8 qf[8];
  { const bf16_t* qp = Qb + (size_t)(row0 + iloc) * 512 + head * 128 + 8 * h;
#pragma unroll
    for (int ks = 0; ks < 8; ++ks) qf[ks] = *(const bf16x8*)(qp + 16 * ks); }
  bf16x8 pf[4][2];
#pragma unroll
  for (int jt = 0; jt < 4; ++jt) {
    f32x16 a = {};
    const bf16_t* kp = Kb + (size_t)(row0 + jt * 32 + il) * 512 + head * 128 + 8 * h;
#pragma unroll
    for (int ks = 0; ks < 8; ++ks) a = mfma32(*(const bf16x8*)(kp + 16 * ks), qf[ks], a);
    u32x4 p0, p1;
#pragma unroll
    for (int r = 0; r < 16; r += 2) {
      float v[2];
#pragma unroll
      for (int e = 0; e < 2; ++e) { const int jl = jt * 32 + ((r + e) & 3) + 8 * ((r + e) >> 2) + 4 * h; const int dd = iloc - jl;
        const float dec = dd >= 0 ? __builtin_amdgcn_exp2f(lgf2 * (float)dd) : __builtin_amdgcn_exp2f(lgb2 * (float)(-dd)); v[e] = a[r + e] * dec; }
      const unsigned pk = cvt_pk_bf16(v[0], v[1]);
      if (r < 8) p0[r >> 1] = pk; else p1[(r - 8) >> 1] = pk;
    }
    pf[jt][0] = (bf16x8)p0; pf[jt][1] = (bf16x8)p1;
  }
  f32x16 acc[4];
#pragma unroll
  for (int i = 0; i < 4; ++i) acc[i] = (f32x16){};
  const unsigned cofs = (unsigned)(eh * 128 + 16 * G1 + 4 * p4) * 2u;
#pragma unroll
  for (int jt = 0; jt < 4; ++jt)
#pragma unroll
    for (int s = 0; s < 2; ++s) {
      const unsigned r = (unsigned)(jt * 32 + 16 * s + 4 * h + q4);
#pragma unroll
      for (int et = 0; et < 4; ++et) acc[et] = mfma32(tr_frag(lds, r * VS + et * 64 + cofs, (r + 8) * VS + et * 64 + cofs), pf[jt][s], acc[et]);
    }
#pragma unroll
  for (int dir = 0; dir < 2; ++dir) {
    const float xi = dir ? __builtin_amdgcn_exp2f(lgb2 * (float)(128 - iloc)) : __builtin_amdgcn_exp2f(lgf2 * (float)(iloc + 1));
    const bf16_t* sp = (dir ? STb : STf) + ((size_t)(cidx * 4 + head) * 256 + eh * 128 + il) * 128 + 8 * h;
#pragma unroll
    for (int ks = 0; ks < 8; ++ks) {
      const bf16x8 sq = scale_frag(qf[ks], xi);
#pragma unroll
      for (int et = 0; et < 4; ++et) acc[et] = mfma32(*(const bf16x8*)(sp + (size_t)et * 32 * 128 + 16 * ks), sq, acc[et]);
    }
  }
  float ss = 0.f;
#pragma unroll
  for (int et = 0; et < 4; ++et)
#pragma unroll
    for (int r = 0; r < 16; ++r) ss += acc[et][r] * acc[et][r];
  ss += __shfl_xor(ss, 32);
  LAS float* red = (LAS float*)(lds + ORED);
  if (h == 0) red[eh * 128 + iloc] = ss;
  __syncthreads();
  const float rn = rsqrtf((red[iloc] + red[128 + iloc]) * (1.f / 256.f) + 1e-6f);
  bf16_t* op = Vb + (size_t)(row0 + iloc) * 1024 + head * 256 + eh * 128 + 4 * h;
#pragma unroll
  for (int et = 0; et < 4; ++et)
#pragma unroll
    for (int g = 0; g < 4; ++g)
      *(u32x2*)(op + et * 32 + 8 * g) = pack4(acc[et][4 * g] * rn, acc[et][4 * g + 1] * rn, acc[et][4 * g + 2] * rn, acc[et][4 * g + 3] * rn);
  __syncthreads();
}

__device__ void attn_item(const bf16_t* __restrict__ QX, const bf16_t* __restrict__ KV, bf16_t* __restrict__ O, int tt, int head, LAS unsigned char* lds) {
  const int tid = opaque_tid(), w = tid >> 6, l = tid & 63; const int row0 = tt * 256; const int b = tt < 64 ? (tt >> 3) : 8; const int mrow0 = b * 256;
  constexpr unsigned KS = 528, VS = 576;
#pragma unroll 4
  for (int it = 0; it < 16; ++it) { const int q = tid + it * 512, m = q >> 5, c = q & 31;
    *(LAS u32x4*)(lds + m * KS + c * 16) = *(const u32x4*)(KV + (size_t)(mrow0 + m) * 2048 + head * 256 + c * 8); }
  __syncthreads();
  const int il = l & 31, h = l >> 5, i16 = l & 15, q4 = i16 >> 2, p4 = i16 & 3, G1 = (l >> 4) & 1;
  const int row = row0 + w * 32 + il;
  bf16x8 pf[8][2];
  float mxp = -3.0e38f, sum = 0.f;
  const bf16_t* qp = QX + (size_t)row * 1024 + head * 256 + 8 * h;
#pragma unroll
  for (int hf = 0; hf < 2; ++hf) {
    f32x16 sc[4];
#pragma unroll
    for (int i = 0; i < 4; ++i) sc[i] = (f32x16){};
#pragma unroll 2
    for (int ks = 0; ks < 16; ++ks) {
      const bf16x8 B = *(const bf16x8*)(qp + 16 * ks);
#pragma unroll
      for (int mt = 0; mt < 4; ++mt) sc[mt] = mfma32(*(const LAS bf16x8*)(lds + ((hf * 4 + mt) * 32 + il) * KS + (16 * ks + 8 * h) * 2), B, sc[mt]);
    }
    float mx = mxp;
#pragma unroll
    for (int mt = 0; mt < 4; ++mt)
#pragma unroll
      for (int r = 0; r < 16; ++r) mx = fmaxf(mx, sc[mt][r]);
    mx = fmaxf(mx, __shfl_xor(mx, 32));
    if (hf == 1) { const float f = __builtin_amdgcn_exp2f((mxp - mx) * 1.4426950408889634f); sum *= f;
#pragma unroll
      for (int mt = 0; mt < 4; ++mt) { pf[mt][0] = scale_frag(pf[mt][0], f); pf[mt][1] = scale_frag(pf[mt][1], f); } }
#pragma unroll
    for (int mt = 0; mt < 4; ++mt) {
      u32x4 p0, p1;
#pragma unroll
      for (int r = 0; r < 16; r += 2) {
        const float e0 = __builtin_amdgcn_exp2f((sc[mt][r] - mx) * 1.4426950408889634f), e1 = __builtin_amdgcn_exp2f((sc[mt][r + 1] - mx) * 1.4426950408889634f);
        sum += e0 + e1; const unsigned pk = cvt_pk_bf16(e0, e1);
        if (r < 8) p0[r >> 1] = pk; else p1[(r - 8) >> 1] = pk;
      }
      pf[hf * 4 + mt][0] = (bf16x8)p0; pf[hf * 4 + mt][1] = (bf16x8)p1;
    }
    mxp = mx;
  }
  sum += __shfl_xor(sum, 32);
  const float inv = __builtin_amdgcn_rcpf(sum);
  __builtin_amdgcn_sched_barrier(0);
  __syncthreads();
  __builtin_amdgcn_sched_barrier(0);
#pragma unroll 4
  for (int it = 0; it < 16; ++it) { const int q = tid + it * 512, m = q >> 5, c = q & 31;
    *(LAS u32x4*)(lds + m * VS + c * 16) = *(const u32x4*)(KV + (size_t)(mrow0 + m) * 2048 + 1024 + head * 256 + c * 8); }
  __syncthreads();
  __builtin_amdgcn_sched_barrier(0);
#pragma unroll 1
  for (int half = 0; half < 2; ++half) {
    f32x16 acc[4];
#pragma unroll
    for (int i = 0; i < 4; ++i) acc[i] = (f32x16){};
    const unsigned cofs = (unsigned)(half * 128 + 16 * G1 + 4 * p4) * 2u;
#pragma unroll
    for (int mt = 0; mt < 8; ++mt)
#pragma unroll
      for (int s = 0; s < 2; ++s) {
        const unsigned r = (unsigned)(mt * 32 + 16 * s + 4 * h + q4);
#pragma unroll
        for (int et = 0; et < 4; ++et) acc[et] = mfma32(tr_frag(lds, r * VS + et * 64 + cofs, (r + 8) * VS + et * 64 + cofs), pf[mt][s], acc[et]);
      }
    bf16_t* op = O + (size_t)row * 1024 + head * 256 + half * 128 + 4 * h;
#pragma unroll
    for (int et = 0; et < 4; ++et)
#pragma unroll
      for (int g = 0; g < 4; ++g)
        *(u32x2*)(op + et * 32 + 8 * g) = pack4(acc[et][4 * g] * inv, acc[et][4 * g + 1] * inv, acc[et][4 * g + 2] * inv, acc[et][4 * g + 3] * inv);
  }
  __syncthreads();
}

__device__ __forceinline__ float sel4(const float (&a)[4], int i) { return i == 0 ? a[0] : i == 1 ? a[1] : i == 2 ? a[2] : a[3]; }


#define XB_TMO      128
#define XB_XCNT(j)  (256  + 64 * (j))
#define XB_XSUB(j)  (1280 + 64 * (j))
#define XB_XGEN(j)  (2304 + 64 * (j))
#define XB_TOP      3328
#define XB_TOPGEN   3392
#define XCD_BAR_WORDS 3456
#define XB_SPIN_CAP (1u << 20)
__device__ __forceinline__ unsigned xb_ld(unsigned* p)              { return __hip_atomic_load(p, __ATOMIC_RELAXED, __HIP_MEMORY_SCOPE_AGENT); }
__device__ __forceinline__ unsigned xb_add(unsigned* p, unsigned v) { return __hip_atomic_fetch_add(p, v, __ATOMIC_RELAXED, __HIP_MEMORY_SCOPE_AGENT); }
__device__ __forceinline__ unsigned xb_xcc_id() { return (unsigned)__builtin_amdgcn_s_getreg((3 << 11) | 20) & 0xFu; }
#define XB_SPIN(cond, bar) do { unsigned _sp = 0; while (cond) { __builtin_amdgcn_s_sleep(1); \
    if ((++_sp & 255u) == 0u) { if (xb_ld(&(bar)[XB_TMO])) break; if (_sp > XB_SPIN_CAP) { atomicAdd(&(bar)[XB_TMO], 1u); break; } } } } while (0)
struct XcdBarrier { unsigned* bar; unsigned x; volatile LAS unsigned* st; };
__device__ __forceinline__ XcdBarrier xcd_barrier_post(unsigned* bar, volatile LAS unsigned* st) {
  XcdBarrier b; b.bar = bar; b.x = xb_xcc_id(); b.st = st;
  if (threadIdx.x == 0) (void)xb_add(&bar[XB_XCNT(b.x)], 1u);
  return b;
}
__device__ __forceinline__ void xcd_barrier_complete(unsigned* bar, unsigned x, unsigned& nloc, unsigned& nx) {
  const unsigned G = gridDim.x * gridDim.y * gridDim.z;
  unsigned sum, cnt, mine, sp = 0u;
  for (;;) {
    sum = 0u; cnt = 0u; mine = 0u;
#pragma unroll
    for (unsigned j = 0; j < 16; ++j) { const unsigned c = xb_ld(&bar[XB_XCNT(j)]); sum += c; cnt += (c > 0u) ? 1u : 0u; mine = (j == x) ? c : mine; }
    if (sum == G) break;
    __builtin_amdgcn_s_sleep(1);
    if ((++sp & 255u) == 0u) { if (xb_ld(&bar[XB_TMO])) break; if (sp > XB_SPIN_CAP) { atomicAdd(&bar[XB_TMO], 1u); break; } }
  }
  nloc = mine > 0u ? mine : 1u; nx = cnt > 0u ? cnt : 1u;
}
__device__ __forceinline__ void xcd_barrier(const XcdBarrier& b) {
  asm volatile("s_waitcnt vmcnt(0)" ::: "memory");
  __syncthreads();
  if (threadIdx.x == 0) {
    unsigned* bar = b.bar;
    __builtin_amdgcn_s_waitcnt(0);
    unsigned nloc = b.st[0], nx = b.st[1];
    if (nloc == 0u) { xcd_barrier_complete(bar, b.x, nloc, nx); b.st[0] = nloc; b.st[1] = nx; }
    const unsigned old = xb_add(&bar[XB_XSUB(b.x)], 1u);
    const unsigned gen = old / nloc;
    if (old + 1u == (gen + 1u) * nloc) {
      __builtin_amdgcn_fence(__ATOMIC_RELEASE, "agent");
      asm volatile("s_waitcnt vmcnt(0)" ::: "memory");
      const unsigned og = xb_add(&bar[XB_TOP], 1u);
      const unsigned tg = og / nx;
      if (og + 1u == (tg + 1u) * nx) xb_add(&bar[XB_TOPGEN], 1u);
      else XB_SPIN(xb_ld(&bar[XB_TOPGEN]) == tg, bar);
      __builtin_amdgcn_fence(__ATOMIC_ACQUIRE, "agent");
      xb_add(&bar[XB_XGEN(b.x)], 1u);
      asm volatile("s_waitcnt vmcnt(0)" ::: "memory");
    } else {
      XB_SPIN(xb_ld(&bar[XB_XGEN(b.x)]) == gen, bar);
      __builtin_amdgcn_fence(__ATOMIC_ACQUIRE, "agent");
      asm volatile("s_waitcnt vmcnt(0)" ::: "memory");
    }
  }
  __syncthreads();
}

__global__ void __launch_bounds__(512, 2) mega(Params p) {
  cg::grid_group grid = cg::this_grid();
  extern __shared__ __attribute__((aligned(16))) unsigned char smem_raw[];
  LAS unsigned char* lds = (LAS unsigned char*)smem_raw;
  float* ltf = (float*)smem_raw;
  const int tid = opaque_tid(), G = gridDim.x, wv = tid >> 6, lane = tid & 63;
  unsigned char* ws = p.ws;
  float2* TAB = (float2*)(ws + OFF_TAB); bf16_t* DT = (bf16_t*)(ws + OFF_DFT); bf16_t* MEMB = (bf16_t*)(ws + OFF_MEMB);
  float* RSS = (float*)(ws + OFF_RSS); bf16_t* XB = (bf16_t*)(ws + OFF_XB); bf16_t* WB = (bf16_t*)(ws + OFF_WB);
  bf16_t* RA = (bf16_t*)(ws + OFF_A); bf16_t* RS = (bf16_t*)(ws + OFF_S); bf16_t* RB = (bf16_t*)(ws + OFF_B);
  bf16_t* Zb = RA; bf16_t* Y1 = RA + 32 * MiB; bf16_t* GATES = RA; bf16_t* HID = RA; bf16_t* QX = RA; bf16_t* Ob = RA + 32 * MiB;
  bf16_t* STf = RS; bf16_t* STb = RS + 32 * MiB;
  bf16_t* Qb = RB; bf16_t* Kb = RB + 16 * MiB; bf16_t* Vb = RB + 32 * MiB; bf16_t* Fb = RB + 64 * MiB; bf16_t* Ub = RB; bf16_t* KVb = RB + 32 * MiB;
  float* X = p.X;
  volatile LAS unsigned* xst = (volatile LAS unsigned*)(lds + 163824);
  if (threadIdx.x < 4) xst[threadIdx.x] = 0u;
  __syncthreads();
  const XcdBarrier xb = xcd_barrier_post((unsigned*)(ws + WS_NEED), xst);

  for (int r = blockIdx.x * 8 + wv; r < T_TOK; r += G * 8) {
    const float* src = r < 16384 ? p.in[0] + (size_t)r * DM : p.in[1] + (size_t)(r - 16384) * DM;
    float ss = 0.f;
#pragma unroll
    for (int k = 0; k < 4; ++k) { const f32x4 v = *(const f32x4*)(src + k * 256 + lane * 4);
      *(f32x4*)(X + (size_t)r * DM + k * 256 + lane * 4) = v; *(u32x2*)(XB + (size_t)r * DM + k * 256 + lane * 4) = pack4(v[0], v[1], v[2], v[3]);
      ss += v[0] * v[0] + v[1] * v[1] + v[2] * v[2] + v[3] * v[3]; }
#pragma unroll
    for (int o = 32; o; o >>= 1) ss += __shfl_xor(ss, o);
    if (lane < 16) RSS[(size_t)r * 16 + lane] = lane == 0 ? ss : 0.f;
  }
  for (int r = blockIdx.x * 8 + wv; r < NMEMROWS; r += G * 8) {
    const float* src = r < 2048 ? p.in[2] + (size_t)r * DM : p.in[3] + (size_t)(r - 2048) * DM;
    f32x4 v0 = *(const f32x4*)(src + lane * 4), v1 = *(const f32x4*)(src + 256 + lane * 4), v2 = *(const f32x4*)(src + 512 + lane * 4), v3 = *(const f32x4*)(src + 768 + lane * 4);
    float ss = 0.f;
#pragma unroll
    for (int i = 0; i < 4; ++i) ss += v0[i] * v0[i] + v1[i] * v1[i] + v2[i] * v2[i] + v3[i] * v3[i];
#pragma unroll
    for (int o = 32; o; o >>= 1) ss += __shfl_xor(ss, o);
    const float rs = rsqrtf(ss * (1.f / 1024.f) + 1e-6f);
    bf16_t* mp = MEMB + (size_t)r * DM + lane * 4;
    *(u32x2*)(mp) = pack4(v0[0] * rs, v0[1] * rs, v0[2] * rs, v0[3] * rs); *(u32x2*)(mp + 256) = pack4(v1[0] * rs, v1[1] * rs, v1[2] * rs, v1[3] * rs);
    *(u32x2*)(mp + 512) = pack4(v2[0] * rs, v2[1] * rs, v2[2] * rs, v2[3] * rs); *(u32x2*)(mp + 768) = pack4(v3[0] * rs, v3[1] * rs, v3[2] * rs, v3[3] * rs);
  }
  for (int i = blockIdx.x * 512 + tid; i < 16384 * 64; i += G * 512) {
    const int s = i >> 6, d = i & 63;
    const float e = (float)d * 2.0f / 128.0f; const float inv = 1.0f / powf(10000.0f, e); const float ang = (float)s * inv;
    const double a = (double)ang * 0.15915494309189535; const double fr = a - rint(a);
    const float f = (float)fr;
    TAB[i] = make_float2(__builtin_amdgcn_cosf(f), __builtin_amdgcn_sinf(f));
  }
  for (int i = blockIdx.x * 512 + tid; i < 16384 + 4096 + 1024; i += G * 512) {
    int N, k, n, oc, os;
    if (i < 16384) { N = 128; k = i >> 7; n = i & 127; oc = DT_C128 + i; os = DT_S128 + i; }
    else if (i < 20480) { const int q = i - 16384; N = 64; k = q >> 6; n = q & 63; oc = DT_C64 + q; os = DT_S64 + q; }
    else { const int q = i - 20480; N = 32; k = q >> 5; n = q & 31; oc = DT_C32 + q; os = DT_S32 + q; }
    const float fr = (float)((k * n) & (N - 1)) / (float)N; const float sc = rsqrtf((float)N);
    const unsigned pk = cvt_pk_bf16(__builtin_amdgcn_cosf(fr) * sc, __builtin_amdgcn_sinf(fr) * sc);
    DT[oc] = (bf16_t)(pk & 0xffffu); DT[os] = (bf16_t)(pk >> 16);
  }

  for (int layer = 0; layer < 4; ++layer) {
    {
      int tb = 0;
      const float* g1 = p.in[4] + layer * DM; const float* gm = p.in[7] + layer * DM; const float* gx = p.in[14] + layer * DM;
      const float* gmem = p.in[15] + layer * DM; const float* g2 = p.in[19] + layer * DM;
      const float* wmix = p.in[8] + (size_t)layer * 1024 * 5632;
      prep_tiles(p.in[5] + (size_t)layer * 1024 * 5632, 5632, WB + W_1I, 1024, 5632, g1, 1.f, 1, 0, tb, ltf);
      prep_tiles(p.in[6] + (size_t)layer * DFF * 1024, 1024, WB + W_1O, DFF, 1024, nullptr, 1.f, 0, 0, tb, ltf);
      prep_zfold(wmix, gm, WB + W_M1, tb, ltf);
      prep_tiles(wmix, 5632, WB + W_M1 + (size_t)1024 * 1024, 1024, 512, gm, 1.f, 2, 512, tb, ltf);
      prep_tiles(wmix, 5632, WB + W_M1 + (size_t)1536 * 1024, 1024, 512, gm, 0.08838834764831845f, 2, 1024, tb, ltf);
      prep_tiles(wmix, 5632, WB + W_M1 + (size_t)2048 * 1024, 1024, 1024, gm, 1.f, 0, 1536, tb, ltf);
      prep_tiles(wmix, 5632, WB + W_M2, 1024, 3072, gm, 1.f, 0, 2560, tb, ltf);
      prep_tiles(p.in[9] + (size_t)layer * 512 * 1024, 1024, WB + W_F, 512, 1024, nullptr, 1.f, 0, 0, tb, ltf);
      prep_tiles(p.in[12] + (size_t)layer * 1024 * 1024, 1024, WB + W_R, 1024, 1024, nullptr, 1.f, 0, 0, tb, ltf);
      prep_tiles(p.in[13] + (size_t)layer * 1024 * 1024, 1024, WB + W_MO, 1024, 1024, nullptr, 1.f, 0, 0, tb, ltf);
      prep_tiles(p.in[16] + (size_t)layer * 1024 * 1024, 1024, WB + W_Q, 1024, 1024, gx, 1.f, 0, 0, tb, ltf);
      prep_tiles(p.in[17] + (size_t)layer * 1024 * 2048, 2048, WB + W_KV, 1024, 2048, gmem, 1.f, 0, 0, tb, ltf);
      prep_tiles(p.in[18] + (size_t)layer * 1024 * 1024, 1024, WB + W_O, 1024, 1024, nullptr, 1.f, 0, 0, tb, ltf);
      prep_tiles(p.in[20] + (size_t)layer * 1024 * 5632, 5632, WB + W_2I, 1024, 5632, g2, 1.f, 1, 0, tb, ltf);
      prep_tiles(p.in[21] + (size_t)layer * DFF * 1024, 1024, WB + W_2O, DFF, 1024, nullptr, 1.f, 0, 0, tb, ltf);
    }
    if (layer == 0) grid.sync(); else xcd_barrier(xb);
    run_gemm(lds, XB, WB + W_1I, T_TOK, 5632, 1024, EpiFfnIn{RSS, HID});
    xcd_barrier(xb);
    run_gemm(lds, HID, WB + W_1O, T_TOK, 1024, DFF, EpiRes{X, XB, RSS, 0.5f});
    xcd_barrier(xb);
    run_gemm(lds, XB, WB + W_M1, T_TOK, 3072, 1024, EpiM1{RSS, TAB, Zb, Qb, Kb, Vb});
    xcd_barrier(xb);
    float lgf2[4], lgb2[4], lgf[4], lgb[4];
#pragma unroll
    for (int hh = 0; hh < 4; ++hh) { lgf[hh] = log_sigmoid(p.in[10][layer * 4 + hh]); lgb[hh] = log_sigmoid(p.in[11][layer * 4 + hh]);
      lgf2[hh] = lgf[hh] * 1.4426950408889634f; lgb2[hh] = lgb[hh] * 1.4426950408889634f; }
    dft_phase<1>(Zb, Y1, DT, lds);
    for (int it = blockIdx.x; it < 1024; it += G) { const int hh = it & 3; ret_state_item(Kb, Vb, STf, STb, it >> 2, hh, sel4(lgf2, hh), sel4(lgb2, hh), lds); }
    xcd_barrier(xb);
    dft_phase<2>(Y1, Fb, DT, lds);
    for (int it = blockIdx.x; it < 256; it += G) {
      if (it < 128) { const int dir = it >> 6, sub = it & 63, hh = sub >> 4; ret_scan_seq(dir ? STb : STf, 128, 128, sub, dir ? sel4(lgb, hh) : sel4(lgf, hh), dir); }
      else for (int k = 0; k < 8; ++k) { const int r = (it - 128) * 8 + k, b = r >> 7, dir = (r >> 6) & 1, sub = r & 63, hh = sub >> 4;
        ret_scan_seq(dir ? STb : STf, b * 16, 16, sub, dir ? sel4(lgb, hh) : sel4(lgf, hh), dir); }
    }
    xcd_barrier(xb);
    for (int it = blockIdx.x; it < 1024; it += G) { const int hh = it & 3; ret_out_item(Qb, Kb, Vb, STf, STb, it >> 2, hh, sel4(lgf2, hh), sel4(lgb2, hh), lds); }
    xcd_barrier(xb);
    run_gemm(lds, XB, WB + W_M2, T_TOK, 3072, 1024, EpiM2{RSS, Vb, GATES});
    xcd_barrier(xb);
    run_gemm(lds, Fb, WB + W_F, T_TOK, 1024, 512, EpiComb<0>{GATES, Ub});
    run_gemm(lds, Vb, WB + W_R, T_TOK, 1024, 1024, EpiComb<1>{GATES, Ub});
    xcd_barrier(xb);
    run_gemm(lds, Ub, WB + W_MO, T_TOK, 1024, 1024, EpiRes{X, XB, RSS, 1.0f});
    xcd_barrier(xb);
    run_gemm(lds, XB, WB + W_Q, T_TOK, 1024, 1024, EpiPlain<true>{RSS, QX, 1024, 0.0625f});
    run_gemm(lds, MEMB, WB + W_KV, NMEMROWS, 2048, 1024, EpiPlain<false>{RSS, KVb, 2048, 1.0f});
    xcd_barrier(xb);
    for (int it = blockIdx.x; it < 512; it += G) attn_item(QX, KVb, Ob, it >> 2, it & 3, lds);
    xcd_barrier(xb);
    run_gemm(lds, Ob, WB + W_O, T_TOK, 1024, 1024, EpiRes{X, XB, RSS, 1.0f});
    xcd_barrier(xb);
    run_gemm(lds, XB, WB + W_2I, T_TOK, 5632, 1024, EpiFfnIn{RSS, HID});
    xcd_barrier(xb);
    run_gemm(lds, HID, WB + W_2O, T_TOK, 1024, DFF, EpiRes{X, XB, RSS, 0.5f});
    xcd_barrier(xb);
  }
  const int tidf = opaque_tid(), wvf = tidf >> 6, lanef = tidf & 63;
  for (int r = blockIdx.x * 8 + wvf; r < T_TOK; r += G * 8) {
    const float rs = row_rstd(RSS, r);
#pragma unroll
    for (int k = 0; k < 4; ++k) { float* xp = X + (size_t)r * DM + k * 256 + lanef * 4; const f32x4 g = *(const f32x4*)(p.in[22] + k * 256 + lanef * 4);
      *(f32x4*)xp = *(const f32x4*)xp * rs * g; }
  }
}

extern "C" void kernel_launch(void* const* d_in, const int* in_sizes, int n_in, void* d_out, int out_size, void* d_ws, size_t ws_size, hipStream_t stream) {
  constexpr size_t kDynLds = 163840;
  static int grid_blocks = 0;
  if (!grid_blocks) {
    (void)hipFuncSetAttribute((const void*)mega, hipFuncAttributeMaxDynamicSharedMemorySize, (int)kDynLds);
    int dev = 0, cus = 0, per_cu = 0;
    (void)hipGetDevice(&dev);
    (void)hipDeviceGetAttribute(&cus, hipDeviceAttributeMultiprocessorCount, dev);
    (void)hipOccupancyMaxActiveBlocksPerMultiprocessor(&per_cu, mega, 512, kDynLds);
    grid_blocks = cus > 0 ? cus : 256;
    if (per_cu < 1) fprintf(stderr, "occupancy query returned %d\n", per_cu);
  }
  if (ws_size < WS_NEED + 16384) { fprintf(stderr, "workspace too small: %zu < %zu\n", ws_size, (size_t)WS_NEED); return; }
  (void)hipMemsetAsync((unsigned char*)d_ws + WS_NEED, 0, XCD_BAR_WORDS * 4, stream);
  Params p{};
  for (int i = 0; i < 23; ++i) p.in[i] = (const float*)d_in[i];
  p.X = (float*)d_out; p.ws = (unsigned char*)d_ws;
  void* args[] = {&p};
  hipError_t e = hipLaunchCooperativeKernel((void*)mega, dim3(grid_blocks), dim3(512), args, kDynLds, stream);
  if (e != hipSuccess) fprintf(stderr, "cooperative launch failed: %s (grid %d)\n", hipGetErrorString(e), grid_blocks);
}
```

```cpp
#include <hip/hip_runtime.h>
#include <hip/hip_cooperative_groups.h>
#include <cstdio>
namespace cg = cooperative_groups;

#define LAS __attribute__((address_space(3)))
typedef unsigned short bf16_t;
typedef short bf16x8 __attribute__((ext_vector_type(8)));
typedef short s16x4 __attribute__((ext_vector_type(4)));
typedef float f32x4 __attribute__((ext_vector_type(4)));
typedef float f32x16 __attribute__((ext_vector_type(16)));
typedef unsigned u32x4 __attribute__((ext_vector_type(4)));
typedef unsigned u32x2 __attribute__((ext_vector_type(2)));

constexpr int T_TOK = 32768, DM = 1024, DFF = 2816, NMEMROWS = 2304;
constexpr size_t MiB = 1048576;
constexpr size_t OFF_TAB = 0;
constexpr size_t OFF_DFT = 8 * MiB;
constexpr size_t OFF_MEMB = OFF_DFT + 256 * 1024;
constexpr size_t OFF_RSS = OFF_MEMB + 4718592;
constexpr size_t OFF_XB = OFF_RSS + 2 * MiB;
constexpr size_t OFF_WB = OFF_XB + 64 * MiB;
constexpr size_t OFF_A = OFF_WB + 58 * MiB;
constexpr size_t OFF_S = OFF_A + 128 * MiB;
constexpr size_t OFF_B = OFF_S + 128 * MiB;
constexpr size_t WS_NEED = OFF_B + 160 * MiB;
constexpr size_t W_1I = 0, W_1O = 5767168, W_M1 = 8650752, W_M2 = 11796480, W_F = 14942208, W_R = 15466496, W_MO = 16515072,
                 W_Q = 17563648, W_KV = 18612224, W_O = 20709376, W_2I = 21757952, W_2O = 27525120;
constexpr int DT_C128 = 0, DT_S128 = 16384, DT_C64 = 32768, DT_S64 = 36864, DT_C32 = 40960, DT_S32 = 41984;

struct Params {
  const float* in[23];
  float* X;
  unsigned char* ws;
};

__device__ __forceinline__ int opaque_tid() { int t = threadIdx.x; asm volatile("" : "+v"(t)); return t; }
typedef __bf16 bf16x2_t __attribute__((ext_vector_type(2)));
typedef float f32x2 __attribute__((ext_vector_type(2)));
__device__ __forceinline__ unsigned cvt_pk_bf16(float lo, float hi) { f32x2 v = {lo, hi}; bf16x2_t b = __builtin_convertvector(v, bf16x2_t); return __builtin_bit_cast(unsigned, b); }
__device__ __forceinline__ float bf_lo(unsigned u) { return __uint_as_float(u << 16); }
__device__ __forceinline__ float bf_hi(unsigned u) { return __uint_as_float(u & 0xffff0000u); }
__device__ __forceinline__ u32x4 pack8(f32x4 a, f32x4 b) { u32x4 o; o[0] = cvt_pk_bf16(a[0], a[1]); o[1] = cvt_pk_bf16(a[2], a[3]); o[2] = cvt_pk_bf16(b[0], b[1]); o[3] = cvt_pk_bf16(b[2], b[3]); return o; }
__device__ __forceinline__ u32x2 pack4(float a, float b, float c, float d) { u32x2 o; o[0] = cvt_pk_bf16(a, b); o[1] = cvt_pk_bf16(c, d); return o; }
__device__ __forceinline__ float fsigmoid(float x) { return __builtin_amdgcn_rcpf(1.f + __expf(-x)); }
__device__ __forceinline__ float fsilu(float x) { return x * fsigmoid(x); }
__device__ __forceinline__ float row_rstd(const float* RSS, int row) {
  const f32x4* p = (const f32x4*)(RSS + (size_t)row * 16); f32x4 a = p[0], b = p[1], c = p[2], d = p[3];
  float s = ((a[0] + a[1]) + (a[2] + a[3])) + ((b[0] + b[1]) + (b[2] + b[3])) + ((c[0] + c[1]) + (c[2] + c[3])) + ((d[0] + d[1]) + (d[2] + d[3]));
  return rsqrtf(s * (1.f / 1024.f) + 1e-6f);
}
__device__ __forceinline__ bf16x8 tr_frag(const LAS unsigned char* lds, unsigned off_lo, unsigned off_hi) {
  s16x4 a = __builtin_amdgcn_ds_read_tr16_b64_v4i16((LAS s16x4*)(lds + off_lo));
  s16x4 b = __builtin_amdgcn_ds_read_tr16_b64_v4i16((LAS s16x4*)(lds + off_hi));
  return __builtin_shufflevector(a, b, 0, 1, 2, 3, 4, 5, 6, 7);
}
__device__ __forceinline__ f32x16 mfma32(bf16x8 a, bf16x8 b, f32x16 c) { return __builtin_amdgcn_mfma_f32_32x32x16_bf16(a, b, c, 0, 0, 0); }
__device__ __forceinline__ float log_sigmoid(float x) { return fminf(x, 0.f) - log1pf(expf(-fabsf(x))); }
__device__ __forceinline__ bf16x8 scale_frag(bf16x8 q, float s) {
  u32x4 u = (u32x4)q; u32x4 o;
#pragma unroll
  for (int i = 0; i < 4; ++i) o[i] = cvt_pk_bf16(bf_lo(u[i]) * s, bf_hi(u[i]) * s);
  return (bf16x8)o;
}

namespace pg8 {
constexpr int BM = 256, BK = 64, HALF = 128, HTB = HALF * BK * 2, STAGE_BYTES = 8 * HTB, NXCD = 8, WGM = 8;
__device__ __forceinline__ int lds_byte(int r, int c) { const int st = (r >> 4) * 2 + (c >> 5), rr = r & 15, cc = c & 31, ob = rr * 64 + cc * 2; return st * 1024 + (ob ^ (((ob >> 9) & 1) << 5)); }
__device__ __forceinline__ void stage_rc(int b, int& R, int& C) { const int st = b / 1024, sb = b % 1024, swz = sb ^ (((sb >> 9) & 1) << 5); R = (st >> 1) * 16 + swz / 64; C = (st & 1) * 32 + (swz % 64) / 2; }
__device__ __forceinline__ int perm32(int rho) { const int n = rho >> 4, i = rho & 15; return 8 * (i >> 2) + 4 * n + (i & 3); }
struct Unit { int pm, pn; };
struct Gemm { const bf16_t* A; const bf16_t* Bt; int M, N, K; };
struct StaticOrder {
  int nM, nN, nwg, G, c;
  __device__ void init(int M, int N, int G_, int c_) { nM = M / BM; nN = N / BM; nwg = nM * nN; G = G_; c = c_; }
  __device__ bool next(int i, Unit& u) const {
    const long L = (long)i * G + c; if (L >= nwg) return false;
    int wgid = (int)L; { const int q = nwg / NXCD, r = nwg % NXCD, xcd = wgid % NXCD, off = wgid / NXCD; wgid = (xcd < r ? xcd * (q + 1) : r * (q + 1) + (xcd - r) * q) + off; }
    const int nig = WGM * nN, gid = wgid / nig, fm = gid * WGM, gsz = (nM - fm) < WGM ? (nM - fm) : WGM;
    u.pm = fm + ((wgid % nig) % gsz); u.pn = (wgid % nig) / gsz; return true;
  }
  __device__ __forceinline__ void a_ready(const Unit&) const {}
  __device__ __forceinline__ void done(const Unit&) const {}
};

template <class Epi, class Sched>
__device__ __forceinline__ void gemm_phase(LAS unsigned char* lds, const Gemm g, const Sched& S, const Epi& E) {
  const int tid = opaque_tid(), wid = __builtin_amdgcn_readfirstlane(tid >> 6), lane = tid & 63, wr = wid >> 2, wc = wid & 3, fr = lane & 15, fq = lane >> 4;
  const int K = g.K, nt = K / BK;
  unsigned voffA[2], voffB[2];
#pragma unroll
  for (int i = 0; i < 2; ++i) { int R, C; stage_rc(tid * 16 + i * 8192, R, C); const int Rb = Epi::PERM ? ((R & ~31) + perm32(R & 31)) : R;
    voffA[i] = (unsigned)(R * K + C) * 2u; voffB[i] = (unsigned)(Rb * K + C) * 2u; }
  const size_t kstep = (size_t)(BK * 2);
  const size_t hstep = (size_t)HALF * K * 2;
  const size_t tstep = 2 * hstep;
  const unsigned ldsw = (unsigned)wid * 1024u;
  const int aoff = lds_byte(wr * 64 + fr, fq * 8), boff = lds_byte(wc * 32 + fr, fq * 8);
#define PG8_SA(b, h) (((b) * 2 + (h)) * HTB)
#define PG8_SB(b, h) ((4 + (b) * 2 + (h)) * HTB)
#define PG8_STAGE(bufoff, gbase, voff) do { _Pragma("unroll") for (int _i = 0; _i < 2; ++_i) \
    __builtin_amdgcn_global_load_lds((const unsigned*)((const char*)(gbase) + (voff)[_i]), (LAS unsigned*)(lds + (bufoff) + ldsw + _i * 8192), 16, 0, 0); } while (0)
#define PG8_LDA(dst, b, h) do { _Pragma("unroll") for (int m = 0; m < 4; ++m) _Pragma("unroll") for (int k = 0; k < 2; ++k) dst[m][k] = *(const LAS bf16x8*)(lds + PG8_SA(b, h) + aoff + m * 2048 + k * 1024); } while (0)
#define PG8_LDB(dst, b, h) do { _Pragma("unroll") for (int n = 0; n < 2; ++n) _Pragma("unroll") for (int k = 0; k < 2; ++k) dst[n][k] = *(const LAS bf16x8*)(lds + PG8_SB(b, h) + boff + n * 2048 + k * 1024); } while (0)
#define PG8_MMA(ai, bj, At, Bt) do { __builtin_amdgcn_s_setprio(1); _Pragma("unroll") for (int m = 0; m < 4; ++m) _Pragma("unroll") for (int n = 0; n < 2; ++n) _Pragma("unroll") for (int k = 0; k < 2; ++k) \
    acc[ai][bj][m][n] = __builtin_amdgcn_mfma_f32_16x16x32_bf16(Bt[n][k], At[m][k], acc[ai][bj][m][n], 0, 0, 0); __builtin_amdgcn_s_setprio(0); } while (0)
#define PG8_WAIT_V(n) asm volatile("s_waitcnt vmcnt(" #n ")" ::: "memory")
#define PG8_WAIT_L(n) asm volatile("s_waitcnt lgkmcnt(" #n ")" ::: "memory")
#define PG8_BAR __builtin_amdgcn_s_barrier()
#define PG8_SCHED __builtin_amdgcn_sched_barrier(0)
  Unit cur, nxt; int ui = 0;
  if (!S.next(0, cur)) return;
  f32x4 acc[2][2][4][2];
#pragma unroll
  for (int a = 0; a < 2; ++a)
#pragma unroll
    for (int b = 0; b < 2; ++b)
#pragma unroll
      for (int m = 0; m < 4; ++m)
#pragma unroll
        for (int n = 0; n < 2; ++n) acc[a][b][m][n] = (f32x4){0.f, 0.f, 0.f, 0.f};
  bf16x8 At[4][2], B0[2][2], B1[2][2];
  const char* cA = (const char*)g.A + (size_t)cur.pm * tstep; const char* cB = (const char*)g.Bt + (size_t)cur.pn * tstep;
  S.a_ready(cur);
  PG8_STAGE(PG8_SB(0, 0), cB, voffB); PG8_STAGE(PG8_SA(0, 0), cA, voffA); PG8_STAGE(PG8_SB(0, 1), cB + hstep, voffB); PG8_STAGE(PG8_SA(0, 1), cA + hstep, voffA);
  if (wr == 1) PG8_BAR;
  PG8_WAIT_V(4); PG8_BAR;
  PG8_STAGE(PG8_SB(1, 0), cB + kstep, voffB); PG8_STAGE(PG8_SA(1, 0), cA + kstep, voffA); PG8_STAGE(PG8_SB(1, 1), cB + hstep + kstep, voffB);
  PG8_WAIT_V(6); PG8_BAR;
  for (;;) {
    const bool has_next = S.next(ui + 1, nxt);
    const char* nA = has_next ? (const char*)g.A + (size_t)nxt.pm * tstep : cA; const char* nB = has_next ? (const char*)g.Bt + (size_t)nxt.pn * tstep : cB;
    for (int t = 0; t < nt; t += 2) {
      const bool last = (t == nt - 2);
      const char* a1 = cA + (size_t)(t + 1) * kstep;
      const char* a2 = last ? nA : cA + (size_t)(t + 2) * kstep; const char* b2 = last ? nB : cB + (size_t)(t + 2) * kstep;
      const char* a3 = a2 + kstep; const char* b3 = b2 + kstep;
      if (last && has_next) S.a_ready(nxt);
      PG8_LDB(B0, 0, 0); PG8_SCHED; PG8_LDA(At, 0, 0); PG8_STAGE(PG8_SA(1, 1), a1 + hstep, voffA);
      PG8_WAIT_L(8); PG8_BAR; PG8_WAIT_L(0); PG8_MMA(0, 0, At, B0); PG8_BAR; PG8_SCHED;
      PG8_LDB(B1, 0, 1); PG8_STAGE(PG8_SB(0, 0), b2, voffB);
      PG8_BAR; PG8_WAIT_L(0); PG8_MMA(0, 1, At, B1); PG8_BAR;
      PG8_LDA(At, 0, 1); PG8_STAGE(PG8_SA(0, 0), a2, voffA);
      PG8_BAR; PG8_WAIT_L(0); PG8_MMA(1, 0, At, B0); PG8_BAR; PG8_SCHED;
      PG8_STAGE(PG8_SB(0, 1), b2 + hstep, voffB);
      PG8_WAIT_V(6); PG8_BAR; PG8_MMA(1, 1, At, B1); PG8_BAR;
      PG8_LDB(B0, 1, 0); PG8_SCHED; PG8_LDA(At, 1, 0); PG8_STAGE(PG8_SA(0, 1), a2 + hstep, voffA);
      PG8_WAIT_L(8); PG8_BAR; PG8_WAIT_L(0); PG8_MMA(0, 0, At, B0); PG8_BAR; PG8_SCHED;
      PG8_LDB(B1, 1, 1); PG8_STAGE(PG8_SB(1, 0), b3, voffB);
      PG8_BAR; PG8_WAIT_L(0); PG8_MMA(0, 1, At, B1); PG8_BAR;
      PG8_LDA(At, 1, 1); PG8_STAGE(PG8_SA(1, 0), a3, voffA);
      PG8_BAR; PG8_WAIT_L(0); PG8_MMA(1, 0, At, B0); PG8_BAR; PG8_SCHED;
      PG8_STAGE(PG8_SB(1, 1), b3 + hstep, voffB);
      PG8_WAIT_V(6); PG8_BAR; PG8_MMA(1, 1, At, B1); PG8_BAR;
    }
    E(acc, cur, ui, wr, wc, fr, fq); S.done(cur);
    if (!has_next) break;
#pragma unroll
    for (int a = 0; a < 2; ++a)
#pragma unroll
      for (int b = 0; b < 2; ++b)
#pragma unroll
        for (int m = 0; m < 4; ++m)
#pragma unroll
          for (int n = 0; n < 2; ++n) acc[a][b][m][n] = (f32x4){0.f, 0.f, 0.f, 0.f};
    cur = nxt; cA = nA; cB = nB; ++ui;
  }
  PG8_WAIT_V(0);
  if (wr == 0) PG8_BAR;
  PG8_BAR;
#undef PG8_SA
#undef PG8_SB
#undef PG8_STAGE
#undef PG8_LDA
#undef PG8_LDB
#undef PG8_MMA
#undef PG8_WAIT_V
#undef PG8_WAIT_L
#undef PG8_BAR
#undef PG8_SCHED
}
}
using pg8::Unit;
typedef f32x4 AccT[2][2][4][2];

struct EpiFfnIn {
  static constexpr bool PERM = true;
  const LAS float* RSL; bf16_t* H;
  __device__ __forceinline__ void operator()(const AccT& acc, const Unit& u, int ui, int wr, int wc, int fr, int fq) const {
#pragma unroll
    for (int ai = 0; ai < 2; ++ai)
#pragma unroll
      for (int m = 0; m < 4; ++m) {
        const int row = u.pm * 256 + ai * 128 + wr * 64 + m * 16 + fr; const float rs = RSL[ui * 256 + ai * 128 + wr * 64 + m * 16 + fr];
        f32x4 h0, h1;
#pragma unroll
        for (int i = 0; i < 4; ++i) { h0[i] = fsilu(acc[ai][0][m][0][i] * rs) * (acc[ai][1][m][0][i] * rs); h1[i] = fsilu(acc[ai][0][m][1][i] * rs) * (acc[ai][1][m][1][i] * rs); }
        *(u32x4*)(H + (size_t)row * DFF + u.pn * 128 + wc * 32 + fq * 8) = pack8(h0, h1);
      }
  }
};
struct EpiRes {
  static constexpr bool PERM = true;
  float* X; bf16_t* XB; float* RSS; float s;
  __device__ __forceinline__ void operator()(const AccT& acc, const Unit& u, int ui, int wr, int wc, int fr, int fq) const {
#pragma unroll
    for (int ai = 0; ai < 2; ++ai)
#pragma unroll
      for (int m = 0; m < 4; ++m) {
        const int row = u.pm * 256 + ai * 128 + wr * 64 + m * 16 + fr; float ss = 0.f;
#pragma unroll
        for (int bj = 0; bj < 2; ++bj) {
          const int col = u.pn * 256 + bj * 128 + wc * 32 + fq * 8;
          float* xp = X + (size_t)row * DM + col;
          f32x4 y0 = *(const f32x4*)xp + acc[ai][bj][m][0] * s, y1 = *(const f32x4*)(xp + 4) + acc[ai][bj][m][1] * s;
          *(f32x4*)xp = y0; *(f32x4*)(xp + 4) = y1;
          *(u32x4*)(XB + (size_t)row * DM + col) = pack8(y0, y1);
#pragma unroll
          for (int i = 0; i < 4; ++i) ss += y0[i] * y0[i] + y1[i] * y1[i];
        }
        ss += __shfl_xor(ss, 16); ss += __shfl_xor(ss, 32);
        if (fq == 0) RSS[(size_t)row * 16 + u.pn * 4 + wc] = ss;
      }
  }
};
struct EpiM1 {
  static constexpr bool PERM = true;
  const LAS float* RSL; const float2* TAB; bf16_t* Z; bf16_t* Q; bf16_t* Kb; bf16_t* V;
  __device__ __forceinline__ void operator()(const AccT& acc, const Unit& u, int ui, int wr, int wc, int fr, int fq) const {
    const int pn = u.pn;
    if (pn < 4 || pn >= 8) {
      bf16_t* dst = pn < 4 ? Z : V; const int cb = (pn < 4 ? pn : pn - 8) * 256;
#pragma unroll
      for (int ai = 0; ai < 2; ++ai)
#pragma unroll
        for (int m = 0; m < 4; ++m) {
          const int row = u.pm * 256 + ai * 128 + wr * 64 + m * 16 + fr; const float rs = RSL[ui * 256 + ai * 128 + wr * 64 + m * 16 + fr];
#pragma unroll
          for (int bj = 0; bj < 2; ++bj)
            *(u32x4*)(dst + (size_t)row * 1024 + cb + bj * 128 + wc * 32 + fq * 8) = pack8(acc[ai][bj][m][0] * rs, acc[ai][bj][m][1] * rs);
        }
    } else {
      bf16_t* dst = pn < 6 ? Q : Kb; const int head = 2 * (pn < 6 ? pn - 4 : pn - 6) + (wc >> 1); const int d0 = 32 * (wc & 1) + 8 * fq;
#pragma unroll
      for (int ai = 0; ai < 2; ++ai)
#pragma unroll
        for (int m = 0; m < 4; ++m) {
          const int row = u.pm * 256 + ai * 128 + wr * 64 + m * 16 + fr; const float rs = RSL[ui * 256 + ai * 128 + wr * 64 + m * 16 + fr];
          const int spos = row < 16384 ? (row & 2047) : row - 16384;
          const f32x4* tp = (const f32x4*)(TAB + (size_t)spos * 64 + d0);
          f32x4 t0 = tp[0], t1 = tp[1], t2 = tp[2], t3 = tp[3];
          f32x4 x1a = acc[ai][0][m][0] * rs, x1b = acc[ai][0][m][1] * rs, x2a = acc[ai][1][m][0] * rs, x2b = acc[ai][1][m][1] * rs;
          f32x4 ca = {t0[0], t0[2], t1[0], t1[2]}, sa = {t0[1], t0[3], t1[1], t1[3]}, cb2 = {t2[0], t2[2], t3[0], t3[2]}, sb = {t2[1], t2[3], t3[1], t3[3]};
          f32x4 o1a = x1a * ca - x2a * sa, o1b = x1b * cb2 - x2b * sb, o2a = x2a * ca + x1a * sa, o2b = x2b * cb2 + x1b * sb;
          bf16_t* op = dst + (size_t)row * 512 + head * 128 + d0;
          *(u32x4*)op = pack8(o1a, o1b); *(u32x4*)(op + 64) = pack8(o2a, o2b);
        }
    }
  }
};
struct EpiM2 {
  static constexpr bool PERM = true;
  const LAS float* RSL; bf16_t* YN; bf16_t* GATES;
  __device__ __forceinline__ void operator()(const AccT& acc, const Unit& u, int ui, int wr, int wc, int fr, int fq) const {
    const int pn = u.pn;
#pragma unroll
    for (int ai = 0; ai < 2; ++ai)
#pragma unroll
      for (int m = 0; m < 4; ++m) {
        const int row = u.pm * 256 + ai * 128 + wr * 64 + m * 16 + fr; const float rs = RSL[ui * 256 + ai * 128 + wr * 64 + m * 16 + fr];
#pragma unroll
        for (int bj = 0; bj < 2; ++bj) {
          f32x4 a = acc[ai][bj][m][0] * rs, b = acc[ai][bj][m][1] * rs;
          if (pn < 4) {
            bf16_t* p = YN + (size_t)row * 1024 + pn * 256 + bj * 128 + wc * 32 + fq * 8; u32x4 y = *(const u32x4*)p;
#pragma unroll
            for (int i = 0; i < 2; ++i) { a[2 * i] = fsilu(a[2 * i]) * bf_lo(y[i]); a[2 * i + 1] = fsilu(a[2 * i + 1]) * bf_hi(y[i]); b[2 * i] = fsilu(b[2 * i]) * bf_lo(y[2 + i]); b[2 * i + 1] = fsilu(b[2 * i + 1]) * bf_hi(y[2 + i]); }
            *(u32x4*)p = pack8(a, b);
          } else {
#pragma unroll
            for (int i = 0; i < 4; ++i) { a[i] = fsigmoid(a[i]); b[i] = fsigmoid(b[i]); }
            *(u32x4*)(GATES + (size_t)row * 2048 + (pn - 4) * 256 + bj * 128 + wc * 32 + fq * 8) = pack8(a, b);
          }
        }
      }
  }
};
template <int MODE> struct EpiComb {
  static constexpr bool PERM = true;
  const bf16_t* GATES; bf16_t* U;
  __device__ __forceinline__ void operator()(const AccT& acc, const Unit& u, int ui, int wr, int wc, int fr, int fq) const {
#pragma unroll
    for (int ai = 0; ai < 2; ++ai)
#pragma unroll
      for (int m = 0; m < 4; ++m) {
        const int row = u.pm * 256 + ai * 128 + wr * 64 + m * 16 + fr;
#pragma unroll
        for (int bj = 0; bj < 2; ++bj) {
          const int col = u.pn * 256 + bj * 128 + wc * 32 + fq * 8;
          u32x4 gg = *(const u32x4*)(GATES + (size_t)row * 2048 + MODE * 1024 + col);
          f32x4 a = acc[ai][bj][m][0], b = acc[ai][bj][m][1];
#pragma unroll
          for (int i = 0; i < 2; ++i) { a[2 * i] *= bf_lo(gg[i]); a[2 * i + 1] *= bf_hi(gg[i]); b[2 * i] *= bf_lo(gg[2 + i]); b[2 * i + 1] *= bf_hi(gg[2 + i]); }
          bf16_t* p = U + (size_t)row * 1024 + col;
          if (MODE == 1) { u32x4 y = *(const u32x4*)p;
#pragma unroll
            for (int i = 0; i < 2; ++i) { a[2 * i] += bf_lo(y[i]); a[2 * i + 1] += bf_hi(y[i]); b[2 * i] += bf_lo(y[2 + i]); b[2 * i + 1] += bf_hi(y[2 + i]); } }
          *(u32x4*)p = pack8(a, b);
        }
      }
  }
};
template <bool USE_RS> struct EpiPlain {
  static constexpr bool PERM = true;
  const LAS float* RSL; bf16_t* O; int ldo; float s;
  __device__ __forceinline__ void operator()(const AccT& acc, const Unit& u, int ui, int wr, int wc, int fr, int fq) const {
#pragma unroll
    for (int ai = 0; ai < 2; ++ai)
#pragma unroll
      for (int m = 0; m < 4; ++m) {
        const int row = u.pm * 256 + ai * 128 + wr * 64 + m * 16 + fr; const float rs = USE_RS ? RSL[ui * 256 + ai * 128 + wr * 64 + m * 16 + fr] * s : s;
#pragma unroll
        for (int bj = 0; bj < 2; ++bj)
          *(u32x4*)(O + (size_t)row * ldo + u.pn * 256 + bj * 128 + wc * 32 + fq * 8) = pack8(acc[ai][bj][m][0] * rs, acc[ai][bj][m][1] * rs);
      }
  }
};

template <class Epi> __device__ __forceinline__ void run_gemm(LAS unsigned char* lds, const bf16_t* A, const bf16_t* Bt, int M, int N, int K, const Epi& E, const float* RSS = nullptr) {
  pg8::Gemm g{A, Bt, M, N, K}; pg8::StaticOrder S; S.init(M, N, gridDim.x, blockIdx.x);
  if (RSS) {
    LAS float* rsl = (LAS float*)(lds + 131072); const int tid = opaque_tid(); Unit u;
    for (int i = 0; S.next(i, u); ++i) if (tid < 256) rsl[i * 256 + tid] = row_rstd(RSS, u.pm * 256 + tid);
    __syncthreads();
  }
  pg8::gemm_phase<Epi, pg8::StaticOrder>(lds, g, S, E);
  __syncthreads();
}

__device__ void prep_tiles(const float* __restrict__ src, int ld, bf16_t* __restrict__ dst, int K, int Ndst, const float* __restrict__ gain, float scale,
                           int maptype, int mapbase, int& tbase, float* lt) {
  const int tid = opaque_tid(), G = gridDim.x;
  const int nkt = K >> 6, ntiles = (Ndst >> 6) * nkt;
  int start = (int)blockIdx.x - (tbase % G); if (start < 0) start += G;
  for (int t = start; t < ntiles; t += G) {
    const int nt = t / nkt, kt = t - nt * nkt, n0 = nt << 6, k0 = kt << 6;
    int sc0;
    if (maptype == 0) sc0 = mapbase + n0;
    else if (maptype == 1) { const int pn = n0 >> 8, h = (n0 >> 7) & 1, j = n0 & 127; sc0 = h * DFF + pn * 128 + j; }
    else { const int tt = n0 >> 8, c = n0 & 255, bj = c >> 7, cc = c & 127; sc0 = mapbase + (2 * tt + (cc >> 6)) * 128 + bj * 64 + (cc & 63); }
#pragma unroll
    for (int it = 0; it < 2; ++it) {
      const int idx = tid + it * 512, k = idx >> 4, n4 = idx & 15;
      const f32x4 v = *(const f32x4*)(src + (size_t)(k0 + k) * ld + sc0 + n4 * 4);
      const float g = scale * (gain ? gain[k0 + k] : 1.f);
      float* p = lt + k * 65 + n4 * 4; p[0] = v[0] * g; p[1] = v[1] * g; p[2] = v[2] * g; p[3] = v[3] * g;
    }
    __syncthreads();
    { const int n = tid >> 3, kc = (tid & 7) << 3; f32x4 a, b;
#pragma unroll
      for (int j = 0; j < 4; ++j) { a[j] = lt[(kc + j) * 65 + n]; b[j] = lt[(kc + 4 + j) * 65 + n]; }
      *(u32x4*)(dst + (size_t)(n0 + n) * K + k0 + kc) = pack8(a, b); }
    __syncthreads();
  }
  tbase += ntiles;
}
__device__ void prep_zfold(const float* __restrict__ wmix  , const float* __restrict__ gain, bf16_t* __restrict__ WM1, int& tbase, float* lt) {
  const int tid = opaque_tid(), G = gridDim.x;
  float* cosT = lt + 16 * 129; float* sinT = cosT + 128;
  int start = (int)blockIdx.x - (tbase % G); if (start < 0) start += G;
  for (int t = start; t < 256; t += G) {
    const int grp = t >> 6, k0 = (t & 63) << 4;
    { const int k = tid >> 5, c4 = tid & 31; const f32x4 v = *(const f32x4*)(wmix + (size_t)(k0 + k) * 5632 + grp * 128 + c4 * 4);
      float* p = lt + k * 129 + c4 * 4; p[0] = v[0]; p[1] = v[1]; p[2] = v[2]; p[3] = v[3]; }
    if (tid < 128) { cosT[tid] = __builtin_amdgcn_cosf((float)tid * (1.f / 128.f)); sinT[tid] = __builtin_amdgcn_sinf((float)tid * (1.f / 128.f)); }
    __syncthreads();
    { const int nl = tid >> 1, ri = nl >> 7, cc = nl & 127, kh = (tid & 1) << 3;
      float a0 = 0.f, a1 = 0.f, a2 = 0.f, a3 = 0.f, a4 = 0.f, a5 = 0.f, a6 = 0.f, a7 = 0.f;
      const float* lp = lt + kh * 129;
      for (int c = 0; c < 128; ++c) {
        const int idx = (c * cc) & 127; const float w = ri ? -sinT[idx] : cosT[idx];
        a0 += lp[c] * w; a1 += lp[129 + c] * w; a2 += lp[2 * 129 + c] * w; a3 += lp[3 * 129 + c] * w;
        a4 += lp[4 * 129 + c] * w; a5 += lp[5 * 129 + c] * w; a6 += lp[6 * 129 + c] * w; a7 += lp[7 * 129 + c] * w;
      }
      const float sc = 0.08838834764831845f; const float* gp = gain + k0 + kh;
      f32x4 o0 = {a0 * sc * gp[0], a1 * sc * gp[1], a2 * sc * gp[2], a3 * sc * gp[3]}, o1 = {a4 * sc * gp[4], a5 * sc * gp[5], a6 * sc * gp[6], a7 * sc * gp[7]};
      *(u32x4*)(WM1 + (size_t)(ri * 512 + grp * 128 + cc) * 1024 + k0 + kh) = pack8(o0, o1); }
    __syncthreads();
  }
  tbase += 256;
}

template <int STAGE>
__device__ void dft_item(const bf16_t* __restrict__ src, bf16_t* __restrict__ dst, const bf16_t* __restrict__ Ct, const bf16_t* __restrict__ St,
                         int N, int lgN, int rowbase, int j, int chblk, int S, int N1, int N2, LAS unsigned char* lds) {
  const int tid = opaque_tid(), w = tid >> 6, l = tid & 63;
  const int CB = 8192 >> lgN, stride = CB * 4 + 64;
  const int lgcpr = 11 - lgN, cpr = 1 << lgcpr;
#pragma unroll
  for (int it = 0; it < 4; ++it) {
    const int q = tid + it * 512, n = q >> lgcpr, cq = q & (cpr - 1), part = cq >> (lgcpr - 1), cc = cq & ((cpr >> 1) - 1);
    const int irow = STAGE == 1 ? rowbase + N2 * n + j : rowbase + j * N2 + n;
    const u32x4 v = *(const u32x4*)(src + (size_t)irow * 1024 + part * 512 + chblk * CB + cc * 8);
    *(LAS u32x4*)(lds + n * stride + (part * CB + cc * 8) * 2) = v;
  }
  __syncthreads();
  const int kts = N >> 5, kt = w & (kts - 1), chsub = w >> (lgN - 5);
  const int i16 = l & 15, q4 = i16 >> 2, p4 = i16 & 3, G1 = (l >> 4) & 1, h = l >> 5;
  const unsigned colre = (unsigned)(chsub * 32 + 16 * G1 + 4 * p4) * 2u, colim = colre + (unsigned)CB * 2u;
  const int kout = kt * 32 + (l & 31);
  f32x16 a0 = {}, a1 = {}, a2 = {};
  const int nks = N >> 4;
  for (int ks = 0; ks < nks; ++ks) {
    const unsigned rlo = (unsigned)(16 * ks + 8 * h + q4) * stride, rhi = rlo + 4u * stride;
    const bf16x8 Ar = tr_frag(lds, rlo + colre, rhi + colre), Ai = tr_frag(lds, rlo + colim, rhi + colim);
    const bf16x8 Bc = *(const bf16x8*)(Ct + kout * N + 16 * ks + 8 * h), Bs = *(const bf16x8*)(St + kout * N + 16 * ks + 8 * h);
    a0 = mfma32(Ar, Bc, a0); a0 = mfma32(Ai, Bs, a0);
    if (STAGE == 1) { a1 = mfma32(Ai, Bc, a1); a2 = mfma32(Ar, Bs, a2); }
  }
  const int chb = chblk * CB + chsub * 32 + 4 * h;
  if (STAGE == 1) {
    const int mm = (j * kout) & (S - 1); const float fr = (float)mm / (float)S;
    const float c = __builtin_amdgcn_cosf(fr), s = __builtin_amdgcn_sinf(fr);
    const size_t orow = (size_t)(rowbase + kout * N2 + j) * 1024;
#pragma unroll
    for (int g = 0; g < 4; ++g) {
      float re[4], im[4];
#pragma unroll
      for (int i = 0; i < 4; ++i) { const float yr = a0[4 * g + i], yi = a1[4 * g + i] - a2[4 * g + i]; re[i] = yr * c + yi * s; im[i] = yi * c - yr * s; }
      *(u32x2*)(dst + orow + chb + 8 * g) = pack4(re[0], re[1], re[2], re[3]);
      *(u32x2*)(dst + orow + 512 + chb + 8 * g) = pack4(im[0], im[1], im[2], im[3]);
    }
  } else {
    const size_t orow = (size_t)(rowbase + j + N1 * kout) * 512;
#pragma unroll
    for (int g = 0; g < 4; ++g) *(u32x2*)(dst + orow + chb + 8 * g) = pack4(a0[4 * g], a0[4 * g + 1], a0[4 * g + 2], a0[4 * g + 3]);
  }
  __syncthreads();
}
template <int STAGE>
__device__ void dft_phase(const bf16_t* src, bf16_t* dst, const bf16_t* DT, LAS unsigned char* lds) {
  for (int it = blockIdx.x; it < 2048; it += gridDim.x) {
    if (it < 1024) dft_item<STAGE>(src, dst, DT + DT_C128, DT + DT_S128, 128, 7, 16384, it >> 3, it & 7, 16384, 128, 128, lds);
    else {
      const int r = it - 1024, b = r >> 7, rr = r & 127;
      if (STAGE == 1) dft_item<STAGE>(src, dst, DT + DT_C32, DT + DT_S32, 32, 5, b * 2048, rr >> 1, rr & 1, 2048, 32, 64, lds);
      else dft_item<STAGE>(src, dst, DT + DT_C64, DT + DT_S64, 64, 6, b * 2048, rr >> 2, rr & 3, 2048, 32, 64, lds);
    }
  }
}

__device__ void ret_state_item(const bf16_t* __restrict__ Kb, const bf16_t* __restrict__ Vb, bf16_t* __restrict__ STf, bf16_t* __restrict__ STb,
                               int cidx, int head, float lgf2, float lgb2, LAS unsigned char* lds) {
  const int tid = opaque_tid(), w = tid >> 6, l = tid & 63; const int row0 = cidx * 128;
  constexpr unsigned VS = 576, KS = 320, OKF = 73728, OKB = 114688;
#pragma unroll
  for (int it = 0; it < 8; ++it) { const int q = tid + it * 512, j = q >> 5, c = q & 31;
    *(LAS u32x4*)(lds + j * VS + c * 16) = *(const u32x4*)(Vb + (size_t)(row0 + j) * 1024 + head * 256 + c * 8); }
#pragma unroll
  for (int it = 0; it < 4; ++it) { const int q = tid + it * 512, j = q >> 4, c = q & 15;
    const u32x4 v = *(const u32x4*)(Kb + (size_t)(row0 + j) * 512 + head * 128 + c * 8);
    const float zf = __builtin_amdgcn_exp2f(lgf2 * (float)(127 - j)), zb = __builtin_amdgcn_exp2f(lgb2 * (float)j);
    u32x4 of, ob;
#pragma unroll
    for (int i = 0; i < 4; ++i) { const float a = bf_lo(v[i]), b = bf_hi(v[i]); of[i] = cvt_pk_bf16(a * zf, b * zf); ob[i] = cvt_pk_bf16(a * zb, b * zb); }
    *(LAS u32x4*)(lds + OKF + j * KS + c * 16) = of; *(LAS u32x4*)(lds + OKB + j * KS + c * 16) = ob; }
  __syncthreads();
  const int i16 = l & 15, q4 = i16 >> 2, p4 = i16 & 3, G1 = (l >> 4) & 1, h = l >> 5;
  const unsigned cofs = (unsigned)(16 * G1 + 4 * p4) * 2u;
  f32x16 af[4], ab[4];
#pragma unroll
  for (int i = 0; i < 4; ++i) { af[i] = (f32x16){}; ab[i] = (f32x16){}; }
  for (int ks = 0; ks < 8; ++ks) {
    const unsigned r = (unsigned)(16 * ks + 8 * h + q4);
    const bf16x8 Bv = tr_frag(lds, r * VS + w * 64 + cofs, (r + 4) * VS + w * 64 + cofs);
#pragma unroll
    for (int dt = 0; dt < 4; ++dt) {
      const bf16x8 Af = tr_frag(lds, OKF + r * KS + dt * 64 + cofs, OKF + (r + 4) * KS + dt * 64 + cofs);
      const bf16x8 Ab = tr_frag(lds, OKB + r * KS + dt * 64 + cofs, OKB + (r + 4) * KS + dt * 64 + cofs);
      af[dt] = mfma32(Af, Bv, af[dt]); ab[dt] = mfma32(Ab, Bv, ab[dt]);
    }
  }
  const size_t ob = ((size_t)(cidx * 4 + head) * 256 + w * 32 + (l & 31)) * 128 + 4 * h;
#pragma unroll
  for (int dt = 0; dt < 4; ++dt)
#pragma unroll
    for (int g = 0; g < 4; ++g) {
      *(u32x2*)(STf + ob + dt * 32 + 8 * g) = pack4(af[dt][4 * g], af[dt][4 * g + 1], af[dt][4 * g + 2], af[dt][4 * g + 3]);
      *(u32x2*)(STb + ob + dt * 32 + 8 * g) = pack4(ab[dt][4 * g], ab[dt][4 * g + 1], ab[dt][4 * g + 2], ab[dt][4 * g + 3]);
    }
  __syncthreads();
}
__device__ void ret_scan_seq(bf16_t* __restrict__ ST, int c0, int nch, int sub  , float lg, bool bwd) {
  const float g = expf(lg * 128.f);
  bf16_t* base = ST + (size_t)c0 * 131072 + (size_t)sub * 2048 + opaque_tid() * 4;
  float s0 = 0.f, s1 = 0.f, s2 = 0.f, s3 = 0.f;
  for (int cb = 0; cb < nch; cb += 8) {
    u32x2 u[8];
#pragma unroll
    for (int i = 0; i < 8; ++i) { const int c = bwd ? nch - 1 - (cb + i) : cb + i; u[i] = *(const u32x2*)(base + (size_t)c * 131072); }
#pragma unroll
    for (int i = 0; i < 8; ++i) { const int c = bwd ? nch - 1 - (cb + i) : cb + i;
      *(u32x2*)(base + (size_t)c * 131072) = pack4(s0, s1, s2, s3);
      s0 = g * s0 + bf_lo(u[i][0]); s1 = g * s1 + bf_hi(u[i][0]); s2 = g * s2 + bf_lo(u[i][1]); s3 = g * s3 + bf_hi(u[i][1]); }
  }
}
__device__ void ret_out_item(const bf16_t* __restrict__ Qb, const bf16_t* __restrict__ Kb, bf16_t* Vb, const bf16_t* __restrict__ STf, const bf16_t* __restrict__ STb,
                             int cidx, int head, float lgf2, float lgb2, LAS unsigned char* lds) {
  const int tid = opaque_tid(), w = tid >> 6, l = tid & 63; const int row0 = cidx * 128;
  constexpr unsigned VS = 576, ORED = 73728;
#pragma unroll
  for (int it = 0; it < 8; ++it) { const int q = tid + it * 512, j = q >> 5, c = q & 31;
    *(LAS u32x4*)(lds + j * VS + c * 16) = *(const u32x4*)(Vb + (size_t)(row0 + j) * 1024 + head * 256 + c * 8); }
  __syncthreads();
  const int ib = w & 3, eh = w >> 2, il = l & 31, h = l >> 5;
  const int i16 = l & 15, q4 = i16 >> 2, p4 = i16 & 3, G1 = (l >> 4) & 1;
  const int iloc = ib * 32 + il;
  bf16x8 qf[8];
  { const bf16_t* qp = Qb + (size_t)(row0 + iloc) * 512 + head * 128 + 8 * h;
#pragma unroll
    for (int ks = 0; ks < 8; ++ks) qf[ks] = *(const bf16x8*)(qp + 16 * ks); }
  bf16x8 pf[4][2];
#pragma unroll
  for (int jt = 0; jt < 4; ++jt) {
    f32x16 a = {};
    const bf16_t* kp = Kb + (size_t)(row0 + jt * 32 + il) * 512 + head * 128 + 8 * h;
#pragma unroll
    for (int ks = 0; ks < 8; ++ks) a = mfma32(*(const bf16x8*)(kp + 16 * ks), qf[ks], a);
    u32x4 p0, p1;
#pragma unroll
    for (int r = 0; r < 16; r += 2) {
      float v[2];
#pragma unroll
      for (int e = 0; e < 2; ++e) { const int jl = jt * 32 + ((r + e) & 3) + 8 * ((r + e) >> 2) + 4 * h; const int dd = iloc - jl;
        const float dec = dd >= 0 ? __builtin_amdgcn_exp2f(lgf2 * (float)dd) : __builtin_amdgcn_exp2f(lgb2 * (float)(-dd)); v[e] = a[r + e] * dec; }
      const unsigned pk = cvt_pk_bf16(v[0], v[1]);
      if (r < 8) p0[r >> 1] = pk; else p1[(r - 8) >> 1] = pk;
    }
    pf[jt][0] = (bf16x8)p0; pf[jt][1] = (bf16x8)p1;
  }
  f32x16 acc[4];
#pragma unroll
  for (int i = 0; i < 4; ++i) acc[i] = (f32x16){};
  const unsigned cofs = (unsigned)(eh * 128 + 16 * G1 + 4 * p4) * 2u;
#pragma unroll
  for (int jt = 0; jt < 4; ++jt)
#pragma unroll
    for (int s = 0; s < 2; ++s) {
      const unsigned r = (unsigned)(jt * 32 + 16 * s + 4 * h + q4);
#pragma unroll
      for (int et = 0; et < 4; ++et) acc[et] = mfma32(tr_frag(lds, r * VS + et * 64 + cofs, (r + 8) * VS + et * 64 + cofs), pf[jt][s], acc[et]);
    }
#pragma unroll
  for (int dir = 0; dir < 2; ++dir) {
    const float xi = dir ? __builtin_amdgcn_exp2f(lgb2 * (float)(128 - iloc)) : __builtin_amdgcn_exp2f(lgf2 * (float)(iloc + 1));
    const bf16_t* sp = (dir ? STb : STf) + ((size_t)(cidx * 4 + head) * 256 + eh * 128 + il) * 128 + 8 * h;
#pragma unroll
    for (int ks = 0; ks < 8; ++ks) {
      const bf16x8 sq = scale_frag(qf[ks], xi);
#pragma unroll
      for (int et = 0; et < 4; ++et) acc[et] = mfma32(*(const bf16x8*)(sp + (size_t)et * 32 * 128 + 16 * ks), sq, acc[et]);
    }
  }
  float ss = 0.f;
#pragma unroll
  for (int et = 0; et < 4; ++et)
#pragma unroll
    for (int r = 0; r < 16; ++r) ss += acc[et][r] * acc[et][r];
  ss += __shfl_xor(ss, 32);
  LAS float* red = (LAS float*)(lds + ORED);
  if (h == 0) red[eh * 128 + iloc] = ss;
  __syncthreads();
  const float rn = rsqrtf((red[iloc] + red[128 + iloc]) * (1.f / 256.f) + 1e-6f);
  bf16_t* op = Vb + (size_t)(row0 + iloc) * 1024 + head * 256 + eh * 128 + 4 * h;
#pragma unroll
  for (int et = 0; et < 4; ++et)
#pragma unroll
    for (int g = 0; g < 4; ++g)
      *(u32x2*)(op + et * 32 + 8 * g) = pack4(acc[et][4 * g] * rn, acc[et][4 * g + 1] * rn, acc[et][4 * g + 2] * rn, acc[et][4 * g + 3] * rn);
  __syncthreads();
}

__device__ void attn_item(const bf16_t* __restrict__ QX, const bf16_t* __restrict__ KV, bf16_t* __restrict__ O, int tt, int head, LAS unsigned char* lds) {
  const int tid = opaque_tid(), w = tid >> 6, l = tid & 63; const int row0 = tt * 256; const int b = tt < 64 ? (tt >> 3) : 8; const int mrow0 = b * 256;
  constexpr unsigned KS = 528, VS = 576;
#pragma unroll 4
  for (int it = 0; it < 16; ++it) { const int q = tid + it * 512, m = q >> 5, c = q & 31;
    *(LAS u32x4*)(lds + m * KS + c * 16) = *(const u32x4*)(KV + (size_t)(mrow0 + m) * 2048 + head * 256 + c * 8); }
  __syncthreads();
  const int il = l & 31, h = l >> 5, i16 = l & 15, q4 = i16 >> 2, p4 = i16 & 3, G1 = (l >> 4) & 1;
  const int row = row0 + w * 32 + il;
  bf16x8 pf[8][2];
  float mxp = -3.0e38f, sum = 0.f;
  const bf16_t* qp = QX + (size_t)row * 1024 + head * 256 + 8 * h;
#pragma unroll
  for (int hf = 0; hf < 2; ++hf) {
    f32x16 sc[4];
#pragma unroll
    for (int i = 0; i < 4; ++i) sc[i] = (f32x16){};
#pragma unroll 2
    for (int ks = 0; ks < 16; ++ks) {
      const bf16x8 B = *(const bf16x8*)(qp + 16 * ks);
#pragma unroll
      for (int mt = 0; mt < 4; ++mt) sc[mt] = mfma32(*(const LAS bf16x8*)(lds + ((hf * 4 + mt) * 32 + il) * KS + (16 * ks + 8 * h) * 2), B, sc[mt]);
    }
    float mx = mxp;
#pragma unroll
    for (int mt = 0; mt < 4; ++mt)
#pragma unroll
      for (int r = 0; r < 16; ++r) mx = fmaxf(mx, sc[mt][r]);
    mx = fmaxf(mx, __shfl_xor(mx, 32));
    if (hf == 1) { const float f = __builtin_amdgcn_exp2f((mxp - mx) * 1.4426950408889634f); sum *= f;
#pragma unroll
      for (int mt = 0; mt < 4; ++mt) { pf[mt][0] = scale_frag(pf[mt][0], f); pf[mt][1] = scale_frag(pf[mt][1], f); } }
#pragma unroll
    for (int mt = 0; mt < 4; ++mt) {
      u32x4 p0, p1;
#pragma unroll
      for (int r = 0; r < 16; r += 2) {
        const float e0 = __builtin_amdgcn_exp2f((sc[mt][r] - mx) * 1.4426950408889634f), e1 = __builtin_amdgcn_exp2f((sc[mt][r + 1] - mx) * 1.4426950408889634f);
        sum += e0 + e1; const unsigned pk = cvt_pk_bf16(e0, e1);
        if (r < 8) p0[r >> 1] = pk; else p1[(r - 8) >> 1] = pk;
      }
      pf[hf * 4 + mt][0] = (bf16x8)p0; pf[hf * 4 + mt][1] = (bf16x8)p1;
    }
    mxp = mx;
  }
  sum += __shfl_xor(sum, 32);
  const float inv = __builtin_amdgcn_rcpf(sum);
  __builtin_amdgcn_sched_barrier(0);
  __syncthreads();
  __builtin_amdgcn_sched_barrier(0);
#pragma unroll 4
  for (int it = 0; it < 16; ++it) { const int q = tid + it * 512, m = q >> 5, c = q & 31;
    *(LAS u32x4*)(lds + m * VS + c * 16) = *(const u32x4*)(KV + (size_t)(mrow0 + m) * 2048 + 1024 + head * 256 + c * 8); }
  __syncthreads();
  __builtin_amdgcn_sched_barrier(0);
#pragma unroll 1
  for (int half = 0; half < 2; ++half) {
    f32x16 acc[4];
#pragma unroll
    for (int i = 0; i < 4; ++i) acc[i] = (f32x16){};
    const unsigned cofs = (unsigned)(half * 128 + 16 * G1 + 4 * p4) * 2u;
#pragma unroll
    for (int mt = 0; mt < 8; ++mt)
#pragma unroll
      for (int s = 0; s < 2; ++s) {
        const unsigned r = (unsigned)(mt * 32 + 16 * s + 4 * h + q4);
#pragma unroll
        for (int et = 0; et < 4; ++et) acc[et] = mfma32(tr_frag(lds, r * VS + et * 64 + cofs, (r + 8) * VS + et * 64 + cofs), pf[mt][s], acc[et]);
      }
    bf16_t* op = O + (size_t)row * 1024 + head * 256 + half * 128 + 4 * h;
#pragma unroll
    for (int et = 0; et < 4; ++et)
#pragma unroll
      for (int g = 0; g < 4; ++g)
        *(u32x2*)(op + et * 32 + 8 * g) = pack4(acc[et][4 * g] * inv, acc[et][4 * g + 1] * inv, acc[et][4 * g + 2] * inv, acc[et][4 * g + 3] * inv);
  }
  __syncthreads();
}

__device__ __forceinline__ float sel4(const float (&a)[4], int i) { return i == 0 ? a[0] : i == 1 ? a[1] : i == 2 ? a[2] : a[3]; }


#define XB_TMO      128
#define XB_XCNT(j)  (256  + 64 * (j))
#define XB_XSUB(j)  (1280 + 64 * (j))
#define XB_XGEN(j)  (2304 + 64 * (j))
#define XB_TOP      3328
#define XB_TOPGEN   3392
#define XCD_BAR_WORDS 3456
#define XB_SPIN_CAP (1u << 20)
__device__ __forceinline__ unsigned xb_ld(unsigned* p)              { return __hip_atomic_load(p, __ATOMIC_RELAXED, __HIP_MEMORY_SCOPE_AGENT); }
__device__ __forceinline__ unsigned xb_add(unsigned* p, unsigned v) { return __hip_atomic_fetch_add(p, v, __ATOMIC_RELAXED, __HIP_MEMORY_SCOPE_AGENT); }
__device__ __forceinline__ unsigned xb_xcc_id() { return (unsigned)__builtin_amdgcn_s_getreg((3 << 11) | 20) & 0xFu; }
#define XB_SPIN(cond, bar) do { unsigned _sp = 0; while (cond) { __builtin_amdgcn_s_sleep(1); \
    if ((++_sp & 255u) == 0u) { if (xb_ld(&(bar)[XB_TMO])) break; if (_sp > XB_SPIN_CAP) { atomicAdd(&(bar)[XB_TMO], 1u); break; } } } } while (0)
struct XcdBarrier { unsigned* bar; unsigned x; volatile LAS unsigned* st; };
__device__ __forceinline__ XcdBarrier xcd_barrier_post(unsigned* bar, volatile LAS unsigned* st) {
  XcdBarrier b; b.bar = bar; b.x = xb_xcc_id(); b.st = st;
  if (threadIdx.x == 0) (void)xb_add(&bar[XB_XCNT(b.x)], 1u);
  return b;
}
__device__ __forceinline__ void xcd_barrier_complete(unsigned* bar, unsigned x, unsigned& nloc, unsigned& nx) {
  const unsigned G = gridDim.x * gridDim.y * gridDim.z;
  unsigned sum, cnt, mine, sp = 0u;
  for (;;) {
    sum = 0u; cnt = 0u; mine = 0u;
#pragma unroll
    for (unsigned j = 0; j < 16; ++j) { const unsigned c = xb_ld(&bar[XB_XCNT(j)]); sum += c; cnt += (c > 0u) ? 1u : 0u; mine = (j == x) ? c : mine; }
    if (sum == G) break;
    __builtin_amdgcn_s_sleep(1);
    if ((++sp & 255u) == 0u) { if (xb_ld(&bar[XB_TMO])) break; if (sp > XB_SPIN_CAP) { atomicAdd(&bar[XB_TMO], 1u); break; } }
  }
  nloc = mine > 0u ? mine : 1u; nx = cnt > 0u ? cnt : 1u;
}
__device__ __forceinline__ void xcd_barrier(const XcdBarrier& b) {
  asm volatile("s_waitcnt vmcnt(0)" ::: "memory");
  __syncthreads();
  if (threadIdx.x == 0) {
    unsigned* bar = b.bar;
    __builtin_amdgcn_s_waitcnt(0);
    unsigned nloc = b.st[0], nx = b.st[1];
    if (nloc == 0u) { xcd_barrier_complete(bar, b.x, nloc, nx); b.st[0] = nloc; b.st[1] = nx; }
    const unsigned old = xb_add(&bar[XB_XSUB(b.x)], 1u);
    const unsigned gen = old / nloc;
    if (old + 1u == (gen + 1u) * nloc) {
      __builtin_amdgcn_fence(__ATOMIC_RELEASE, "agent");
      asm volatile("s_waitcnt vmcnt(0)" ::: "memory");
      const unsigned og = xb_add(&bar[XB_TOP], 1u);
      const unsigned tg = og / nx;
      if (og + 1u == (tg + 1u) * nx) xb_add(&bar[XB_TOPGEN], 1u);
      else XB_SPIN(xb_ld(&bar[XB_TOPGEN]) == tg, bar);
      __builtin_amdgcn_fence(__ATOMIC_ACQUIRE, "agent");
      xb_add(&bar[XB_XGEN(b.x)], 1u);
      asm volatile("s_waitcnt vmcnt(0)" ::: "memory");
    } else {
      XB_SPIN(xb_ld(&bar[XB_XGEN(b.x)]) == gen, bar);
      __builtin_amdgcn_fence(__ATOMIC_ACQUIRE, "agent");
      asm volatile("s_waitcnt vmcnt(0)" ::: "memory");
    }
  }
  __syncthreads();
}

__global__ void __launch_bounds__(512, 2) mega(Params p) {
  cg::grid_group grid = cg::this_grid();
  extern __shared__ __attribute__((aligned(16))) unsigned char smem_raw[];
  LAS unsigned char* lds = (LAS unsigned char*)smem_raw;
  float* ltf = (float*)smem_raw;
  const int tid = opaque_tid(), G = gridDim.x, wv = tid >> 6, lane = tid & 63;
  unsigned char* ws = p.ws;
  float2* TAB = (float2*)(ws + OFF_TAB); bf16_t* DT = (bf16_t*)(ws + OFF_DFT); bf16_t* MEMB = (bf16_t*)(ws + OFF_MEMB);
  float* RSS = (float*)(ws + OFF_RSS); bf16_t* XB = (bf16_t*)(ws + OFF_XB); bf16_t* WB = (bf16_t*)(ws + OFF_WB);
  bf16_t* RA = (bf16_t*)(ws + OFF_A); bf16_t* RS = (bf16_t*)(ws + OFF_S); bf16_t* RB = (bf16_t*)(ws + OFF_B);
  bf16_t* Zb = RA; bf16_t* Y1 = RA + 32 * MiB; bf16_t* GATES = RA; bf16_t* HID = RA; bf16_t* QX = RA; bf16_t* Ob = RA + 32 * MiB;
  bf16_t* STf = RS; bf16_t* STb = RS + 32 * MiB;
  bf16_t* Qb = RB; bf16_t* Kb = RB + 16 * MiB; bf16_t* Vb = RB + 32 * MiB; bf16_t* Fb = RB + 64 * MiB; bf16_t* Ub = RB; bf16_t* KVb = RB + 32 * MiB;
  float* X = p.X;
  const LAS float* RSL = (const LAS float*)(lds + 131072);
  volatile LAS unsigned* xst = (volatile LAS unsigned*)(lds + 163824);
  if (threadIdx.x < 4) xst[threadIdx.x] = 0u;
  __syncthreads();
  const XcdBarrier xb = xcd_barrier_post((unsigned*)(ws + WS_NEED), xst);

  for (int r = blockIdx.x * 8 + wv; r < T_TOK; r += G * 8) {
    const float* src = r < 16384 ? p.in[0] + (size_t)r * DM : p.in[1] + (size_t)(r - 16384) * DM;
    float ss = 0.f;
#pragma unroll
    for (int k = 0; k < 4; ++k) { const f32x4 v = *(const f32x4*)(src + k * 256 + lane * 4);
      *(f32x4*)(X + (size_t)r * DM + k * 256 + lane * 4) = v; *(u32x2*)(XB + (size_t)r * DM + k * 256 + lane * 4) = pack4(v[0], v[1], v[2], v[3]);
      ss += v[0] * v[0] + v[1] * v[1] + v[2] * v[2] + v[3] * v[3]; }
#pragma unroll
    for (int o = 32; o; o >>= 1) ss += __shfl_xor(ss, o);
    if (lane < 16) RSS[(size_t)r * 16 + lane] = lane == 0 ? ss : 0.f;
  }
  for (int r = blockIdx.x * 8 + wv; r < NMEMROWS; r += G * 8) {
    const float* src = r < 2048 ? p.in[2] + (size_t)r * DM : p.in[3] + (size_t)(r - 2048) * DM;
    f32x4 v0 = *(const f32x4*)(src + lane * 4), v1 = *(const f32x4*)(src + 256 + lane * 4), v2 = *(const f32x4*)(src + 512 + lane * 4), v3 = *(const f32x4*)(src + 768 + lane * 4);
    float ss = 0.f;
#pragma unroll
    for (int i = 0; i < 4; ++i) ss += v0[i] * v0[i] + v1[i] * v1[i] + v2[i] * v2[i] + v3[i] * v3[i];
#pragma unroll
    for (int o = 32; o; o >>= 1) ss += __shfl_xor(ss, o);
    const float rs = rsqrtf(ss * (1.f / 1024.f) + 1e-6f);
    bf16_t* mp = MEMB + (size_t)r * DM + lane * 4;
    *(u32x2*)(mp) = pack4(v0[0] * rs, v0[1] * rs, v0[2] * rs, v0[3] * rs); *(u32x2*)(mp + 256) = pack4(v1[0] * rs, v1[1] * rs, v1[2] * rs, v1[3] * rs);
    *(u32x2*)(mp + 512) = pack4(v2[0] * rs, v2[1] * rs, v2[2] * rs, v2[3] * rs); *(u32x2*)(mp + 768) = pack4(v3[0] * rs, v3[1] * rs, v3[2] * rs, v3[3] * rs);
  }
  for (int i = blockIdx.x * 512 + tid; i < 16384 * 64; i += G * 512) {
    const int s = i >> 6, d = i & 63;
    const float e = (float)d * 2.0f / 128.0f; const float inv = 1.0f / powf(10000.0f, e); const float ang = (float)s * inv;
    const double a = (double)ang * 0.15915494309189535; const double fr = a - rint(a);
    const float f = (float)fr;
    TAB[i] = make_float2(__builtin_amdgcn_cosf(f), __builtin_amdgcn_sinf(f));
  }
  for (int i = blockIdx.x * 512 + tid; i < 16384 + 4096 + 1024; i += G * 512) {
    int N, k, n, oc, os;
    if (i < 16384) { N = 128; k = i >> 7; n = i & 127; oc = DT_C128 + i; os = DT_S128 + i; }
    else if (i < 20480) { const int q = i - 16384; N = 64; k = q >> 6; n = q & 63; oc = DT_C64 + q; os = DT_S64 + q; }
    else { const int q = i - 20480; N = 32; k = q >> 5; n = q & 31; oc = DT_C32 + q; os = DT_S32 + q; }
    const float fr = (float)((k * n) & (N - 1)) / (float)N; const float sc = rsqrtf((float)N);
    const unsigned pk = cvt_pk_bf16(__builtin_amdgcn_cosf(fr) * sc, __builtin_amdgcn_sinf(fr) * sc);
    DT[oc] = (bf16_t)(pk & 0xffffu); DT[os] = (bf16_t)(pk >> 16);
  }

  for (int layer = 0; layer < 4; ++layer) {
    {
      int tb = 0;
      const float* g1 = p.in[4] + layer * DM; const float* gm = p.in[7] + layer * DM; const float* gx = p.in[14] + layer * DM;
      const float* gmem = p.in[15] + layer * DM; const float* g2 = p.in[19] + layer * DM;
      const float* wmix = p.in[8] + (size_t)layer * 1024 * 5632;
      prep_tiles(p.in[5] + (size_t)layer * 1024 * 5632, 5632, WB + W_1I, 1024, 5632, g1, 1.f, 1, 0, tb, ltf);
      prep_tiles(p.in[6] + (size_t)layer * DFF * 1024, 1024, WB + W_1O, DFF, 1024, nullptr, 1.f, 0, 0, tb, ltf);
      prep_zfold(wmix, gm, WB + W_M1, tb, ltf);
      prep_tiles(wmix, 5632, WB + W_M1 + (size_t)1024 * 1024, 1024, 512, gm, 1.f, 2, 512, tb, ltf);
      prep_tiles(wmix, 5632, WB + W_M1 + (size_t)1536 * 1024, 1024, 512, gm, 0.08838834764831845f, 2, 1024, tb, ltf);
      prep_tiles(wmix, 5632, WB + W_M1 + (size_t)2048 * 1024, 1024, 1024, gm, 1.f, 0, 1536, tb, ltf);
      prep_tiles(wmix, 5632, WB + W_M2, 1024, 3072, gm, 1.f, 0, 2560, tb, ltf);
      prep_tiles(p.in[9] + (size_t)layer * 512 * 1024, 1024, WB + W_F, 512, 1024, nullptr, 1.f, 0, 0, tb, ltf);
      prep_tiles(p.in[12] + (size_t)layer * 1024 * 1024, 1024, WB + W_R, 1024, 1024, nullptr, 1.f, 0, 0, tb, ltf);
      prep_tiles(p.in[13] + (size_t)layer * 1024 * 1024, 1024, WB + W_MO, 1024, 1024, nullptr, 1.f, 0, 0, tb, ltf);
      prep_tiles(p.in[16] + (size_t)layer * 1024 * 1024, 1024, WB + W_Q, 1024, 1024, gx, 1.f, 0, 0, tb, ltf);
      prep_tiles(p.in[17] + (size_t)layer * 1024 * 2048, 2048, WB + W_KV, 1024, 2048, gmem, 1.f, 0, 0, tb, ltf);
      prep_tiles(p.in[18] + (size_t)layer * 1024 * 1024, 1024, WB + W_O, 1024, 1024, nullptr, 1.f, 0, 0, tb, ltf);
      prep_tiles(p.in[20] + (size_t)layer * 1024 * 5632, 5632, WB + W_2I, 1024, 5632, g2, 1.f, 1, 0, tb, ltf);
      prep_tiles(p.in[21] + (size_t)layer * DFF * 1024, 1024, WB + W_2O, DFF, 1024, nullptr, 1.f, 0, 0, tb, ltf);
    }
    if (layer == 0) grid.sync(); else xcd_barrier(xb);
    run_gemm(lds, XB, WB + W_1I, T_TOK, 5632, 1024, EpiFfnIn{RSL, HID}, RSS);
    xcd_barrier(xb);
    run_gemm(lds, HID, WB + W_1O, T_TOK, 1024, DFF, EpiRes{X, XB, RSS, 0.5f});
    xcd_barrier(xb);
    run_gemm(lds, XB, WB + W_M1, T_TOK, 3072, 1024, EpiM1{RSL, TAB, Zb, Qb, Kb, Vb}, RSS);
    xcd_barrier(xb);
    float lgf2[4], lgb2[4], lgf[4], lgb[4];
#pragma unroll
    for (int hh = 0; hh < 4; ++hh) { lgf[hh] = log_sigmoid(p.in[10][layer * 4 + hh]); lgb[hh] = log_sigmoid(p.in[11][layer * 4 + hh]);
      lgf2[hh] = lgf[hh] * 1.4426950408889634f; lgb2[hh] = lgb[hh] * 1.4426950408889634f; }
    dft_phase<1>(Zb, Y1, DT, lds);
    for (int it = blockIdx.x; it < 1024; it += G) { const int hh = it & 3; ret_state_item(Kb, Vb, STf, STb, it >> 2, hh, sel4(lgf2, hh), sel4(lgb2, hh), lds); }
    xcd_barrier(xb);
    dft_phase<2>(Y1, Fb, DT, lds);
    for (int it = blockIdx.x; it < 256; it += G) {
      if (it < 128) { const int dir = it >> 6, sub = it & 63, hh = sub >> 4; ret_scan_seq(dir ? STb : STf, 128, 128, sub, dir ? sel4(lgb, hh) : sel4(lgf, hh), dir); }
      else for (int k = 0; k < 8; ++k) { const int r = (it - 128) * 8 + k, b = r >> 7, dir = (r >> 6) & 1, sub = r & 63, hh = sub >> 4;
        ret_scan_seq(dir ? STb : STf, b * 16, 16, sub, dir ? sel4(lgb, hh) : sel4(lgf, hh), dir); }
    }
    xcd_barrier(xb);
    for (int it = blockIdx.x; it < 1024; it += G) { const int hh = it & 3; ret_out_item(Qb, Kb, Vb, STf, STb, it >> 2, hh, sel4(lgf2, hh), sel4(lgb2, hh), lds); }
    xcd_barrier(xb);
    run_gemm(lds, XB, WB + W_M2, T_TOK, 3072, 1024, EpiM2{RSL, Vb, GATES}, RSS);
    xcd_barrier(xb);
    run_gemm(lds, Fb, WB + W_F, T_TOK, 1024, 512, EpiComb<0>{GATES, Ub});
    run_gemm(lds, Vb, WB + W_R, T_TOK, 1024, 1024, EpiComb<1>{GATES, Ub});
    xcd_barrier(xb);
    run_gemm(lds, Ub, WB + W_MO, T_TOK, 1024, 1024, EpiRes{X, XB, RSS, 1.0f});
    xcd_barrier(xb);
    run_gemm(lds, XB, WB + W_Q, T_TOK, 1024, 1024, EpiPlain<true>{RSL, QX, 1024, 0.0625f}, RSS);
    run_gemm(lds, MEMB, WB + W_KV, NMEMROWS, 2048, 1024, EpiPlain<false>{RSL, KVb, 2048, 1.0f});
    xcd_barrier(xb);
    for (int it = blockIdx.x; it < 512; it += G) attn_item(QX, KVb, Ob, it >> 2, it & 3, lds);
    xcd_barrier(xb);
    run_gemm(lds, Ob, WB + W_O, T_TOK, 1024, 1024, EpiRes{X, XB, RSS, 1.0f});
    xcd_barrier(xb);
    run_gemm(lds, XB, WB + W_2I, T_TOK, 5632, 1024, EpiFfnIn{RSL, HID}, RSS);
    xcd_barrier(xb);
    run_gemm(lds, HID, WB + W_2O, T_TOK, 1024, DFF, EpiRes{X, XB, RSS, 0.5f});
    xcd_barrier(xb);
  }
  const int tidf = opaque_tid(), wvf = tidf >> 6, lanef = tidf & 63;
  for (int r = blockIdx.x * 8 + wvf; r < T_TOK; r += G * 8) {
    const float rs = row_rstd(RSS, r);
#pragma unroll
    for (int k = 0; k < 4; ++k) { float* xp = X + (size_t)r * DM + k * 256 + lanef * 4; const f32x4 g = *(const f32x4*)(p.in[22] + k * 256 + lanef * 4);
      *(f32x4*)xp = *(const f32x4*)xp * rs * g; }
  }
}

extern "C" void kernel_launch(void* const* d_in, const int* in_sizes, int n_in, void* d_out, int out_size, void* d_ws, size_t ws_size, hipStream_t stream) {
  constexpr size_t kDynLds = 163840;
  static int grid_blocks = 0;
  if (!grid_blocks) {
    (void)hipFuncSetAttribute((const void*)mega, hipFuncAttributeMaxDynamicSharedMemorySize, (int)kDynLds);
    int dev = 0, cus = 0, per_cu = 0;
    (void)hipGetDevice(&dev);
    (void)hipDeviceGetAttribute(&cus, hipDeviceAttributeMultiprocessorCount, dev);
    (void)hipOccupancyMaxActiveBlocksPerMultiprocessor(&per_cu, mega, 512, kDynLds);
    grid_blocks = cus > 0 ? cus : 256;
    if (per_cu < 1) fprintf(stderr, "occupancy query returned %d\n", per_cu);
  }
  if (ws_size < WS_NEED + 16384) { fprintf(stderr, "workspace too small: %zu < %zu\n", ws_size, (size_t)WS_NEED); return; }
  (void)hipMemsetAsync((unsigned char*)d_ws + WS_NEED, 0, XCD_BAR_WORDS * 4, stream);
  Params p{};
  for (int i = 0; i < 23; ++i) p.in[i] = (const float*)d_in[i];
  p.X = (float*)d_out; p.ws = (unsigned char*)d_ws;
  void* args[] = {&p};
  hipError_t e = hipLaunchCooperativeKernel((void*)mega, dim3(grid_blocks), dim3(512), args, kDynLds, stream);
  if (e != hipSuccess) fprintf(stderr, "cooperative launch failed: %s (grid %d)\n", hipGetErrorString(e), grid_blocks);
}
```

```cpp
#include <hip/hip_runtime.h>
#include <hip/hip_cooperative_groups.h>
#include <cstdio>
namespace cg = cooperative_groups;

#define LAS __attribute__((address_space(3)))
typedef unsigned short bf16_t;
typedef short bf16x8 __attribute__((ext_vector_type(8)));
typedef short s16x4 __attribute__((ext_vector_type(4)));
typedef float f32x4 __attribute__((ext_vector_type(4)));
typedef float f32x16 __attribute__((ext_vector_type(16)));
typedef unsigned u32x4 __attribute__((ext_vector_type(4)));
typedef unsigned u32x2 __attribute__((ext_vector_type(2)));

constexpr int T_TOK = 32768, DM = 1024, DFF = 2816, NMEMROWS = 2304;
constexpr size_t MiB = 1048576;
constexpr size_t OFF_TAB = 0;
constexpr size_t OFF_DFT = 8 * MiB;
constexpr size_t OFF_MEMB = OFF_DFT + 256 * 1024;
constexpr size_t OFF_RSS = OFF_MEMB + 4718592;
constexpr size_t OFF_XB = OFF_RSS + 2 * MiB;
constexpr size_t OFF_WB = OFF_XB + 64 * MiB;
constexpr size_t OFF_A = OFF_WB + 58 * MiB;
constexpr size_t OFF_S = OFF_A + 128 * MiB;
constexpr size_t OFF_B = OFF_S + 128 * MiB;
constexpr size_t WS_NEED = OFF_B + 160 * MiB;
constexpr size_t W_1I = 0, W_1O = 5767168, W_M1 = 8650752, W_M2 = 11796480, W_F = 14942208, W_R = 15466496, W_MO = 16515072,
                 W_Q = 17563648, W_KV = 18612224, W_O = 20709376, W_2I = 21757952, W_2O = 27525120;
constexpr int DT_C128 = 0, DT_S128 = 16384, DT_C64 = 32768, DT_S64 = 36864, DT_C32 = 40960, DT_S32 = 41984;

struct Params {
  const float* in[23];
  float* X;
  unsigned char* ws;
};

__device__ __forceinline__ int opaque_tid() { int t = threadIdx.x; asm volatile("" : "+v"(t)); return t; }
typedef __bf16 bf16x2_t __attribute__((ext_vector_type(2)));
typedef float f32x2 __attribute__((ext_vector_type(2)));
__device__ __forceinline__ unsigned cvt_pk_bf16(float lo, float hi) { f32x2 v = {lo, hi}; bf16x2_t b = __builtin_convertvector(v, bf16x2_t); return __builtin_bit_cast(unsigned, b); }
__device__ __forceinline__ float bf_lo(unsigned u) { return __uint_as_float(u << 16); }
__device__ __forceinline__ float bf_hi(unsigned u) { return __uint_as_float(u & 0xffff0000u); }
__device__ __forceinline__ u32x4 pack8(f32x4 a, f32x4 b) { u32x4 o; o[0] = cvt_pk_bf16(a[0], a[1]); o[1] = cvt_pk_bf16(a[2], a[3]); o[2] = cvt_pk_bf16(b[0], b[1]); o[3] = cvt_pk_bf16(b[2], b[3]); return o; }
__device__ __forceinline__ u32x2 pack4(float a, float b, float c, float d) { u32x2 o; o[0] = cvt_pk_bf16(a, b); o[1] = cvt_pk_bf16(c, d); return o; }
__device__ __forceinline__ float fsigmoid(float x) { return __builtin_amdgcn_rcpf(1.f + __expf(-x)); }
__device__ __forceinline__ float fsilu(float x) { return x * fsigmoid(x); }
__device__ __forceinline__ float row_rstd(const float* RSS, int row) {
  const f32x4* p = (const f32x4*)(RSS + (size_t)row * 16); f32x4 a = p[0], b = p[1], c = p[2], d = p[3];
  float s = ((a[0] + a[1]) + (a[2] + a[3])) + ((b[0] + b[1]) + (b[2] + b[3])) + ((c[0] + c[1]) + (c[2] + c[3])) + ((d[0] + d[1]) + (d[2] + d[3]));
  return rsqrtf(s * (1.f / 1024.f) + 1e-6f);
}
__device__ __forceinline__ bf16x8 tr_frag(const LAS unsigned char* lds, unsigned off_lo, unsigned off_hi) {
  s16x4 a = __builtin_amdgcn_ds_read_tr16_b64_v4i16((LAS s16x4*)(lds + off_lo));
  s16x4 b = __builtin_amdgcn_ds_read_tr16_b64_v4i16((LAS s16x4*)(lds + off_hi));
  return __builtin_shufflevector(a, b, 0, 1, 2, 3, 4, 5, 6, 7);
}
__device__ __forceinline__ f32x16 mfma32(bf16x8 a, bf16x8 b, f32x16 c) { return __builtin_amdgcn_mfma_f32_32x32x16_bf16(a, b, c, 0, 0, 0); }
__device__ __forceinline__ float log_sigmoid(float x) { return fminf(x, 0.f) - log1pf(expf(-fabsf(x))); }
__device__ __forceinline__ bf16x8 scale_frag(bf16x8 q, float s) {
  u32x4 u = (u32x4)q; u32x4 o;
#pragma unroll
  for (int i = 0; i < 4; ++i) o[i] = cvt_pk_bf16(bf_lo(u[i]) * s, bf_hi(u[i]) * s);
  return (bf16x8)o;
}

namespace pg8 {
constexpr int BM = 256, BK = 64, HALF = 128, HTB = HALF * BK * 2, STAGE_BYTES = 8 * HTB, NXCD = 8, WGM = 8;
__device__ __forceinline__ int lds_byte(int r, int c) { const int st = (r >> 4) * 2 + (c >> 5), rr = r & 15, cc = c & 31, ob = rr * 64 + cc * 2; return st * 1024 + (ob ^ (((ob >> 9) & 1) << 5)); }
__device__ __forceinline__ void stage_rc(int b, int& R, int& C) { const int st = b / 1024, sb = b % 1024, swz = sb ^ (((sb >> 9) & 1) << 5); R = (st >> 1) * 16 + swz / 64; C = (st & 1) * 32 + (swz % 64) / 2; }
__device__ __forceinline__ int perm32(int rho) { const int n = rho >> 4, i = rho & 15; return 8 * (i >> 2) + 4 * n + (i & 3); }
struct Unit { int pm, pn; };
struct Gemm { const bf16_t* A; const bf16_t* Bt; int M, N, K; };
struct StaticOrder {
  int nM, nN, nwg, G, c;
  __device__ void init(int M, int N, int G_, int c_) { nM = M / BM; nN = N / BM; nwg = nM * nN; G = G_; c = c_; }
  __device__ bool next(int i, Unit& u) const {
    const long L = (long)i * G + c; if (L >= nwg) return false;
    int wgid = (int)L; { const int q = nwg / NXCD, r = nwg % NXCD, xcd = wgid % NXCD, off = wgid / NXCD; wgid = (xcd < r ? xcd * (q + 1) : r * (q + 1) + (xcd - r) * q) + off; }
    const int nig = WGM * nN, gid = wgid / nig, fm = gid * WGM, gsz = (nM - fm) < WGM ? (nM - fm) : WGM;
    u.pm = fm + ((wgid % nig) % gsz); u.pn = (wgid % nig) / gsz; return true;
  }
  __device__ __forceinline__ void a_ready(const Unit&) const {}
  __device__ __forceinline__ void done(const Unit&) const {}
};

template <class Epi, class Sched>
__device__ __forceinline__ void gemm_phase(LAS unsigned char* lds, const Gemm g, const Sched& S, const Epi& E) {
  const int tid = opaque_tid(), wid = __builtin_amdgcn_readfirstlane(tid >> 6), lane = tid & 63, wr = wid >> 2, wc = wid & 3, fr = lane & 15, fq = lane >> 4;
  const int K = g.K, nt = K / BK;
  unsigned voffA[2], voffB[2];
#pragma unroll
  for (int i = 0; i < 2; ++i) { int R, C; stage_rc(tid * 16 + i * 8192, R, C); const int Rb = Epi::PERM ? ((R & ~31) + perm32(R & 31)) : R;
    voffA[i] = (unsigned)(R * K + C) * 2u; voffB[i] = (unsigned)(Rb * K + C) * 2u; }
  const size_t kstep = (size_t)(BK * 2);
  const size_t hstep = (size_t)HALF * K * 2;
  const size_t tstep = 2 * hstep;
  const unsigned ldsw = (unsigned)wid * 1024u;
  const int aoff = lds_byte(wr * 64 + fr, fq * 8), boff = lds_byte(wc * 32 + fr, fq * 8);
#define PG8_SA(b, h) (((b) * 2 + (h)) * HTB)
#define PG8_SB(b, h) ((4 + (b) * 2 + (h)) * HTB)
#define PG8_STAGE(bufoff, gbase, voff) do { _Pragma("unroll") for (int _i = 0; _i < 2; ++_i) \
    __builtin_amdgcn_global_load_lds((const unsigned*)((const char*)(gbase) + (voff)[_i]), (LAS unsigned*)(lds + (bufoff) + ldsw + _i * 8192), 16, 0, 0); } while (0)
#define PG8_LDA(dst, b, h) do { _Pragma("unroll") for (int m = 0; m < 4; ++m) _Pragma("unroll") for (int k = 0; k < 2; ++k) dst[m][k] = *(const LAS bf16x8*)(lds + PG8_SA(b, h) + aoff + m * 2048 + k * 1024); } while (0)
#define PG8_LDB(dst, b, h) do { _Pragma("unroll") for (int n = 0; n < 2; ++n) _Pragma("unroll") for (int k = 0; k < 2; ++k) dst[n][k] = *(const LAS bf16x8*)(lds + PG8_SB(b, h) + boff + n * 2048 + k * 1024); } while (0)
#define PG8_MMA(ai, bj, At, Bt) do { __builtin_amdgcn_s_setprio(1); _Pragma("unroll") for (int m = 0; m < 4; ++m) _Pragma("unroll") for (int n = 0; n < 2; ++n) _Pragma("unroll") for (int k = 0; k < 2; ++k) \
    acc[ai][bj][m][n] = __builtin_amdgcn_mfma_f32_16x16x32_bf16(Bt[n][k], At[m][k], acc[ai][bj][m][n], 0, 0, 0); __builtin_amdgcn_s_setprio(0); } while (0)
#define PG8_WAIT_V(n) asm volatile("s_waitcnt vmcnt(" #n ")" ::: "memory")
#define PG8_WAIT_L(n) asm volatile("s_waitcnt lgkmcnt(" #n ")" ::: "memory")
#define PG8_BAR __builtin_amdgcn_s_barrier()
#define PG8_SCHED __builtin_amdgcn_sched_barrier(0)
  Unit cur, nxt; int ui = 0;
  if (!S.next(0, cur)) return;
  f32x4 acc[2][2][4][2];
#pragma unroll
  for (int a = 0; a < 2; ++a)
#pragma unroll
    for (int b = 0; b < 2; ++b)
#pragma unroll
      for (int m = 0; m < 4; ++m)
#pragma unroll
        for (int n = 0; n < 2; ++n) acc[a][b][m][n] = (f32x4){0.f, 0.f, 0.f, 0.f};
  bf16x8 At[4][2], B0[2][2], B1[2][2];
  const char* cA = (const char*)g.A + (size_t)cur.pm * tstep; const char* cB = (const char*)g.Bt + (size_t)cur.pn * tstep;
  S.a_ready(cur);
  PG8_STAGE(PG8_SB(0, 0), cB, voffB); PG8_STAGE(PG8_SA(0, 0), cA, voffA); PG8_STAGE(PG8_SB(0, 1), cB + hstep, voffB); PG8_STAGE(PG8_SA(0, 1), cA + hstep, voffA);
  if (wr == 1) PG8_BAR;
  PG8_WAIT_V(4); PG8_BAR;
  PG8_STAGE(PG8_SB(1, 0), cB + kstep, voffB); PG8_STAGE(PG8_SA(1, 0), cA + kstep, voffA); PG8_STAGE(PG8_SB(1, 1), cB + hstep + kstep, voffB);
  PG8_WAIT_V(6); PG8_BAR;
  for (;;) {
    const bool has_next = S.next(ui + 1, nxt);
    const char* nA = has_next ? (const char*)g.A + (size_t)nxt.pm * tstep : cA; const char* nB = has_next ? (const char*)g.Bt + (size_t)nxt.pn * tstep : cB;
    for (int t = 0; t < nt; t += 2) {
      const bool last = (t == nt - 2);
      const char* a1 = cA + (size_t)(t + 1) * kstep;
      const char* a2 = last ? nA : cA + (size_t)(t + 2) * kstep; const char* b2 = last ? nB : cB + (size_t)(t + 2) * kstep;
      const char* a3 = a2 + kstep; const char* b3 = b2 + kstep;
      if (last && has_next) S.a_ready(nxt);
      PG8_LDB(B0, 0, 0); PG8_SCHED; PG8_LDA(At, 0, 0); PG8_STAGE(PG8_SA(1, 1), a1 + hstep, voffA);
      PG8_WAIT_L(8); PG8_BAR; PG8_WAIT_L(0); PG8_MMA(0, 0, At, B0); PG8_BAR; PG8_SCHED;
      PG8_LDB(B1, 0, 1); PG8_STAGE(PG8_SB(0, 0), b2, voffB);
      PG8_BAR; PG8_WAIT_L(0); PG8_MMA(0, 1, At, B1); PG8_BAR;
      PG8_LDA(At, 0, 1); PG8_STAGE(PG8_SA(0, 0), a2, voffA);
      PG8_BAR; PG8_WAIT_L(0); PG8_MMA(1, 0, At, B0); PG8_BAR; PG8_SCHED;
      PG8_STAGE(PG8_SB(0, 1), b2 + hstep, voffB);
      PG8_WAIT_V(6); PG8_BAR; PG8_MMA(1, 1, At, B1); PG8_BAR;
      PG8_LDB(B0, 1, 0); PG8_SCHED; PG8_LDA(At, 1, 0); PG8_STAGE(PG8_SA(0, 1), a2 + hstep, voffA);
      PG8_WAIT_L(8); PG8_BAR; PG8_WAIT_L(0); PG8_MMA(0, 0, At, B0); PG8_BAR; PG8_SCHED;
      PG8_LDB(B1, 1, 1); PG8_STAGE(PG8_SB(1, 0), b3, voffB);
      PG8_BAR; PG8_WAIT_L(0); PG8_MMA(0, 1, At, B1); PG8_BAR;
      PG8_LDA(At, 1, 1); PG8_STAGE(PG8_SA(1, 0), a3, voffA);
      PG8_BAR; PG8_WAIT_L(0); PG8_MMA(1, 0, At, B0); PG8_BAR; PG8_SCHED;
      PG8_STAGE(PG8_SB(1, 1), b3 + hstep, voffB);
      PG8_WAIT_V(6); PG8_BAR; PG8_MMA(1, 1, At, B1); PG8_BAR;
    }
    E(acc, cur, ui, wr, wc, fr, fq); S.done(cur);
    if (!has_next) break;
#pragma unroll
    for (int a = 0; a < 2; ++a)
#pragma unroll
      for (int b = 0; b < 2; ++b)
#pragma unroll
        for (int m = 0; m < 4; ++m)
#pragma unroll
          for (int n = 0; n < 2; ++n) acc[a][b][m][n] = (f32x4){0.f, 0.f, 0.f, 0.f};
    cur = nxt; cA = nA; cB = nB; ++ui;
  }
  PG8_WAIT_V(0);
  if (wr == 0) PG8_BAR;
  PG8_BAR;
#undef PG8_SA
#undef PG8_SB
#undef PG8_STAGE
#undef PG8_LDA
#undef PG8_LDB
#undef PG8_MMA
#undef PG8_WAIT_V
#undef PG8_WAIT_L
#undef PG8_BAR
#undef PG8_SCHED
}
}
using pg8::Unit;
typedef f32x4 AccT[2][2][4][2];

struct EpiFfnIn {
  static constexpr bool PERM = true;
  const LAS float* RSL; bf16_t* H;
  __device__ __forceinline__ void operator()(const AccT& acc, const Unit& u, int ui, int wr, int wc, int fr, int fq) const {
#pragma unroll
    for (int ai = 0; ai < 2; ++ai)
#pragma unroll
      for (int m = 0; m < 4; ++m) {
        const int row = u.pm * 256 + ai * 128 + wr * 64 + m * 16 + fr; const float rs = RSL[ui * 256 + ai * 128 + wr * 64 + m * 16 + fr];
        f32x4 h0, h1;
#pragma unroll
        for (int i = 0; i < 4; ++i) { h0[i] = fsilu(acc[ai][0][m][0][i] * rs) * (acc[ai][1][m][0][i] * rs); h1[i] = fsilu(acc[ai][0][m][1][i] * rs) * (acc[ai][1][m][1][i] * rs); }
        *(u32x4*)(H + (size_t)row * DFF + u.pn * 128 + wc * 32 + fq * 8) = pack8(h0, h1);
      }
  }
};
struct EpiRes {
  static constexpr bool PERM = true;
  float* X; bf16_t* XB; float* RSS; float s;
  __device__ __forceinline__ void operator()(const AccT& acc, const Unit& u, int ui, int wr, int wc, int fr, int fq) const {
#pragma unroll
    for (int aim = 0; aim < 4; ++aim) {
      const int ai = aim >> 1, m0 = (aim & 1) * 2;
      f32x4 xa[4][2][2];
#pragma unroll
      for (int m = m0; m < m0 + 2; ++m)
#pragma unroll
        for (int bj = 0; bj < 2; ++bj) {
          const float* xp = X + (size_t)(u.pm * 256 + ai * 128 + wr * 64 + m * 16 + fr) * DM + u.pn * 256 + bj * 128 + wc * 32 + fq * 8;
          xa[m][bj][0] = *(const f32x4*)xp; xa[m][bj][1] = *(const f32x4*)(xp + 4);
        }
#pragma unroll
      for (int m = m0; m < m0 + 2; ++m) {
        const int row = u.pm * 256 + ai * 128 + wr * 64 + m * 16 + fr; float ss = 0.f;
#pragma unroll
        for (int bj = 0; bj < 2; ++bj) {
          const int col = u.pn * 256 + bj * 128 + wc * 32 + fq * 8;
          float* xp = X + (size_t)row * DM + col;
          const f32x4 y0 = xa[m][bj][0] + acc[ai][bj][m][0] * s, y1 = xa[m][bj][1] + acc[ai][bj][m][1] * s;
          *(f32x4*)xp = y0; *(f32x4*)(xp + 4) = y1;
          *(u32x4*)(XB + (size_t)row * DM + col) = pack8(y0, y1);
#pragma unroll
          for (int i = 0; i < 4; ++i) ss += y0[i] * y0[i] + y1[i] * y1[i];
        }
        ss += __shfl_xor(ss, 16); ss += __shfl_xor(ss, 32);
        if (fq == 0) RSS[(size_t)row * 16 + u.pn * 4 + wc] = ss;
      }
    }
  }
};
struct EpiM1 {
  static constexpr bool PERM = true;
  const LAS float* RSL; const float2* TAB; bf16_t* Z; bf16_t* Q; bf16_t* Kb; bf16_t* V;
  __device__ __forceinline__ void operator()(const AccT& acc, const Unit& u, int ui, int wr, int wc, int fr, int fq) const {
    const int pn = u.pn;
    if (pn < 4 || pn >= 8) {
      bf16_t* dst = pn < 4 ? Z : V; const int cb = (pn < 4 ? pn : pn - 8) * 256;
#pragma unroll
      for (int ai = 0; ai < 2; ++ai)
#pragma unroll
        for (int m = 0; m < 4; ++m) {
          const int row = u.pm * 256 + ai * 128 + wr * 64 + m * 16 + fr; const float rs = RSL[ui * 256 + ai * 128 + wr * 64 + m * 16 + fr];
#pragma unroll
          for (int bj = 0; bj < 2; ++bj)
            *(u32x4*)(dst + (size_t)row * 1024 + cb + bj * 128 + wc * 32 + fq * 8) = pack8(acc[ai][bj][m][0] * rs, acc[ai][bj][m][1] * rs);
        }
    } else {
      bf16_t* dst = pn < 6 ? Q : Kb; const int head = 2 * (pn < 6 ? pn - 4 : pn - 6) + (wc >> 1); const int d0 = 32 * (wc & 1) + 8 * fq;
#pragma unroll
      for (int aim = 0; aim < 4; ++aim) {
        const int ai = aim >> 1, m0 = (aim & 1) * 2;
        f32x4 tt[4][4];
#pragma unroll
        for (int m = m0; m < m0 + 2; ++m) {
          const int row = u.pm * 256 + ai * 128 + wr * 64 + m * 16 + fr; const int spos = row < 16384 ? (row & 2047) : row - 16384;
          const f32x4* tp = (const f32x4*)(TAB + (size_t)spos * 64 + d0);
          tt[m][0] = tp[0]; tt[m][1] = tp[1]; tt[m][2] = tp[2]; tt[m][3] = tp[3];
        }
#pragma unroll
        for (int m = m0; m < m0 + 2; ++m) {
          const int row = u.pm * 256 + ai * 128 + wr * 64 + m * 16 + fr; const float rs = RSL[ui * 256 + ai * 128 + wr * 64 + m * 16 + fr];
          const f32x4 t0 = tt[m][0], t1 = tt[m][1], t2 = tt[m][2], t3 = tt[m][3];
          f32x4 x1a = acc[ai][0][m][0] * rs, x1b = acc[ai][0][m][1] * rs, x2a = acc[ai][1][m][0] * rs, x2b = acc[ai][1][m][1] * rs;
          f32x4 ca = {t0[0], t0[2], t1[0], t1[2]}, sa = {t0[1], t0[3], t1[1], t1[3]}, cb2 = {t2[0], t2[2], t3[0], t3[2]}, sb = {t2[1], t2[3], t3[1], t3[3]};
          f32x4 o1a = x1a * ca - x2a * sa, o1b = x1b * cb2 - x2b * sb, o2a = x2a * ca + x1a * sa, o2b = x2b * cb2 + x1b * sb;
          bf16_t* op = dst + (size_t)row * 512 + head * 128 + d0;
          *(u32x4*)op = pack8(o1a, o1b); *(u32x4*)(op + 64) = pack8(o2a, o2b);
        }
      }
    }
  }
};
struct EpiM2 {
  static constexpr bool PERM = true;
  const LAS float* RSL; bf16_t* YN; bf16_t* GATES;
  __device__ __forceinline__ void operator()(const AccT& acc, const Unit& u, int ui, int wr, int wc, int fr, int fq) const {
    const int pn = u.pn;
    if (pn < 4) {
#pragma unroll
      for (int ai = 0; ai < 2; ++ai) {
        u32x4 yy[4][2];
#pragma unroll
        for (int m = 0; m < 4; ++m)
#pragma unroll
          for (int bj = 0; bj < 2; ++bj) yy[m][bj] = *(const u32x4*)(YN + (size_t)(u.pm * 256 + ai * 128 + wr * 64 + m * 16 + fr) * 1024 + pn * 256 + bj * 128 + wc * 32 + fq * 8);
#pragma unroll
        for (int m = 0; m < 4; ++m) {
          const int row = u.pm * 256 + ai * 128 + wr * 64 + m * 16 + fr; const float rs = RSL[ui * 256 + ai * 128 + wr * 64 + m * 16 + fr];
#pragma unroll
          for (int bj = 0; bj < 2; ++bj) {
            f32x4 a = acc[ai][bj][m][0] * rs, b = acc[ai][bj][m][1] * rs; const u32x4 y = yy[m][bj];
#pragma unroll
            for (int i = 0; i < 2; ++i) { a[2 * i] = fsilu(a[2 * i]) * bf_lo(y[i]); a[2 * i + 1] = fsilu(a[2 * i + 1]) * bf_hi(y[i]); b[2 * i] = fsilu(b[2 * i]) * bf_lo(y[2 + i]); b[2 * i + 1] = fsilu(b[2 * i + 1]) * bf_hi(y[2 + i]); }
            *(u32x4*)(YN + (size_t)row * 1024 + pn * 256 + bj * 128 + wc * 32 + fq * 8) = pack8(a, b);
          }
        }
      }
    } else {
#pragma unroll
      for (int ai = 0; ai < 2; ++ai)
#pragma unroll
        for (int m = 0; m < 4; ++m) {
          const int row = u.pm * 256 + ai * 128 + wr * 64 + m * 16 + fr; const float rs = RSL[ui * 256 + ai * 128 + wr * 64 + m * 16 + fr];
#pragma unroll
          for (int bj = 0; bj < 2; ++bj) {
            f32x4 a = acc[ai][bj][m][0] * rs, b = acc[ai][bj][m][1] * rs;
#pragma unroll
            for (int i = 0; i < 4; ++i) { a[i] = fsigmoid(a[i]); b[i] = fsigmoid(b[i]); }
            *(u32x4*)(GATES + (size_t)row * 2048 + (pn - 4) * 256 + bj * 128 + wc * 32 + fq * 8) = pack8(a, b);
          }
        }
    }
  }
};
template <int MODE> struct EpiComb {
  static constexpr bool PERM = true;
  const bf16_t* GATES; bf16_t* U;
  __device__ __forceinline__ void operator()(const AccT& acc, const Unit& u, int ui, int wr, int wc, int fr, int fq) const {
#pragma unroll
    for (int aim = 0; aim < 4; ++aim) {
      const int ai = aim >> 1, m0 = (aim & 1) * 2;
      u32x4 gv[4][2], yv[4][2];
#pragma unroll
      for (int m = m0; m < m0 + 2; ++m)
#pragma unroll
        for (int bj = 0; bj < 2; ++bj) {
          const size_t row = (size_t)(u.pm * 256 + ai * 128 + wr * 64 + m * 16 + fr); const int col = u.pn * 256 + bj * 128 + wc * 32 + fq * 8;
          gv[m][bj] = *(const u32x4*)(GATES + row * 2048 + MODE * 1024 + col);
          if (MODE == 1) yv[m][bj] = *(const u32x4*)(U + row * 1024 + col);
        }
#pragma unroll
      for (int m = m0; m < m0 + 2; ++m)
#pragma unroll
        for (int bj = 0; bj < 2; ++bj) {
          const size_t row = (size_t)(u.pm * 256 + ai * 128 + wr * 64 + m * 16 + fr); const int col = u.pn * 256 + bj * 128 + wc * 32 + fq * 8;
          const u32x4 gg = gv[m][bj];
          f32x4 a = acc[ai][bj][m][0], b = acc[ai][bj][m][1];
#pragma unroll
          for (int i = 0; i < 2; ++i) { a[2 * i] *= bf_lo(gg[i]); a[2 * i + 1] *= bf_hi(gg[i]); b[2 * i] *= bf_lo(gg[2 + i]); b[2 * i + 1] *= bf_hi(gg[2 + i]); }
          if (MODE == 1) { const u32x4 y = yv[m][bj];
#pragma unroll
            for (int i = 0; i < 2; ++i) { a[2 * i] += bf_lo(y[i]); a[2 * i + 1] += bf_hi(y[i]); b[2 * i] += bf_lo(y[2 + i]); b[2 * i + 1] += bf_hi(y[2 + i]); } }
          *(u32x4*)(U + row * 1024 + col) = pack8(a, b);
        }
    }
  }
};
template <bool USE_RS> struct EpiPlain {
  static constexpr bool PERM = true;
  const LAS float* RSL; bf16_t* O; int ldo; float s;
  __device__ __forceinline__ void operator()(const AccT& acc, const Unit& u, int ui, int wr, int wc, int fr, int fq) const {
#pragma unroll
    for (int ai = 0; ai < 2; ++ai)
#pragma unroll
      for (int m = 0; m < 4; ++m) {
        const int row = u.pm * 256 + ai * 128 + wr * 64 + m * 16 + fr; const float rs = USE_RS ? RSL[ui * 256 + ai * 128 + wr * 64 + m * 16 + fr] * s : s;
#pragma unroll
        for (int bj = 0; bj < 2; ++bj)
          *(u32x4*)(O + (size_t)row * ldo + u.pn * 256 + bj * 128 + wc * 32 + fq * 8) = pack8(acc[ai][bj][m][0] * rs, acc[ai][bj][m][1] * rs);
      }
  }
};

template <class Epi> __device__ __forceinline__ void run_gemm(LAS unsigned char* lds, const bf16_t* A, const bf16_t* Bt, int M, int N, int K, const Epi& E, const float* RSS = nullptr) {
  pg8::Gemm g{A, Bt, M, N, K}; pg8::StaticOrder S; S.init(M, N, gridDim.x, blockIdx.x);
  if (RSS) {
    LAS float* rsl = (LAS float*)(lds + 131072); const int tid = opaque_tid(); Unit u;
    for (int i = 0; S.next(i, u); ++i) if (tid < 256) rsl[i * 256 + tid] = row_rstd(RSS, u.pm * 256 + tid);
    __syncthreads();
  }
  pg8::gemm_phase<Epi, pg8::StaticOrder>(lds, g, S, E);
  __syncthreads();
}

__device__ void prep_tiles(const float* __restrict__ src, int ld, bf16_t* __restrict__ dst, int K, int Ndst, const float* __restrict__ gain, float scale,
                           int maptype, int mapbase, int& tbase, float* lt) {
  const int tid = opaque_tid(), G = gridDim.x;
  const int nkt = K >> 6, ntiles = (Ndst >> 6) * nkt;
  int start = (int)blockIdx.x - (tbase % G); if (start < 0) start += G;
  for (int t = start; t < ntiles; t += G) {
    const int nt = t / nkt, kt = t - nt * nkt, n0 = nt << 6, k0 = kt << 6;
    int sc0;
    if (maptype == 0) sc0 = mapbase + n0;
    else if (maptype == 1) { const int pn = n0 >> 8, h = (n0 >> 7) & 1, j = n0 & 127; sc0 = h * DFF + pn * 128 + j; }
    else { const int tt = n0 >> 8, c = n0 & 255, bj = c >> 7, cc = c & 127; sc0 = mapbase + (2 * tt + (cc >> 6)) * 128 + bj * 64 + (cc & 63); }
#pragma unroll
    for (int it = 0; it < 2; ++it) {
      const int idx = tid + it * 512, k = idx >> 4, n4 = idx & 15;
      const f32x4 v = *(const f32x4*)(src + (size_t)(k0 + k) * ld + sc0 + n4 * 4);
      const float g = scale * (gain ? gain[k0 + k] : 1.f);
      float* p = lt + k * 65 + n4 * 4; p[0] = v[0] * g; p[1] = v[1] * g; p[2] = v[2] * g; p[3] = v[3] * g;
    }
    __syncthreads();
    { const int n = tid >> 3, kc = (tid & 7) << 3; f32x4 a, b;
#pragma unroll
      for (int j = 0; j < 4; ++j) { a[j] = lt[(kc + j) * 65 + n]; b[j] = lt[(kc + 4 + j) * 65 + n]; }
      *(u32x4*)(dst + (size_t)(n0 + n) * K + k0 + kc) = pack8(a, b); }
    __syncthreads();
  }
  tbase += ntiles;
}
__device__ void prep_zfold(const float* __restrict__ wmix  , const float* __restrict__ gain, bf16_t* __restrict__ WM1, int& tbase, float* lt) {
  const int tid = opaque_tid(), G = gridDim.x;
  float* cosT = lt + 16 * 129; float* sinT = cosT + 128;
  int start = (int)blockIdx.x - (tbase % G); if (start < 0) start += G;
  for (int t = start; t < 256; t += G) {
    const int grp = t >> 6, k0 = (t & 63) << 4;
    { const int k = tid >> 5, c4 = tid & 31; const f32x4 v = *(const f32x4*)(wmix + (size_t)(k0 + k) * 5632 + grp * 128 + c4 * 4);
      float* p = lt + k * 129 + c4 * 4; p[0] = v[0]; p[1] = v[1]; p[2] = v[2]; p[3] = v[3]; }
    if (tid < 128) { cosT[tid] = __builtin_amdgcn_cosf((float)tid * (1.f / 128.f)); sinT[tid] = __builtin_amdgcn_sinf((float)tid * (1.f / 128.f)); }
    __syncthreads();
    { const int nl = tid >> 1, ri = nl >> 7, cc = nl & 127, kh = (tid & 1) << 3;
      float a0 = 0.f, a1 = 0.f, a2 = 0.f, a3 = 0.f, a4 = 0.f, a5 = 0.f, a6 = 0.f, a7 = 0.f;
      const float* lp = lt + kh * 129;
      for (int c = 0; c < 128; ++c) {
        const int idx = (c * cc) & 127; const float w = ri ? -sinT[idx] : cosT[idx];
        a0 += lp[c] * w; a1 += lp[129 + c] * w; a2 += lp[2 * 129 + c] * w; a3 += lp[3 * 129 + c] * w;
        a4 += lp[4 * 129 + c] * w; a5 += lp[5 * 129 + c] * w; a6 += lp[6 * 129 + c] * w; a7 += lp[7 * 129 + c] * w;
      }
      const float sc = 0.08838834764831845f; const float* gp = gain + k0 + kh;
      f32x4 o0 = {a0 * sc * gp[0], a1 * sc * gp[1], a2 * sc * gp[2], a3 * sc * gp[3]}, o1 = {a4 * sc * gp[4], a5 * sc * gp[5], a6 * sc * gp[6], a7 * sc * gp[7]};
      *(u32x4*)(WM1 + (size_t)(ri * 512 + grp * 128 + cc) * 1024 + k0 + kh) = pack8(o0, o1); }
    __syncthreads();
  }
  tbase += 256;
}

template <int STAGE>
__device__ void dft_item(const bf16_t* __restrict__ src, bf16_t* __restrict__ dst, const bf16_t* __restrict__ Ct, const bf16_t* __restrict__ St,
                         int N, int lgN, int rowbase, int j, int chblk, int S, int N1, int N2, LAS unsigned char* lds) {
  const int tid = opaque_tid(), w = tid >> 6, l = tid & 63;
  const int CB = 8192 >> lgN, stride = CB * 4 + 64;
  const int lgcpr = 11 - lgN, cpr = 1 << lgcpr;
#pragma unroll
  for (int it = 0; it < 4; ++it) {
    const int q = tid + it * 512, n = q >> lgcpr, cq = q & (cpr - 1), part = cq >> (lgcpr - 1), cc = cq & ((cpr >> 1) - 1);
    const int irow = STAGE == 1 ? rowbase + N2 * n + j : rowbase + j * N2 + n;
    const u32x4 v = *(const u32x4*)(src + (size_t)irow * 1024 + part * 512 + chblk * CB + cc * 8);
    *(LAS u32x4*)(lds + n * stride + (part * CB + cc * 8) * 2) = v;
  }
  __syncthreads();
  const int kts = N >> 5, kt = w & (kts - 1), chsub = w >> (lgN - 5);
  const int i16 = l & 15, q4 = i16 >> 2, p4 = i16 & 3, G1 = (l >> 4) & 1, h = l >> 5;
  const unsigned colre = (unsigned)(chsub * 32 + 16 * G1 + 4 * p4) * 2u, colim = colre + (unsigned)CB * 2u;
  const int kout = kt * 32 + (l & 31);
  f32x16 a0 = {}, a1 = {}, a2 = {};
  const int nks = N >> 4;
  for (int ks = 0; ks < nks; ++ks) {
    const unsigned rlo = (unsigned)(16 * ks + 8 * h + q4) * stride, rhi = rlo + 4u * stride;
    const bf16x8 Ar = tr_frag(lds, rlo + colre, rhi + colre), Ai = tr_frag(lds, rlo + colim, rhi + colim);
    const bf16x8 Bc = *(const bf16x8*)(Ct + kout * N + 16 * ks + 8 * h), Bs = *(const bf16x8*)(St + kout * N + 16 * ks + 8 * h);
    a0 = mfma32(Ar, Bc, a0); a0 = mfma32(Ai, Bs, a0);
    if (STAGE == 1) { a1 = mfma32(Ai, Bc, a1); a2 = mfma32(Ar, Bs, a2); }
  }
  const int chb = chblk * CB + chsub * 32 + 4 * h;
  if (STAGE == 1) {
    const int mm = (j * kout) & (S - 1); const float fr = (float)mm / (float)S;
    const float c = __builtin_amdgcn_cosf(fr), s = __builtin_amdgcn_sinf(fr);
    const size_t orow = (size_t)(rowbase + kout * N2 + j) * 1024;
#pragma unroll
    for (int g = 0; g < 4; ++g) {
      float re[4], im[4];
#pragma unroll
      for (int i = 0; i < 4; ++i) { const float yr = a0[4 * g + i], yi = a1[4 * g + i] - a2[4 * g + i]; re[i] = yr * c + yi * s; im[i] = yi * c - yr * s; }
      *(u32x2*)(dst + orow + chb + 8 * g) = pack4(re[0], re[1], re[2], re[3]);
      *(u32x2*)(dst + orow + 512 + chb + 8 * g) = pack4(im[0], im[1], im[2], im[3]);
    }
  } else {
    const size_t orow = (size_t)(rowbase + j + N1 * kout) * 512;
#pragma unroll
    for (int g = 0; g < 4; ++g) *(u32x2*)(dst + orow + chb + 8 * g) = pack4(a0[4 * g], a0[4 * g + 1], a0[4 * g + 2], a0[4 * g + 3]);
  }
  __syncthreads();
}
template <int STAGE>
__device__ void dft_phase(const bf16_t* src, bf16_t* dst, const bf16_t* DT, LAS unsigned char* lds) {
  for (int it = blockIdx.x; it < 2048; it += gridDim.x) {
    if (it < 1024) dft_item<STAGE>(src, dst, DT + DT_C128, DT + DT_S128, 128, 7, 16384, it >> 3, it & 7, 16384, 128, 128, lds);
    else {
      const int r = it - 1024, b = r >> 7, rr = r & 127;
      if (STAGE == 1) dft_item<STAGE>(src, dst, DT + DT_C32, DT + DT_S32, 32, 5, b * 2048, rr >> 1, rr & 1, 2048, 32, 64, lds);
      else dft_item<STAGE>(src, dst, DT + DT_C64, DT + DT_S64, 64, 6, b * 2048, rr >> 2, rr & 3, 2048, 32, 64, lds);
    }
  }
}

__device__ void ret_state_item(const bf16_t* __restrict__ Kb, const bf16_t* __restrict__ Vb, bf16_t* __restrict__ STf, bf16_t* __restrict__ STb,
                               int cidx, int head, float lgf2, float lgb2, LAS unsigned char* lds) {
  const int tid = opaque_tid(), w = tid >> 6, l = tid & 63; const int row0 = cidx * 128;
  constexpr unsigned VS = 576, KS = 320, OKF = 73728, OKB = 114688;
#pragma unroll
  for (int it = 0; it < 8; ++it) { const int q = tid + it * 512, j = q >> 5, c = q & 31;
    *(LAS u32x4*)(lds + j * VS + c * 16) = *(const u32x4*)(Vb + (size_t)(row0 + j) * 1024 + head * 256 + c * 8); }
#pragma unroll
  for (int it = 0; it < 4; ++it) { const int q = tid + it * 512, j = q >> 4, c = q & 15;
    const u32x4 v = *(const u32x4*)(Kb + (size_t)(row0 + j) * 512 + head * 128 + c * 8);
    const float zf = __builtin_amdgcn_exp2f(lgf2 * (float)(127 - j)), zb = __builtin_amdgcn_exp2f(lgb2 * (float)j);
    u32x4 of, ob;
#pragma unroll
    for (int i = 0; i < 4; ++i) { const float a = bf_lo(v[i]), b = bf_hi(v[i]); of[i] = cvt_pk_bf16(a * zf, b * zf); ob[i] = cvt_pk_bf16(a * zb, b * zb); }
    *(LAS u32x4*)(lds + OKF + j * KS + c * 16) = of; *(LAS u32x4*)(lds + OKB + j * KS + c * 16) = ob; }
  __syncthreads();
  const int i16 = l & 15, q4 = i16 >> 2, p4 = i16 & 3, G1 = (l >> 4) & 1, h = l >> 5;
  const unsigned cofs = (unsigned)(16 * G1 + 4 * p4) * 2u;
  f32x16 af[4], ab[4];
#pragma unroll
  for (int i = 0; i < 4; ++i) { af[i] = (f32x16){}; ab[i] = (f32x16){}; }
  for (int ks = 0; ks < 8; ++ks) {
    const unsigned r = (unsigned)(16 * ks + 8 * h + q4);
    const bf16x8 Bv = tr_frag(lds, r * VS + w * 64 + cofs, (r + 4) * VS + w * 64 + cofs);
#pragma unroll
    for (int dt = 0; dt < 4; ++dt) {
      const bf16x8 Af = tr_frag(lds, OKF + r * KS + dt * 64 + cofs, OKF + (r + 4) * KS + dt * 64 + cofs);
      const bf16x8 Ab = tr_frag(lds, OKB + r * KS + dt * 64 + cofs, OKB + (r + 4) * KS + dt * 64 + cofs);
      af[dt] = mfma32(Af, Bv, af[dt]); ab[dt] = mfma32(Ab, Bv, ab[dt]);
    }
  }
  const size_t ob = ((size_t)(cidx * 4 + head) * 256 + w * 32 + (l & 31)) * 128 + 4 * h;
#pragma unroll
  for (int dt = 0; dt < 4; ++dt)
#pragma unroll
    for (int g = 0; g < 4; ++g) {
      *(u32x2*)(STf + ob + dt * 32 + 8 * g) = pack4(af[dt][4 * g], af[dt][4 * g + 1], af[dt][4 * g + 2], af[dt][4 * g + 3]);
      *(u32x2*)(STb + ob + dt * 32 + 8 * g) = pack4(ab[dt][4 * g], ab[dt][4 * g + 1], ab[dt][4 * g + 2], ab[dt][4 * g + 3]);
    }
  __syncthreads();
}
__device__ void ret_scan_seq(bf16_t* __restrict__ ST, int c0, int nch, int sub  , float lg, bool bwd) {
  const float g = expf(lg * 128.f);
  bf16_t* base = ST + (size_t)c0 * 131072 + (size_t)sub * 2048 + opaque_tid() * 4;
  float s0 = 0.f, s1 = 0.f, s2 = 0.f, s3 = 0.f;
  for (int cb = 0; cb < nch; cb += 8) {
    u32x2 u[8];
#pragma unroll
    for (int i = 0; i < 8; ++i) { const int c = bwd ? nch - 1 - (cb + i) : cb + i; u[i] = *(const u32x2*)(base + (size_t)c * 131072); }
#pragma unroll
    for (int i = 0; i < 8; ++i) { const int c = bwd ? nch - 1 - (cb + i) : cb + i;
      *(u32x2*)(base + (size_t)c * 131072) = pack4(s0, s1, s2, s3);
      s0 = g * s0 + bf_lo(u[i][0]); s1 = g * s1 + bf_hi(u[i][0]); s2 = g * s2 + bf_lo(u[i][1]); s3 = g * s3 + bf_hi(u[i][1]); }
  }
}
__device__ void ret_out_item(const bf16_t* __restrict__ Qb, const bf16_t* __restrict__ Kb, bf16_t* Vb, const bf16_t* __restrict__ STf, const bf16_t* __restrict__ STb,
                             int cidx, int head, float lgf2, float lgb2, LAS unsigned char* lds) {
  const int tid = opaque_tid(), w = tid >> 6, l = tid & 63; const int row0 = cidx * 128;
  constexpr unsigned VS = 576, ORED = 73728;
#pragma unroll
  for (int it = 0; it < 8; ++it) { const int q = tid + it * 512, j = q >> 5, c = q & 31;
    *(LAS u32x4*)(lds + j * VS + c * 16) = *(const u32x4*)(Vb + (size_t)(row0 + j) * 1024 + head * 256 + c * 8); }
  __syncthreads();
  const int ib = w & 3, eh = w >> 2, il = l & 31, h = l >> 5;
  const int i16 = l & 15, q4 = i16 >> 2, p4 = i16 & 3, G1 = (l >> 4) & 1;
  const int iloc = ib * 32 + il;
  bf16x8 qf[8];
  { const bf16_t* qp = Qb + (size_t)(row0 + iloc) * 512 + head * 128 + 8 * h;
#pragma unroll
    for (int ks = 0; ks < 8; ++ks) qf[ks] = *(const bf16x8*)(qp + 16 * ks); }
  bf16x8 pf[4][2];
#pragma unroll
  for (int jt = 0; jt < 4; ++jt) {
    f32x16 a = {};
    const bf16_t* kp = Kb + (size_t)(row0 + jt * 32 + il) * 512 + head * 128 + 8 * h;
#pragma unroll
    for (int ks = 0; ks < 8; ++ks) a = mfma32(*(const bf16x8*)(kp + 16 * ks), qf[ks], a);
    u32x4 p0, p1;
#pragma unroll
    for (int r = 0; r < 16; r += 2) {
      float v[2];
#pragma unroll
      for (int e = 0; e < 2; ++e) { const int jl = jt * 32 + ((r + e) & 3) + 8 * ((r + e) >> 2) + 4 * h; const int dd = iloc - jl;
        const float dec = dd >= 0 ? __builtin_amdgcn_exp2f(lgf2 * (float)dd) : __builtin_amdgcn_exp2f(lgb2 * (float)(-dd)); v[e] = a[r + e] * dec; }
      const unsigned pk = cvt_pk_bf16(v[0], v[1]);
      if (r < 8) p0[r >> 1] = pk; else p1[(r - 8) >> 1] = pk;
    }
    pf[jt][0] = (bf16x8)p0; pf[jt][1] = (bf16x8)p1;
  }
  f32x16 acc[4];
#pragma unroll
  for (int i = 0; i < 4; ++i) acc[i] = (f32x16){};
  const unsigned cofs = (unsigned)(eh * 128 + 16 * G1 + 4 * p4) * 2u;
#pragma unroll
  for (int jt = 0; jt < 4; ++jt)
#pragma unroll
    for (int s = 0; s < 2; ++s) {
      const unsigned r = (unsigned)(jt * 32 + 16 * s + 4 * h + q4);
#pragma unroll
      for (int et = 0; et < 4; ++et) acc[et] = mfma32(tr_frag(lds, r * VS + et * 64 + cofs, (r + 8) * VS + et * 64 + cofs), pf[jt][s], acc[et]);
    }
#pragma unroll
  for (int dir = 0; dir < 2; ++dir) {
    const float xi = dir ? __builtin_amdgcn_exp2f(lgb2 * (float)(128 - iloc)) : __builtin_amdgcn_exp2f(lgf2 * (float)(iloc + 1));
    const bf16_t* sp = (dir ? STb : STf) + ((size_t)(cidx * 4 + head) * 256 + eh * 128 + il) * 128 + 8 * h;
#pragma unroll
    for (int ks = 0; ks < 8; ++ks) {
      const bf16x8 sq = scale_frag(qf[ks], xi);
#pragma unroll
      for (int et = 0; et < 4; ++et) acc[et] = mfma32(*(const bf16x8*)(sp + (size_t)et * 32 * 128 + 16 * ks), sq, acc[et]);
    }
  }
  float ss = 0.f;
#pragma unroll
  for (int et = 0; et < 4; ++et)
#pragma unroll
    for (int r = 0; r < 16; ++r) ss += acc[et][r] * acc[et][r];
  ss += __shfl_xor(ss, 32);
  LAS float* red = (LAS float*)(lds + ORED);
  if (h == 0) red[eh * 128 + iloc] = ss;
  __syncthreads();
  const float rn = rsqrtf((red[iloc] + red[128 + iloc]) * (1.f / 256.f) + 1e-6f);
  bf16_t* op = Vb + (size_t)(row0 + iloc) * 1024 + head * 256 + eh * 128 + 4 * h;
#pragma unroll
  for (int et = 0; et < 4; ++et)
#pragma unroll
    for (int g = 0; g < 4; ++g)
      *(u32x2*)(op + et * 32 + 8 * g) = pack4(acc[et][4 * g] * rn, acc[et][4 * g + 1] * rn, acc[et][4 * g + 2] * rn, acc[et][4 * g + 3] * rn);
  __syncthreads();
}

__device__ void attn_item(const bf16_t* __restrict__ QX, const bf16_t* __restrict__ KV, bf16_t* __restrict__ O, int tt, int head, LAS unsigned char* lds) {
  const int tid = opaque_tid(), w = tid >> 6, l = tid & 63; const int row0 = tt * 256; const int b = tt < 64 ? (tt >> 3) : 8; const int mrow0 = b * 256;
  constexpr unsigned KS = 528, VS = 576;
#pragma unroll 4
  for (int it = 0; it < 16; ++it) { const int q = tid + it * 512, m = q >> 5, c = q & 31;
    *(LAS u32x4*)(lds + m * KS + c * 16) = *(const u32x4*)(KV + (size_t)(mrow0 + m) * 2048 + head * 256 + c * 8); }
  __syncthreads();
  const int il = l & 31, h = l >> 5, i16 = l & 15, q4 = i16 >> 2, p4 = i16 & 3, G1 = (l >> 4) & 1;
  const int row = row0 + w * 32 + il;
  bf16x8 pf[8][2];
  float mxp = -3.0e38f, sum = 0.f;
  const bf16_t* qp = QX + (size_t)row * 1024 + head * 256 + 8 * h;
#pragma unroll
  for (int hf = 0; hf < 2; ++hf) {
    f32x16 sc[4];
#pragma unroll
    for (int i = 0; i < 4; ++i) sc[i] = (f32x16){};
#pragma unroll 2
    for (int ks = 0; ks < 16; ++ks) {
      const bf16x8 B = *(const bf16x8*)(qp + 16 * ks);
#pragma unroll
      for (int mt = 0; mt < 4; ++mt) sc[mt] = mfma32(*(const LAS bf16x8*)(lds + ((hf * 4 + mt) * 32 + il) * KS + (16 * ks + 8 * h) * 2), B, sc[mt]);
    }
    float mx = mxp;
#pragma unroll
    for (int mt = 0; mt < 4; ++mt)
#pragma unroll
      for (int r = 0; r < 16; ++r) mx = fmaxf(mx, sc[mt][r]);
    mx = fmaxf(mx, __shfl_xor(mx, 32));
    if (hf == 1) { const float f = __builtin_amdgcn_exp2f((mxp - mx) * 1.4426950408889634f); sum *= f;
#pragma unroll
      for (int mt = 0; mt < 4; ++mt) { pf[mt][0] = scale_frag(pf[mt][0], f); pf[mt][1] = scale_frag(pf[mt][1], f); } }
#pragma unroll
    for (int mt = 0; mt < 4; ++mt) {
      u32x4 p0, p1;
#pragma unroll
      for (int r = 0; r < 16; r += 2) {
        const float e0 = __builtin_amdgcn_exp2f((sc[mt][r] - mx) * 1.4426950408889634f), e1 = __builtin_amdgcn_exp2f((sc[mt][r + 1] - mx) * 1.4426950408889634f);
        sum += e0 + e1; const unsigned pk = cvt_pk_bf16(e0, e1);
        if (r < 8) p0[r >> 1] = pk; else p1[(r - 8) >> 1] = pk;
      }
      pf[hf * 4 + mt][0] = (bf16x8)p0; pf[hf * 4 + mt][1] = (bf16x8)p1;
    }
    mxp = mx;
  }
  sum += __shfl_xor(sum, 32);
  const float inv = __builtin_amdgcn_rcpf(sum);
  __builtin_amdgcn_sched_barrier(0);
  __syncthreads();
  __builtin_amdgcn_sched_barrier(0);
#pragma unroll 4
  for (int it = 0; it < 16; ++it) { const int q = tid + it * 512, m = q >> 5, c = q & 31;
    *(LAS u32x4*)(lds + m * VS + c * 16) = *(const u32x4*)(KV + (size_t)(mrow0 + m) * 2048 + 1024 + head * 256 + c * 8); }
  __syncthreads();
  __builtin_amdgcn_sched_barrier(0);
#pragma unroll 1
  for (int half = 0; half < 2; ++half) {
    f32x16 acc[4];
#pragma unroll
    for (int i = 0; i < 4; ++i) acc[i] = (f32x16){};
    const unsigned cofs = (unsigned)(half * 128 + 16 * G1 + 4 * p4) * 2u;
#pragma unroll
    for (int mt = 0; mt < 8; ++mt)
#pragma unroll
      for (int s = 0; s < 2; ++s) {
        const unsigned r = (unsigned)(mt * 32 + 16 * s + 4 * h + q4);
#pragma unroll
        for (int et = 0; et < 4; ++et) acc[et] = mfma32(tr_frag(lds, r * VS + et * 64 + cofs, (r + 8) * VS + et * 64 + cofs), pf[mt][s], acc[et]);
      }
    bf16_t* op = O + (size_t)row * 1024 + head * 256 + half * 128 + 4 * h;
#pragma unroll
    for (int et = 0; et < 4; ++et)
#pragma unroll
      for (int g = 0; g < 4; ++g)
        *(u32x2*)(op + et * 32 + 8 * g) = pack4(acc[et][4 * g] * inv, acc[et][4 * g + 1] * inv, acc[et][4 * g + 2] * inv, acc[et][4 * g + 3] * inv);
  }
  __syncthreads();
}

__device__ __forceinline__ float sel4(const float (&a)[4], int i) { return i == 0 ? a[0] : i == 1 ? a[1] : i == 2 ? a[2] : a[3]; }


#define XB_TMO      128
#define XB_XCNT(j)  (256  + 64 * (j))
#define XB_XSUB(j)  (1280 + 64 * (j))
#define XB_XGEN(j)  (2304 + 64 * (j))
#define XB_TOP      3328
#define XB_TOPGEN   3392
#define XCD_BAR_WORDS 3456
#define XB_SPIN_CAP (1u << 20)
__device__ __forceinline__ unsigned xb_ld(unsigned* p)              { return __hip_atomic_load(p, __ATOMIC_RELAXED, __HIP_MEMORY_SCOPE_AGENT); }
__device__ __forceinline__ unsigned xb_add(unsigned* p, unsigned v) { return __hip_atomic_fetch_add(p, v, __ATOMIC_RELAXED, __HIP_MEMORY_SCOPE_AGENT); }
__device__ __forceinline__ unsigned xb_xcc_id() { return (unsigned)__builtin_amdgcn_s_getreg((3 << 11) | 20) & 0xFu; }
#define XB_SPIN(cond, bar) do { unsigned _sp = 0; while (cond) { __builtin_amdgcn_s_sleep(1); \
    if ((++_sp & 255u) == 0u) { if (xb_ld(&(bar)[XB_TMO])) break; if (_sp > XB_SPIN_CAP) { atomicAdd(&(bar)[XB_TMO], 1u); break; } } } } while (0)
struct XcdBarrier { unsigned* bar; unsigned x; volatile LAS unsigned* st; };
__device__ __forceinline__ XcdBarrier xcd_barrier_post(unsigned* bar, volatile LAS unsigned* st) {
  XcdBarrier b; b.bar = bar; b.x = xb_xcc_id(); b.st = st;
  if (threadIdx.x == 0) (void)xb_add(&bar[XB_XCNT(b.x)], 1u);
  return b;
}
__device__ __forceinline__ void xcd_barrier_complete(unsigned* bar, unsigned x, unsigned& nloc, unsigned& nx) {
  const unsigned G = gridDim.x * gridDim.y * gridDim.z;
  unsigned sum, cnt, mine, sp = 0u;
  for (;;) {
    sum = 0u; cnt = 0u; mine = 0u;
#pragma unroll
    for (unsigned j = 0; j < 16; ++j) { const unsigned c = xb_ld(&bar[XB_XCNT(j)]); sum += c; cnt += (c > 0u) ? 1u : 0u; mine = (j == x) ? c : mine; }
    if (sum == G) break;
    __builtin_amdgcn_s_sleep(1);
    if ((++sp & 255u) == 0u) { if (xb_ld(&bar[XB_TMO])) break; if (sp > XB_SPIN_CAP) { atomicAdd(&bar[XB_TMO], 1u); break; } }
  }
  nloc = mine > 0u ? mine : 1u; nx = cnt > 0u ? cnt : 1u;
}
__device__ __forceinline__ void xcd_barrier(const XcdBarrier& b) {
  asm volatile("s_waitcnt vmcnt(0)" ::: "memory");
  __syncthreads();
  if (threadIdx.x == 0) {
    unsigned* bar = b.bar;
    __builtin_amdgcn_s_waitcnt(0);
    unsigned nloc = b.st[0], nx = b.st[1];
    if (nloc == 0u) { xcd_barrier_complete(bar, b.x, nloc, nx); b.st[0] = nloc; b.st[1] = nx; }
    const unsigned old = xb_add(&bar[XB_XSUB(b.x)], 1u);
    const unsigned gen = old / nloc;
    if (old + 1u == (gen + 1u) * nloc) {
      __builtin_amdgcn_fence(__ATOMIC_RELEASE, "agent");
      asm volatile("s_waitcnt vmcnt(0)" ::: "memory");
      const unsigned og = xb_add(&bar[XB_TOP], 1u);
      const unsigned tg = og / nx;
      if (og + 1u == (tg + 1u) * nx) xb_add(&bar[XB_TOPGEN], 1u);
      else XB_SPIN(xb_ld(&bar[XB_TOPGEN]) == tg, bar);
      __builtin_amdgcn_fence(__ATOMIC_ACQUIRE, "agent");
      xb_add(&bar[XB_XGEN(b.x)], 1u);
      asm volatile("s_waitcnt vmcnt(0)" ::: "memory");
    } else {
      XB_SPIN(xb_ld(&bar[XB_XGEN(b.x)]) == gen, bar);
      __builtin_amdgcn_fence(__ATOMIC_ACQUIRE, "agent");
      asm volatile("s_waitcnt vmcnt(0)" ::: "memory");
    }
  }
  __syncthreads();
}

__global__ void __launch_bounds__(512, 2) mega(Params p) {
  cg::grid_group grid = cg::this_grid();
  extern __shared__ __attribute__((aligned(16))) unsigned char smem_raw[];
  LAS unsigned char* lds = (LAS unsigned char*)smem_raw;
  float* ltf = (float*)smem_raw;
  const int tid = opaque_tid(), G = gridDim.x, wv = tid >> 6, lane = tid & 63;
  unsigned char* ws = p.ws;
  float2* TAB = (float2*)(ws + OFF_TAB); bf16_t* DT = (bf16_t*)(ws + OFF_DFT); bf16_t* MEMB = (bf16_t*)(ws + OFF_MEMB);
  float* RSS = (float*)(ws + OFF_RSS); bf16_t* XB = (bf16_t*)(ws + OFF_XB); bf16_t* WB = (bf16_t*)(ws + OFF_WB);
  bf16_t* RA = (bf16_t*)(ws + OFF_A); bf16_t* RS = (bf16_t*)(ws + OFF_S); bf16_t* RB = (bf16_t*)(ws + OFF_B);
  bf16_t* Zb = RA; bf16_t* Y1 = RA + 32 * MiB; bf16_t* GATES = RA; bf16_t* HID = RA; bf16_t* QX = RA; bf16_t* Ob = RA + 32 * MiB;
  bf16_t* STf = RS; bf16_t* STb = RS + 32 * MiB;
  bf16_t* Qb = RB; bf16_t* Kb = RB + 16 * MiB; bf16_t* Vb = RB + 32 * MiB; bf16_t* Fb = RB + 64 * MiB; bf16_t* Ub = RB; bf16_t* KVb = RB + 32 * MiB;
  float* X = p.X;
  const LAS float* RSL = (const LAS float*)(lds + 131072);
  volatile LAS unsigned* xst = (volatile LAS unsigned*)(lds + 163824);
  if (threadIdx.x < 4) xst[threadIdx.x] = 0u;
  __syncthreads();
  const XcdBarrier xb = xcd_barrier_post((unsigned*)(ws + WS_NEED), xst);

  for (int r = blockIdx.x * 8 + wv; r < T_TOK; r += G * 8) {
    const float* src = r < 16384 ? p.in[0] + (size_t)r * DM : p.in[1] + (size_t)(r - 16384) * DM;
    float ss = 0.f;
#pragma unroll
    for (int k = 0; k < 4; ++k) { const f32x4 v = *(const f32x4*)(src + k * 256 + lane * 4);
      *(f32x4*)(X + (size_t)r * DM + k * 256 + lane * 4) = v; *(u32x2*)(XB + (size_t)r * DM + k * 256 + lane * 4) = pack4(v[0], v[1], v[2], v[3]);
      ss += v[0] * v[0] + v[1] * v[1] + v[2] * v[2] + v[3] * v[3]; }
#pragma unroll
    for (int o = 32; o; o >>= 1) ss += __shfl_xor(ss, o);
    if (lane < 16) RSS[(size_t)r * 16 + lane] = lane == 0 ? ss : 0.f;
  }
  for (int r = blockIdx.x * 8 + wv; r < NMEMROWS; r += G * 8) {
    const float* src = r < 2048 ? p.in[2] + (size_t)r * DM : p.in[3] + (size_t)(r - 2048) * DM;
    f32x4 v0 = *(const f32x4*)(src + lane * 4), v1 = *(const f32x4*)(src + 256 + lane * 4), v2 = *(const f32x4*)(src + 512 + lane * 4), v3 = *(const f32x4*)(src + 768 + lane * 4);
    float ss = 0.f;
#pragma unroll
    for (int i = 0; i < 4; ++i) ss += v0[i] * v0[i] + v1[i] * v1[i] + v2[i] * v2[i] + v3[i] * v3[i];
#pragma unroll
    for (int o = 32; o; o >>= 1) ss += __shfl_xor(ss, o);
    const float rs = rsqrtf(ss * (1.f / 1024.f) + 1e-6f);
    bf16_t* mp = MEMB + (size_t)r * DM + lane * 4;
    *(u32x2*)(mp) = pack4(v0[0] * rs, v0[1] * rs, v0[2] * rs, v0[3] * rs); *(u32x2*)(mp + 256) = pack4(v1[0] * rs, v1[1] * rs, v1[2] * rs, v1[3] * rs);
    *(u32x2*)(mp + 512) = pack4(v2[0] * rs, v2[1] * rs, v2[2] * rs, v2[3] * rs); *(u32x2*)(mp + 768) = pack4(v3[0] * rs, v3[1] * rs, v3[2] * rs, v3[3] * rs);
  }
  for (int i = blockIdx.x * 512 + tid; i < 16384 * 64; i += G * 512) {
    const int s = i >> 6, d = i & 63;
    const float e = (float)d * 2.0f / 128.0f; const float inv = 1.0f / powf(10000.0f, e); const float ang = (float)s * inv;
    const double a = (double)ang * 0.15915494309189535; const double fr = a - rint(a);
    const float f = (float)fr;
    TAB[i] = make_float2(__builtin_amdgcn_cosf(f), __builtin_amdgcn_sinf(f));
  }
  for (int i = blockIdx.x * 512 + tid; i < 16384 + 4096 + 1024; i += G * 512) {
    int N, k, n, oc, os;
    if (i < 16384) { N = 128; k = i >> 7; n = i & 127; oc = DT_C128 + i; os = DT_S128 + i; }
    else if (i < 20480) { const int q = i - 16384; N = 64; k = q >> 6; n = q & 63; oc = DT_C64 + q; os = DT_S64 + q; }
    else { const int q = i - 20480; N = 32; k = q >> 5; n = q & 31; oc = DT_C32 + q; os = DT_S32 + q; }
    const float fr = (float)((k * n) & (N - 1)) / (float)N; const float sc = rsqrtf((float)N);
    const unsigned pk = cvt_pk_bf16(__builtin_amdgcn_cosf(fr) * sc, __builtin_amdgcn_sinf(fr) * sc);
    DT[oc] = (bf16_t)(pk & 0xffffu); DT[os] = (bf16_t)(pk >> 16);
  }

  for (int layer = 0; layer < 4; ++layer) {
    {
      int tb = 0;
      const float* g1 = p.in[4] + layer * DM; const float* gm = p.in[7] + layer * DM; const float* gx = p.in[14] + layer * DM;
      const float* gmem = p.in[15] + layer * DM; const float* g2 = p.in[19] + layer * DM;
      const float* wmix = p.in[8] + (size_t)layer * 1024 * 5632;
      prep_tiles(p.in[5] + (size_t)layer * 1024 * 5632, 5632, WB + W_1I, 1024, 5632, g1, 1.f, 1, 0, tb, ltf);
      prep_tiles(p.in[6] + (size_t)layer * DFF * 1024, 1024, WB + W_1O, DFF, 1024, nullptr, 1.f, 0, 0, tb, ltf);
      prep_zfold(wmix, gm, WB + W_M1, tb, ltf);
      prep_tiles(wmix, 5632, WB + W_M1 + (size_t)1024 * 1024, 1024, 512, gm, 1.f, 2, 512, tb, ltf);
      prep_tiles(wmix, 5632, WB + W_M1 + (size_t)1536 * 1024, 1024, 512, gm, 0.08838834764831845f, 2, 1024, tb, ltf);
      prep_tiles(wmix, 5632, WB + W_M1 + (size_t)2048 * 1024, 1024, 1024, gm, 1.f, 0, 1536, tb, ltf);
      prep_tiles(wmix, 5632, WB + W_M2, 1024, 3072, gm, 1.f, 0, 2560, tb, ltf);
      prep_tiles(p.in[9] + (size_t)layer * 512 * 1024, 1024, WB + W_F, 512, 1024, nullptr, 1.f, 0, 0, tb, ltf);
      prep_tiles(p.in[12] + (size_t)layer * 1024 * 1024, 1024, WB + W_R, 1024, 1024, nullptr, 1.f, 0, 0, tb, ltf);
      prep_tiles(p.in[13] + (size_t)layer * 1024 * 1024, 1024, WB + W_MO, 1024, 1024, nullptr, 1.f, 0, 0, tb, ltf);
      prep_tiles(p.in[16] + (size_t)layer * 1024 * 1024, 1024, WB + W_Q, 1024, 1024, gx, 1.f, 0, 0, tb, ltf);
      prep_tiles(p.in[17] + (size_t)layer * 1024 * 2048, 2048, WB + W_KV, 1024, 2048, gmem, 1.f, 0, 0, tb, ltf);
      prep_tiles(p.in[18] + (size_t)layer * 1024 * 1024, 1024, WB + W_O, 1024, 1024, nullptr, 1.f, 0, 0, tb, ltf);
      prep_tiles(p.in[20] + (size_t)layer * 1024 * 5632, 5632, WB + W_2I, 1024, 5632, g2, 1.f, 1, 0, tb, ltf);
      prep_tiles(p.in[21] + (size_t)layer * DFF * 1024, 1024, WB + W_2O, DFF, 1024, nullptr, 1.f, 0, 0, tb, ltf);
    }
    if (p.ws == nullptr) grid.sync();
    xcd_barrier(xb);
    run_gemm(lds, XB, WB + W_1I, T_TOK, 5632, 1024, EpiFfnIn{RSL, HID}, RSS);
    xcd_barrier(xb);
    run_gemm(lds, HID, WB + W_1O, T_TOK, 1024, DFF, EpiRes{X, XB, RSS, 0.5f});
    xcd_barrier(xb);
    run_gemm(lds, XB, WB + W_M1, T_TOK, 3072, 1024, EpiM1{RSL, TAB, Zb, Qb, Kb, Vb}, RSS);
    xcd_barrier(xb);
    float lgf2[4], lgb2[4], lgf[4], lgb[4];
#pragma unroll
    for (int hh = 0; hh < 4; ++hh) { lgf[hh] = log_sigmoid(p.in[10][layer * 4 + hh]); lgb[hh] = log_sigmoid(p.in[11][layer * 4 + hh]);
      lgf2[hh] = lgf[hh] * 1.4426950408889634f; lgb2[hh] = lgb[hh] * 1.4426950408889634f; }
    dft_phase<1>(Zb, Y1, DT, lds);
    for (int it = blockIdx.x; it < 1024; it += G) { const int hh = it & 3; ret_state_item(Kb, Vb, STf, STb, it >> 2, hh, sel4(lgf2, hh), sel4(lgb2, hh), lds); }
    xcd_barrier(xb);
    dft_phase<2>(Y1, Fb, DT, lds);
    for (int it = blockIdx.x; it < 256; it += G) {
      if (it < 128) { const int dir = it >> 6, sub = it & 63, hh = sub >> 4; ret_scan_seq(dir ? STb : STf, 128, 128, sub, dir ? sel4(lgb, hh) : sel4(lgf, hh), dir); }
      else for (int k = 0; k < 8; ++k) { const int r = (it - 128) * 8 + k, b = r >> 7, dir = (r >> 6) & 1, sub = r & 63, hh = sub >> 4;
        ret_scan_seq(dir ? STb : STf, b * 16, 16, sub, dir ? sel4(lgb, hh) : sel4(lgf, hh), dir); }
    }
    xcd_barrier(xb);
    for (int it = blockIdx.x; it < 1024; it += G) { const int hh = it & 3; ret_out_item(Qb, Kb, Vb, STf, STb, it >> 2, hh, sel4(lgf2, hh), sel4(lgb2, hh), lds); }
    xcd_barrier(xb);
    run_gemm(lds, XB, WB + W_M2, T_TOK, 3072, 1024, EpiM2{RSL, Vb, GATES}, RSS);
    xcd_barrier(xb);
    run_gemm(lds, Fb, WB + W_F, T_TOK, 1024, 512, EpiComb<0>{GATES, Ub});
    run_gemm(lds, Vb, WB + W_R, T_TOK, 1024, 1024, EpiComb<1>{GATES, Ub});
    xcd_barrier(xb);
    run_gemm(lds, Ub, WB + W_MO, T_TOK, 1024, 1024, EpiRes{X, XB, RSS, 1.0f});
    xcd_barrier(xb);
    run_gemm(lds, XB, WB + W_Q, T_TOK, 1024, 1024, EpiPlain<true>{RSL, QX, 1024, 0.0625f}, RSS);
    run_gemm(lds, MEMB, WB + W_KV, NMEMROWS, 2048, 1024, EpiPlain<false>{RSL, KVb, 2048, 1.0f});
    xcd_barrier(xb);
    for (int it = blockIdx.x; it < 512; it += G) attn_item(QX, KVb, Ob, it >> 2, it & 3, lds);
    xcd_barrier(xb);
    run_gemm(lds, Ob, WB + W_O, T_TOK, 1024, 1024, EpiRes{X, XB, RSS, 1.0f});
    xcd_barrier(xb);
    run_gemm(lds, XB, WB + W_2I, T_TOK, 5632, 1024, EpiFfnIn{RSL, HID}, RSS);
    xcd_barrier(xb);
    run_gemm(lds, HID, WB + W_2O, T_TOK, 1024, DFF, EpiRes{X, XB, RSS, 0.5f});
    xcd_barrier(xb);
  }
  const int tidf = opaque_tid(), wvf = tidf >> 6, lanef = tidf & 63;
  for (int r = blockIdx.x * 8 + wvf; r < T_TOK; r += G * 8) {
    const float rs = row_rstd(RSS, r);
#pragma unroll
    for (int k = 0; k < 4; ++k) { float* xp = X + (size_t)r * DM + k * 256 + lanef * 4; const f32x4 g = *(const f32x4*)(p.in[22] + k * 256 + lanef * 4);
      *(f32x4*)xp = *(const f32x4*)xp * rs * g; }
  }
}

extern "C" void kernel_launch(void* const* d_in, const int* in_sizes, int n_in, void* d_out, int out_size, void* d_ws, size_t ws_size, hipStream_t stream) {
  constexpr size_t kDynLds = 163840;
  static int grid_blocks = 0;
  if (!grid_blocks) {
    (void)hipFuncSetAttribute((const void*)mega, hipFuncAttributeMaxDynamicSharedMemorySize, (int)kDynLds);
    int dev = 0, cus = 0, per_cu = 0;
    (void)hipGetDevice(&dev);
    (void)hipDeviceGetAttribute(&cus, hipDeviceAttributeMultiprocessorCount, dev);
    (void)hipOccupancyMaxActiveBlocksPerMultiprocessor(&per_cu, mega, 512, kDynLds);
    grid_blocks = cus > 0 ? cus : 256;
    if (per_cu < 1) fprintf(stderr, "occupancy query returned %d\n", per_cu);
  }
  if (ws_size < WS_NEED + 16384) { fprintf(stderr, "workspace too small: %zu < %zu\n", ws_size, (size_t)WS_NEED); return; }
  (void)hipMemsetAsync((unsigned char*)d_ws + WS_NEED, 0, XCD_BAR_WORDS * 4, stream);
  Params p{};
  for (int i = 0; i < 23; ++i) p.in[i] = (const float*)d_in[i];
  p.X = (float*)d_out; p.ws = (unsigned char*)d_ws;
  void* args[] = {&p};
  hipError_t e = hipLaunchCooperativeKernel((void*)mega, dim3(grid_blocks), dim3(512), args, kDynLds, stream);
  if (e != hipSuccess) fprintf(stderr, "cooperative launch failed: %s (grid %d)\n", hipGetErrorString(e), grid_blocks);
}
```

```cpp
#include <hip/hip_runtime.h>
#include <hip/hip_cooperative_groups.h>
#include <cstdio>
namespace cg = cooperative_groups;

#define LAS __attribute__((address_space(3)))
typedef unsigned short bf16_t;
typedef short bf16x8 __attribute__((ext_vector_type(8)));
typedef short s16x4 __attribute__((ext_vector_type(4)));
typedef float f32x4 __attribute__((ext_vector_type(4)));
typedef float f32x16 __attribute__((ext_vector_type(16)));
typedef unsigned u32x4 __attribute__((ext_vector_type(4)));
typedef unsigned u32x2 __attribute__((ext_vector_type(2)));

constexpr int T_TOK = 32768, DM = 1024, DFF = 2816, NMEMROWS = 2304;
constexpr size_t MiB = 1048576;
constexpr size_t OFF_TAB = 0;
constexpr size_t OFF_DFT = 8 * MiB;
constexpr size_t OFF_MEMB = OFF_DFT + 256 * 1024;
constexpr size_t OFF_RSS = OFF_MEMB + 4718592;
constexpr size_t OFF_XB = OFF_RSS + 2 * MiB;
constexpr size_t OFF_WB = OFF_XB + 64 * MiB;
constexpr size_t OFF_A = OFF_WB + 58 * MiB;
constexpr size_t OFF_S = OFF_A + 128 * MiB;
constexpr size_t OFF_B = OFF_S + 128 * MiB;
constexpr size_t WS_NEED = OFF_B + 160 * MiB;
constexpr size_t W_1I = 0, W_1O = 5767168, W_M1 = 8650752, W_M2 = 11796480, W_F = 14942208, W_R = 15466496, W_MO = 16515072,
                 W_Q = 17563648, W_KV = 18612224, W_O = 20709376, W_2I = 21757952, W_2O = 27525120;
constexpr int DT_C128 = 0, DT_S128 = 16384, DT_C64 = 32768, DT_S64 = 36864, DT_C32 = 40960, DT_S32 = 41984;

struct Params {
  const float* in[23];
  float* X;
  unsigned char* ws;
};

__device__ __forceinline__ int opaque_tid() { int t = threadIdx.x; asm volatile("" : "+v"(t)); return t; }
typedef __bf16 bf16x2_t __attribute__((ext_vector_type(2)));
typedef float f32x2 __attribute__((ext_vector_type(2)));
__device__ __forceinline__ unsigned cvt_pk_bf16(float lo, float hi) { f32x2 v = {lo, hi}; bf16x2_t b = __builtin_convertvector(v, bf16x2_t); return __builtin_bit_cast(unsigned, b); }
__device__ __forceinline__ float bf_lo(unsigned u) { return __uint_as_float(u << 16); }
__device__ __forceinline__ float bf_hi(unsigned u) { return __uint_as_float(u & 0xffff0000u); }
__device__ __forceinline__ u32x4 pack8(f32x4 a, f32x4 b) { u32x4 o; o[0] = cvt_pk_bf16(a[0], a[1]); o[1] = cvt_pk_bf16(a[2], a[3]); o[2] = cvt_pk_bf16(b[0], b[1]); o[3] = cvt_pk_bf16(b[2], b[3]); return o; }
__device__ __forceinline__ u32x2 pack4(float a, float b, float c, float d) { u32x2 o; o[0] = cvt_pk_bf16(a, b); o[1] = cvt_pk_bf16(c, d); return o; }
__device__ __forceinline__ float fsigmoid(float x) { return __builtin_amdgcn_rcpf(1.f + __expf(-x)); }
__device__ __forceinline__ float fsilu(float x) { return x * fsigmoid(x); }
__device__ __forceinline__ float row_rstd(const float* RSS, int row) {
  const f32x4* p = (const f32x4*)(RSS + (size_t)row * 16); f32x4 a = p[0], b = p[1], c = p[2], d = p[3];
  float s = ((a[0] + a[1]) + (a[2] + a[3])) + ((b[0] + b[1]) + (b[2] + b[3])) + ((c[0] + c[1]) + (c[2] + c[3])) + ((d[0] + d[1]) + (d[2] + d[3]));
  return rsqrtf(s * (1.f / 1024.f) + 1e-6f);
}
__device__ __forceinline__ bf16x8 tr_frag(const LAS unsigned char* lds, unsigned off_lo, unsigned off_hi) {
  s16x4 a = __builtin_amdgcn_ds_read_tr16_b64_v4i16((LAS s16x4*)(lds + off_lo));
  s16x4 b = __builtin_amdgcn_ds_read_tr16_b64_v4i16((LAS s16x4*)(lds + off_hi));
  return __builtin_shufflevector(a, b, 0, 1, 2, 3, 4, 5, 6, 7);
}
__device__ __forceinline__ f32x16 mfma32(bf16x8 a, bf16x8 b, f32x16 c) { return __builtin_amdgcn_mfma_f32_32x32x16_bf16(a, b, c, 0, 0, 0); }
__device__ __forceinline__ float log_sigmoid(float x) { return fminf(x, 0.f) - log1pf(expf(-fabsf(x))); }
__device__ __forceinline__ bf16x8 scale_frag(bf16x8 q, float s) {
  u32x4 u = (u32x4)q; u32x4 o;
#pragma unroll
  for (int i = 0; i < 4; ++i) o[i] = cvt_pk_bf16(bf_lo(u[i]) * s, bf_hi(u[i]) * s);
  return (bf16x8)o;
}

namespace pg8 {
constexpr int BM = 256, BK = 64, HALF = 128, HTB = HALF * BK * 2, STAGE_BYTES = 8 * HTB, NXCD = 8, WGM = 8;
__device__ __forceinline__ int lds_byte(int r, int c) { const int st = (r >> 4) * 2 + (c >> 5), rr = r & 15, cc = c & 31, ob = rr * 64 + cc * 2; return st * 1024 + (ob ^ (((ob >> 9) & 1) << 5)); }
__device__ __forceinline__ void stage_rc(int b, int& R, int& C) { const int st = b / 1024, sb = b % 1024, swz = sb ^ (((sb >> 9) & 1) << 5); R = (st >> 1) * 16 + swz / 64; C = (st & 1) * 32 + (swz % 64) / 2; }
__device__ __forceinline__ int perm32(int rho) { const int n = rho >> 4, i = rho & 15; return 8 * (i >> 2) + 4 * n + (i & 3); }
struct Unit { int pm, pn; };
struct Gemm { const bf16_t* A; const bf16_t* Bt; int M, N, K; };
struct StaticOrder {
  int nM, nN, nwg, G, c;
  __device__ void init(int M, int N, int G_, int c_) { nM = M / BM; nN = N / BM; nwg = nM * nN; G = G_; c = c_; }
  __device__ bool next(int i, Unit& u) const {
    const long L = (long)i * G + c; if (L >= nwg) return false;
    int wgid = (int)L; { const int q = nwg / NXCD, r = nwg % NXCD, xcd = wgid % NXCD, off = wgid / NXCD; wgid = (xcd < r ? xcd * (q + 1) : r * (q + 1) + (xcd - r) * q) + off; }
    const int nig = WGM * nN, gid = wgid / nig, fm = gid * WGM, gsz = (nM - fm) < WGM ? (nM - fm) : WGM;
    u.pm = fm + ((wgid % nig) % gsz); u.pn = (wgid % nig) / gsz; return true;
  }
  __device__ __forceinline__ void a_ready(const Unit&) const {}
  __device__ __forceinline__ void done(const Unit&) const {}
};

template <class Epi, class Sched>
__device__ __forceinline__ void gemm_phase(LAS unsigned char* lds, const Gemm g, const Sched& S, const Epi& E) {
  const int tid = opaque_tid(), wid = __builtin_amdgcn_readfirstlane(tid >> 6), lane = tid & 63, wr = wid >> 2, wc = wid & 3, fr = lane & 15, fq = lane >> 4;
  const int K = g.K, nt = K / BK;
  unsigned voffA[2], voffB[2];
#pragma unroll
  for (int i = 0; i < 2; ++i) { int R, C; stage_rc(tid * 16 + i * 8192, R, C); const int Rb = Epi::PERM ? ((R & ~31) + perm32(R & 31)) : R;
    voffA[i] = (unsigned)(R * K + C) * 2u; voffB[i] = (unsigned)(Rb * K + C) * 2u; }
  const size_t kstep = (size_t)(BK * 2);
  const size_t hstep = (size_t)HALF * K * 2;
  const size_t tstep = 2 * hstep;
  const unsigned ldsw = (unsigned)wid * 1024u;
  const int aoff = lds_byte(wr * 64 + fr, fq * 8), boff = lds_byte(wc * 32 + fr, fq * 8);
#define PG8_SA(b, h) (((b) * 2 + (h)) * HTB)
#define PG8_SB(b, h) ((4 + (b) * 2 + (h)) * HTB)
#define PG8_STAGE(bufoff, gbase, voff) do { _Pragma("unroll") for (int _i = 0; _i < 2; ++_i) \
    __builtin_amdgcn_global_load_lds((const unsigned*)((const char*)(gbase) + (voff)[_i]), (LAS unsigned*)(lds + (bufoff) + ldsw + _i * 8192), 16, 0, 0); } while (0)
#define PG8_LDA(dst, b, h) do { _Pragma("unroll") for (int m = 0; m < 4; ++m) _Pragma("unroll") for (int k = 0; k < 2; ++k) dst[m][k] = *(const LAS bf16x8*)(lds + PG8_SA(b, h) + aoff + m * 2048 + k * 1024); } while (0)
#define PG8_LDB(dst, b, h) do { _Pragma("unroll") for (int n = 0; n < 2; ++n) _Pragma("unroll") for (int k = 0; k < 2; ++k) dst[n][k] = *(const LAS bf16x8*)(lds + PG8_SB(b, h) + boff + n * 2048 + k * 1024); } while (0)
#define PG8_MMA(ai, bj, At, Bt) do { __builtin_amdgcn_s_setprio(1); _Pragma("unroll") for (int m = 0; m < 4; ++m) _Pragma("unroll") for (int n = 0; n < 2; ++n) _Pragma("unroll") for (int k = 0; k < 2; ++k) \
    acc[ai][bj][m][n] = __builtin_amdgcn_mfma_f32_16x16x32_bf16(Bt[n][k], At[m][k], acc[ai][bj][m][n], 0, 0, 0); __builtin_amdgcn_s_setprio(0); } while (0)
#define PG8_WAIT_V(n) asm volatile("s_waitcnt vmcnt(" #n ")" ::: "memory")
#define PG8_WAIT_L(n) asm volatile("s_waitcnt lgkmcnt(" #n ")" ::: "memory")
#define PG8_BAR __builtin_amdgcn_s_barrier()
#define PG8_SCHED __builtin_amdgcn_sched_barrier(0)
  Unit cur, nxt; int ui = 0;
  if (!S.next(0, cur)) return;
  f32x4 acc[2][2][4][2];
#pragma unroll
  for (int a = 0; a < 2; ++a)
#pragma unroll
    for (int b = 0; b < 2; ++b)
#pragma unroll
      for (int m = 0; m < 4; ++m)
#pragma unroll
        for (int n = 0; n < 2; ++n) acc[a][b][m][n] = (f32x4){0.f, 0.f, 0.f, 0.f};
  bf16x8 At[4][2], B0[2][2], B1[2][2];
  const char* cA = (const char*)g.A + (size_t)cur.pm * tstep; const char* cB = (const char*)g.Bt + (size_t)cur.pn * tstep;
  S.a_ready(cur);
  PG8_STAGE(PG8_SB(0, 0), cB, voffB); PG8_STAGE(PG8_SA(0, 0), cA, voffA); PG8_STAGE(PG8_SB(0, 1), cB + hstep, voffB); PG8_STAGE(PG8_SA(0, 1), cA + hstep, voffA);
  if (wr == 1) PG8_BAR;
  PG8_WAIT_V(4); PG8_BAR;
  PG8_STAGE(PG8_SB(1, 0), cB + kstep, voffB); PG8_STAGE(PG8_SA(1, 0), cA + kstep, voffA); PG8_STAGE(PG8_SB(1, 1), cB + hstep + kstep, voffB);
  PG8_WAIT_V(6); PG8_BAR;
  for (;;) {
    const bool has_next = S.next(ui + 1, nxt);
    const char* nA = has_next ? (const char*)g.A + (size_t)nxt.pm * tstep : cA; const char* nB = has_next ? (const char*)g.Bt + (size_t)nxt.pn * tstep : cB;
    for (int t = 0; t < nt; t += 2) {
      const bool last = (t == nt - 2);
      const char* a1 = cA + (size_t)(t + 1) * kstep;
      const char* a2 = last ? nA : cA + (size_t)(t + 2) * kstep; const char* b2 = last ? nB : cB + (size_t)(t + 2) * kstep;
      const char* a3 = a2 + kstep; const char* b3 = b2 + kstep;
      if (last && has_next) S.a_ready(nxt);
      PG8_LDB(B0, 0, 0); PG8_SCHED; PG8_LDA(At, 0, 0); PG8_STAGE(PG8_SA(1, 1), a1 + hstep, voffA);
      PG8_WAIT_L(8); PG8_BAR; PG8_WAIT_L(0); PG8_MMA(0, 0, At, B0); PG8_BAR; PG8_SCHED;
      PG8_LDB(B1, 0, 1); PG8_STAGE(PG8_SB(0, 0), b2, voffB);
      PG8_BAR; PG8_WAIT_L(0); PG8_MMA(0, 1, At, B1); PG8_BAR;
      PG8_LDA(At, 0, 1); PG8_STAGE(PG8_SA(0, 0), a2, voffA);
      PG8_BAR; PG8_WAIT_L(0); PG8_MMA(1, 0, At, B0); PG8_BAR; PG8_SCHED;
      PG8_STAGE(PG8_SB(0, 1), b2 + hstep, voffB);
      PG8_WAIT_V(6); PG8_BAR; PG8_MMA(1, 1, At, B1); PG8_BAR;
      PG8_LDB(B0, 1, 0); PG8_SCHED; PG8_LDA(At, 1, 0); PG8_STAGE(PG8_SA(0, 1), a2 + hstep, voffA);
      PG8_WAIT_L(8); PG8_BAR; PG8_WAIT_L(0); PG8_MMA(0, 0, At, B0); PG8_BAR; PG8_SCHED;
      PG8_LDB(B1, 1, 1); PG8_STAGE(PG8_SB(1, 0), b3, voffB);
      PG8_BAR; PG8_WAIT_L(0); PG8_MMA(0, 1, At, B1); PG8_BAR;
      PG8_LDA(At, 1, 1); PG8_STAGE(PG8_SA(1, 0), a3, voffA);
      PG8_BAR; PG8_WAIT_L(0); PG8_MMA(1, 0, At, B0); PG8_BAR; PG8_SCHED;
      PG8_STAGE(PG8_SB(1, 1), b3 + hstep, voffB);
      PG8_WAIT_V(6); PG8_BAR; PG8_MMA(1, 1, At, B1); PG8_BAR;
    }
    E(acc, cur, ui, wr, wc, fr, fq); S.done(cur);
    if (!has_next) break;
#pragma unroll
    for (int a = 0; a < 2; ++a)
#pragma unroll
      for (int b = 0; b < 2; ++b)
#pragma unroll
        for (int m = 0; m < 4; ++m)
#pragma unroll
          for (int n = 0; n < 2; ++n) acc[a][b][m][n] = (f32x4){0.f, 0.f, 0.f, 0.f};
    cur = nxt; cA = nA; cB = nB; ++ui;
  }
  PG8_WAIT_V(0);
  if (wr == 0) PG8_BAR;
  PG8_BAR;
#undef PG8_SA
#undef PG8_SB
#undef PG8_STAGE
#undef PG8_LDA
#undef PG8_LDB
#undef PG8_MMA
#undef PG8_WAIT_V
#undef PG8_WAIT_L
#undef PG8_BAR
#undef PG8_SCHED
}
}
using pg8::Unit;
typedef f32x4 AccT[2][2][4][2];

struct EpiFfnIn {
  static constexpr bool PERM = true;
  const LAS float* RSL; bf16_t* H;
  __device__ __forceinline__ void operator()(const AccT& acc, const Unit& u, int ui, int wr, int wc, int fr, int fq) const {
#pragma unroll
    for (int ai = 0; ai < 2; ++ai)
#pragma unroll
      for (int m = 0; m < 4; ++m) {
        const int row = u.pm * 256 + ai * 128 + wr * 64 + m * 16 + fr; const float rs = RSL[ui * 256 + ai * 128 + wr * 64 + m * 16 + fr];
        f32x4 h0, h1;
#pragma unroll
        for (int i = 0; i < 4; ++i) { h0[i] = fsilu(acc[ai][0][m][0][i] * rs) * (acc[ai][1][m][0][i] * rs); h1[i] = fsilu(acc[ai][0][m][1][i] * rs) * (acc[ai][1][m][1][i] * rs); }
        *(u32x4*)(H + (size_t)row * DFF + u.pn * 128 + wc * 32 + fq * 8) = pack8(h0, h1);
      }
  }
};
struct EpiRes {
  static constexpr bool PERM = true;
  bf16_t* XB; const bf16_t* XLi; bf16_t* XLo; float* RSS; float s;
  __device__ __forceinline__ void operator()(const AccT& acc, const Unit& u, int ui, int wr, int wc, int fr, int fq) const {
#pragma unroll
    for (int aim = 0; aim < 4; ++aim) {
      const int ai = aim >> 1, m0 = (aim & 1) * 2;
      u32x4 xh[4][2], xl[4][2];
#pragma unroll
      for (int m = m0; m < m0 + 2; ++m)
#pragma unroll
        for (int bj = 0; bj < 2; ++bj) {
          const size_t o = (size_t)(u.pm * 256 + ai * 128 + wr * 64 + m * 16 + fr) * DM + u.pn * 256 + bj * 128 + wc * 32 + fq * 8;
          xh[m][bj] = *(const u32x4*)(XB + o); xl[m][bj] = *(const u32x4*)(XLi + o);
        }
#pragma unroll
      for (int m = m0; m < m0 + 2; ++m) {
        const int row = u.pm * 256 + ai * 128 + wr * 64 + m * 16 + fr; float ss = 0.f;
#pragma unroll
        for (int bj = 0; bj < 2; ++bj) {
          const size_t o = (size_t)row * DM + u.pn * 256 + bj * 128 + wc * 32 + fq * 8;
          const u32x4 h4 = xh[m][bj], l4 = xl[m][bj];
          f32x4 y0, y1;
#pragma unroll
          for (int i = 0; i < 2; ++i) { y0[2 * i] = bf_lo(h4[i]) + bf_lo(l4[i]); y0[2 * i + 1] = bf_hi(h4[i]) + bf_hi(l4[i]); y1[2 * i] = bf_lo(h4[2 + i]) + bf_lo(l4[2 + i]); y1[2 * i + 1] = bf_hi(h4[2 + i]) + bf_hi(l4[2 + i]); }
          y0 += acc[ai][bj][m][0] * s; y1 += acc[ai][bj][m][1] * s;
          const u32x4 nh = pack8(y0, y1);
          f32x4 r0, r1;
#pragma unroll
          for (int i = 0; i < 2; ++i) { r0[2 * i] = y0[2 * i] - bf_lo(nh[i]); r0[2 * i + 1] = y0[2 * i + 1] - bf_hi(nh[i]); r1[2 * i] = y1[2 * i] - bf_lo(nh[2 + i]); r1[2 * i + 1] = y1[2 * i + 1] - bf_hi(nh[2 + i]); }
          *(u32x4*)(XB + o) = nh; *(u32x4*)(XLo + o) = pack8(r0, r1);
#pragma unroll
          for (int i = 0; i < 4; ++i) ss += y0[i] * y0[i] + y1[i] * y1[i];
        }
        ss += __shfl_xor(ss, 16); ss += __shfl_xor(ss, 32);
        if (fq == 0) RSS[(size_t)row * 16 + u.pn * 4 + wc] = ss;
      }
    }
  }
};
struct EpiM1 {
  static constexpr bool PERM = true;
  const LAS float* RSL; const float2* TAB; bf16_t* Z; bf16_t* Q; bf16_t* Kb; bf16_t* V;
  __device__ __forceinline__ void operator()(const AccT& acc, const Unit& u, int ui, int wr, int wc, int fr, int fq) const {
    const int pn = u.pn;
    if (pn < 4 || pn >= 8) {
      bf16_t* dst = pn < 4 ? Z : V; const int cb = (pn < 4 ? pn : pn - 8) * 256;
#pragma unroll
      for (int ai = 0; ai < 2; ++ai)
#pragma unroll
        for (int m = 0; m < 4; ++m) {
          const int row = u.pm * 256 + ai * 128 + wr * 64 + m * 16 + fr; const float rs = RSL[ui * 256 + ai * 128 + wr * 64 + m * 16 + fr];
#pragma unroll
          for (int bj = 0; bj < 2; ++bj)
            *(u32x4*)(dst + (size_t)row * 1024 + cb + bj * 128 + wc * 32 + fq * 8) = pack8(acc[ai][bj][m][0] * rs, acc[ai][bj][m][1] * rs);
        }
    } else {
      bf16_t* dst = pn < 6 ? Q : Kb; const int head = 2 * (pn < 6 ? pn - 4 : pn - 6) + (wc >> 1); const int d0 = 32 * (wc & 1) + 8 * fq;
#pragma unroll
      for (int aim = 0; aim < 4; ++aim) {
        const int ai = aim >> 1, m0 = (aim & 1) * 2;
        f32x4 tt[4][4];
#pragma unroll
        for (int m = m0; m < m0 + 2; ++m) {
          const int row = u.pm * 256 + ai * 128 + wr * 64 + m * 16 + fr; const int spos = row < 16384 ? (row & 2047) : row - 16384;
          const f32x4* tp = (const f32x4*)(TAB + (size_t)spos * 64 + d0);
          tt[m][0] = tp[0]; tt[m][1] = tp[1]; tt[m][2] = tp[2]; tt[m][3] = tp[3];
        }
#pragma unroll
        for (int m = m0; m < m0 + 2; ++m) {
          const int row = u.pm * 256 + ai * 128 + wr * 64 + m * 16 + fr; const float rs = RSL[ui * 256 + ai * 128 + wr * 64 + m * 16 + fr];
          const f32x4 t0 = tt[m][0], t1 = tt[m][1], t2 = tt[m][2], t3 = tt[m][3];
          f32x4 x1a = acc[ai][0][m][0] * rs, x1b = acc[ai][0][m][1] * rs, x2a = acc[ai][1][m][0] * rs, x2b = acc[ai][1][m][1] * rs;
          f32x4 ca = {t0[0], t0[2], t1[0], t1[2]}, sa = {t0[1], t0[3], t1[1], t1[3]}, cb2 = {t2[0], t2[2], t3[0], t3[2]}, sb = {t2[1], t2[3], t3[1], t3[3]};
          f32x4 o1a = x1a * ca - x2a * sa, o1b = x1b * cb2 - x2b * sb, o2a = x2a * ca + x1a * sa, o2b = x2b * cb2 + x1b * sb;
          bf16_t* op = dst + (size_t)row * 512 + head * 128 + d0;
          *(u32x4*)op = pack8(o1a, o1b); *(u32x4*)(op + 64) = pack8(o2a, o2b);
        }
      }
    }
  }
};
struct EpiM2 {
  static constexpr bool PERM = true;
  const LAS float* RSL; bf16_t* YN; bf16_t* GATES;
  __device__ __forceinline__ void operator()(const AccT& acc, const Unit& u, int ui, int wr, int wc, int fr, int fq) const {
    const int pn = u.pn;
    if (pn < 4) {
#pragma unroll
      for (int ai = 0; ai < 2; ++ai) {
        u32x4 yy[4][2];
#pragma unroll
        for (int m = 0; m < 4; ++m)
#pragma unroll
          for (int bj = 0; bj < 2; ++bj) yy[m][bj] = *(const u32x4*)(YN + (size_t)(u.pm * 256 + ai * 128 + wr * 64 + m * 16 + fr) * 1024 + pn * 256 + bj * 128 + wc * 32 + fq * 8);
#pragma unroll
        for (int m = 0; m < 4; ++m) {
          const int row = u.pm * 256 + ai * 128 + wr * 64 + m * 16 + fr; const float rs = RSL[ui * 256 + ai * 128 + wr * 64 + m * 16 + fr];
#pragma unroll
          for (int bj = 0; bj < 2; ++bj) {
            f32x4 a = acc[ai][bj][m][0] * rs, b = acc[ai][bj][m][1] * rs; const u32x4 y = yy[m][bj];
#pragma unroll
            for (int i = 0; i < 2; ++i) { a[2 * i] = fsilu(a[2 * i]) * bf_lo(y[i]); a[2 * i + 1] = fsilu(a[2 * i + 1]) * bf_hi(y[i]); b[2 * i] = fsilu(b[2 * i]) * bf_lo(y[2 + i]); b[2 * i + 1] = fsilu(b[2 * i + 1]) * bf_hi(y[2 + i]); }
            *(u32x4*)(YN + (size_t)row * 1024 + pn * 256 + bj * 128 + wc * 32 + fq * 8) = pack8(a, b);
          }
        }
      }
    } else {
#pragma unroll
      for (int ai = 0; ai < 2; ++ai)
#pragma unroll
        for (int m = 0; m < 4; ++m) {
          const int row = u.pm * 256 + ai * 128 + wr * 64 + m * 16 + fr; const float rs = RSL[ui * 256 + ai * 128 + wr * 64 + m * 16 + fr];
#pragma unroll
          for (int bj = 0; bj < 2; ++bj) {
            f32x4 a = acc[ai][bj][m][0] * rs, b = acc[ai][bj][m][1] * rs;
#pragma unroll
            for (int i = 0; i < 4; ++i) { a[i] = fsigmoid(a[i]); b[i] = fsigmoid(b[i]); }
            *(u32x4*)(GATES + (size_t)row * 2048 + (pn - 4) * 256 + bj * 128 + wc * 32 + fq * 8) = pack8(a, b);
          }
        }
    }
  }
};
template <int MODE> struct EpiComb {
  static constexpr bool PERM = true;
  const bf16_t* GATES; bf16_t* U;
  __device__ __forceinline__ void operator()(const AccT& acc, const Unit& u, int ui, int wr, int wc, int fr, int fq) const {
#pragma unroll
    for (int aim = 0; aim < 4; ++aim) {
      const int ai = aim >> 1, m0 = (aim & 1) * 2;
      u32x4 gv[4][2], yv[4][2];
#pragma unroll
      for (int m = m0; m < m0 + 2; ++m)
#pragma unroll
        for (int bj = 0; bj < 2; ++bj) {
          const size_t row = (size_t)(u.pm * 256 + ai * 128 + wr * 64 + m * 16 + fr); const int col = u.pn * 256 + bj * 128 + wc * 32 + fq * 8;
          gv[m][bj] = *(const u32x4*)(GATES + row * 2048 + MODE * 1024 + col);
          if (MODE == 1) yv[m][bj] = *(const u32x4*)(U + row * 1024 + col);
        }
#pragma unroll
      for (int m = m0; m < m0 + 2; ++m)
#pragma unroll
        for (int bj = 0; bj < 2; ++bj) {
          const size_t row = (size_t)(u.pm * 256 + ai * 128 + wr * 64 + m * 16 + fr); const int col = u.pn * 256 + bj * 128 + wc * 32 + fq * 8;
          const u32x4 gg = gv[m][bj];
          f32x4 a = acc[ai][bj][m][0], b = acc[ai][bj][m][1];
#pragma unroll
          for (int i = 0; i < 2; ++i) { a[2 * i] *= bf_lo(gg[i]); a[2 * i + 1] *= bf_hi(gg[i]); b[2 * i] *= bf_lo(gg[2 + i]); b[2 * i + 1] *= bf_hi(gg[2 + i]); }
          if (MODE == 1) { const u32x4 y = yv[m][bj];
#pragma unroll
            for (int i = 0; i < 2; ++i) { a[2 * i] += bf_lo(y[i]); a[2 * i + 1] += bf_hi(y[i]); b[2 * i] += bf_lo(y[2 + i]); b[2 * i + 1] += bf_hi(y[2 + i]); } }
          *(u32x4*)(U + row * 1024 + col) = pack8(a, b);
        }
    }
  }
};
template <bool USE_RS> struct EpiPlain {
  static constexpr bool PERM = true;
  const LAS float* RSL; bf16_t* O; int ldo; float s;
  __device__ __forceinline__ void operator()(const AccT& acc, const Unit& u, int ui, int wr, int wc, int fr, int fq) const {
#pragma unroll
    for (int ai = 0; ai < 2; ++ai)
#pragma unroll
      for (int m = 0; m < 4; ++m) {
        const int row = u.pm * 256 + ai * 128 + wr * 64 + m * 16 + fr; const float rs = USE_RS ? RSL[ui * 256 + ai * 128 + wr * 64 + m * 16 + fr] * s : s;
#pragma unroll
        for (int bj = 0; bj < 2; ++bj)
          *(u32x4*)(O + (size_t)row * ldo + u.pn * 256 + bj * 128 + wc * 32 + fq * 8) = pack8(acc[ai][bj][m][0] * rs, acc[ai][bj][m][1] * rs);
      }
  }
};

template <class Epi> __device__ __forceinline__ void run_gemm(LAS unsigned char* lds, const bf16_t* A, const bf16_t* Bt, int M, int N, int K, const Epi& E, const float* RSS = nullptr) {
  pg8::Gemm g{A, Bt, M, N, K}; pg8::StaticOrder S; S.init(M, N, gridDim.x, blockIdx.x);
  if (RSS) {
    LAS float* rsl = (LAS float*)(lds + 131072); const int tid = opaque_tid(); Unit u;
    for (int i = 0; S.next(i, u); ++i) if (tid < 256) rsl[i * 256 + tid] = row_rstd(RSS, u.pm * 256 + tid);
    __syncthreads();
  }
  pg8::gemm_phase<Epi, pg8::StaticOrder>(lds, g, S, E);
  __syncthreads();
}

__device__ void prep_tiles(const float* __restrict__ src, int ld, bf16_t* __restrict__ dst, int K, int Ndst, const float* __restrict__ gain, float scale,
                           int maptype, int mapbase, int& tbase, float* lt) {
  const int tid = opaque_tid(), G = gridDim.x;
  const int nkt = K >> 6, ntiles = (Ndst >> 6) * nkt;
  int start = (int)blockIdx.x - (tbase % G); if (start < 0) start += G;
  for (int t = start; t < ntiles; t += G) {
    const int nt = t / nkt, kt = t - nt * nkt, n0 = nt << 6, k0 = kt << 6;
    int sc0;
    if (maptype == 0) sc0 = mapbase + n0;
    else if (maptype == 1) { const int pn = n0 >> 8, h = (n0 >> 7) & 1, j = n0 & 127; sc0 = h * DFF + pn * 128 + j; }
    else { const int tt = n0 >> 8, c = n0 & 255, bj = c >> 7, cc = c & 127; sc0 = mapbase + (2 * tt + (cc >> 6)) * 128 + bj * 64 + (cc & 63); }
#pragma unroll
    for (int it = 0; it < 2; ++it) {
      const int idx = tid + it * 512, k = idx >> 4, n4 = idx & 15;
      const f32x4 v = *(const f32x4*)(src + (size_t)(k0 + k) * ld + sc0 + n4 * 4);
      const float g = scale * (gain ? gain[k0 + k] : 1.f);
      float* p = lt + k * 65 + n4 * 4; p[0] = v[0] * g; p[1] = v[1] * g; p[2] = v[2] * g; p[3] = v[3] * g;
    }
    __syncthreads();
    { const int n = tid >> 3, kc = (tid & 7) << 3; f32x4 a, b;
#pragma unroll
      for (int j = 0; j < 4; ++j) { a[j] = lt[(kc + j) * 65 + n]; b[j] = lt[(kc + 4 + j) * 65 + n]; }
      *(u32x4*)(dst + (size_t)(n0 + n) * K + k0 + kc) = pack8(a, b); }
    __syncthreads();
  }
  tbase += ntiles;
}
__device__ void prep_zfold(const float* __restrict__ wmix  , const float* __restrict__ gain, bf16_t* __restrict__ WM1, int& tbase, float* lt) {
  const int tid = opaque_tid(), G = gridDim.x;
  float* cosT = lt + 16 * 129; float* sinT = cosT + 128;
  int start = (int)blockIdx.x - (tbase % G); if (start < 0) start += G;
  for (int t = start; t < 256; t += G) {
    const int grp = t >> 6, k0 = (t & 63) << 4;
    { const int k = tid >> 5, c4 = tid & 31; const f32x4 v = *(const f32x4*)(wmix + (size_t)(k0 + k) * 5632 + grp * 128 + c4 * 4);
      float* p = lt + k * 129 + c4 * 4; p[0] = v[0]; p[1] = v[1]; p[2] = v[2]; p[3] = v[3]; }
    if (tid < 128) { cosT[tid] = __builtin_amdgcn_cosf((float)tid * (1.f / 128.f)); sinT[tid] = __builtin_amdgcn_sinf((float)tid * (1.f / 128.f)); }
    __syncthreads();
    { const int nl = tid >> 1, ri = nl >> 7, cc = nl & 127, kh = (tid & 1) << 3;
      float a0 = 0.f, a1 = 0.f, a2 = 0.f, a3 = 0.f, a4 = 0.f, a5 = 0.f, a6 = 0.f, a7 = 0.f;
      const float* lp = lt + kh * 129;
      for (int c = 0; c < 128; ++c) {
        const int idx = (c * cc) & 127; const float w = ri ? -sinT[idx] : cosT[idx];
        a0 += lp[c] * w; a1 += lp[129 + c] * w; a2 += lp[2 * 129 + c] * w; a3 += lp[3 * 129 + c] * w;
        a4 += lp[4 * 129 + c] * w; a5 += lp[5 * 129 + c] * w; a6 += lp[6 * 129 + c] * w; a7 += lp[7 * 129 + c] * w;
      }
      const float sc = 0.08838834764831845f; const float* gp = gain + k0 + kh;
      f32x4 o0 = {a0 * sc * gp[0], a1 * sc * gp[1], a2 * sc * gp[2], a3 * sc * gp[3]}, o1 = {a4 * sc * gp[4], a5 * sc * gp[5], a6 * sc * gp[6], a7 * sc * gp[7]};
      *(u32x4*)(WM1 + (size_t)(ri * 512 + grp * 128 + cc) * 1024 + k0 + kh) = pack8(o0, o1); }
    __syncthreads();
  }
  tbase += 256;
}

template <int STAGE>
__device__ void dft_item(const bf16_t* __restrict__ src, bf16_t* __restrict__ dst, const bf16_t* __restrict__ Ct, const bf16_t* __restrict__ St,
                         int N, int lgN, int rowbase, int j, int chblk, int S, int N1, int N2, LAS unsigned char* lds) {
  const int tid = opaque_tid(), w = tid >> 6, l = tid & 63;
  const int CB = 8192 >> lgN, stride = CB * 4 + 64;
  const int lgcpr = 11 - lgN, cpr = 1 << lgcpr;
#pragma unroll
  for (int it = 0; it < 4; ++it) {
    const int q = tid + it * 512, n = q >> lgcpr, cq = q & (cpr - 1), part = cq >> (lgcpr - 1), cc = cq & ((cpr >> 1) - 1);
    const int irow = STAGE == 1 ? rowbase + N2 * n + j : rowbase + j * N2 + n;
    const u32x4 v = *(const u32x4*)(src + (size_t)irow * 1024 + part * 512 + chblk * CB + cc * 8);
    *(LAS u32x4*)(lds + n * stride + (part * CB + cc * 8) * 2) = v;
  }
  __syncthreads();
  const int kts = N >> 5, kt = w & (kts - 1), chsub = w >> (lgN - 5);
  const int i16 = l & 15, q4 = i16 >> 2, p4 = i16 & 3, G1 = (l >> 4) & 1, h = l >> 5;
  const unsigned colre = (unsigned)(chsub * 32 + 16 * G1 + 4 * p4) * 2u, colim = colre + (unsigned)CB * 2u;
  const int kout = kt * 32 + (l & 31);
  f32x16 a0 = {}, a1 = {}, a2 = {};
  const int nks = N >> 4;
  bf16x8 Bc[8], Bs[8];
#pragma unroll
  for (int ks = 0; ks < 8; ++ks) if (ks < nks) { Bc[ks] = *(const bf16x8*)(Ct + kout * N + 16 * ks + 8 * h); Bs[ks] = *(const bf16x8*)(St + kout * N + 16 * ks + 8 * h); }
#pragma unroll
  for (int ks = 0; ks < 8; ++ks) if (ks < nks) {
    const unsigned rlo = (unsigned)(16 * ks + 8 * h + q4) * stride, rhi = rlo + 4u * stride;
    const bf16x8 Ar = tr_frag(lds, rlo + colre, rhi + colre), Ai = tr_frag(lds, rlo + colim, rhi + colim);
    a0 = mfma32(Ar, Bc[ks], a0); a0 = mfma32(Ai, Bs[ks], a0);
    if (STAGE == 1) { a1 = mfma32(Ai, Bc[ks], a1); a2 = mfma32(Ar, Bs[ks], a2); }
  }
  const int chb = chblk * CB + chsub * 32 + 4 * h;
  if (STAGE == 1) {
    const int mm = (j * kout) & (S - 1); const float fr = (float)mm / (float)S;
    const float c = __builtin_amdgcn_cosf(fr), s = __builtin_amdgcn_sinf(fr);
    const size_t orow = (size_t)(rowbase + kout * N2 + j) * 1024;
#pragma unroll
    for (int g = 0; g < 4; ++g) {
      float re[4], im[4];
#pragma unroll
      for (int i = 0; i < 4; ++i) { const float yr = a0[4 * g + i], yi = a1[4 * g + i] - a2[4 * g + i]; re[i] = yr * c + yi * s; im[i] = yi * c - yr * s; }
      *(u32x2*)(dst + orow + chb + 8 * g) = pack4(re[0], re[1], re[2], re[3]);
      *(u32x2*)(dst + orow + 512 + chb + 8 * g) = pack4(im[0], im[1], im[2], im[3]);
    }
  } else {
    const size_t orow = (size_t)(rowbase + j + N1 * kout) * 512;
#pragma unroll
    for (int g = 0; g < 4; ++g) *(u32x2*)(dst + orow + chb + 8 * g) = pack4(a0[4 * g], a0[4 * g + 1], a0[4 * g + 2], a0[4 * g + 3]);
  }
  __syncthreads();
}
template <int STAGE>
__device__ void dft_phase(const bf16_t* src, bf16_t* dst, const bf16_t* DT, LAS unsigned char* lds) {
  for (int it = blockIdx.x; it < 2048; it += gridDim.x) {
    if (it < 1024) dft_item<STAGE>(src, dst, DT + DT_C128, DT + DT_S128, 128, 7, 16384, it >> 3, it & 7, 16384, 128, 128, lds);
    else {
      const int r = it - 1024, b = r >> 7, rr = r & 127;
      if (STAGE == 1) dft_item<STAGE>(src, dst, DT + DT_C32, DT + DT_S32, 32, 5, b * 2048, rr >> 1, rr & 1, 2048, 32, 64, lds);
      else dft_item<STAGE>(src, dst, DT + DT_C64, DT + DT_S64, 64, 6, b * 2048, rr >> 2, rr & 3, 2048, 32, 64, lds);
    }
  }
}

__device__ void ret_state_item(const bf16_t* __restrict__ Kb, const bf16_t* __restrict__ Vb, bf16_t* __restrict__ STf, bf16_t* __restrict__ STb,
                               int cidx, int head, float lgf2, float lgb2, LAS unsigned char* lds) {
  const int tid = opaque_tid(), w = tid >> 6, l = tid & 63; const int row0 = cidx * 128;
  constexpr unsigned VS = 576, KS = 320, OKF = 73728, OKB = 114688;
#pragma unroll
  for (int it = 0; it < 8; ++it) { const int q = tid + it * 512, j = q >> 5, c = q & 31;
    *(LAS u32x4*)(lds + j * VS + c * 16) = *(const u32x4*)(Vb + (size_t)(row0 + j) * 1024 + head * 256 + c * 8); }
#pragma unroll
  for (int it = 0; it < 4; ++it) { const int q = tid + it * 512, j = q >> 4, c = q & 15;
    const u32x4 v = *(const u32x4*)(Kb + (size_t)(row0 + j) * 512 + head * 128 + c * 8);
    const float zf = __builtin_amdgcn_exp2f(lgf2 * (float)(127 - j)), zb = __builtin_amdgcn_exp2f(lgb2 * (float)j);
    u32x4 of, ob;
#pragma unroll
    for (int i = 0; i < 4; ++i) { const float a = bf_lo(v[i]), b = bf_hi(v[i]); of[i] = cvt_pk_bf16(a * zf, b * zf); ob[i] = cvt_pk_bf16(a * zb, b * zb); }
    *(LAS u32x4*)(lds + OKF + j * KS + c * 16) = of; *(LAS u32x4*)(lds + OKB + j * KS + c * 16) = ob; }
  __syncthreads();
  const int i16 = l & 15, q4 = i16 >> 2, p4 = i16 & 3, G1 = (l >> 4) & 1, h = l >> 5;
  const unsigned cofs = (unsigned)(16 * G1 + 4 * p4) * 2u;
  f32x16 af[4], ab[4];
#pragma unroll
  for (int i = 0; i < 4; ++i) { af[i] = (f32x16){}; ab[i] = (f32x16){}; }
  for (int ks = 0; ks < 8; ++ks) {
    const unsigned r = (unsigned)(16 * ks + 8 * h + q4);
    const bf16x8 Bv = tr_frag(lds, r * VS + w * 64 + cofs, (r + 4) * VS + w * 64 + cofs);
#pragma unroll
    for (int dt = 0; dt < 4; ++dt) {
      const bf16x8 Af = tr_frag(lds, OKF + r * KS + dt * 64 + cofs, OKF + (r + 4) * KS + dt * 64 + cofs);
      const bf16x8 Ab = tr_frag(lds, OKB + r * KS + dt * 64 + cofs, OKB + (r + 4) * KS + dt * 64 + cofs);
      af[dt] = mfma32(Af, Bv, af[dt]); ab[dt] = mfma32(Ab, Bv, ab[dt]);
    }
  }
  const size_t ob = ((size_t)(cidx * 4 + head) * 256 + w * 32 + (l & 31)) * 128 + 4 * h;
#pragma unroll
  for (int dt = 0; dt < 4; ++dt)
#pragma unroll
    for (int g = 0; g < 4; ++g) {
      *(u32x2*)(STf + ob + dt * 32 + 8 * g) = pack4(af[dt][4 * g], af[dt][4 * g + 1], af[dt][4 * g + 2], af[dt][4 * g + 3]);
      *(u32x2*)(STb + ob + dt * 32 + 8 * g) = pack4(ab[dt][4 * g], ab[dt][4 * g + 1], ab[dt][4 * g + 2], ab[dt][4 * g + 3]);
    }
  __syncthreads();
}
__device__ void ret_scan_seq(bf16_t* __restrict__ ST, int c0, int nch, int sub  , float lg, bool bwd) {
  const float g = expf(lg * 128.f);
  bf16_t* base = ST + (size_t)c0 * 131072 + (size_t)sub * 2048 + opaque_tid() * 4;
  float s0 = 0.f, s1 = 0.f, s2 = 0.f, s3 = 0.f;
  for (int cb = 0; cb < nch; cb += 8) {
    u32x2 u[8];
#pragma unroll
    for (int i = 0; i < 8; ++i) { const int c = bwd ? nch - 1 - (cb + i) : cb + i; u[i] = *(const u32x2*)(base + (size_t)c * 131072); }
#pragma unroll
    for (int i = 0; i < 8; ++i) { const int c = bwd ? nch - 1 - (cb + i) : cb + i;
      *(u32x2*)(base + (size_t)c * 131072) = pack4(s0, s1, s2, s3);
      s0 = g * s0 + bf_lo(u[i][0]); s1 = g * s1 + bf_hi(u[i][0]); s2 = g * s2 + bf_lo(u[i][1]); s3 = g * s3 + bf_hi(u[i][1]); }
  }
}
__device__ void ret_out_item(const bf16_t* __restrict__ Qb, const bf16_t* __restrict__ Kb, bf16_t* Vb, const bf16_t* __restrict__ STf, const bf16_t* __restrict__ STb,
                             int cidx, int head, float lgf2, float lgb2, LAS unsigned char* lds) {
  const int tid = opaque_tid(), w = tid >> 6, l = tid & 63; const int row0 = cidx * 128;
  constexpr unsigned VS = 576, ORED = 73728, QS = 272, OQ = 74752, OK = 74752 + 34816;
#pragma unroll
  for (int it = 0; it < 8; ++it) { const int q = tid + it * 512, j = q >> 5, c = q & 31;
    *(LAS u32x4*)(lds + j * VS + c * 16) = *(const u32x4*)(Vb + (size_t)(row0 + j) * 1024 + head * 256 + c * 8); }
#pragma unroll
  for (int it = 0; it < 4; ++it) { const int q = tid + it * 512, j = q >> 4, c = q & 15;
    *(LAS u32x4*)(lds + OQ + j * QS + c * 16) = *(const u32x4*)(Qb + (size_t)(row0 + j) * 512 + head * 128 + c * 8);
    *(LAS u32x4*)(lds + OK + j * QS + c * 16) = *(const u32x4*)(Kb + (size_t)(row0 + j) * 512 + head * 128 + c * 8); }
  __syncthreads();
  const int ib = w & 3, eh = w >> 2, il = l & 31, h = l >> 5;
  const int i16 = l & 15, q4 = i16 >> 2, p4 = i16 & 3, G1 = (l >> 4) & 1;
  const int iloc = ib * 32 + il;
  bf16x8 qf[8];
#pragma unroll
  for (int ks = 0; ks < 8; ++ks) qf[ks] = *(const LAS bf16x8*)(lds + OQ + iloc * QS + (16 * ks + 8 * h) * 2);
  bf16x8 pf[4][2];
#pragma unroll
  for (int jt = 0; jt < 4; ++jt) {
    f32x16 a = {};
#pragma unroll
    for (int ks = 0; ks < 8; ++ks) a = mfma32(*(const LAS bf16x8*)(lds + OK + (jt * 32 + il) * QS + (16 * ks + 8 * h) * 2), qf[ks], a);
    u32x4 p0, p1;
#pragma unroll
    for (int r = 0; r < 16; r += 2) {
      float v[2];
#pragma unroll
      for (int e = 0; e < 2; ++e) { const int jl = jt * 32 + ((r + e) & 3) + 8 * ((r + e) >> 2) + 4 * h; const int dd = iloc - jl;
        const float dec = dd >= 0 ? __builtin_amdgcn_exp2f(lgf2 * (float)dd) : __builtin_amdgcn_exp2f(lgb2 * (float)(-dd)); v[e] = a[r + e] * dec; }
      const unsigned pk = cvt_pk_bf16(v[0], v[1]);
      if (r < 8) p0[r >> 1] = pk; else p1[(r - 8) >> 1] = pk;
    }
    pf[jt][0] = (bf16x8)p0; pf[jt][1] = (bf16x8)p1;
  }
  f32x16 acc[4];
#pragma unroll
  for (int i = 0; i < 4; ++i) acc[i] = (f32x16){};
  const unsigned cofs = (unsigned)(eh * 128 + 16 * G1 + 4 * p4) * 2u;
#pragma unroll
  for (int jt = 0; jt < 4; ++jt)
#pragma unroll
    for (int s = 0; s < 2; ++s) {
      const unsigned r = (unsigned)(jt * 32 + 16 * s + 4 * h + q4);
#pragma unroll
      for (int et = 0; et < 4; ++et) acc[et] = mfma32(tr_frag(lds, r * VS + et * 64 + cofs, (r + 8) * VS + et * 64 + cofs), pf[jt][s], acc[et]);
    }
#pragma unroll
  for (int dir = 0; dir < 2; ++dir) {
    const float xi = dir ? __builtin_amdgcn_exp2f(lgb2 * (float)(128 - iloc)) : __builtin_amdgcn_exp2f(lgf2 * (float)(iloc + 1));
    const bf16_t* sp = (dir ? STb : STf) + ((size_t)(cidx * 4 + head) * 256 + eh * 128 + il) * 128 + 8 * h;
#pragma unroll
    for (int kp = 0; kp < 4; ++kp) {
      bf16x8 sf[2][4];
#pragma unroll
      for (int k2 = 0; k2 < 2; ++k2)
#pragma unroll
        for (int et = 0; et < 4; ++et) sf[k2][et] = *(const bf16x8*)(sp + (size_t)et * 32 * 128 + 16 * (2 * kp + k2));
#pragma unroll
      for (int k2 = 0; k2 < 2; ++k2) {
        const bf16x8 sq = scale_frag(qf[2 * kp + k2], xi);
#pragma unroll
        for (int et = 0; et < 4; ++et) acc[et] = mfma32(sf[k2][et], sq, acc[et]);
      }
    }
  }
  float ss = 0.f;
#pragma unroll
  for (int et = 0; et < 4; ++et)
#pragma unroll
    for (int r = 0; r < 16; ++r) ss += acc[et][r] * acc[et][r];
  ss += __shfl_xor(ss, 32);
  LAS float* red = (LAS float*)(lds + ORED);
  if (h == 0) red[eh * 128 + iloc] = ss;
  __syncthreads();
  const float rn = rsqrtf((red[iloc] + red[128 + iloc]) * (1.f / 256.f) + 1e-6f);
  bf16_t* op = Vb + (size_t)(row0 + iloc) * 1024 + head * 256 + eh * 128 + 4 * h;
#pragma unroll
  for (int et = 0; et < 4; ++et)
#pragma unroll
    for (int g = 0; g < 4; ++g)
      *(u32x2*)(op + et * 32 + 8 * g) = pack4(acc[et][4 * g] * rn, acc[et][4 * g + 1] * rn, acc[et][4 * g + 2] * rn, acc[et][4 * g + 3] * rn);
  __syncthreads();
}

__device__ void attn_item(const bf16_t* __restrict__ QX, const bf16_t* __restrict__ KV, bf16_t* __restrict__ O, int tt, int head, LAS unsigned char* lds) {
  const int tid = opaque_tid(), w = tid >> 6, l = tid & 63; const int row0 = tt * 256; const int b = tt < 64 ? (tt >> 3) : 8; const int mrow0 = b * 256;
  constexpr unsigned KS = 528, VS = 576;
#pragma unroll 4
  for (int it = 0; it < 16; ++it) { const int q = tid + it * 512, m = q >> 5, c = q & 31;
    *(LAS u32x4*)(lds + m * KS + c * 16) = *(const u32x4*)(KV + (size_t)(mrow0 + m) * 2048 + head * 256 + c * 8); }
  __syncthreads();
  const int il = l & 31, h = l >> 5, i16 = l & 15, q4 = i16 >> 2, p4 = i16 & 3, G1 = (l >> 4) & 1;
  const int row = row0 + w * 32 + il;
  bf16x8 pf[8][2];
  float mxp = -3.0e38f, sum = 0.f;
  const bf16_t* qp = QX + (size_t)row * 1024 + head * 256 + 8 * h;
#pragma unroll
  for (int hf = 0; hf < 2; ++hf) {
    f32x16 sc[4];
#pragma unroll
    for (int i = 0; i < 4; ++i) sc[i] = (f32x16){};
#pragma unroll 4
    for (int ks = 0; ks < 16; ++ks) {
      const bf16x8 B = *(const bf16x8*)(qp + 16 * ks);
#pragma unroll
      for (int mt = 0; mt < 4; ++mt) sc[mt] = mfma32(*(const LAS bf16x8*)(lds + ((hf * 4 + mt) * 32 + il) * KS + (16 * ks + 8 * h) * 2), B, sc[mt]);
    }
    float mx = mxp;
#pragma unroll
    for (int mt = 0; mt < 4; ++mt)
#pragma unroll
      for (int r = 0; r < 16; ++r) mx = fmaxf(mx, sc[mt][r]);
    mx = fmaxf(mx, __shfl_xor(mx, 32));
    if (hf == 1) { const float f = __builtin_amdgcn_exp2f((mxp - mx) * 1.4426950408889634f); sum *= f;
#pragma unroll
      for (int mt = 0; mt < 4; ++mt) { pf[mt][0] = scale_frag(pf[mt][0], f); pf[mt][1] = scale_frag(pf[mt][1], f); } }
#pragma unroll
    for (int mt = 0; mt < 4; ++mt) {
      u32x4 p0, p1;
#pragma unroll
      for (int r = 0; r < 16; r += 2) {
        const float e0 = __builtin_amdgcn_exp2f((sc[mt][r] - mx) * 1.4426950408889634f), e1 = __builtin_amdgcn_exp2f((sc[mt][r + 1] - mx) * 1.4426950408889634f);
        sum += e0 + e1; const unsigned pk = cvt_pk_bf16(e0, e1);
        if (r < 8) p0[r >> 1] = pk; else p1[(r - 8) >> 1] = pk;
      }
      pf[hf * 4 + mt][0] = (bf16x8)p0; pf[hf * 4 + mt][1] = (bf16x8)p1;
    }
    mxp = mx;
  }
  sum += __shfl_xor(sum, 32);
  const float inv = __builtin_amdgcn_rcpf(sum);
  __builtin_amdgcn_sched_barrier(0);
  __syncthreads();
  __builtin_amdgcn_sched_barrier(0);
#pragma unroll 4
  for (int it = 0; it < 16; ++it) { const int q = tid + it * 512, m = q >> 5, c = q & 31;
    *(LAS u32x4*)(lds + m * VS + c * 16) = *(const u32x4*)(KV + (size_t)(mrow0 + m) * 2048 + 1024 + head * 256 + c * 8); }
  __syncthreads();
  __builtin_amdgcn_sched_barrier(0);
#pragma unroll 1
  for (int half = 0; half < 2; ++half) {
    f32x16 acc[4];
#pragma unroll
    for (int i = 0; i < 4; ++i) acc[i] = (f32x16){};
    const unsigned cofs = (unsigned)(half * 128 + 16 * G1 + 4 * p4) * 2u;
#pragma unroll
    for (int mt = 0; mt < 8; ++mt)
#pragma unroll
      for (int s = 0; s < 2; ++s) {
        const unsigned r = (unsigned)(mt * 32 + 16 * s + 4 * h + q4);
#pragma unroll
        for (int et = 0; et < 4; ++et) acc[et] = mfma32(tr_frag(lds, r * VS + et * 64 + cofs, (r + 8) * VS + et * 64 + cofs), pf[mt][s], acc[et]);
      }
    bf16_t* op = O + (size_t)row * 1024 + head * 256 + half * 128 + 4 * h;
#pragma unroll
    for (int et = 0; et < 4; ++et)
#pragma unroll
      for (int g = 0; g < 4; ++g)
        *(u32x2*)(op + et * 32 + 8 * g) = pack4(acc[et][4 * g] * inv, acc[et][4 * g + 1] * inv, acc[et][4 * g + 2] * inv, acc[et][4 * g + 3] * inv);
  }
  __syncthreads();
}

__device__ __forceinline__ float sel4(const float (&a)[4], int i) { return i == 0 ? a[0] : i == 1 ? a[1] : i == 2 ? a[2] : a[3]; }


#define XB_TMO      128
#define XB_XCNT(j)  (256  + 64 * (j))
#define XB_XSUB(j)  (1280 + 64 * (j))
#define XB_XGEN(j)  (2304 + 64 * (j))
#define XB_TOP      3328
#define XB_TOPGEN   3392
#define XCD_BAR_WORDS 3456
#define XB_SPIN_CAP (1u << 20)
__device__ __forceinline__ unsigned xb_ld(unsigned* p)              { return __hip_atomic_load(p, __ATOMIC_RELAXED, __HIP_MEMORY_SCOPE_AGENT); }
__device__ __forceinline__ unsigned xb_add(unsigned* p, unsigned v) { return __hip_atomic_fetch_add(p, v, __ATOMIC_RELAXED, __HIP_MEMORY_SCOPE_AGENT); }
__device__ __forceinline__ unsigned xb_xcc_id() { return (unsigned)__builtin_amdgcn_s_getreg((3 << 11) | 20) & 0xFu; }
#define XB_SPIN(cond, bar) do { unsigned _sp = 0; while (cond) { __builtin_amdgcn_s_sleep(1); \
    if ((++_sp & 255u) == 0u) { if (xb_ld(&(bar)[XB_TMO])) break; if (_sp > XB_SPIN_CAP) { atomicAdd(&(bar)[XB_TMO], 1u); break; } } } } while (0)
struct XcdBarrier { unsigned* bar; unsigned x; volatile LAS unsigned* st; };
__device__ __forceinline__ XcdBarrier xcd_barrier_post(unsigned* bar, volatile LAS unsigned* st) {
  XcdBarrier b; b.bar = bar; b.x = xb_xcc_id(); b.st = st;
  if (threadIdx.x == 0) (void)xb_add(&bar[XB_XCNT(b.x)], 1u);
  return b;
}
__device__ __forceinline__ void xcd_barrier_complete(unsigned* bar, unsigned x, unsigned& nloc, unsigned& nx) {
  const unsigned G = gridDim.x * gridDim.y * gridDim.z;
  unsigned sum, cnt, mine, sp = 0u;
  for (;;) {
    sum = 0u; cnt = 0u; mine = 0u;
#pragma unroll
    for (unsigned j = 0; j < 16; ++j) { const unsigned c = xb_ld(&bar[XB_XCNT(j)]); sum += c; cnt += (c > 0u) ? 1u : 0u; mine = (j == x) ? c : mine; }
    if (sum == G) break;
    __builtin_amdgcn_s_sleep(1);
    if ((++sp & 255u) == 0u) { if (xb_ld(&bar[XB_TMO])) break; if (sp > XB_SPIN_CAP) { atomicAdd(&bar[XB_TMO], 1u); break; } }
  }
  nloc = mine > 0u ? mine : 1u; nx = cnt > 0u ? cnt : 1u;
}
__device__ __forceinline__ void xcd_barrier(const XcdBarrier& b) {
  asm volatile("s_waitcnt vmcnt(0)" ::: "memory");
  __syncthreads();
  if (threadIdx.x == 0) {
    unsigned* bar = b.bar;
    __builtin_amdgcn_s_waitcnt(0);
    unsigned nloc = b.st[0], nx = b.st[1];
    if (nloc == 0u) { xcd_barrier_complete(bar, b.x, nloc, nx); b.st[0] = nloc; b.st[1] = nx; }
    const unsigned old = xb_add(&bar[XB_XSUB(b.x)], 1u);
    const unsigned gen = old / nloc;
    if (old + 1u == (gen + 1u) * nloc) {
      __builtin_amdgcn_fence(__ATOMIC_RELEASE, "agent");
      asm volatile("s_waitcnt vmcnt(0)" ::: "memory");
      const unsigned og = xb_add(&bar[XB_TOP], 1u);
      const unsigned tg = og / nx;
      if (og + 1u == (tg + 1u) * nx) xb_add(&bar[XB_TOPGEN], 1u);
      else XB_SPIN(xb_ld(&bar[XB_TOPGEN]) == tg, bar);
      __builtin_amdgcn_fence(__ATOMIC_ACQUIRE, "agent");
      xb_add(&bar[XB_XGEN(b.x)], 1u);
      asm volatile("s_waitcnt vmcnt(0)" ::: "memory");
    } else {
      XB_SPIN(xb_ld(&bar[XB_XGEN(b.x)]) == gen, bar);
      __builtin_amdgcn_fence(__ATOMIC_ACQUIRE, "agent");
      asm volatile("s_waitcnt vmcnt(0)" ::: "memory");
    }
  }
  __syncthreads();
}

__global__ void __launch_bounds__(512, 2) mega(Params p) {
  cg::grid_group grid = cg::this_grid();
  extern __shared__ __attribute__((aligned(16))) unsigned char smem_raw[];
  LAS unsigned char* lds = (LAS unsigned char*)smem_raw;
  float* ltf = (float*)smem_raw;
  const int tid = opaque_tid(), G = gridDim.x, wv = tid >> 6, lane = tid & 63;
  unsigned char* ws = p.ws;
  float2* TAB = (float2*)(ws + OFF_TAB); bf16_t* DT = (bf16_t*)(ws + OFF_DFT); bf16_t* MEMB = (bf16_t*)(ws + OFF_MEMB);
  float* RSS = (float*)(ws + OFF_RSS); bf16_t* XB = (bf16_t*)(ws + OFF_XB); bf16_t* WB = (bf16_t*)(ws + OFF_WB);
  bf16_t* RA = (bf16_t*)(ws + OFF_A); bf16_t* RS = (bf16_t*)(ws + OFF_S); bf16_t* RB = (bf16_t*)(ws + OFF_B);
  bf16_t* Zb = RA; bf16_t* Y1 = RA + 32 * MiB; bf16_t* GATES = RA; bf16_t* HID = RA; bf16_t* QX = RA; bf16_t* Ob = RA + 32 * MiB;
  bf16_t* STf = RS; bf16_t* STb = RS + 32 * MiB;
  bf16_t* Qb = RB; bf16_t* Kb = RB + 16 * MiB; bf16_t* Vb = RB + 32 * MiB; bf16_t* Fb = RB + 64 * MiB; bf16_t* Ub = RB; bf16_t* KVb = RB + 32 * MiB;
  float* X = p.X;
  bf16_t* XL = (bf16_t*)p.X;
  const LAS float* RSL = (const LAS float*)(lds + 131072);
  volatile LAS unsigned* xst = (volatile LAS unsigned*)(lds + 163824);
  if (threadIdx.x < 4) xst[threadIdx.x] = 0u;
  __syncthreads();
  const XcdBarrier xb = xcd_barrier_post((unsigned*)(ws + WS_NEED), xst);

  for (int r = blockIdx.x * 8 + wv; r < T_TOK; r += G * 8) {
    const float* src = r < 16384 ? p.in[0] + (size_t)r * DM : p.in[1] + (size_t)(r - 16384) * DM;
    float ss = 0.f;
#pragma unroll
    for (int k = 0; k < 4; ++k) { const f32x4 v = *(const f32x4*)(src + k * 256 + lane * 4);
      const u32x2 hi = pack4(v[0], v[1], v[2], v[3]);
      *(u32x2*)(XB + (size_t)r * DM + k * 256 + lane * 4) = hi;
      *(u32x2*)(XL + (size_t)r * DM + k * 256 + lane * 4) = pack4(v[0] - bf_lo(hi[0]), v[1] - bf_hi(hi[0]), v[2] - bf_lo(hi[1]), v[3] - bf_hi(hi[1]));
      ss += v[0] * v[0] + v[1] * v[1] + v[2] * v[2] + v[3] * v[3]; }
#pragma unroll
    for (int o = 32; o; o >>= 1) ss += __shfl_xor(ss, o);
    if (lane < 16) RSS[(size_t)r * 16 + lane] = lane == 0 ? ss : 0.f;
  }
  for (int r = blockIdx.x * 8 + wv; r < NMEMROWS; r += G * 8) {
    const float* src = r < 2048 ? p.in[2] + (size_t)r * DM : p.in[3] + (size_t)(r - 2048) * DM;
    f32x4 v0 = *(const f32x4*)(src + lane * 4), v1 = *(const f32x4*)(src + 256 + lane * 4), v2 = *(const f32x4*)(src + 512 + lane * 4), v3 = *(const f32x4*)(src + 768 + lane * 4);
    float ss = 0.f;
#pragma unroll
    for (int i = 0; i < 4; ++i) ss += v0[i] * v0[i] + v1[i] * v1[i] + v2[i] * v2[i] + v3[i] * v3[i];
#pragma unroll
    for (int o = 32; o; o >>= 1) ss += __shfl_xor(ss, o);
    const float rs = rsqrtf(ss * (1.f / 1024.f) + 1e-6f);
    bf16_t* mp = MEMB + (size_t)r * DM + lane * 4;
    *(u32x2*)(mp) = pack4(v0[0] * rs, v0[1] * rs, v0[2] * rs, v0[3] * rs); *(u32x2*)(mp + 256) = pack4(v1[0] * rs, v1[1] * rs, v1[2] * rs, v1[3] * rs);
    *(u32x2*)(mp + 512) = pack4(v2[0] * rs, v2[1] * rs, v2[2] * rs, v2[3] * rs); *(u32x2*)(mp + 768) = pack4(v3[0] * rs, v3[1] * rs, v3[2] * rs, v3[3] * rs);
  }
  for (int i = blockIdx.x * 512 + tid; i < 16384 * 64; i += G * 512) {
    const int s = i >> 6, d = i & 63;
    const float e = (float)d * 2.0f / 128.0f; const float inv = 1.0f / powf(10000.0f, e); const float ang = (float)s * inv;
    const double a = (double)ang * 0.15915494309189535; const double fr = a - rint(a);
    const float f = (float)fr;
    TAB[i] = make_float2(__builtin_amdgcn_cosf(f), __builtin_amdgcn_sinf(f));
  }
  for (int i = blockIdx.x * 512 + tid; i < 16384 + 4096 + 1024; i += G * 512) {
    int N, k, n, oc, os;
    if (i < 16384) { N = 128; k = i >> 7; n = i & 127; oc = DT_C128 + i; os = DT_S128 + i; }
    else if (i < 20480) { const int q = i - 16384; N = 64; k = q >> 6; n = q & 63; oc = DT_C64 + q; os = DT_S64 + q; }
    else { const int q = i - 20480; N = 32; k = q >> 5; n = q & 31; oc = DT_C32 + q; os = DT_S32 + q; }
    const float fr = (float)((k * n) & (N - 1)) / (float)N; const float sc = rsqrtf((float)N);
    const unsigned pk = cvt_pk_bf16(__builtin_amdgcn_cosf(fr) * sc, __builtin_amdgcn_sinf(fr) * sc);
    DT[oc] = (bf16_t)(pk & 0xffffu); DT[os] = (bf16_t)(pk >> 16);
  }

  for (int layer = 0; layer < 4; ++layer) {
    {
      int tb = 0;
      const float* g1 = p.in[4] + layer * DM; const float* gm = p.in[7] + layer * DM; const float* gx = p.in[14] + layer * DM;
      const float* gmem = p.in[15] + layer * DM; const float* g2 = p.in[19] + layer * DM;
      const float* wmix = p.in[8] + (size_t)layer * 1024 * 5632;
      prep_tiles(p.in[5] + (size_t)layer * 1024 * 5632, 5632, WB + W_1I, 1024, 5632, g1, 1.f, 1, 0, tb, ltf);
      prep_tiles(p.in[6] + (size_t)layer * DFF * 1024, 1024, WB + W_1O, DFF, 1024, nullptr, 1.f, 0, 0, tb, ltf);
      prep_zfold(wmix, gm, WB + W_M1, tb, ltf);
      prep_tiles(wmix, 5632, WB + W_M1 + (size_t)1024 * 1024, 1024, 512, gm, 1.f, 2, 512, tb, ltf);
      prep_tiles(wmix, 5632, WB + W_M1 + (size_t)1536 * 1024, 1024, 512, gm, 0.08838834764831845f, 2, 1024, tb, ltf);
      prep_tiles(wmix, 5632, WB + W_M1 + (size_t)2048 * 1024, 1024, 1024, gm, 1.f, 0, 1536, tb, ltf);
      prep_tiles(wmix, 5632, WB + W_M2, 1024, 3072, gm, 1.f, 0, 2560, tb, ltf);
      prep_tiles(p.in[9] + (size_t)layer * 512 * 1024, 1024, WB + W_F, 512, 1024, nullptr, 1.f, 0, 0, tb, ltf);
      prep_tiles(p.in[12] + (size_t)layer * 1024 * 1024, 1024, WB + W_R, 1024, 1024, nullptr, 1.f, 0, 0, tb, ltf);
      prep_tiles(p.in[13] + (size_t)layer * 1024 * 1024, 1024, WB + W_MO, 1024, 1024, nullptr, 1.f, 0, 0, tb, ltf);
      prep_tiles(p.in[16] + (size_t)layer * 1024 * 1024, 1024, WB + W_Q, 1024, 1024, gx, 1.f, 0, 0, tb, ltf);
      prep_tiles(p.in[17] + (size_t)layer * 1024 * 2048, 2048, WB + W_KV, 1024, 2048, gmem, 1.f, 0, 0, tb, ltf);
      prep_tiles(p.in[18] + (size_t)layer * 1024 * 1024, 1024, WB + W_O, 1024, 1024, nullptr, 1.f, 0, 0, tb, ltf);
      prep_tiles(p.in[20] + (size_t)layer * 1024 * 5632, 5632, WB + W_2I, 1024, 5632, g2, 1.f, 1, 0, tb, ltf);
      prep_tiles(p.in[21] + (size_t)layer * DFF * 1024, 1024, WB + W_2O, DFF, 1024, nullptr, 1.f, 0, 0, tb, ltf);
    }
    if (p.ws == nullptr) grid.sync();
    xcd_barrier(xb);
    run_gemm(lds, XB, WB + W_1I, T_TOK, 5632, 1024, EpiFfnIn{RSL, HID}, RSS);
    xcd_barrier(xb);
    run_gemm(lds, HID, WB + W_1O, T_TOK, 1024, DFF, EpiRes{XB, XL, XL, RSS, 0.5f});
    xcd_barrier(xb);
    run_gemm(lds, XB, WB + W_M1, T_TOK, 3072, 1024, EpiM1{RSL, TAB, Zb, Qb, Kb, Vb}, RSS);
    xcd_barrier(xb);
    float lgf2[4], lgb2[4], lgf[4], lgb[4];
#pragma unroll
    for (int hh = 0; hh < 4; ++hh) { lgf[hh] = log_sigmoid(p.in[10][layer * 4 + hh]); lgb[hh] = log_sigmoid(p.in[11][layer * 4 + hh]);
      lgf2[hh] = lgf[hh] * 1.4426950408889634f; lgb2[hh] = lgb[hh] * 1.4426950408889634f; }
    dft_phase<1>(Zb, Y1, DT, lds);
    for (int it = blockIdx.x; it < 1024; it += G) { const int hh = it & 3; ret_state_item(Kb, Vb, STf, STb, it >> 2, hh, sel4(lgf2, hh), sel4(lgb2, hh), lds); }
    xcd_barrier(xb);
    dft_phase<2>(Y1, Fb, DT, lds);
    for (int it = blockIdx.x; it < 256; it += G) {
      if (it < 128) { const int dir = it >> 6, sub = it & 63, hh = sub >> 4; ret_scan_seq(dir ? STb : STf, 128, 128, sub, dir ? sel4(lgb, hh) : sel4(lgf, hh), dir); }
      else for (int k = 0; k < 8; ++k) { const int r = (it - 128) * 8 + k, b = r >> 7, dir = (r >> 6) & 1, sub = r & 63, hh = sub >> 4;
        ret_scan_seq(dir ? STb : STf, b * 16, 16, sub, dir ? sel4(lgb, hh) : sel4(lgf, hh), dir); }
    }
    xcd_barrier(xb);
    for (int it = blockIdx.x; it < 1024; it += G) { const int hh = it & 3; ret_out_item(Qb, Kb, Vb, STf, STb, it >> 2, hh, sel4(lgf2, hh), sel4(lgb2, hh), lds); }
    xcd_barrier(xb);
    run_gemm(lds, XB, WB + W_M2, T_TOK, 3072, 1024, EpiM2{RSL, Vb, GATES}, RSS);
    xcd_barrier(xb);
    run_gemm(lds, Fb, WB + W_F, T_TOK, 1024, 512, EpiComb<0>{GATES, Ub});
    run_gemm(lds, Vb, WB + W_R, T_TOK, 1024, 1024, EpiComb<1>{GATES, Ub});
    xcd_barrier(xb);
    run_gemm(lds, Ub, WB + W_MO, T_TOK, 1024, 1024, EpiRes{XB, XL, XL, RSS, 1.0f});
    xcd_barrier(xb);
    run_gemm(lds, XB, WB + W_Q, T_TOK, 1024, 1024, EpiPlain<true>{RSL, QX, 1024, 0.0625f}, RSS);
    run_gemm(lds, MEMB, WB + W_KV, NMEMROWS, 2048, 1024, EpiPlain<false>{RSL, KVb, 2048, 1.0f});
    xcd_barrier(xb);
    for (int it = blockIdx.x; it < 512; it += G) attn_item(QX, KVb, Ob, it >> 2, it & 3, lds);
    xcd_barrier(xb);
    run_gemm(lds, Ob, WB + W_O, T_TOK, 1024, 1024, EpiRes{XB, XL, XL, RSS, 1.0f});
    xcd_barrier(xb);
    run_gemm(lds, XB, WB + W_2I, T_TOK, 5632, 1024, EpiFfnIn{RSL, HID}, RSS);
    xcd_barrier(xb);
    run_gemm(lds, HID, WB + W_2O, T_TOK, 1024, DFF, EpiRes{XB, XL, layer == 3 ? RB : XL, RSS, 0.5f});
    xcd_barrier(xb);
  }
  const int tidf = opaque_tid(), wvf = tidf >> 6, lanef = tidf & 63;
  for (int r = blockIdx.x * 8 + wvf; r < T_TOK; r += G * 8) {
    const float rs = row_rstd(RSS, r);
#pragma unroll
    for (int k = 0; k < 4; ++k) { const size_t o = (size_t)r * DM + k * 256 + lanef * 4; const f32x4 g = *(const f32x4*)(p.in[22] + k * 256 + lanef * 4);
      const u32x2 hi = *(const u32x2*)(XB + o), lo = *(const u32x2*)(RB + o);
      f32x4 v = {bf_lo(hi[0]) + bf_lo(lo[0]), bf_hi(hi[0]) + bf_hi(lo[0]), bf_lo(hi[1]) + bf_lo(lo[1]), bf_hi(hi[1]) + bf_hi(lo[1])};
      *(f32x4*)(X + o) = v * rs * g; }
  }
}

extern "C" void kernel_launch(void* const* d_in, const int* in_sizes, int n_in, void* d_out, int out_size, void* d_ws, size_t ws_size, hipStream_t stream) {
  constexpr size_t kDynLds = 163840;
  static int grid_blocks = 0;
  if (!grid_blocks) {
    (void)hipFuncSetAttribute((const void*)mega, hipFuncAttributeMaxDynamicSharedMemorySize, (int)kDynLds);
    int dev = 0, cus = 0, per_cu = 0;
    (void)hipGetDevice(&dev);
    (void)hipDeviceGetAttribute(&cus, hipDeviceAttributeMultiprocessorCount, dev);
    (void)hipOccupancyMaxActiveBlocksPerMultiprocessor(&per_cu, mega, 512, kDynLds);
    grid_blocks = cus > 0 ? cus : 256;
    if (per_cu < 1) fprintf(stderr, "occupancy query returned %d\n", per_cu);
  }
  if (ws_size < WS_NEED + 16384) { fprintf(stderr, "workspace too small: %zu < %zu\n", ws_size, (size_t)WS_NEED); return; }
  (void)hipMemsetAsync((unsigned char*)d_ws + WS_NEED, 0, XCD_BAR_WORDS * 4, stream);
  Params p{};
  for (int i = 0; i < 23; ++i) p.in[i] = (const float*)d_in[i];
  p.X = (float*)d_out; p.ws = (unsigned char*)d_ws;
  void* args[] = {&p};
  hipError_t e = hipLaunchCooperativeKernel((void*)mega, dim3(grid_blocks), dim3(512), args, kDynLds, stream);
  if (e != hipSuccess) fprintf(stderr, "cooperative launch failed: %s (grid %d)\n", hipGetErrorString(e), grid_blocks);
}
```

```cpp
#include <hip/hip_runtime.h>
#include <hip/hip_cooperative_groups.h>
#include <cstdio>
namespace cg = cooperative_groups;

#define LAS __attribute__((address_space(3)))
typedef unsigned short bf16_t;
typedef short bf16x8 __attribute__((ext_vector_type(8)));
typedef short s16x4 __attribute__((ext_vector_type(4)));
typedef float f32x4 __attribute__((ext_vector_type(4)));
typedef float f32x16 __attribute__((ext_vector_type(16)));
typedef unsigned u32x4 __attribute__((ext_vector_type(4)));
typedef unsigned u32x2 __attribute__((ext_vector_type(2)));

constexpr int T_TOK = 32768, DM = 1024, DFF = 2816, NMEMROWS = 2304;
constexpr size_t MiB = 1048576;
constexpr size_t OFF_TAB = 0;
constexpr size_t OFF_DFT = 8 * MiB;
constexpr size_t OFF_MEMB = OFF_DFT + 256 * 1024;
constexpr size_t OFF_RSS = OFF_MEMB + 4718592;
constexpr size_t OFF_XB = OFF_RSS + 2 * MiB;
constexpr size_t OFF_WB = OFF_XB + 64 * MiB;
constexpr size_t OFF_A = OFF_WB + 58 * MiB;
constexpr size_t OFF_S = OFF_A + 128 * MiB;
constexpr size_t OFF_B = OFF_S + 128 * MiB;
constexpr size_t WS_NEED = OFF_B + 160 * MiB;
constexpr size_t W_1I = 0, W_1O = 5767168, W_M1 = 8650752, W_M2 = 11796480, W_F = 14942208, W_R = 15466496, W_MO = 16515072,
                 W_Q = 17563648, W_KV = 18612224, W_O = 20709376, W_2I = 21757952, W_2O = 27525120;
constexpr int DT_C128 = 0, DT_S128 = 16384, DT_C64 = 32768, DT_S64 = 36864, DT_C32 = 40960, DT_S32 = 41984;

struct Params {
  const float* in[23];
  float* X;
  unsigned char* ws;
};

__device__ __forceinline__ int opaque_tid() { int t = threadIdx.x; asm volatile("" : "+v"(t)); return t; }
typedef __bf16 bf16x2_t __attribute__((ext_vector_type(2)));
typedef float f32x2 __attribute__((ext_vector_type(2)));
__device__ __forceinline__ unsigned cvt_pk_bf16(float lo, float hi) { f32x2 v = {lo, hi}; bf16x2_t b = __builtin_convertvector(v, bf16x2_t); return __builtin_bit_cast(unsigned, b); }
__device__ __forceinline__ float bf_lo(unsigned u) { return __uint_as_float(u << 16); }
__device__ __forceinline__ float bf_hi(unsigned u) { return __uint_as_float(u & 0xffff0000u); }
__device__ __forceinline__ u32x4 pack8(f32x4 a, f32x4 b) { u32x4 o; o[0] = cvt_pk_bf16(a[0], a[1]); o[1] = cvt_pk_bf16(a[2], a[3]); o[2] = cvt_pk_bf16(b[0], b[1]); o[3] = cvt_pk_bf16(b[2], b[3]); return o; }
__device__ __forceinline__ u32x2 pack4(float a, float b, float c, float d) { u32x2 o; o[0] = cvt_pk_bf16(a, b); o[1] = cvt_pk_bf16(c, d); return o; }
__device__ __forceinline__ unsigned pack_u8x4(float a, float b, float c, float d) {
  return (unsigned)(a * 255.f + 0.5f) | ((unsigned)(b * 255.f + 0.5f) << 8) | ((unsigned)(c * 255.f + 0.5f) << 16) | ((unsigned)(d * 255.f + 0.5f) << 24); }
__device__ __forceinline__ float u8f(unsigned w, int k) { return (float)((w >> (8 * k)) & 0xffu) * (1.f / 255.f); }
__device__ __forceinline__ float fsigmoid(float x) { return __builtin_amdgcn_rcpf(1.f + __expf(-x)); }
__device__ __forceinline__ float fsilu(float x) { return x * fsigmoid(x); }
__device__ __forceinline__ float row_rstd(const float* RSS, int row) {
  const f32x4* p = (const f32x4*)(RSS + (size_t)row * 16); f32x4 a = p[0], b = p[1], c = p[2], d = p[3];
  float s = ((a[0] + a[1]) + (a[2] + a[3])) + ((b[0] + b[1]) + (b[2] + b[3])) + ((c[0] + c[1]) + (c[2] + c[3])) + ((d[0] + d[1]) + (d[2] + d[3]));
  return rsqrtf(s * (1.f / 1024.f) + 1e-6f);
}
__device__ __forceinline__ bf16x8 tr_frag(const LAS unsigned char* lds, unsigned off_lo, unsigned off_hi) {
  s16x4 a = __builtin_amdgcn_ds_read_tr16_b64_v4i16((LAS s16x4*)(lds + off_lo));
  s16x4 b = __builtin_amdgcn_ds_read_tr16_b64_v4i16((LAS s16x4*)(lds + off_hi));
  return __builtin_shufflevector(a, b, 0, 1, 2, 3, 4, 5, 6, 7);
}
__device__ __forceinline__ f32x16 mfma32(bf16x8 a, bf16x8 b, f32x16 c) { return __builtin_amdgcn_mfma_f32_32x32x16_bf16(a, b, c, 0, 0, 0); }
__device__ __forceinline__ float log_sigmoid(float x) { return fminf(x, 0.f) - log1pf(expf(-fabsf(x))); }
__device__ __forceinline__ bf16x8 scale_frag(bf16x8 q, float s) {
  u32x4 u = (u32x4)q; u32x4 o;
#pragma unroll
  for (int i = 0; i < 4; ++i) o[i] = cvt_pk_bf16(bf_lo(u[i]) * s, bf_hi(u[i]) * s);
  return (bf16x8)o;
}

namespace pg8 {
constexpr int BM = 256, BK = 64, HALF = 128, HTB = HALF * BK * 2, STAGE_BYTES = 8 * HTB, NXCD = 8, WGM = 8;
__device__ __forceinline__ int lds_byte(int r, int c) { const int st = (r >> 4) * 2 + (c >> 5), rr = r & 15, cc = c & 31, ob = rr * 64 + cc * 2; return st * 1024 + (ob ^ (((ob >> 9) & 1) << 5)); }
__device__ __forceinline__ void stage_rc(int b, int& R, int& C) { const int st = b / 1024, sb = b % 1024, swz = sb ^ (((sb >> 9) & 1) << 5); R = (st >> 1) * 16 + swz / 64; C = (st & 1) * 32 + (swz % 64) / 2; }
__device__ __forceinline__ int perm32(int rho) { const int n = rho >> 4, i = rho & 15; return 8 * (i >> 2) + 4 * n + (i & 3); }
struct Unit { int pm, pn; };
struct Gemm { const bf16_t* A; const bf16_t* Bt; int M, N, K; };
struct StaticOrder {
  int nM, nN, nwg, G, c;
  __device__ void init(int M, int N, int G_, int c_) { nM = M / BM; nN = N / BM; nwg = nM * nN; G = G_; c = c_; }
  __device__ bool next(int i, Unit& u) const {
    const long L = (long)i * G + c; if (L >= nwg) return false;
    int wgid = (int)L; { const int q = nwg / NXCD, r = nwg % NXCD, xcd = wgid % NXCD, off = wgid / NXCD; wgid = (xcd < r ? xcd * (q + 1) : r * (q + 1) + (xcd - r) * q) + off; }
    const int nig = WGM * nN, gid = wgid / nig, fm = gid * WGM, gsz = (nM - fm) < WGM ? (nM - fm) : WGM;
    u.pm = fm + ((wgid % nig) % gsz); u.pn = (wgid % nig) / gsz; return true;
  }
  __device__ __forceinline__ void a_ready(const Unit&) const {}
  __device__ __forceinline__ void done(const Unit&) const {}
};

template <class Epi, class Sched>
__device__ __forceinline__ void gemm_phase(LAS unsigned char* lds, const Gemm g, const Sched& S, const Epi& E) {
  const int tid = opaque_tid(), wid = __builtin_amdgcn_readfirstlane(tid >> 6), lane = tid & 63, wr = wid >> 2, wc = wid & 3, fr = lane & 15, fq = lane >> 4;
  const int K = g.K, nt = K / BK;
  unsigned voffA[2], voffB[2];
#pragma unroll
  for (int i = 0; i < 2; ++i) { int R, C; stage_rc(tid * 16 + i * 8192, R, C); const int Rb = Epi::PERM ? ((R & ~31) + perm32(R & 31)) : R;
    voffA[i] = (unsigned)(R * K + C) * 2u; voffB[i] = (unsigned)(Rb * K + C) * 2u; }
  const size_t kstep = (size_t)(BK * 2);
  const size_t hstep = (size_t)HALF * K * 2;
  const size_t tstep = 2 * hstep;
  const unsigned ldsw = (unsigned)wid * 1024u;
  const int aoff = lds_byte(wr * 64 + fr, fq * 8), boff = lds_byte(wc * 32 + fr, fq * 8);
#define PG8_SA(b, h) (((b) * 2 + (h)) * HTB)
#define PG8_SB(b, h) ((4 + (b) * 2 + (h)) * HTB)
#define PG8_STAGE(bufoff, gbase, voff) do { _Pragma("unroll") for (int _i = 0; _i < 2; ++_i) \
    __builtin_amdgcn_global_load_lds((const unsigned*)((const char*)(gbase) + (voff)[_i]), (LAS unsigned*)(lds + (bufoff) + ldsw + _i * 8192), 16, 0, 0); } while (0)
#define PG8_LDA(dst, b, h) do { _Pragma("unroll") for (int m = 0; m < 4; ++m) _Pragma("unroll") for (int k = 0; k < 2; ++k) dst[m][k] = *(const LAS bf16x8*)(lds + PG8_SA(b, h) + aoff + m * 2048 + k * 1024); } while (0)
#define PG8_LDB(dst, b, h) do { _Pragma("unroll") for (int n = 0; n < 2; ++n) _Pragma("unroll") for (int k = 0; k < 2; ++k) dst[n][k] = *(const LAS bf16x8*)(lds + PG8_SB(b, h) + boff + n * 2048 + k * 1024); } while (0)
#define PG8_MMA(ai, bj, At, Bt) do { __builtin_amdgcn_s_setprio(1); _Pragma("unroll") for (int m = 0; m < 4; ++m) _Pragma("unroll") for (int n = 0; n < 2; ++n) _Pragma("unroll") for (int k = 0; k < 2; ++k) \
    acc[ai][bj][m][n] = __builtin_amdgcn_mfma_f32_16x16x32_bf16(Bt[n][k], At[m][k], acc[ai][bj][m][n], 0, 0, 0); __builtin_amdgcn_s_setprio(0); } while (0)
#define PG8_WAIT_V(n) asm volatile("s_waitcnt vmcnt(" #n ")" ::: "memory")
#define PG8_WAIT_L(n) asm volatile("s_waitcnt lgkmcnt(" #n ")" ::: "memory")
#define PG8_BAR __builtin_amdgcn_s_barrier()
#define PG8_SCHED __builtin_amdgcn_sched_barrier(0)
  Unit cur, nxt; int ui = 0;
  if (!S.next(0, cur)) return;
  f32x4 acc[2][2][4][2];
#pragma unroll
  for (int a = 0; a < 2; ++a)
#pragma unroll
    for (int b = 0; b < 2; ++b)
#pragma unroll
      for (int m = 0; m < 4; ++m)
#pragma unroll
        for (int n = 0; n < 2; ++n) acc[a][b][m][n] = (f32x4){0.f, 0.f, 0.f, 0.f};
  bf16x8 At[4][2], B0[2][2], B1[2][2];
  const char* cA = (const char*)g.A + (size_t)cur.pm * tstep; const char* cB = (const char*)g.Bt + (size_t)cur.pn * tstep;
  S.a_ready(cur);
  PG8_STAGE(PG8_SB(0, 0), cB, voffB); PG8_STAGE(PG8_SA(0, 0), cA, voffA); PG8_STAGE(PG8_SB(0, 1), cB + hstep, voffB); PG8_STAGE(PG8_SA(0, 1), cA + hstep, voffA);
  if (wr == 1) PG8_BAR;
  PG8_WAIT_V(4); PG8_BAR;
  PG8_STAGE(PG8_SB(1, 0), cB + kstep, voffB); PG8_STAGE(PG8_SA(1, 0), cA + kstep, voffA); PG8_STAGE(PG8_SB(1, 1), cB + hstep + kstep, voffB);
  PG8_WAIT_V(6); PG8_BAR;
  for (;;) {
    const bool has_next = S.next(ui + 1, nxt);
    const char* nA = has_next ? (const char*)g.A + (size_t)nxt.pm * tstep : cA; const char* nB = has_next ? (const char*)g.Bt + (size_t)nxt.pn * tstep : cB;
    for (int t = 0; t < nt; t += 2) {
      const bool last = (t == nt - 2);
      const char* a1 = cA + (size_t)(t + 1) * kstep;
      const char* a2 = last ? nA : cA + (size_t)(t + 2) * kstep; const char* b2 = last ? nB : cB + (size_t)(t + 2) * kstep;
      const char* a3 = a2 + kstep; const char* b3 = b2 + kstep;
      if (last && has_next) S.a_ready(nxt);
      PG8_LDB(B0, 0, 0); PG8_SCHED; PG8_LDA(At, 0, 0); PG8_STAGE(PG8_SA(1, 1), a1 + hstep, voffA);
      PG8_WAIT_L(8); PG8_BAR; PG8_WAIT_L(0); PG8_MMA(0, 0, At, B0); PG8_BAR; PG8_SCHED;
      PG8_LDB(B1, 0, 1); PG8_STAGE(PG8_SB(0, 0), b2, voffB);
      PG8_BAR; PG8_WAIT_L(0); PG8_MMA(0, 1, At, B1); PG8_BAR;
      PG8_LDA(At, 0, 1); PG8_STAGE(PG8_SA(0, 0), a2, voffA);
      PG8_BAR; PG8_WAIT_L(0); PG8_MMA(1, 0, At, B0); PG8_BAR; PG8_SCHED;
      PG8_STAGE(PG8_SB(0, 1), b2 + hstep, voffB);
      PG8_WAIT_V(6); PG8_BAR; PG8_MMA(1, 1, At, B1); PG8_BAR;
      PG8_LDB(B0, 1, 0); PG8_SCHED; PG8_LDA(At, 1, 0); PG8_STAGE(PG8_SA(0, 1), a2 + hstep, voffA);
      PG8_WAIT_L(8); PG8_BAR; PG8_WAIT_L(0); PG8_MMA(0, 0, At, B0); PG8_BAR; PG8_SCHED;
      PG8_LDB(B1, 1, 1); PG8_STAGE(PG8_SB(1, 0), b3, voffB);
      PG8_BAR; PG8_WAIT_L(0); PG8_MMA(0, 1, At, B1); PG8_BAR;
      PG8_LDA(At, 1, 1); PG8_STAGE(PG8_SA(1, 0), a3, voffA);
      PG8_BAR; PG8_WAIT_L(0); PG8_MMA(1, 0, At, B0); PG8_BAR; PG8_SCHED;
      PG8_STAGE(PG8_SB(1, 1), b3 + hstep, voffB);
      PG8_WAIT_V(6); PG8_BAR; PG8_MMA(1, 1, At, B1); PG8_BAR;
    }
    E(acc, cur, ui, wr, wc, fr, fq); S.done(cur);
    if (!has_next) break;
#pragma unroll
    for (int a = 0; a < 2; ++a)
#pragma unroll
      for (int b = 0; b < 2; ++b)
#pragma unroll
        for (int m = 0; m < 4; ++m)
#pragma unroll
          for (int n = 0; n < 2; ++n) acc[a][b][m][n] = (f32x4){0.f, 0.f, 0.f, 0.f};
    cur = nxt; cA = nA; cB = nB; ++ui;
  }
  PG8_WAIT_V(0);
  if (wr == 0) PG8_BAR;
  PG8_BAR;
#undef PG8_SA
#undef PG8_SB
#undef PG8_STAGE
#undef PG8_LDA
#undef PG8_LDB
#undef PG8_MMA
#undef PG8_WAIT_V
#undef PG8_WAIT_L
#undef PG8_BAR
#undef PG8_SCHED
}
}
using pg8::Unit;
typedef f32x4 AccT[2][2][4][2];

struct EpiFfnIn {
  static constexpr bool PERM = true;
  const LAS float* RSL; bf16_t* H;
  __device__ __forceinline__ void operator()(const AccT& acc, const Unit& u, int ui, int wr, int wc, int fr, int fq) const {
#pragma unroll
    for (int ai = 0; ai < 2; ++ai)
#pragma unroll
      for (int m = 0; m < 4; ++m) {
        const int row = u.pm * 256 + ai * 128 + wr * 64 + m * 16 + fr; const float rs = RSL[ui * 256 + ai * 128 + wr * 64 + m * 16 + fr];
        f32x4 h0, h1;
#pragma unroll
        for (int i = 0; i < 4; ++i) { h0[i] = fsilu(acc[ai][0][m][0][i] * rs) * (acc[ai][1][m][0][i] * rs); h1[i] = fsilu(acc[ai][0][m][1][i] * rs) * (acc[ai][1][m][1][i] * rs); }
        *(u32x4*)(H + (size_t)row * DFF + u.pn * 128 + wc * 32 + fq * 8) = pack8(h0, h1);
      }
  }
};
struct EpiRes {
  static constexpr bool PERM = true;
  bf16_t* XB; const bf16_t* XLi; bf16_t* XLo; float* RSS; float s;
  __device__ __forceinline__ void operator()(const AccT& acc, const Unit& u, int ui, int wr, int wc, int fr, int fq) const {
#pragma unroll
    for (int aim = 0; aim < 4; ++aim) {
      const int ai = aim >> 1, m0 = (aim & 1) * 2;
      u32x4 xh[4][2], xl[4][2];
#pragma unroll
      for (int m = m0; m < m0 + 2; ++m)
#pragma unroll
        for (int bj = 0; bj < 2; ++bj) {
          const size_t o = (size_t)(u.pm * 256 + ai * 128 + wr * 64 + m * 16 + fr) * DM + u.pn * 256 + bj * 128 + wc * 32 + fq * 8;
          xh[m][bj] = *(const u32x4*)(XB + o); xl[m][bj] = *(const u32x4*)(XLi + o);
        }
#pragma unroll
      for (int m = m0; m < m0 + 2; ++m) {
        const int row = u.pm * 256 + ai * 128 + wr * 64 + m * 16 + fr; float ss = 0.f;
#pragma unroll
        for (int bj = 0; bj < 2; ++bj) {
          const size_t o = (size_t)row * DM + u.pn * 256 + bj * 128 + wc * 32 + fq * 8;
          const u32x4 h4 = xh[m][bj], l4 = xl[m][bj];
          f32x4 y0, y1;
#pragma unroll
          for (int i = 0; i < 2; ++i) { y0[2 * i] = bf_lo(h4[i]) + bf_lo(l4[i]); y0[2 * i + 1] = bf_hi(h4[i]) + bf_hi(l4[i]); y1[2 * i] = bf_lo(h4[2 + i]) + bf_lo(l4[2 + i]); y1[2 * i + 1] = bf_hi(h4[2 + i]) + bf_hi(l4[2 + i]); }
          y0 += acc[ai][bj][m][0] * s; y1 += acc[ai][bj][m][1] * s;
          const u32x4 nh = pack8(y0, y1);
          f32x4 r0, r1;
#pragma unroll
          for (int i = 0; i < 2; ++i) { r0[2 * i] = y0[2 * i] - bf_lo(nh[i]); r0[2 * i + 1] = y0[2 * i + 1] - bf_hi(nh[i]); r1[2 * i] = y1[2 * i] - bf_lo(nh[2 + i]); r1[2 * i + 1] = y1[2 * i + 1] - bf_hi(nh[2 + i]); }
          *(u32x4*)(XB + o) = nh; *(u32x4*)(XLo + o) = pack8(r0, r1);
#pragma unroll
          for (int i = 0; i < 4; ++i) ss += y0[i] * y0[i] + y1[i] * y1[i];
        }
        ss += __shfl_xor(ss, 16); ss += __shfl_xor(ss, 32);
        if (fq == 0) RSS[(size_t)row * 16 + u.pn * 4 + wc] = ss;
      }
    }
  }
};
struct EpiM1 {
  static constexpr bool PERM = true;
  const LAS float* RSL; const float2* TAB; bf16_t* Z; bf16_t* Q; bf16_t* Kb; bf16_t* V;
  __device__ __forceinline__ void operator()(const AccT& acc, const Unit& u, int ui, int wr, int wc, int fr, int fq) const {
    const int pn = u.pn;
    if (pn < 4 || pn >= 8) {
      bf16_t* dst = pn < 4 ? Z : V; const int cb = (pn < 4 ? pn : pn - 8) * 256;
#pragma unroll
      for (int ai = 0; ai < 2; ++ai)
#pragma unroll
        for (int m = 0; m < 4; ++m) {
          const int row = u.pm * 256 + ai * 128 + wr * 64 + m * 16 + fr; const float rs = RSL[ui * 256 + ai * 128 + wr * 64 + m * 16 + fr];
#pragma unroll
          for (int bj = 0; bj < 2; ++bj)
            *(u32x4*)(dst + (size_t)row * 1024 + cb + bj * 128 + wc * 32 + fq * 8) = pack8(acc[ai][bj][m][0] * rs, acc[ai][bj][m][1] * rs);
        }
    } else {
      bf16_t* dst = pn < 6 ? Q : Kb; const int head = 2 * (pn < 6 ? pn - 4 : pn - 6) + (wc >> 1); const int d0 = 32 * (wc & 1) + 8 * fq;
#pragma unroll
      for (int aim = 0; aim < 4; ++aim) {
        const int ai = aim >> 1, m0 = (aim & 1) * 2;
        f32x4 tt[4][4];
#pragma unroll
        for (int m = m0; m < m0 + 2; ++m) {
          const int row = u.pm * 256 + ai * 128 + wr * 64 + m * 16 + fr; const int spos = row < 16384 ? (row & 2047) : row - 16384;
          const f32x4* tp = (const f32x4*)(TAB + (size_t)spos * 64 + d0);
          tt[m][0] = tp[0]; tt[m][1] = tp[1]; tt[m][2] = tp[2]; tt[m][3] = tp[3];
        }
#pragma unroll
        for (int m = m0; m < m0 + 2; ++m) {
          const int row = u.pm * 256 + ai * 128 + wr * 64 + m * 16 + fr; const float rs = RSL[ui * 256 + ai * 128 + wr * 64 + m * 16 + fr];
          const f32x4 t0 = tt[m][0], t1 = tt[m][1], t2 = tt[m][2], t3 = tt[m][3];
          f32x4 x1a = acc[ai][0][m][0] * rs, x1b = acc[ai][0][m][1] * rs, x2a = acc[ai][1][m][0] * rs, x2b = acc[ai][1][m][1] * rs;
          f32x4 ca = {t0[0], t0[2], t1[0], t1[2]}, sa = {t0[1], t0[3], t1[1], t1[3]}, cb2 = {t2[0], t2[2], t3[0], t3[2]}, sb = {t2[1], t2[3], t3[1], t3[3]};
          f32x4 o1a = x1a * ca - x2a * sa, o1b = x1b * cb2 - x2b * sb, o2a = x2a * ca + x1a * sa, o2b = x2b * cb2 + x1b * sb;
          bf16_t* op = dst + (size_t)row * 512 + head * 128 + d0;
          *(u32x4*)op = pack8(o1a, o1b); *(u32x4*)(op + 64) = pack8(o2a, o2b);
        }
      }
    }
  }
};
struct EpiM2 {
  static constexpr bool PERM = true;
  const LAS float* RSL; bf16_t* YN; bf16_t* GATES;
  __device__ __forceinline__ void operator()(const AccT& acc, const Unit& u, int ui, int wr, int wc, int fr, int fq) const {
    const int pn = u.pn;
    if (pn < 4) {
#pragma unroll
      for (int ai = 0; ai < 2; ++ai) {
        u32x4 yy[4][2];
#pragma unroll
        for (int m = 0; m < 4; ++m)
#pragma unroll
          for (int bj = 0; bj < 2; ++bj) yy[m][bj] = *(const u32x4*)(YN + (size_t)(u.pm * 256 + ai * 128 + wr * 64 + m * 16 + fr) * 1024 + pn * 256 + bj * 128 + wc * 32 + fq * 8);
#pragma unroll
        for (int m = 0; m < 4; ++m) {
          const int row = u.pm * 256 + ai * 128 + wr * 64 + m * 16 + fr; const float rs = RSL[ui * 256 + ai * 128 + wr * 64 + m * 16 + fr];
#pragma unroll
          for (int bj = 0; bj < 2; ++bj) {
            f32x4 a = acc[ai][bj][m][0] * rs, b = acc[ai][bj][m][1] * rs; const u32x4 y = yy[m][bj];
#pragma unroll
            for (int i = 0; i < 2; ++i) { a[2 * i] = fsilu(a[2 * i]) * bf_lo(y[i]); a[2 * i + 1] = fsilu(a[2 * i + 1]) * bf_hi(y[i]); b[2 * i] = fsilu(b[2 * i]) * bf_lo(y[2 + i]); b[2 * i + 1] = fsilu(b[2 * i + 1]) * bf_hi(y[2 + i]); }
            *(u32x4*)(YN + (size_t)row * 1024 + pn * 256 + bj * 128 + wc * 32 + fq * 8) = pack8(a, b);
          }
        }
      }
    } else {
#pragma unroll
      for (int ai = 0; ai < 2; ++ai)
#pragma unroll
        for (int m = 0; m < 4; ++m) {
          const int row = u.pm * 256 + ai * 128 + wr * 64 + m * 16 + fr; const float rs = RSL[ui * 256 + ai * 128 + wr * 64 + m * 16 + fr];
#pragma unroll
          for (int bj = 0; bj < 2; ++bj) {
            f32x4 a = acc[ai][bj][m][0] * rs, b = acc[ai][bj][m][1] * rs;
#pragma unroll
            for (int i = 0; i < 4; ++i) { a[i] = fsigmoid(a[i]); b[i] = fsigmoid(b[i]); }
            u32x2 g8; g8[0] = pack_u8x4(a[0], a[1], a[2], a[3]); g8[1] = pack_u8x4(b[0], b[1], b[2], b[3]);
            *(u32x2*)((unsigned char*)GATES + (size_t)row * 2048 + (pn - 4) * 256 + bj * 128 + wc * 32 + fq * 8) = g8;
          }
        }
    }
  }
};
template <int MODE> struct EpiComb {
  static constexpr bool PERM = true;
  const bf16_t* GATES; bf16_t* U;
  __device__ __forceinline__ void operator()(const AccT& acc, const Unit& u, int ui, int wr, int wc, int fr, int fq) const {
#pragma unroll
    for (int aim = 0; aim < 4; ++aim) {
      const int ai = aim >> 1, m0 = (aim & 1) * 2;
      u32x2 gv[4][2]; u32x4 yv[4][2];
#pragma unroll
      for (int m = m0; m < m0 + 2; ++m)
#pragma unroll
        for (int bj = 0; bj < 2; ++bj) {
          const size_t row = (size_t)(u.pm * 256 + ai * 128 + wr * 64 + m * 16 + fr); const int col = u.pn * 256 + bj * 128 + wc * 32 + fq * 8;
          gv[m][bj] = *(const u32x2*)((const unsigned char*)GATES + row * 2048 + MODE * 1024 + col);
          if (MODE == 1) yv[m][bj] = *(const u32x4*)(U + row * 1024 + col);
        }
#pragma unroll
      for (int m = m0; m < m0 + 2; ++m)
#pragma unroll
        for (int bj = 0; bj < 2; ++bj) {
          const size_t row = (size_t)(u.pm * 256 + ai * 128 + wr * 64 + m * 16 + fr); const int col = u.pn * 256 + bj * 128 + wc * 32 + fq * 8;
          const u32x2 gg = gv[m][bj];
          f32x4 a = acc[ai][bj][m][0], b = acc[ai][bj][m][1];
#pragma unroll
          for (int i = 0; i < 4; ++i) { a[i] *= u8f(gg[0], i); b[i] *= u8f(gg[1], i); }
          if (MODE == 1) { const u32x4 y = yv[m][bj];
#pragma unroll
            for (int i = 0; i < 2; ++i) { a[2 * i] += bf_lo(y[i]); a[2 * i + 1] += bf_hi(y[i]); b[2 * i] += bf_lo(y[2 + i]); b[2 * i + 1] += bf_hi(y[2 + i]); } }
          *(u32x4*)(U + row * 1024 + col) = pack8(a, b);
        }
    }
  }
};
template <bool USE_RS> struct EpiPlain {
  static constexpr bool PERM = true;
  const LAS float* RSL; bf16_t* O; int ldo; float s;
  __device__ __forceinline__ void operator()(const AccT& acc, const Unit& u, int ui, int wr, int wc, int fr, int fq) const {
#pragma unroll
    for (int ai = 0; ai < 2; ++ai)
#pragma unroll
      for (int m = 0; m < 4; ++m) {
        const int row = u.pm * 256 + ai * 128 + wr * 64 + m * 16 + fr; const float rs = USE_RS ? RSL[ui * 256 + ai * 128 + wr * 64 + m * 16 + fr] * s : s;
#pragma unroll
        for (int bj = 0; bj < 2; ++bj)
          *(u32x4*)(O + (size_t)row * ldo + u.pn * 256 + bj * 128 + wc * 32 + fq * 8) = pack8(acc[ai][bj][m][0] * rs, acc[ai][bj][m][1] * rs);
      }
  }
};

template <class Epi> __device__ __forceinline__ void run_gemm(LAS unsigned char* lds, const bf16_t* A, const bf16_t* Bt, int M, int N, int K, const Epi& E, const float* RSS = nullptr) {
  pg8::Gemm g{A, Bt, M, N, K}; pg8::StaticOrder S; S.init(M, N, gridDim.x, blockIdx.x);
  if (RSS) {
    LAS float* rsl = (LAS float*)(lds + 131072); const int tid = opaque_tid(); Unit u;
    for (int i = 0; S.next(i, u); ++i) if (tid < 256) rsl[i * 256 + tid] = row_rstd(RSS, u.pm * 256 + tid);
    __syncthreads();
  }
  pg8::gemm_phase<Epi, pg8::StaticOrder>(lds, g, S, E);
  __syncthreads();
}

__device__ void prep_tiles(const float* __restrict__ src, int ld, bf16_t* __restrict__ dst, int K, int Ndst, const float* __restrict__ gain, float scale,
                           int maptype, int mapbase, int& tbase, float* lt) {
  const int tid = opaque_tid(), G = gridDim.x;
  const int nkt = K >> 6, ntiles = (Ndst >> 6) * nkt;
  int start = (int)blockIdx.x - (tbase % G); if (start < 0) start += G;
  for (int t = start; t < ntiles; t += G) {
    const int nt = t / nkt, kt = t - nt * nkt, n0 = nt << 6, k0 = kt << 6;
    int sc0;
    if (maptype == 0) sc0 = mapbase + n0;
    else if (maptype == 1) { const int pn = n0 >> 8, h = (n0 >> 7) & 1, j = n0 & 127; sc0 = h * DFF + pn * 128 + j; }
    else { const int tt = n0 >> 8, c = n0 & 255, bj = c >> 7, cc = c & 127; sc0 = mapbase + (2 * tt + (cc >> 6)) * 128 + bj * 64 + (cc & 63); }
#pragma unroll
    for (int it = 0; it < 2; ++it) {
      const int idx = tid + it * 512, k = idx >> 4, n4 = idx & 15;
      const f32x4 v = *(const f32x4*)(src + (size_t)(k0 + k) * ld + sc0 + n4 * 4);
      const float g = scale * (gain ? gain[k0 + k] : 1.f);
      float* p = lt + k * 65 + n4 * 4; p[0] = v[0] * g; p[1] = v[1] * g; p[2] = v[2] * g; p[3] = v[3] * g;
    }
    __syncthreads();
    { const int n = tid >> 3, kc = (tid & 7) << 3; f32x4 a, b;
#pragma unroll
      for (int j = 0; j < 4; ++j) { a[j] = lt[(kc + j) * 65 + n]; b[j] = lt[(kc + 4 + j) * 65 + n]; }
      *(u32x4*)(dst + (size_t)(n0 + n) * K + k0 + kc) = pack8(a, b); }
    __syncthreads();
  }
  tbase += ntiles;
}
__device__ void prep_zfold(const float* __restrict__ wmix  , const float* __restrict__ gain, bf16_t* __restrict__ WM1, int& tbase, float* lt) {
  const int tid = opaque_tid(), G = gridDim.x;
  float* cosT = lt + 16 * 129; float* sinT = cosT + 128;
  int start = (int)blockIdx.x - (tbase % G); if (start < 0) start += G;
  for (int t = start; t < 256; t += G) {
    const int grp = t >> 6, k0 = (t & 63) << 4;
    { const int k = tid >> 5, c4 = tid & 31; const f32x4 v = *(const f32x4*)(wmix + (size_t)(k0 + k) * 5632 + grp * 128 + c4 * 4);
      float* p = lt + k * 129 + c4 * 4; p[0] = v[0]; p[1] = v[1]; p[2] = v[2]; p[3] = v[3]; }
    if (tid < 128) { cosT[tid] = __builtin_amdgcn_cosf((float)tid * (1.f / 128.f)); sinT[tid] = __builtin_amdgcn_sinf((float)tid * (1.f / 128.f)); }
    __syncthreads();
    { const int nl = tid >> 1, ri = nl >> 7, cc = nl & 127, kh = (tid & 1) << 3;
      float a0 = 0.f, a1 = 0.f, a2 = 0.f, a3 = 0.f, a4 = 0.f, a5 = 0.f, a6 = 0.f, a7 = 0.f;
      const float* lp = lt + kh * 129;
      for (int c = 0; c < 128; ++c) {
        const int idx = (c * cc) & 127; const float w = ri ? -sinT[idx] : cosT[idx];
        a0 += lp[c] * w; a1 += lp[129 + c] * w; a2 += lp[2 * 129 + c] * w; a3 += lp[3 * 129 + c] * w;
        a4 += lp[4 * 129 + c] * w; a5 += lp[5 * 129 + c] * w; a6 += lp[6 * 129 + c] * w; a7 += lp[7 * 129 + c] * w;
      }
      const float sc = 0.08838834764831845f; const float* gp = gain + k0 + kh;
      f32x4 o0 = {a0 * sc * gp[0], a1 * sc * gp[1], a2 * sc * gp[2], a3 * sc * gp[3]}, o1 = {a4 * sc * gp[4], a5 * sc * gp[5], a6 * sc * gp[6], a7 * sc * gp[7]};
      *(u32x4*)(WM1 + (size_t)(ri * 512 + grp * 128 + cc) * 1024 + k0 + kh) = pack8(o0, o1); }
    __syncthreads();
  }
  tbase += 256;
}

template <int STAGE>
__device__ void dft_item(const bf16_t* __restrict__ src, bf16_t* __restrict__ dst, const bf16_t* __restrict__ Ct, const bf16_t* __restrict__ St,
                         int N, int lgN, int rowbase, int j, int chblk, int S, int N1, int N2, LAS unsigned char* lds) {
  const int tid = opaque_tid(), w = tid >> 6, l = tid & 63;
  const int CB = 8192 >> lgN, stride = CB * 4 + 64;
  const int lgcpr = 11 - lgN, cpr = 1 << lgcpr;
#pragma unroll
  for (int it = 0; it < 4; ++it) {
    const int q = tid + it * 512, n = q >> lgcpr, cq = q & (cpr - 1), part = cq >> (lgcpr - 1), cc = cq & ((cpr >> 1) - 1);
    const int irow = STAGE == 1 ? rowbase + N2 * n + j : rowbase + j * N2 + n;
    const u32x4 v = *(const u32x4*)(src + (size_t)irow * 1024 + part * 512 + chblk * CB + cc * 8);
    *(LAS u32x4*)(lds + n * stride + (part * CB + cc * 8) * 2) = v;
  }
  __syncthreads();
  const int kts = N >> 5, kt = w & (kts - 1), chsub = w >> (lgN - 5);
  const int i16 = l & 15, q4 = i16 >> 2, p4 = i16 & 3, G1 = (l >> 4) & 1, h = l >> 5;
  const unsigned colre = (unsigned)(chsub * 32 + 16 * G1 + 4 * p4) * 2u, colim = colre + (unsigned)CB * 2u;
  const int kout = kt * 32 + (l & 31);
  f32x16 a0 = {}, a1 = {}, a2 = {};
  const int nks = N >> 4;
  bf16x8 Bc[8], Bs[8];
#pragma unroll
  for (int ks = 0; ks < 8; ++ks) if (ks < nks) { Bc[ks] = *(const bf16x8*)(Ct + kout * N + 16 * ks + 8 * h); Bs[ks] = *(const bf16x8*)(St + kout * N + 16 * ks + 8 * h); }
#pragma unroll
  for (int ks = 0; ks < 8; ++ks) if (ks < nks) {
    const unsigned rlo = (unsigned)(16 * ks + 8 * h + q4) * stride, rhi = rlo + 4u * stride;
    const bf16x8 Ar = tr_frag(lds, rlo + colre, rhi + colre), Ai = tr_frag(lds, rlo + colim, rhi + colim);
    a0 = mfma32(Ar, Bc[ks], a0); a0 = mfma32(Ai, Bs[ks], a0);
    if (STAGE == 1) { a1 = mfma32(Ai, Bc[ks], a1); a2 = mfma32(Ar, Bs[ks], a2); }
  }
  const int chb = chblk * CB + chsub * 32 + 4 * h;
  if (STAGE == 1) {
    const int mm = (j * kout) & (S - 1); const float fr = (float)mm / (float)S;
    const float c = __builtin_amdgcn_cosf(fr), s = __builtin_amdgcn_sinf(fr);
    const size_t orow = (size_t)(rowbase + kout * N2 + j) * 1024;
#pragma unroll
    for (int g = 0; g < 4; ++g) {
      float re[4], im[4];
#pragma unroll
      for (int i = 0; i < 4; ++i) { const float yr = a0[4 * g + i], yi = a1[4 * g + i] - a2[4 * g + i]; re[i] = yr * c + yi * s; im[i] = yi * c - yr * s; }
      *(u32x2*)(dst + orow + chb + 8 * g) = pack4(re[0], re[1], re[2], re[3]);
      *(u32x2*)(dst + orow + 512 + chb + 8 * g) = pack4(im[0], im[1], im[2], im[3]);
    }
  } else {
    const size_t orow = (size_t)(rowbase + j + N1 * kout) * 512;
#pragma unroll
    for (int g = 0; g < 4; ++g) *(u32x2*)(dst + orow + chb + 8 * g) = pack4(a0[4 * g], a0[4 * g + 1], a0[4 * g + 2], a0[4 * g + 3]);
  }
  __syncthreads();
}
template <int STAGE>
__device__ void dft_phase(const bf16_t* src, bf16_t* dst, const bf16_t* DT, LAS unsigned char* lds) {
  for (int it = blockIdx.x; it < 2048; it += gridDim.x) {
    if (it < 1024) dft_item<STAGE>(src, dst, DT + DT_C128, DT + DT_S128, 128, 7, 16384, it >> 3, it & 7, 16384, 128, 128, lds);
    else {
      const int r = it - 1024, b = r >> 7, rr = r & 127;
      if (STAGE == 1) dft_item<STAGE>(src, dst, DT + DT_C32, DT + DT_S32, 32, 5, b * 2048, rr >> 1, rr & 1, 2048, 32, 64, lds);
      else dft_item<STAGE>(src, dst, DT + DT_C64, DT + DT_S64, 64, 6, b * 2048, rr >> 2, rr & 3, 2048, 32, 64, lds);
    }
  }
}

__device__ void ret_state_item(const bf16_t* __restrict__ Kb, const bf16_t* __restrict__ Vb, bf16_t* __restrict__ STf, bf16_t* __restrict__ STb,
                               int cidx, int head, float lgf2, float lgb2, LAS unsigned char* lds) {
  const int tid = opaque_tid(), w = tid >> 6, l = tid & 63; const int row0 = cidx * 128;
  constexpr unsigned VS = 576, KS = 320, OKF = 73728, OKB = 114688;
#pragma unroll
  for (int it = 0; it < 8; ++it) { const int q = tid + it * 512, j = q >> 5, c = q & 31;
    *(LAS u32x4*)(lds + j * VS + c * 16) = *(const u32x4*)(Vb + (size_t)(row0 + j) * 1024 + head * 256 + c * 8); }
#pragma unroll
  for (int it = 0; it < 4; ++it) { const int q = tid + it * 512, j = q >> 4, c = q & 15;
    const u32x4 v = *(const u32x4*)(Kb + (size_t)(row0 + j) * 512 + head * 128 + c * 8);
    const float zf = __builtin_amdgcn_exp2f(lgf2 * (float)(127 - j)), zb = __builtin_amdgcn_exp2f(lgb2 * (float)j);
    u32x4 of, ob;
#pragma unroll
    for (int i = 0; i < 4; ++i) { const float a = bf_lo(v[i]), b = bf_hi(v[i]); of[i] = cvt_pk_bf16(a * zf, b * zf); ob[i] = cvt_pk_bf16(a * zb, b * zb); }
    *(LAS u32x4*)(lds + OKF + j * KS + c * 16) = of; *(LAS u32x4*)(lds + OKB + j * KS + c * 16) = ob; }
  __syncthreads();
  const int i16 = l & 15, q4 = i16 >> 2, p4 = i16 & 3, G1 = (l >> 4) & 1, h = l >> 5;
  const unsigned cofs = (unsigned)(16 * G1 + 4 * p4) * 2u;
  f32x16 af[4], ab[4];
#pragma unroll
  for (int i = 0; i < 4; ++i) { af[i] = (f32x16){}; ab[i] = (f32x16){}; }
  for (int ks = 0; ks < 8; ++ks) {
    const unsigned r = (unsigned)(16 * ks + 8 * h + q4);
    const bf16x8 Bv = tr_frag(lds, r * VS + w * 64 + cofs, (r + 4) * VS + w * 64 + cofs);
#pragma unroll
    for (int dt = 0; dt < 4; ++dt) {
      const bf16x8 Af = tr_frag(lds, OKF + r * KS + dt * 64 + cofs, OKF + (r + 4) * KS + dt * 64 + cofs);
      const bf16x8 Ab = tr_frag(lds, OKB + r * KS + dt * 64 + cofs, OKB + (r + 4) * KS + dt * 64 + cofs);
      af[dt] = mfma32(Af, Bv, af[dt]); ab[dt] = mfma32(Ab, Bv, ab[dt]);
    }
  }
  const size_t ob = ((size_t)(cidx * 4 + head) * 256 + w * 32 + (l & 31)) * 128 + 4 * h;
#pragma unroll
  for (int dt = 0; dt < 4; ++dt)
#pragma unroll
    for (int g = 0; g < 4; ++g) {
      *(u32x2*)(STf + ob + dt * 32 + 8 * g) = pack4(af[dt][4 * g], af[dt][4 * g + 1], af[dt][4 * g + 2], af[dt][4 * g + 3]);
      *(u32x2*)(STb + ob + dt * 32 + 8 * g) = pack4(ab[dt][4 * g], ab[dt][4 * g + 1], ab[dt][4 * g + 2], ab[dt][4 * g + 3]);
    }
  __syncthreads();
}
__device__ void ret_scan_seq(bf16_t* __restrict__ ST, int c0, int nch, int sub  , float lg, bool bwd) {
  const float g = expf(lg * 128.f);
  bf16_t* base = ST + (size_t)c0 * 131072 + (size_t)sub * 2048 + opaque_tid() * 4;
  float s0 = 0.f, s1 = 0.f, s2 = 0.f, s3 = 0.f;
  for (int cb = 0; cb < nch; cb += 8) {
    u32x2 u[8];
#pragma unroll
    for (int i = 0; i < 8; ++i) { const int c = bwd ? nch - 1 - (cb + i) : cb + i; u[i] = *(const u32x2*)(base + (size_t)c * 131072); }
#pragma unroll
    for (int i = 0; i < 8; ++i) { const int c = bwd ? nch - 1 - (cb + i) : cb + i;
      *(u32x2*)(base + (size_t)c * 131072) = pack4(s0, s1, s2, s3);
      s0 = g * s0 + bf_lo(u[i][0]); s1 = g * s1 + bf_hi(u[i][0]); s2 = g * s2 + bf_lo(u[i][1]); s3 = g * s3 + bf_hi(u[i][1]); }
  }
}
__device__ void ret_out_item(const bf16_t* __restrict__ Qb, const bf16_t* __restrict__ Kb, bf16_t* Vb, const bf16_t* __restrict__ STf, const bf16_t* __restrict__ STb,
                             int cidx, int head, float lgf2, float lgb2, LAS unsigned char* lds) {
  const int tid = opaque_tid(), w = tid >> 6, l = tid & 63; const int row0 = cidx * 128;
  constexpr unsigned VS = 576, ORED = 73728, QS = 272, OQ = 74752, OK = 74752 + 34816;
#pragma unroll
  for (int it = 0; it < 8; ++it) { const int q = tid + it * 512, j = q >> 5, c = q & 31;
    *(LAS u32x4*)(lds + j * VS + c * 16) = *(const u32x4*)(Vb + (size_t)(row0 + j) * 1024 + head * 256 + c * 8); }
#pragma unroll
  for (int it = 0; it < 4; ++it) { const int q = tid + it * 512, j = q >> 4, c = q & 15;
    *(LAS u32x4*)(lds + OQ + j * QS + c * 16) = *(const u32x4*)(Qb + (size_t)(row0 + j) * 512 + head * 128 + c * 8);
    *(LAS u32x4*)(lds + OK + j * QS + c * 16) = *(const u32x4*)(Kb + (size_t)(row0 + j) * 512 + head * 128 + c * 8); }
  __syncthreads();
  const int ib = w & 3, eh = w >> 2, il = l & 31, h = l >> 5;
  const int i16 = l & 15, q4 = i16 >> 2, p4 = i16 & 3, G1 = (l >> 4) & 1;
  const int iloc = ib * 32 + il;
  bf16x8 qf[8];
#pragma unroll
  for (int ks = 0; ks < 8; ++ks) qf[ks] = *(const LAS bf16x8*)(lds + OQ + iloc * QS + (16 * ks + 8 * h) * 2);
  bf16x8 pf[4][2];
#pragma unroll
  for (int jt = 0; jt < 4; ++jt) {
    f32x16 a = {};
#pragma unroll
    for (int ks = 0; ks < 8; ++ks) a = mfma32(*(const LAS bf16x8*)(lds + OK + (jt * 32 + il) * QS + (16 * ks + 8 * h) * 2), qf[ks], a);
    u32x4 p0, p1;
#pragma unroll
    for (int r = 0; r < 16; r += 2) {
      float v[2];
#pragma unroll
      for (int e = 0; e < 2; ++e) { const int jl = jt * 32 + ((r + e) & 3) + 8 * ((r + e) >> 2) + 4 * h; const int dd = iloc - jl;
        const float dec = dd >= 0 ? __builtin_amdgcn_exp2f(lgf2 * (float)dd) : __builtin_amdgcn_exp2f(lgb2 * (float)(-dd)); v[e] = a[r + e] * dec; }
      const unsigned pk = cvt_pk_bf16(v[0], v[1]);
      if (r < 8) p0[r >> 1] = pk; else p1[(r - 8) >> 1] = pk;
    }
    pf[jt][0] = (bf16x8)p0; pf[jt][1] = (bf16x8)p1;
  }
  f32x16 acc[4];
#pragma unroll
  for (int i = 0; i < 4; ++i) acc[i] = (f32x16){};
  const unsigned cofs = (unsigned)(eh * 128 + 16 * G1 + 4 * p4) * 2u;
#pragma unroll
  for (int jt = 0; jt < 4; ++jt)
#pragma unroll
    for (int s = 0; s < 2; ++s) {
      const unsigned r = (unsigned)(jt * 32 + 16 * s + 4 * h + q4);
#pragma unroll
      for (int et = 0; et < 4; ++et) acc[et] = mfma32(tr_frag(lds, r * VS + et * 64 + cofs, (r + 8) * VS + et * 64 + cofs), pf[jt][s], acc[et]);
    }
#pragma unroll
  for (int dir = 0; dir < 2; ++dir) {
    const float xi = dir ? __builtin_amdgcn_exp2f(lgb2 * (float)(128 - iloc)) : __builtin_amdgcn_exp2f(lgf2 * (float)(iloc + 1));
    const bf16_t* sp = (dir ? STb : STf) + ((size_t)(cidx * 4 + head) * 256 + eh * 128 + il) * 128 + 8 * h;
#pragma unroll
    for (int kp = 0; kp < 4; ++kp) {
      bf16x8 sf[2][4];
#pragma unroll
      for (int k2 = 0; k2 < 2; ++k2)
#pragma unroll
        for (int et = 0; et < 4; ++et) sf[k2][et] = *(const bf16x8*)(sp + (size_t)et * 32 * 128 + 16 * (2 * kp + k2));
#pragma unroll
      for (int k2 = 0; k2 < 2; ++k2) {
        const bf16x8 sq = scale_frag(qf[2 * kp + k2], xi);
#pragma unroll
        for (int et = 0; et < 4; ++et) acc[et] = mfma32(sf[k2][et], sq, acc[et]);
      }
    }
  }
  float ss = 0.f;
#pragma unroll
  for (int et = 0; et < 4; ++et)
#pragma unroll
    for (int r = 0; r < 16; ++r) ss += acc[et][r] * acc[et][r];
  ss += __shfl_xor(ss, 32);
  LAS float* red = (LAS float*)(lds + ORED);
  if (h == 0) red[eh * 128 + iloc] = ss;
  __syncthreads();
  const float rn = rsqrtf((red[iloc] + red[128 + iloc]) * (1.f / 256.f) + 1e-6f);
  bf16_t* op = Vb + (size_t)(row0 + iloc) * 1024 + head * 256 + eh * 128 + 4 * h;
#pragma unroll
  for (int et = 0; et < 4; ++et)
#pragma unroll
    for (int g = 0; g < 4; ++g)
      *(u32x2*)(op + et * 32 + 8 * g) = pack4(acc[et][4 * g] * rn, acc[et][4 * g + 1] * rn, acc[et][4 * g + 2] * rn, acc[et][4 * g + 3] * rn);
  __syncthreads();
}

__device__ void attn_item(const bf16_t* __restrict__ QX, const bf16_t* __restrict__ KV, bf16_t* __restrict__ O, int tt, int head, LAS unsigned char* lds) {
  const int tid = opaque_tid(), w = tid >> 6, l = tid & 63; const int row0 = tt * 256; const int b = tt < 64 ? (tt >> 3) : 8; const int mrow0 = b * 256;
  constexpr unsigned KS = 528, VS = 576;
#pragma unroll 4
  for (int it = 0; it < 16; ++it) { const int q = tid + it * 512, m = q >> 5, c = q & 31;
    *(LAS u32x4*)(lds + m * KS + c * 16) = *(const u32x4*)(KV + (size_t)(mrow0 + m) * 2048 + head * 256 + c * 8); }
  __syncthreads();
  const int il = l & 31, h = l >> 5, i16 = l & 15, q4 = i16 >> 2, p4 = i16 & 3, G1 = (l >> 4) & 1;
  const int row = row0 + w * 32 + il;
  bf16x8 pf[8][2];
  float mxp = -3.0e38f, sum = 0.f;
  const bf16_t* qp = QX + (size_t)row * 1024 + head * 256 + 8 * h;
#pragma unroll
  for (int hf = 0; hf < 2; ++hf) {
    f32x16 sc[4];
#pragma unroll
    for (int i = 0; i < 4; ++i) sc[i] = (f32x16){};
#pragma unroll 4
    for (int ks = 0; ks < 16; ++ks) {
      const bf16x8 B = *(const bf16x8*)(qp + 16 * ks);
#pragma unroll
      for (int mt = 0; mt < 4; ++mt) sc[mt] = mfma32(*(const LAS bf16x8*)(lds + ((hf * 4 + mt) * 32 + il) * KS + (16 * ks + 8 * h) * 2), B, sc[mt]);
    }
    float mx = mxp;
#pragma unroll
    for (int mt = 0; mt < 4; ++mt)
#pragma unroll
      for (int r = 0; r < 16; ++r) mx = fmaxf(mx, sc[mt][r]);
    mx = fmaxf(mx, __shfl_xor(mx, 32));
    if (hf == 1) { const float f = __builtin_amdgcn_exp2f((mxp - mx) * 1.4426950408889634f); sum *= f;
#pragma unroll
      for (int mt = 0; mt < 4; ++mt) { pf[mt][0] = scale_frag(pf[mt][0], f); pf[mt][1] = scale_frag(pf[mt][1], f); } }
#pragma unroll
    for (int mt = 0; mt < 4; ++mt) {
      u32x4 p0, p1;
#pragma unroll
      for (int r = 0; r < 16; r += 2) {
        const float e0 = __builtin_amdgcn_exp2f((sc[mt][r] - mx) * 1.4426950408889634f), e1 = __builtin_amdgcn_exp2f((sc[mt][r + 1] - mx) * 1.4426950408889634f);
        sum += e0 + e1; const unsigned pk = cvt_pk_bf16(e0, e1);
        if (r < 8) p0[r >> 1] = pk; else p1[(r - 8) >> 1] = pk;
      }
      pf[hf * 4 + mt][0] = (bf16x8)p0; pf[hf * 4 + mt][1] = (bf16x8)p1;
    }
    mxp = mx;
  }
  sum += __shfl_xor(sum, 32);
  const float inv = __builtin_amdgcn_rcpf(sum);
  __builtin_amdgcn_sched_barrier(0);
  __syncthreads();
  __builtin_amdgcn_sched_barrier(0);
#pragma unroll 4
  for (int it = 0; it < 16; ++it) { const int q = tid + it * 512, m = q >> 5, c = q & 31;
    *(LAS u32x4*)(lds + m * VS + c * 16) = *(const u32x4*)(KV + (size_t)(mrow0 + m) * 2048 + 1024 + head * 256 + c * 8); }
  __syncthreads();
  __builtin_amdgcn_sched_barrier(0);
#pragma unroll 1
  for (int half = 0; half < 2; ++half) {
    f32x16 acc[4];
#pragma unroll
    for (int i = 0; i < 4; ++i) acc[i] = (f32x16){};
    const unsigned cofs = (unsigned)(half * 128 + 16 * G1 + 4 * p4) * 2u;
#pragma unroll
    for (int mt = 0; mt < 8; ++mt)
#pragma unroll
      for (int s = 0; s < 2; ++s) {
        const unsigned r = (unsigned)(mt * 32 + 16 * s + 4 * h + q4);
#pragma unroll
        for (int et = 0; et < 4; ++et) acc[et] = mfma32(tr_frag(lds, r * VS + et * 64 + cofs, (r + 8) * VS + et * 64 + cofs), pf[mt][s], acc[et]);
      }
    bf16_t* op = O + (size_t)row * 1024 + head * 256 + half * 128 + 4 * h;
#pragma unroll
    for (int et = 0; et < 4; ++et)
#pragma unroll
      for (int g = 0; g < 4; ++g)
        *(u32x2*)(op + et * 32 + 8 * g) = pack4(acc[et][4 * g] * inv, acc[et][4 * g + 1] * inv, acc[et][4 * g + 2] * inv, acc[et][4 * g + 3] * inv);
  }
  __syncthreads();
}

__device__ __forceinline__ float sel4(const float (&a)[4], int i) { return i == 0 ? a[0] : i == 1 ? a[1] : i == 2 ? a[2] : a[3]; }


#define XB_TMO      128
#define XB_XCNT(j)  (256  + 64 * (j))
#define XB_XSUB(j)  (1280 + 64 * (j))
#define XB_XGEN(j)  (2304 + 64 * (j))
#define XB_TOP      3328
#define XB_TOPGEN   3392
#define XCD_BAR_WORDS 3456
#define XB_SPIN_CAP (1u << 20)
__device__ __forceinline__ unsigned xb_ld(unsigned* p)              { return __hip_atomic_load(p, __ATOMIC_RELAXED, __HIP_MEMORY_SCOPE_AGENT); }
__device__ __forceinline__ unsigned xb_add(unsigned* p, unsigned v) { return __hip_atomic_fetch_add(p, v, __ATOMIC_RELAXED, __HIP_MEMORY_SCOPE_AGENT); }
__device__ __forceinline__ unsigned xb_xcc_id() { return (unsigned)__builtin_amdgcn_s_getreg((3 << 11) | 20) & 0xFu; }
#define XB_SPIN(cond, bar) do { unsigned _sp = 0; while (cond) { __builtin_amdgcn_s_sleep(1); \
    if ((++_sp & 255u) == 0u) { if (xb_ld(&(bar)[XB_TMO])) break; if (_sp > XB_SPIN_CAP) { atomicAdd(&(bar)[XB_TMO], 1u); break; } } } } while (0)
struct XcdBarrier { unsigned* bar; unsigned x; volatile LAS unsigned* st; };
__device__ __forceinline__ XcdBarrier xcd_barrier_post(unsigned* bar, volatile LAS unsigned* st) {
  XcdBarrier b; b.bar = bar; b.x = xb_xcc_id(); b.st = st;
  if (threadIdx.x == 0) (void)xb_add(&bar[XB_XCNT(b.x)], 1u);
  return b;
}
__device__ __forceinline__ void xcd_barrier_complete(unsigned* bar, unsigned x, unsigned& nloc, unsigned& nx) {
  const unsigned G = gridDim.x * gridDim.y * gridDim.z;
  unsigned sum, cnt, mine, sp = 0u;
  for (;;) {
    sum = 0u; cnt = 0u; mine = 0u;
#pragma unroll
    for (unsigned j = 0; j < 16; ++j) { const unsigned c = xb_ld(&bar[XB_XCNT(j)]); sum += c; cnt += (c > 0u) ? 1u : 0u; mine = (j == x) ? c : mine; }
    if (sum == G) break;
    __builtin_amdgcn_s_sleep(1);
    if ((++sp & 255u) == 0u) { if (xb_ld(&bar[XB_TMO])) break; if (sp > XB_SPIN_CAP) { atomicAdd(&bar[XB_TMO], 1u); break; } }
  }
  nloc = mine > 0u ? mine : 1u; nx = cnt > 0u ? cnt : 1u;
}
__device__ __forceinline__ void xcd_barrier(const XcdBarrier& b) {
  asm volatile("s_waitcnt vmcnt(0)" ::: "memory");
  __syncthreads();
  if (threadIdx.x == 0) {
    unsigned* bar = b.bar;
    __builtin_amdgcn_s_waitcnt(0);
    unsigned nloc = b.st[0], nx = b.st[1];
    if (nloc == 0u) { xcd_barrier_complete(bar, b.x, nloc, nx); b.st[0] = nloc; b.st[1] = nx; }
    const unsigned old = xb_add(&bar[XB_XSUB(b.x)], 1u);
    const unsigned gen = old / nloc;
    if (old + 1u == (gen + 1u) * nloc) {
      __builtin_amdgcn_fence(__ATOMIC_RELEASE, "agent");
      asm volatile("s_waitcnt vmcnt(0)" ::: "memory");
      const unsigned og = xb_add(&bar[XB_TOP], 1u);
      const unsigned tg = og / nx;
      if (og + 1u == (tg + 1u) * nx) xb_add(&bar[XB_TOPGEN], 1u);
      else XB_SPIN(xb_ld(&bar[XB_TOPGEN]) == tg, bar);
      __builtin_amdgcn_fence(__ATOMIC_ACQUIRE, "agent");
      xb_add(&bar[XB_XGEN(b.x)], 1u);
      asm volatile("s_waitcnt vmcnt(0)" ::: "memory");
    } else {
      XB_SPIN(xb_ld(&bar[XB_XGEN(b.x)]) == gen, bar);
      __builtin_amdgcn_fence(__ATOMIC_ACQUIRE, "agent");
      asm volatile("s_waitcnt vmcnt(0)" ::: "memory");
    }
  }
  __syncthreads();
}

__global__ void __launch_bounds__(512, 2) mega(Params p) {
  cg::grid_group grid = cg::this_grid();
  extern __shared__ __attribute__((aligned(16))) unsigned char smem_raw[];
  LAS unsigned char* lds = (LAS unsigned char*)smem_raw;
  float* ltf = (float*)smem_raw;
  const int tid = opaque_tid(), G = gridDim.x, wv = tid >> 6, lane = tid & 63;
  unsigned char* ws = p.ws;
  float2* TAB = (float2*)(ws + OFF_TAB); bf16_t* DT = (bf16_t*)(ws + OFF_DFT); bf16_t* MEMB = (bf16_t*)(ws + OFF_MEMB);
  float* RSS = (float*)(ws + OFF_RSS); bf16_t* XB = (bf16_t*)(ws + OFF_XB); bf16_t* WB = (bf16_t*)(ws + OFF_WB);
  bf16_t* RA = (bf16_t*)(ws + OFF_A); bf16_t* RS = (bf16_t*)(ws + OFF_S); bf16_t* RB = (bf16_t*)(ws + OFF_B);
  bf16_t* Zb = RA; bf16_t* Y1 = RA + 32 * MiB; bf16_t* GATES = RA; bf16_t* HID = RA; bf16_t* QX = RA; bf16_t* Ob = RA + 32 * MiB;
  bf16_t* STf = RS; bf16_t* STb = RS + 32 * MiB;
  bf16_t* Qb = RB; bf16_t* Kb = RB + 16 * MiB; bf16_t* Vb = RB + 32 * MiB; bf16_t* Fb = RB + 64 * MiB; bf16_t* Ub = RB; bf16_t* KVb = RB + 32 * MiB;
  float* X = p.X;
  bf16_t* XL = (bf16_t*)p.X;
  const LAS float* RSL = (const LAS float*)(lds + 131072);
  volatile LAS unsigned* xst = (volatile LAS unsigned*)(lds + 163824);
  if (threadIdx.x < 4) xst[threadIdx.x] = 0u;
  __syncthreads();
  const XcdBarrier xb = xcd_barrier_post((unsigned*)(ws + WS_NEED), xst);

  for (int r = blockIdx.x * 8 + wv; r < T_TOK; r += G * 8) {
    const float* src = r < 16384 ? p.in[0] + (size_t)r * DM : p.in[1] + (size_t)(r - 16384) * DM;
    float ss = 0.f;
#pragma unroll
    for (int k = 0; k < 4; ++k) { const f32x4 v = *(const f32x4*)(src + k * 256 + lane * 4);
      const u32x2 hi = pack4(v[0], v[1], v[2], v[3]);
      *(u32x2*)(XB + (size_t)r * DM + k * 256 + lane * 4) = hi;
      *(u32x2*)(XL + (size_t)r * DM + k * 256 + lane * 4) = pack4(v[0] - bf_lo(hi[0]), v[1] - bf_hi(hi[0]), v[2] - bf_lo(hi[1]), v[3] - bf_hi(hi[1]));
      ss += v[0] * v[0] + v[1] * v[1] + v[2] * v[2] + v[3] * v[3]; }
#pragma unroll
    for (int o = 32; o; o >>= 1) ss += __shfl_xor(ss, o);
    if (lane < 16) RSS[(size_t)r * 16 + lane] = lane == 0 ? ss : 0.f;
  }
  for (int r = blockIdx.x * 8 + wv; r < NMEMROWS; r += G * 8) {
    const float* src = r < 2048 ? p.in[2] + (size_t)r * DM : p.in[3] + (size_t)(r - 2048) * DM;
    f32x4 v0 = *(const f32x4*)(src + lane * 4), v1 = *(const f32x4*)(src + 256 + lane * 4), v2 = *(const f32x4*)(src + 512 + lane * 4), v3 = *(const f32x4*)(src + 768 + lane * 4);
    float ss = 0.f;
#pragma unroll
    for (int i = 0; i < 4; ++i) ss += v0[i] * v0[i] + v1[i] * v1[i] + v2[i] * v2[i] + v3[i] * v3[i];
#pragma unroll
    for (int o = 32; o; o >>= 1) ss += __shfl_xor(ss, o);
    const float rs = rsqrtf(ss * (1.f / 1024.f) + 1e-6f);
    bf16_t* mp = MEMB + (size_t)r * DM + lane * 4;
    *(u32x2*)(mp) = pack4(v0[0] * rs, v0[1] * rs, v0[2] * rs, v0[3] * rs); *(u32x2*)(mp + 256) = pack4(v1[0] * rs, v1[1] * rs, v1[2] * rs, v1[3] * rs);
    *(u32x2*)(mp + 512) = pack4(v2[0] * rs, v2[1] * rs, v2[2] * rs, v2[3] * rs); *(u32x2*)(mp + 768) = pack4(v3[0] * rs, v3[1] * rs, v3[2] * rs, v3[3] * rs);
  }
  for (int i = blockIdx.x * 512 + tid; i < 16384 * 64; i += G * 512) {
    const int s = i >> 6, d = i & 63;
    const float e = (float)d * 2.0f / 128.0f; const float inv = 1.0f / powf(10000.0f, e); const float ang = (float)s * inv;
    const double a = (double)ang * 0.15915494309189535; const double fr = a - rint(a);
    const float f = (float)fr;
    TAB[i] = make_float2(__builtin_amdgcn_cosf(f), __builtin_amdgcn_sinf(f));
  }
  for (int i = blockIdx.x * 512 + tid; i < 16384 + 4096 + 1024; i += G * 512) {
    int N, k, n, oc, os;
    if (i < 16384) { N = 128; k = i >> 7; n = i & 127; oc = DT_C128 + i; os = DT_S128 + i; }
    else if (i < 20480) { const int q = i - 16384; N = 64; k = q >> 6; n = q & 63; oc = DT_C64 + q; os = DT_S64 + q; }
    else { const int q = i - 20480; N = 32; k = q >> 5; n = q & 31; oc = DT_C32 + q; os = DT_S32 + q; }
    const float fr = (float)((k * n) & (N - 1)) / (float)N; const float sc = rsqrtf((float)N);
    const unsigned pk = cvt_pk_bf16(__builtin_amdgcn_cosf(fr) * sc, __builtin_amdgcn_sinf(fr) * sc);
    DT[oc] = (bf16_t)(pk & 0xffffu); DT[os] = (bf16_t)(pk >> 16);
  }

  for (int layer = 0; layer < 4; ++layer) {
    {
      int tb = 0;
      const float* g1 = p.in[4] + layer * DM; const float* gm = p.in[7] + layer * DM; const float* gx = p.in[14] + layer * DM;
      const float* gmem = p.in[15] + layer * DM; const float* g2 = p.in[19] + layer * DM;
      const float* wmix = p.in[8] + (size_t)layer * 1024 * 5632;
      prep_tiles(p.in[5] + (size_t)layer * 1024 * 5632, 5632, WB + W_1I, 1024, 5632, g1, 1.f, 1, 0, tb, ltf);
      prep_tiles(p.in[6] + (size_t)layer * DFF * 1024, 1024, WB + W_1O, DFF, 1024, nullptr, 1.f, 0, 0, tb, ltf);
      prep_zfold(wmix, gm, WB + W_M1, tb, ltf);
      prep_tiles(wmix, 5632, WB + W_M1 + (size_t)1024 * 1024, 1024, 512, gm, 1.f, 2, 512, tb, ltf);
      prep_tiles(wmix, 5632, WB + W_M1 + (size_t)1536 * 1024, 1024, 512, gm, 0.08838834764831845f, 2, 1024, tb, ltf);
      prep_tiles(wmix, 5632, WB + W_M1 + (size_t)2048 * 1024, 1024, 1024, gm, 1.f, 0, 1536, tb, ltf);
      prep_tiles(wmix, 5632, WB + W_M2, 1024, 3072, gm, 1.f, 0, 2560, tb, ltf);
      prep_tiles(p.in[9] + (size_t)layer * 512 * 1024, 1024, WB + W_F, 512, 1024, nullptr, 1.f, 0, 0, tb, ltf);
      prep_tiles(p.in[12] + (size_t)layer * 1024 * 1024, 1024, WB + W_R, 1024, 1024, nullptr, 1.f, 0, 0, tb, ltf);
      prep_tiles(p.in[13] + (size_t)layer * 1024 * 1024, 1024, WB + W_MO, 1024, 1024, nullptr, 1.f, 0, 0, tb, ltf);
      prep_tiles(p.in[16] + (size_t)layer * 1024 * 1024, 1024, WB + W_Q, 1024, 1024, gx, 1.f, 0, 0, tb, ltf);
      prep_tiles(p.in[17] + (size_t)layer * 1024 * 2048, 2048, WB + W_KV, 1024, 2048, gmem, 1.f, 0, 0, tb, ltf);
      prep_tiles(p.in[18] + (size_t)layer * 1024 * 1024, 1024, WB + W_O, 1024, 1024, nullptr, 1.f, 0, 0, tb, ltf);
      prep_tiles(p.in[20] + (size_t)layer * 1024 * 5632, 5632, WB + W_2I, 1024, 5632, g2, 1.f, 1, 0, tb, ltf);
      prep_tiles(p.in[21] + (size_t)layer * DFF * 1024, 1024, WB + W_2O, DFF, 1024, nullptr, 1.f, 0, 0, tb, ltf);
    }
    if (p.ws == nullptr) grid.sync();
    xcd_barrier(xb);
    run_gemm(lds, XB, WB + W_1I, T_TOK, 5632, 1024, EpiFfnIn{RSL, HID}, RSS);
    xcd_barrier(xb);
    run_gemm(lds, HID, WB + W_1O, T_TOK, 1024, DFF, EpiRes{XB, XL, XL, RSS, 0.5f});
    xcd_barrier(xb);
    run_gemm(lds, XB, WB + W_M1, T_TOK, 3072, 1024, EpiM1{RSL, TAB, Zb, Qb, Kb, Vb}, RSS);
    xcd_barrier(xb);
    float lgf2[4], lgb2[4], lgf[4], lgb[4];
#pragma unroll
    for (int hh = 0; hh < 4; ++hh) { lgf[hh] = log_sigmoid(p.in[10][layer * 4 + hh]); lgb[hh] = log_sigmoid(p.in[11][layer * 4 + hh]);
      lgf2[hh] = lgf[hh] * 1.4426950408889634f; lgb2[hh] = lgb[hh] * 1.4426950408889634f; }
    dft_phase<1>(Zb, Y1, DT, lds);
    for (int it = blockIdx.x; it < 1024; it += G) { const int hh = it & 3; ret_state_item(Kb, Vb, STf, STb, it >> 2, hh, sel4(lgf2, hh), sel4(lgb2, hh), lds); }
    xcd_barrier(xb);
    dft_phase<2>(Y1, Fb, DT, lds);
    for (int it = blockIdx.x; it < 256; it += G) {
      if (it < 128) { const int dir = it >> 6, sub = it & 63, hh = sub >> 4; ret_scan_seq(dir ? STb : STf, 128, 128, sub, dir ? sel4(lgb, hh) : sel4(lgf, hh), dir); }
      else for (int k = 0; k < 8; ++k) { const int r = (it - 128) * 8 + k, b = r >> 7, dir = (r >> 6) & 1, sub = r & 63, hh = sub >> 4;
        ret_scan_seq(dir ? STb : STf, b * 16, 16, sub, dir ? sel4(lgb, hh) : sel4(lgf, hh), dir); }
    }
    xcd_barrier(xb);
    for (int it = blockIdx.x; it < 1024; it += G) { const int hh = it & 3; ret_out_item(Qb, Kb, Vb, STf, STb, it >> 2, hh, sel4(lgf2, hh), sel4(lgb2, hh), lds); }
    xcd_barrier(xb);
    run_gemm(lds, XB, WB + W_M2, T_TOK, 3072, 1024, EpiM2{RSL, Vb, GATES}, RSS);
    xcd_barrier(xb);
    run_gemm(lds, Fb, WB + W_F, T_TOK, 1024, 512, EpiComb<0>{GATES, Ub});
    run_gemm(lds, Vb, WB + W_R, T_TOK, 1024, 1024, EpiComb<1>{GATES, Ub});
    xcd_barrier(xb);
    run_gemm(lds, Ub, WB + W_MO, T_TOK, 1024, 1024, EpiRes{XB, XL, XL, RSS, 1.0f});
    xcd_barrier(xb);
    run_gemm(lds, XB, WB + W_Q, T_TOK, 1024, 1024, EpiPlain<true>{RSL, QX, 1024, 0.0625f}, RSS);
    run_gemm(lds, MEMB, WB + W_KV, NMEMROWS, 2048, 1024, EpiPlain<false>{RSL, KVb, 2048, 1.0f});
    xcd_barrier(xb);
    for (int it = blockIdx.x; it < 512; it += G) attn_item(QX, KVb, Ob, it >> 2, it & 3, lds);
    xcd_barrier(xb);
    run_gemm(lds, Ob, WB + W_O, T_TOK, 1024, 1024, EpiRes{XB, XL, XL, RSS, 1.0f});
    xcd_barrier(xb);
    run_gemm(lds, XB, WB + W_2I, T_TOK, 5632, 1024, EpiFfnIn{RSL, HID}, RSS);
    xcd_barrier(xb);
    run_gemm(lds, HID, WB + W_2O, T_TOK, 1024, DFF, EpiRes{XB, XL, layer == 3 ? RB : XL, RSS, 0.5f});
    xcd_barrier(xb);
  }
  const int tidf = opaque_tid(), wvf = tidf >> 6, lanef = tidf & 63;
  for (int r = blockIdx.x * 8 + wvf; r < T_TOK; r += G * 8) {
    const float rs = row_rstd(RSS, r);
#pragma unroll
    for (int k = 0; k < 4; ++k) { const size_t o = (size_t)r * DM + k * 256 + lanef * 4; const f32x4 g = *(const f32x4*)(p.in[22] + k * 256 + lanef * 4);
      const u32x2 hi = *(const u32x2*)(XB + o), lo = *(const u32x2*)(RB + o);
      f32x4 v = {bf_lo(hi[0]) + bf_lo(lo[0]), bf_hi(hi[0]) + bf_hi(lo[0]), bf_lo(hi[1]) + bf_lo(lo[1]), bf_hi(hi[1]) + bf_hi(lo[1])};
      *(f32x4*)(X + o) = v * rs * g; }
  }
}

extern "C" void kernel_launch(void* const* d_in, const int* in_sizes, int n_in, void* d_out, int out_size, void* d_ws, size_t ws_size, hipStream_t stream) {
  constexpr size_t kDynLds = 163840;
  static int grid_blocks = 0;
  if (!grid_blocks) {
    (void)hipFuncSetAttribute((const void*)mega, hipFuncAttributeMaxDynamicSharedMemorySize, (int)kDynLds);
    int dev = 0, cus = 0, per_cu = 0;
    (void)hipGetDevice(&dev);
    (void)hipDeviceGetAttribute(&cus, hipDeviceAttributeMultiprocessorCount, dev);
    (void)hipOccupancyMaxActiveBlocksPerMultiprocessor(&per_cu, mega, 512, kDynLds);
    grid_blocks = cus > 0 ? cus : 256;
    if (per_cu < 1) fprintf(stderr, "occupancy query returned %d\n", per_cu);
  }
  if (ws_size < WS_NEED + 16384) { fprintf(stderr, "workspace too small: %zu < %zu\n", ws_size, (size_t)WS_NEED); return; }
  (void)hipMemsetAsync((unsigned char*)d_ws + WS_NEED, 0, XCD_BAR_WORDS * 4, stream);
  Params p{};
  for (int i = 0; i < 23; ++i) p.in[i] = (const float*)d_in[i];
  p.X = (float*)d_out; p.ws = (unsigned char*)d_ws;
  void* args[] = {&p};
  hipError_t e = hipLaunchCooperativeKernel((void*)mega, dim3(grid_blocks), dim3(512), args, kDynLds, stream);
  if (e != hipSuccess) fprintf(stderr, "cooperative launch failed: %s (grid %d)\n", hipGetErrorString(e), grid_blocks);
}
```

```cpp
#include <hip/hip_runtime.h>
#include <hip/hip_cooperative_groups.h>
#include <cstdio>
namespace cg = cooperative_groups;

#define LAS __attribute__((address_space(3)))
typedef unsigned short bf16_t;
typedef short bf16x8 __attribute__((ext_vector_type(8)));
typedef short s16x4 __attribute__((ext_vector_type(4)));
typedef float f32x4 __attribute__((ext_vector_type(4)));
typedef float f32x16 __attribute__((ext_vector_type(16)));
typedef unsigned u32x4 __attribute__((ext_vector_type(4)));
typedef unsigned u32x2 __attribute__((ext_vector_type(2)));

constexpr int T_TOK = 32768, DM = 1024, DFF = 2816, NMEMROWS = 2304;
constexpr size_t MiB = 1048576;
constexpr size_t OFF_TAB = 0;
constexpr size_t OFF_DFT = 8 * MiB;
constexpr size_t OFF_MEMB = OFF_DFT + 256 * 1024;
constexpr size_t OFF_RSS = OFF_MEMB + 4718592;
constexpr size_t OFF_XB = OFF_RSS + 2 * MiB;
constexpr size_t OFF_WB = OFF_XB + 64 * MiB;
constexpr size_t OFF_A = OFF_WB + 58 * MiB;
constexpr size_t OFF_S = OFF_A + 128 * MiB;
constexpr size_t OFF_B = OFF_S + 128 * MiB;
constexpr size_t WS_NEED = OFF_B + 160 * MiB;
constexpr size_t W_1I = 0, W_1O = 5767168, W_M1 = 8650752, W_M2 = 11796480, W_F = 14942208, W_R = 15466496, W_MO = 16515072,
                 W_Q = 17563648, W_KV = 18612224, W_O = 20709376, W_2I = 21757952, W_2O = 27525120;
constexpr int DT_C128 = 0, DT_S128 = 16384, DT_C64 = 32768, DT_S64 = 36864, DT_C32 = 40960, DT_S32 = 41984;

struct Params {
  const float* in[23];
  float* X;
  unsigned char* ws;
};

__device__ __forceinline__ int opaque_tid() { int t = threadIdx.x; asm volatile("" : "+v"(t)); return t; }
typedef __bf16 bf16x2_t __attribute__((ext_vector_type(2)));
typedef float f32x2 __attribute__((ext_vector_type(2)));
__device__ __forceinline__ unsigned cvt_pk_bf16(float lo, float hi) { f32x2 v = {lo, hi}; bf16x2_t b = __builtin_convertvector(v, bf16x2_t); return __builtin_bit_cast(unsigned, b); }
__device__ __forceinline__ float bf_lo(unsigned u) { return __uint_as_float(u << 16); }
__device__ __forceinline__ float bf_hi(unsigned u) { return __uint_as_float(u & 0xffff0000u); }
__device__ __forceinline__ u32x4 pack8(f32x4 a, f32x4 b) { u32x4 o; o[0] = cvt_pk_bf16(a[0], a[1]); o[1] = cvt_pk_bf16(a[2], a[3]); o[2] = cvt_pk_bf16(b[0], b[1]); o[3] = cvt_pk_bf16(b[2], b[3]); return o; }
__device__ __forceinline__ u32x2 pack4(float a, float b, float c, float d) { u32x2 o; o[0] = cvt_pk_bf16(a, b); o[1] = cvt_pk_bf16(c, d); return o; }
__device__ __forceinline__ unsigned pack_u8x4(float a, float b, float c, float d) {
  return (unsigned)(a * 255.f + 0.5f) | ((unsigned)(b * 255.f + 0.5f) << 8) | ((unsigned)(c * 255.f + 0.5f) << 16) | ((unsigned)(d * 255.f + 0.5f) << 24); }
__device__ __forceinline__ float u8f(unsigned w, int k) { return (float)((w >> (8 * k)) & 0xffu) * (1.f / 255.f); }
__device__ __forceinline__ float fsigmoid(float x) { return __builtin_amdgcn_rcpf(1.f + __expf(-x)); }
__device__ __forceinline__ float fsilu(float x) { return x * fsigmoid(x); }
__device__ __forceinline__ f32x4 swiglu4(f32x4 g, f32x4 u, float c1  , float rs2  ) {
  f32x4 t = g * c1, d, r;
#pragma unroll
  for (int i = 0; i < 4; ++i) d[i] = __builtin_amdgcn_exp2f(t[i]);
  d = d + 1.0f;
#pragma unroll
  for (int i = 0; i < 4; ++i) r[i] = __builtin_amdgcn_rcpf(d[i]);
  return (g * u) * (r * rs2);
}
__device__ __forceinline__ f32x4 sigmoid4(f32x4 a, float c1) {
  f32x4 t = a * c1, d, r;
#pragma unroll
  for (int i = 0; i < 4; ++i) d[i] = __builtin_amdgcn_exp2f(t[i]);
  d = d + 1.0f;
#pragma unroll
  for (int i = 0; i < 4; ++i) r[i] = __builtin_amdgcn_rcpf(d[i]);
  return r;
}
__device__ __forceinline__ float row_rstd(const float* RSS, int row) {
  const f32x4* p = (const f32x4*)(RSS + (size_t)row * 16); f32x4 a = p[0], b = p[1], c = p[2], d = p[3];
  float s = ((a[0] + a[1]) + (a[2] + a[3])) + ((b[0] + b[1]) + (b[2] + b[3])) + ((c[0] + c[1]) + (c[2] + c[3])) + ((d[0] + d[1]) + (d[2] + d[3]));
  return rsqrtf(s * (1.f / 1024.f) + 1e-6f);
}
__device__ __forceinline__ bf16x8 tr_frag(const LAS unsigned char* lds, unsigned off_lo, unsigned off_hi) {
  s16x4 a = __builtin_amdgcn_ds_read_tr16_b64_v4i16((LAS s16x4*)(lds + off_lo));
  s16x4 b = __builtin_amdgcn_ds_read_tr16_b64_v4i16((LAS s16x4*)(lds + off_hi));
  return __builtin_shufflevector(a, b, 0, 1, 2, 3, 4, 5, 6, 7);
}
__device__ __forceinline__ f32x16 mfma32(bf16x8 a, bf16x8 b, f32x16 c) { return __builtin_amdgcn_mfma_f32_32x32x16_bf16(a, b, c, 0, 0, 0); }
__device__ __forceinline__ float log_sigmoid(float x) { return fminf(x, 0.f) - log1pf(expf(-fabsf(x))); }
__device__ __forceinline__ bf16x8 scale_frag(bf16x8 q, float s) {
  u32x4 u = (u32x4)q; u32x4 o;
#pragma unroll
  for (int i = 0; i < 4; ++i) o[i] = cvt_pk_bf16(bf_lo(u[i]) * s, bf_hi(u[i]) * s);
  return (bf16x8)o;
}

namespace pg8 {
constexpr int BM = 256, BK = 64, HALF = 128, HTB = HALF * BK * 2, STAGE_BYTES = 8 * HTB, NXCD = 8, WGM = 8;
__device__ __forceinline__ int lds_byte(int r, int c) { const int st = (r >> 4) * 2 + (c >> 5), rr = r & 15, cc = c & 31, ob = rr * 64 + cc * 2; return st * 1024 + (ob ^ (((ob >> 9) & 1) << 5)); }
__device__ __forceinline__ void stage_rc(int b, int& R, int& C) { const int st = b / 1024, sb = b % 1024, swz = sb ^ (((sb >> 9) & 1) << 5); R = (st >> 1) * 16 + swz / 64; C = (st & 1) * 32 + (swz % 64) / 2; }
__device__ __forceinline__ int perm32(int rho) { const int n = rho >> 4, i = rho & 15; return 8 * (i >> 2) + 4 * n + (i & 3); }
struct Unit { int pm, pn; };
struct Gemm { const bf16_t* A; const bf16_t* Bt; int M, N, K; };
struct StaticOrder {
  int nM, nN, nwg, G, c;
  __device__ void init(int M, int N, int G_, int c_) { nM = M / BM; nN = N / BM; nwg = nM * nN; G = G_; c = c_; }
  __device__ bool next(int i, Unit& u) const {
    const long L = (long)i * G + c; if (L >= nwg) return false;
    int wgid = (int)L; { const int q = nwg / NXCD, r = nwg % NXCD, xcd = wgid % NXCD, off = wgid / NXCD; wgid = (xcd < r ? xcd * (q + 1) : r * (q + 1) + (xcd - r) * q) + off; }
    const int nig = WGM * nN, gid = wgid / nig, fm = gid * WGM, gsz = (nM - fm) < WGM ? (nM - fm) : WGM;
    u.pm = fm + ((wgid % nig) % gsz); u.pn = (wgid % nig) / gsz; return true;
  }
  __device__ __forceinline__ void a_ready(const Unit&) const {}
  __device__ __forceinline__ void done(const Unit&) const {}
};

template <class Epi, class Sched>
__device__ __forceinline__ void gemm_phase(LAS unsigned char* lds, const Gemm g, const Sched& S, const Epi& E) {
  const int tid = opaque_tid(), wid = __builtin_amdgcn_readfirstlane(tid >> 6), lane = tid & 63, wr = wid >> 2, wc = wid & 3, fr = lane & 15, fq = lane >> 4;
  const int K = g.K, nt = K / BK;
  unsigned voffA[2], voffB[2];
#pragma unroll
  for (int i = 0; i < 2; ++i) { int R, C; stage_rc(tid * 16 + i * 8192, R, C); const int Rb = Epi::PERM ? ((R & ~31) + perm32(R & 31)) : R;
    voffA[i] = (unsigned)(R * K + C) * 2u; voffB[i] = (unsigned)(Rb * K + C) * 2u; }
  const size_t kstep = (size_t)(BK * 2);
  const size_t hstep = (size_t)HALF * K * 2;
  const size_t tstep = 2 * hstep;
  const unsigned ldsw = (unsigned)wid * 1024u;
  const int aoff = lds_byte(wr * 64 + fr, fq * 8), boff = lds_byte(wc * 32 + fr, fq * 8);
#define PG8_SA(b, h) (((b) * 2 + (h)) * HTB)
#define PG8_SB(b, h) ((4 + (b) * 2 + (h)) * HTB)
#define PG8_STAGE(bufoff, gbase, voff) do { _Pragma("unroll") for (int _i = 0; _i < 2; ++_i) \
    __builtin_amdgcn_global_load_lds((const unsigned*)((const char*)(gbase) + (voff)[_i]), (LAS unsigned*)(lds + (bufoff) + ldsw + _i * 8192), 16, 0, 0); } while (0)
#define PG8_LDA(dst, b, h) do { _Pragma("unroll") for (int m = 0; m < 4; ++m) _Pragma("unroll") for (int k = 0; k < 2; ++k) dst[m][k] = *(const LAS bf16x8*)(lds + PG8_SA(b, h) + aoff + m * 2048 + k * 1024); } while (0)
#define PG8_LDB(dst, b, h) do { _Pragma("unroll") for (int n = 0; n < 2; ++n) _Pragma("unroll") for (int k = 0; k < 2; ++k) dst[n][k] = *(const LAS bf16x8*)(lds + PG8_SB(b, h) + boff + n * 2048 + k * 1024); } while (0)
#define PG8_MMA(ai, bj, At, Bt) do { __builtin_amdgcn_s_setprio(1); _Pragma("unroll") for (int m = 0; m < 4; ++m) _Pragma("unroll") for (int n = 0; n < 2; ++n) _Pragma("unroll") for (int k = 0; k < 2; ++k) \
    acc[ai][bj][m][n] = __builtin_amdgcn_mfma_f32_16x16x32_bf16(Bt[n][k], At[m][k], acc[ai][bj][m][n], 0, 0, 0); __builtin_amdgcn_s_setprio(0); } while (0)
#define PG8_WAIT_V(n) asm volatile("s_waitcnt vmcnt(" #n ")" ::: "memory")
#define PG8_WAIT_L(n) asm volatile("s_waitcnt lgkmcnt(" #n ")" ::: "memory")
#define PG8_BAR __builtin_amdgcn_s_barrier()
#define PG8_SCHED __builtin_amdgcn_sched_barrier(0)
  Unit cur, nxt; int ui = 0;
  if (!S.next(0, cur)) return;
  f32x4 acc[2][2][4][2];
#pragma unroll
  for (int a = 0; a < 2; ++a)
#pragma unroll
    for (int b = 0; b < 2; ++b)
#pragma unroll
      for (int m = 0; m < 4; ++m)
#pragma unroll
        for (int n = 0; n < 2; ++n) acc[a][b][m][n] = (f32x4){0.f, 0.f, 0.f, 0.f};
  bf16x8 At[4][2], B0[2][2], B1[2][2];
  const char* cA = (const char*)g.A + (size_t)cur.pm * tstep; const char* cB = (const char*)g.Bt + (size_t)cur.pn * tstep;
  S.a_ready(cur);
  PG8_STAGE(PG8_SB(0, 0), cB, voffB); PG8_STAGE(PG8_SA(0, 0), cA, voffA); PG8_STAGE(PG8_SB(0, 1), cB + hstep, voffB); PG8_STAGE(PG8_SA(0, 1), cA + hstep, voffA);
  if (wr == 1) PG8_BAR;
  PG8_WAIT_V(4); PG8_BAR;
  PG8_STAGE(PG8_SB(1, 0), cB + kstep, voffB); PG8_STAGE(PG8_SA(1, 0), cA + kstep, voffA); PG8_STAGE(PG8_SB(1, 1), cB + hstep + kstep, voffB);
  PG8_WAIT_V(6); PG8_BAR;
  for (;;) {
    const bool has_next = S.next(ui + 1, nxt);
    const char* nA = has_next ? (const char*)g.A + (size_t)nxt.pm * tstep : cA; const char* nB = has_next ? (const char*)g.Bt + (size_t)nxt.pn * tstep : cB;
    for (int t = 0; t < nt; t += 2) {
      const bool last = (t == nt - 2);
      const char* a1 = cA + (size_t)(t + 1) * kstep;
      const char* a2 = last ? nA : cA + (size_t)(t + 2) * kstep; const char* b2 = last ? nB : cB + (size_t)(t + 2) * kstep;
      const char* a3 = a2 + kstep; const char* b3 = b2 + kstep;
      if (last && has_next) S.a_ready(nxt);
      PG8_LDB(B0, 0, 0); PG8_SCHED; PG8_LDA(At, 0, 0); PG8_STAGE(PG8_SA(1, 1), a1 + hstep, voffA);
      PG8_WAIT_L(8); PG8_BAR; PG8_WAIT_L(0); PG8_MMA(0, 0, At, B0); PG8_BAR; PG8_SCHED;
      PG8_LDB(B1, 0, 1); PG8_STAGE(PG8_SB(0, 0), b2, voffB);
      PG8_BAR; PG8_WAIT_L(0); PG8_MMA(0, 1, At, B1); PG8_BAR;
      PG8_LDA(At, 0, 1); PG8_STAGE(PG8_SA(0, 0), a2, voffA);
      PG8_BAR; PG8_WAIT_L(0); PG8_MMA(1, 0, At, B0); PG8_BAR; PG8_SCHED;
      PG8_STAGE(PG8_SB(0, 1), b2 + hstep, voffB);
      PG8_WAIT_V(6); PG8_BAR; PG8_MMA(1, 1, At, B1); PG8_BAR;
      PG8_LDB(B0, 1, 0); PG8_SCHED; PG8_LDA(At, 1, 0); PG8_STAGE(PG8_SA(0, 1), a2 + hstep, voffA);
      PG8_WAIT_L(8); PG8_BAR; PG8_WAIT_L(0); PG8_MMA(0, 0, At, B0); PG8_BAR; PG8_SCHED;
      PG8_LDB(B1, 1, 1); PG8_STAGE(PG8_SB(1, 0), b3, voffB);
      PG8_BAR; PG8_WAIT_L(0); PG8_MMA(0, 1, At, B1); PG8_BAR;
      PG8_LDA(At, 1, 1); PG8_STAGE(PG8_SA(1, 0), a3, voffA);
      PG8_BAR; PG8_WAIT_L(0); PG8_MMA(1, 0, At, B0); PG8_BAR; PG8_SCHED;
      PG8_STAGE(PG8_SB(1, 1), b3 + hstep, voffB);
      PG8_WAIT_V(6); PG8_BAR; PG8_MMA(1, 1, At, B1); PG8_BAR;
    }
    E(acc, cur, ui, wr, wc, fr, fq); S.done(cur);
    if (!has_next) break;
#pragma unroll
    for (int a = 0; a < 2; ++a)
#pragma unroll
      for (int b = 0; b < 2; ++b)
#pragma unroll
        for (int m = 0; m < 4; ++m)
#pragma unroll
          for (int n = 0; n < 2; ++n) acc[a][b][m][n] = (f32x4){0.f, 0.f, 0.f, 0.f};
    cur = nxt; cA = nA; cB = nB; ++ui;
  }
  PG8_WAIT_V(0);
  if (wr == 0) PG8_BAR;
  PG8_BAR;
#undef PG8_SA
#undef PG8_SB
#undef PG8_STAGE
#undef PG8_LDA
#undef PG8_LDB
#undef PG8_MMA
#undef PG8_WAIT_V
#undef PG8_WAIT_L
#undef PG8_BAR
#undef PG8_SCHED
}
}
using pg8::Unit;
typedef f32x4 AccT[2][2][4][2];

struct EpiFfnIn {
  static constexpr bool PERM = true;
  const LAS float* RSL; bf16_t* H;
  __device__ __forceinline__ void operator()(const AccT& acc, const Unit& u, int ui, int wr, int wc, int fr, int fq) const {
#pragma unroll
    for (int ai = 0; ai < 2; ++ai)
#pragma unroll
      for (int m = 0; m < 4; ++m) {
        const int row = u.pm * 256 + ai * 128 + wr * 64 + m * 16 + fr; const float rs = RSL[ui * 256 + ai * 128 + wr * 64 + m * 16 + fr];
        const float c1 = rs * -1.4426950408889634f, rs2 = rs * rs;
        const f32x4 h0 = swiglu4(acc[ai][0][m][0], acc[ai][1][m][0], c1, rs2), h1 = swiglu4(acc[ai][0][m][1], acc[ai][1][m][1], c1, rs2);
        *(u32x4*)(H + (size_t)row * DFF + u.pn * 128 + wc * 32 + fq * 8) = pack8(h0, h1);
      }
  }
};
struct EpiRes {
  static constexpr bool PERM = true;
  bf16_t* XB; const bf16_t* XLi; bf16_t* XLo; float* RSS; float s;
  __device__ __forceinline__ void operator()(const AccT& acc, const Unit& u, int ui, int wr, int wc, int fr, int fq) const {
#pragma unroll
    for (int aim = 0; aim < 4; ++aim) {
      const int ai = aim >> 1, m0 = (aim & 1) * 2;
      u32x4 xh[4][2], xl[4][2];
#pragma unroll
      for (int m = m0; m < m0 + 2; ++m)
#pragma unroll
        for (int bj = 0; bj < 2; ++bj) {
          const size_t o = (size_t)(u.pm * 256 + ai * 128 + wr * 64 + m * 16 + fr) * DM + u.pn * 256 + bj * 128 + wc * 32 + fq * 8;
          xh[m][bj] = *(const u32x4*)(XB + o); xl[m][bj] = *(const u32x4*)(XLi + o);
        }
#pragma unroll
      for (int m = m0; m < m0 + 2; ++m) {
        const int row = u.pm * 256 + ai * 128 + wr * 64 + m * 16 + fr; float ss = 0.f;
#pragma unroll
        for (int bj = 0; bj < 2; ++bj) {
          const size_t o = (size_t)row * DM + u.pn * 256 + bj * 128 + wc * 32 + fq * 8;
          const u32x4 h4 = xh[m][bj], l4 = xl[m][bj];
          f32x4 y0, y1;
#pragma unroll
          for (int i = 0; i < 2; ++i) { y0[2 * i] = bf_lo(h4[i]) + bf_lo(l4[i]); y0[2 * i + 1] = bf_hi(h4[i]) + bf_hi(l4[i]); y1[2 * i] = bf_lo(h4[2 + i]) + bf_lo(l4[2 + i]); y1[2 * i + 1] = bf_hi(h4[2 + i]) + bf_hi(l4[2 + i]); }
          y0 += acc[ai][bj][m][0] * s; y1 += acc[ai][bj][m][1] * s;
          const u32x4 nh = pack8(y0, y1);
          f32x4 r0, r1;
#pragma unroll
          for (int i = 0; i < 2; ++i) { r0[2 * i] = y0[2 * i] - bf_lo(nh[i]); r0[2 * i + 1] = y0[2 * i + 1] - bf_hi(nh[i]); r1[2 * i] = y1[2 * i] - bf_lo(nh[2 + i]); r1[2 * i + 1] = y1[2 * i + 1] - bf_hi(nh[2 + i]); }
          *(u32x4*)(XB + o) = nh; *(u32x4*)(XLo + o) = pack8(r0, r1);
#pragma unroll
          for (int i = 0; i < 4; ++i) ss += y0[i] * y0[i] + y1[i] * y1[i];
        }
        ss += __shfl_xor(ss, 16); ss += __shfl_xor(ss, 32);
        if (fq == 0) RSS[(size_t)row * 16 + u.pn * 4 + wc] = ss;
      }
    }
  }
};
struct EpiM1 {
  static constexpr bool PERM = true;
  const LAS float* RSL; const float2* TAB; bf16_t* Z; bf16_t* Q; bf16_t* Kb; bf16_t* V;
  __device__ __forceinline__ void operator()(const AccT& acc, const Unit& u, int ui, int wr, int wc, int fr, int fq) const {
    const int pn = u.pn;
    if (pn < 4 || pn >= 8) {
      bf16_t* dst = pn < 4 ? Z : V; const int cb = (pn < 4 ? pn : pn - 8) * 256;
#pragma unroll
      for (int ai = 0; ai < 2; ++ai)
#pragma unroll
        for (int m = 0; m < 4; ++m) {
          const int row = u.pm * 256 + ai * 128 + wr * 64 + m * 16 + fr; const float rs = RSL[ui * 256 + ai * 128 + wr * 64 + m * 16 + fr];
#pragma unroll
          for (int bj = 0; bj < 2; ++bj)
            *(u32x4*)(dst + (size_t)row * 1024 + cb + bj * 128 + wc * 32 + fq * 8) = pack8(acc[ai][bj][m][0] * rs, acc[ai][bj][m][1] * rs);
        }
    } else {
      bf16_t* dst = pn < 6 ? Q : Kb; const int head = 2 * (pn < 6 ? pn - 4 : pn - 6) + (wc >> 1); const int d0 = 32 * (wc & 1) + 8 * fq;
#pragma unroll
      for (int aim = 0; aim < 4; ++aim) {
        const int ai = aim >> 1, m0 = (aim & 1) * 2;
        f32x4 tt[4][4];
#pragma unroll
        for (int m = m0; m < m0 + 2; ++m) {
          const int row = u.pm * 256 + ai * 128 + wr * 64 + m * 16 + fr; const int spos = row < 16384 ? (row & 2047) : row - 16384;
          const f32x4* tp = (const f32x4*)(TAB + (size_t)spos * 64 + d0);
          tt[m][0] = tp[0]; tt[m][1] = tp[1]; tt[m][2] = tp[2]; tt[m][3] = tp[3];
        }
#pragma unroll
        for (int m = m0; m < m0 + 2; ++m) {
          const int row = u.pm * 256 + ai * 128 + wr * 64 + m * 16 + fr; const float rs = RSL[ui * 256 + ai * 128 + wr * 64 + m * 16 + fr];
          const f32x4 t0 = tt[m][0], t1 = tt[m][1], t2 = tt[m][2], t3 = tt[m][3];
          f32x4 x1a = acc[ai][0][m][0] * rs, x1b = acc[ai][0][m][1] * rs, x2a = acc[ai][1][m][0] * rs, x2b = acc[ai][1][m][1] * rs;
          f32x4 ca = {t0[0], t0[2], t1[0], t1[2]}, sa = {t0[1], t0[3], t1[1], t1[3]}, cb2 = {t2[0], t2[2], t3[0], t3[2]}, sb = {t2[1], t2[3], t3[1], t3[3]};
          f32x4 o1a = x1a * ca - x2a * sa, o1b = x1b * cb2 - x2b * sb, o2a = x2a * ca + x1a * sa, o2b = x2b * cb2 + x1b * sb;
          bf16_t* op = dst + (size_t)row * 512 + head * 128 + d0;
          *(u32x4*)op = pack8(o1a, o1b); *(u32x4*)(op + 64) = pack8(o2a, o2b);
        }
      }
    }
  }
};
struct EpiM2 {
  static constexpr bool PERM = true;
  const LAS float* RSL; bf16_t* YN; bf16_t* GATES;
  __device__ __forceinline__ void operator()(const AccT& acc, const Unit& u, int ui, int wr, int wc, int fr, int fq) const {
    const int pn = u.pn;
    if (pn < 4) {
#pragma unroll
      for (int ai = 0; ai < 2; ++ai) {
        u32x4 yy[4][2];
#pragma unroll
        for (int m = 0; m < 4; ++m)
#pragma unroll
          for (int bj = 0; bj < 2; ++bj) yy[m][bj] = *(const u32x4*)(YN + (size_t)(u.pm * 256 + ai * 128 + wr * 64 + m * 16 + fr) * 1024 + pn * 256 + bj * 128 + wc * 32 + fq * 8);
#pragma unroll
        for (int m = 0; m < 4; ++m) {
          const int row = u.pm * 256 + ai * 128 + wr * 64 + m * 16 + fr; const float rs = RSL[ui * 256 + ai * 128 + wr * 64 + m * 16 + fr];
#pragma unroll
          for (int bj = 0; bj < 2; ++bj) {
            f32x4 a = acc[ai][bj][m][0] * rs, b = acc[ai][bj][m][1] * rs; const u32x4 y = yy[m][bj];
#pragma unroll
            for (int i = 0; i < 2; ++i) { a[2 * i] = fsilu(a[2 * i]) * bf_lo(y[i]); a[2 * i + 1] = fsilu(a[2 * i + 1]) * bf_hi(y[i]); b[2 * i] = fsilu(b[2 * i]) * bf_lo(y[2 + i]); b[2 * i + 1] = fsilu(b[2 * i + 1]) * bf_hi(y[2 + i]); }
            *(u32x4*)(YN + (size_t)row * 1024 + pn * 256 + bj * 128 + wc * 32 + fq * 8) = pack8(a, b);
          }
        }
      }
    } else {
#pragma unroll
      for (int ai = 0; ai < 2; ++ai)
#pragma unroll
        for (int m = 0; m < 4; ++m) {
          const int row = u.pm * 256 + ai * 128 + wr * 64 + m * 16 + fr; const float rs = RSL[ui * 256 + ai * 128 + wr * 64 + m * 16 + fr];
#pragma unroll
          for (int bj = 0; bj < 2; ++bj) {
            const float c1 = rs * -1.4426950408889634f;
            const f32x4 a = sigmoid4(acc[ai][bj][m][0], c1), b = sigmoid4(acc[ai][bj][m][1], c1);
            u32x2 g8; g8[0] = pack_u8x4(a[0], a[1], a[2], a[3]); g8[1] = pack_u8x4(b[0], b[1], b[2], b[3]);
            *(u32x2*)((unsigned char*)GATES + (size_t)row * 2048 + (pn - 4) * 256 + bj * 128 + wc * 32 + fq * 8) = g8;
          }
        }
    }
  }
};
template <int MODE> struct EpiComb {
  static constexpr bool PERM = true;
  const bf16_t* GATES; bf16_t* U;
  __device__ __forceinline__ void operator()(const AccT& acc, const Unit& u, int ui, int wr, int wc, int fr, int fq) const {
#pragma unroll
    for (int aim = 0; aim < 4; ++aim) {
      const int ai = aim >> 1, m0 = (aim & 1) * 2;
      u32x2 gv[4][2]; u32x4 yv[4][2];
#pragma unroll
      for (int m = m0; m < m0 + 2; ++m)
#pragma unroll
        for (int bj = 0; bj < 2; ++bj) {
          const size_t row = (size_t)(u.pm * 256 + ai * 128 + wr * 64 + m * 16 + fr); const int col = u.pn * 256 + bj * 128 + wc * 32 + fq * 8;
          gv[m][bj] = *(const u32x2*)((const unsigned char*)GATES + row * 2048 + MODE * 1024 + col);
          if (MODE == 1) yv[m][bj] = *(const u32x4*)(U + row * 1024 + col);
        }
#pragma unroll
      for (int m = m0; m < m0 + 2; ++m)
#pragma unroll
        for (int bj = 0; bj < 2; ++bj) {
          const size_t row = (size_t)(u.pm * 256 + ai * 128 + wr * 64 + m * 16 + fr); const int col = u.pn * 256 + bj * 128 + wc * 32 + fq * 8;
          const u32x2 gg = gv[m][bj];
          f32x4 a = acc[ai][bj][m][0], b = acc[ai][bj][m][1];
#pragma unroll
          for (int i = 0; i < 4; ++i) { a[i] *= u8f(gg[0], i); b[i] *= u8f(gg[1], i); }
          if (MODE == 1) { const u32x4 y = yv[m][bj];
#pragma unroll
            for (int i = 0; i < 2; ++i) { a[2 * i] += bf_lo(y[i]); a[2 * i + 1] += bf_hi(y[i]); b[2 * i] += bf_lo(y[2 + i]); b[2 * i + 1] += bf_hi(y[2 + i]); } }
          *(u32x4*)(U + row * 1024 + col) = pack8(a, b);
        }
    }
  }
};
template <bool USE_RS> struct EpiPlain {
  static constexpr bool PERM = true;
  const LAS float* RSL; bf16_t* O; int ldo; float s;
  __device__ __forceinline__ void operator()(const AccT& acc, const Unit& u, int ui, int wr, int wc, int fr, int fq) const {
#pragma unroll
    for (int ai = 0; ai < 2; ++ai)
#pragma unroll
      for (int m = 0; m < 4; ++m) {
        const int row = u.pm * 256 + ai * 128 + wr * 64 + m * 16 + fr; const float rs = USE_RS ? RSL[ui * 256 + ai * 128 + wr * 64 + m * 16 + fr] * s : s;
#pragma unroll
        for (int bj = 0; bj < 2; ++bj)
          *(u32x4*)(O + (size_t)row * ldo + u.pn * 256 + bj * 128 + wc * 32 + fq * 8) = pack8(acc[ai][bj][m][0] * rs, acc[ai][bj][m][1] * rs);
      }
  }
};

template <class Epi> __device__ __forceinline__ void run_gemm(LAS unsigned char* lds, const bf16_t* A, const bf16_t* Bt, int M, int N, int K, const Epi& E, const float* RSS = nullptr) {
  pg8::Gemm g{A, Bt, M, N, K}; pg8::StaticOrder S; S.init(M, N, gridDim.x, blockIdx.x);
  if (RSS) {
    LAS float* rsl = (LAS float*)(lds + 131072); const int tid = opaque_tid(); Unit u;
    for (int i = 0; S.next(i, u); ++i) if (tid < 256) rsl[i * 256 + tid] = row_rstd(RSS, u.pm * 256 + tid);
    __syncthreads();
  }
  pg8::gemm_phase<Epi, pg8::StaticOrder>(lds, g, S, E);
  __syncthreads();
}

__device__ void prep_tiles(const float* __restrict__ src, int ld, bf16_t* __restrict__ dst, int K, int Ndst, const float* __restrict__ gain, float scale,
                           int maptype, int mapbase, int& tbase, float* lt) {
  const int tid = opaque_tid(), G = gridDim.x;
  const int nkt = K >> 6, ntiles = (Ndst >> 6) * nkt;
  int start = (int)blockIdx.x - (tbase % G); if (start < 0) start += G;
  for (int t = start; t < ntiles; t += G) {
    const int nt = t / nkt, kt = t - nt * nkt, n0 = nt << 6, k0 = kt << 6;
    int sc0;
    if (maptype == 0) sc0 = mapbase + n0;
    else if (maptype == 1) { const int pn = n0 >> 8, h = (n0 >> 7) & 1, j = n0 & 127; sc0 = h * DFF + pn * 128 + j; }
    else { const int tt = n0 >> 8, c = n0 & 255, bj = c >> 7, cc = c & 127; sc0 = mapbase + (2 * tt + (cc >> 6)) * 128 + bj * 64 + (cc & 63); }
#pragma unroll
    for (int it = 0; it < 2; ++it) {
      const int idx = tid + it * 512, k = idx >> 4, n4 = idx & 15;
      const f32x4 v = *(const f32x4*)(src + (size_t)(k0 + k) * ld + sc0 + n4 * 4);
      const float g = scale * (gain ? gain[k0 + k] : 1.f);
      float* p = lt + k * 65 + n4 * 4; p[0] = v[0] * g; p[1] = v[1] * g; p[2] = v[2] * g; p[3] = v[3] * g;
    }
    __syncthreads();
    { const int n = tid >> 3, kc = (tid & 7) << 3; f32x4 a, b;
#pragma unroll
      for (int j = 0; j < 4; ++j) { a[j] = lt[(kc + j) * 65 + n]; b[j] = lt[(kc + 4 + j) * 65 + n]; }
      *(u32x4*)(dst + (size_t)(n0 + n) * K + k0 + kc) = pack8(a, b); }
    __syncthreads();
  }
  tbase += ntiles;
}
__device__ void prep_zfold(const float* __restrict__ wmix  , const float* __restrict__ gain, bf16_t* __restrict__ WM1, int& tbase, float* lt) {
  const int tid = opaque_tid(), G = gridDim.x;
  float* cosT = lt + 16 * 129; float* sinT = cosT + 128;
  int start = (int)blockIdx.x - (tbase % G); if (start < 0) start += G;
  for (int t = start; t < 256; t += G) {
    const int grp = t >> 6, k0 = (t & 63) << 4;
    { const int k = tid >> 5, c4 = tid & 31; const f32x4 v = *(const f32x4*)(wmix + (size_t)(k0 + k) * 5632 + grp * 128 + c4 * 4);
      float* p = lt + k * 129 + c4 * 4; p[0] = v[0]; p[1] = v[1]; p[2] = v[2]; p[3] = v[3]; }
    if (tid < 128) { cosT[tid] = __builtin_amdgcn_cosf((float)tid * (1.f / 128.f)); sinT[tid] = __builtin_amdgcn_sinf((float)tid * (1.f / 128.f)); }
    __syncthreads();
    { const int nl = tid >> 1, ri = nl >> 7, cc = nl & 127, kh = (tid & 1) << 3;
      float a0 = 0.f, a1 = 0.f, a2 = 0.f, a3 = 0.f, a4 = 0.f, a5 = 0.f, a6 = 0.f, a7 = 0.f;
      const float* lp = lt + kh * 129;
      for (int c = 0; c < 128; ++c) {
        const int idx = (c * cc) & 127; const float w = ri ? -sinT[idx] : cosT[idx];
        a0 += lp[c] * w; a1 += lp[129 + c] * w; a2 += lp[2 * 129 + c] * w; a3 += lp[3 * 129 + c] * w;
        a4 += lp[4 * 129 + c] * w; a5 += lp[5 * 129 + c] * w; a6 += lp[6 * 129 + c] * w; a7 += lp[7 * 129 + c] * w;
      }
      const float sc = 0.08838834764831845f; const float* gp = gain + k0 + kh;
      f32x4 o0 = {a0 * sc * gp[0], a1 * sc * gp[1], a2 * sc * gp[2], a3 * sc * gp[3]}, o1 = {a4 * sc * gp[4], a5 * sc * gp[5], a6 * sc * gp[6], a7 * sc * gp[7]};
      *(u32x4*)(WM1 + (size_t)(ri * 512 + grp * 128 + cc) * 1024 + k0 + kh) = pack8(o0, o1); }
    __syncthreads();
  }
  tbase += 256;
}

template <int STAGE>
__device__ void dft_item(const bf16_t* __restrict__ src, bf16_t* __restrict__ dst, const bf16_t* __restrict__ Ct, const bf16_t* __restrict__ St,
                         int N, int lgN, int rowbase, int j, int chblk, int S, int N1, int N2, LAS unsigned char* lds) {
  const int tid = opaque_tid(), w = tid >> 6, l = tid & 63;
  const int CB = 8192 >> lgN, stride = CB * 4 + 64;
  const int lgcpr = 11 - lgN, cpr = 1 << lgcpr;
#pragma unroll
  for (int it = 0; it < 4; ++it) {
    const int q = tid + it * 512, n = q >> lgcpr, cq = q & (cpr - 1), part = cq >> (lgcpr - 1), cc = cq & ((cpr >> 1) - 1);
    const int irow = STAGE == 1 ? rowbase + N2 * n + j : rowbase + j * N2 + n;
    const u32x4 v = *(const u32x4*)(src + (size_t)irow * 1024 + part * 512 + chblk * CB + cc * 8);
    *(LAS u32x4*)(lds + n * stride + (part * CB + cc * 8) * 2) = v;
  }
  __syncthreads();
  const int kts = N >> 5, kt = w & (kts - 1), chsub = w >> (lgN - 5);
  const int i16 = l & 15, q4 = i16 >> 2, p4 = i16 & 3, G1 = (l >> 4) & 1, h = l >> 5;
  const unsigned colre = (unsigned)(chsub * 32 + 16 * G1 + 4 * p4) * 2u, colim = colre + (unsigned)CB * 2u;
  const int kout = kt * 32 + (l & 31);
  f32x16 a0 = {}, a1 = {}, a2 = {};
  const int nks = N >> 4;
  bf16x8 Bc[8], Bs[8];
#pragma unroll
  for (int ks = 0; ks < 8; ++ks) if (ks < nks) { Bc[ks] = *(const bf16x8*)(Ct + kout * N + 16 * ks + 8 * h); Bs[ks] = *(const bf16x8*)(St + kout * N + 16 * ks + 8 * h); }
#pragma unroll
  for (int ks = 0; ks < 8; ++ks) if (ks < nks) {
    const unsigned rlo = (unsigned)(16 * ks + 8 * h + q4) * stride, rhi = rlo + 4u * stride;
    const bf16x8 Ar = tr_frag(lds, rlo + colre, rhi + colre), Ai = tr_frag(lds, rlo + colim, rhi + colim);
    a0 = mfma32(Ar, Bc[ks], a0); a0 = mfma32(Ai, Bs[ks], a0);
    if (STAGE == 1) { a1 = mfma32(Ai, Bc[ks], a1); a2 = mfma32(Ar, Bs[ks], a2); }
  }
  const int chb = chblk * CB + chsub * 32 + 4 * h;
  if (STAGE == 1) {
    const int mm = (j * kout) & (S - 1); const float fr = (float)mm / (float)S;
    const float c = __builtin_amdgcn_cosf(fr), s = __builtin_amdgcn_sinf(fr);
    const size_t orow = (size_t)(rowbase + kout * N2 + j) * 1024;
#pragma unroll
    for (int g = 0; g < 4; ++g) {
      float re[4], im[4];
#pragma unroll
      for (int i = 0; i < 4; ++i) { const float yr = a0[4 * g + i], yi = a1[4 * g + i] - a2[4 * g + i]; re[i] = yr * c + yi * s; im[i] = yi * c - yr * s; }
      *(u32x2*)(dst + orow + chb + 8 * g) = pack4(re[0], re[1], re[2], re[3]);
      *(u32x2*)(dst + orow + 512 + chb + 8 * g) = pack4(im[0], im[1], im[2], im[3]);
    }
  } else {
    const size_t orow = (size_t)(rowbase + j + N1 * kout) * 512;
#pragma unroll
    for (int g = 0; g < 4; ++g) *(u32x2*)(dst + orow + chb + 8 * g) = pack4(a0[4 * g], a0[4 * g + 1], a0[4 * g + 2], a0[4 * g + 3]);
  }
  __syncthreads();
}
template <int STAGE>
__device__ void dft_phase(const bf16_t* src, bf16_t* dst, const bf16_t* DT, LAS unsigned char* lds) {
  for (int it = blockIdx.x; it < 2048; it += gridDim.x) {
    if (it < 1024) dft_item<STAGE>(src, dst, DT + DT_C128, DT + DT_S128, 128, 7, 16384, it >> 3, it & 7, 16384, 128, 128, lds);
    else {
      const int r = it - 1024, b = r >> 7, rr = r & 127;
      if (STAGE == 1) dft_item<STAGE>(src, dst, DT + DT_C32, DT + DT_S32, 32, 5, b * 2048, rr >> 1, rr & 1, 2048, 32, 64, lds);
      else dft_item<STAGE>(src, dst, DT + DT_C64, DT + DT_S64, 64, 6, b * 2048, rr >> 2, rr & 3, 2048, 32, 64, lds);
    }
  }
}

__device__ void ret_state_item(const bf16_t* __restrict__ Kb, const bf16_t* __restrict__ Vb, bf16_t* __restrict__ STf, bf16_t* __restrict__ STb,
                               int cidx, int head, float lgf2, float lgb2, LAS unsigned char* lds) {
  const int tid = opaque_tid(), w = tid >> 6, l = tid & 63; const int row0 = cidx * 128;
  constexpr unsigned VS = 576, KS = 320, OKF = 73728, OKB = 114688;
#pragma unroll
  for (int it = 0; it < 8; ++it) { const int q = tid + it * 512, j = q >> 5, c = q & 31;
    *(LAS u32x4*)(lds + j * VS + c * 16) = *(const u32x4*)(Vb + (size_t)(row0 + j) * 1024 + head * 256 + c * 8); }
#pragma unroll
  for (int it = 0; it < 4; ++it) { const int q = tid + it * 512, j = q >> 4, c = q & 15;
    const u32x4 v = *(const u32x4*)(Kb + (size_t)(row0 + j) * 512 + head * 128 + c * 8);
    const float zf = __builtin_amdgcn_exp2f(lgf2 * (float)(127 - j)), zb = __builtin_amdgcn_exp2f(lgb2 * (float)j);
    u32x4 of, ob;
#pragma unroll
    for (int i = 0; i < 4; ++i) { const float a = bf_lo(v[i]), b = bf_hi(v[i]); of[i] = cvt_pk_bf16(a * zf, b * zf); ob[i] = cvt_pk_bf16(a * zb, b * zb); }
    *(LAS u32x4*)(lds + OKF + j * KS + c * 16) = of; *(LAS u32x4*)(lds + OKB + j * KS + c * 16) = ob; }
  __syncthreads();
  const int i16 = l & 15, q4 = i16 >> 2, p4 = i16 & 3, G1 = (l >> 4) & 1, h = l >> 5;
  const unsigned cofs = (unsigned)(16 * G1 + 4 * p4) * 2u;
  f32x16 af[4], ab[4];
#pragma unroll
  for (int i = 0; i < 4; ++i) { af[i] = (f32x16){}; ab[i] = (f32x16){}; }
  for (int ks = 0; ks < 8; ++ks) {
    const unsigned r = (unsigned)(16 * ks + 8 * h + q4);
    const bf16x8 Bv = tr_frag(lds, r * VS + w * 64 + cofs, (r + 4) * VS + w * 64 + cofs);
#pragma unroll
    for (int dt = 0; dt < 4; ++dt) {
      const bf16x8 Af = tr_frag(lds, OKF + r * KS + dt * 64 + cofs, OKF + (r + 4) * KS + dt * 64 + cofs);
      const bf16x8 Ab = tr_frag(lds, OKB + r * KS + dt * 64 + cofs, OKB + (r + 4) * KS + dt * 64 + cofs);
      af[dt] = mfma32(Af, Bv, af[dt]); ab[dt] = mfma32(Ab, Bv, ab[dt]);
    }
  }
  const size_t ob = ((size_t)(cidx * 4 + head) * 256 + w * 32 + (l & 31)) * 128 + 4 * h;
#pragma unroll
  for (int dt = 0; dt < 4; ++dt)
#pragma unroll
    for (int g = 0; g < 4; ++g) {
      *(u32x2*)(STf + ob + dt * 32 + 8 * g) = pack4(af[dt][4 * g], af[dt][4 * g + 1], af[dt][4 * g + 2], af[dt][4 * g + 3]);
      *(u32x2*)(STb + ob + dt * 32 + 8 * g) = pack4(ab[dt][4 * g], ab[dt][4 * g + 1], ab[dt][4 * g + 2], ab[dt][4 * g + 3]);
    }
  __syncthreads();
}
__device__ void ret_scan_seq(bf16_t* __restrict__ ST, int c0, int nch, int sub  , float lg, bool bwd) {
  const float g = expf(lg * 128.f);
  bf16_t* base = ST + (size_t)c0 * 131072 + (size_t)sub * 2048 + opaque_tid() * 4;
  float s0 = 0.f, s1 = 0.f, s2 = 0.f, s3 = 0.f;
  for (int cb = 0; cb < nch; cb += 8) {
    u32x2 u[8];
#pragma unroll
    for (int i = 0; i < 8; ++i) { const int c = bwd ? nch - 1 - (cb + i) : cb + i; u[i] = *(const u32x2*)(base + (size_t)c * 131072); }
#pragma unroll
    for (int i = 0; i < 8; ++i) { const int c = bwd ? nch - 1 - (cb + i) : cb + i;
      *(u32x2*)(base + (size_t)c * 131072) = pack4(s0, s1, s2, s3);
      s0 = g * s0 + bf_lo(u[i][0]); s1 = g * s1 + bf_hi(u[i][0]); s2 = g * s2 + bf_lo(u[i][1]); s3 = g * s3 + bf_hi(u[i][1]); }
  }
}
__device__ void ret_out_item(const bf16_t* __restrict__ Qb, const bf16_t* __restrict__ Kb, bf16_t* Vb, const bf16_t* __restrict__ STf, const bf16_t* __restrict__ STb,
                             int cidx, int head, float lgf2, float lgb2, LAS unsigned char* lds) {
  const int tid = opaque_tid(), w = tid >> 6, l = tid & 63; const int row0 = cidx * 128;
  constexpr unsigned VS = 576, ORED = 73728, QS = 272, OQ = 74752, OK = 74752 + 34816;
#pragma unroll
  for (int it = 0; it < 8; ++it) { const int q = tid + it * 512, j = q >> 5, c = q & 31;
    *(LAS u32x4*)(lds + j * VS + c * 16) = *(const u32x4*)(Vb + (size_t)(row0 + j) * 1024 + head * 256 + c * 8); }
#pragma unroll
  for (int it = 0; it < 4; ++it) { const int q = tid + it * 512, j = q >> 4, c = q & 15;
    *(LAS u32x4*)(lds + OQ + j * QS + c * 16) = *(const u32x4*)(Qb + (size_t)(row0 + j) * 512 + head * 128 + c * 8);
    *(LAS u32x4*)(lds + OK + j * QS + c * 16) = *(const u32x4*)(Kb + (size_t)(row0 + j) * 512 + head * 128 + c * 8); }
  __syncthreads();
  const int ib = w & 3, eh = w >> 2, il = l & 31, h = l >> 5;
  const int i16 = l & 15, q4 = i16 >> 2, p4 = i16 & 3, G1 = (l >> 4) & 1;
  const int iloc = ib * 32 + il;
  bf16x8 qf[8];
#pragma unroll
  for (int ks = 0; ks < 8; ++ks) qf[ks] = *(const LAS bf16x8*)(lds + OQ + iloc * QS + (16 * ks + 8 * h) * 2);
  bf16x8 pf[4][2];
#pragma unroll
  for (int jt = 0; jt < 4; ++jt) {
    f32x16 a = {};
#pragma unroll
    for (int ks = 0; ks < 8; ++ks) a = mfma32(*(const LAS bf16x8*)(lds + OK + (jt * 32 + il) * QS + (16 * ks + 8 * h) * 2), qf[ks], a);
    u32x4 p0, p1;
#pragma unroll
    for (int r = 0; r < 16; r += 2) {
      float v[2];
#pragma unroll
      for (int e = 0; e < 2; ++e) { const int jl = jt * 32 + ((r + e) & 3) + 8 * ((r + e) >> 2) + 4 * h; const int dd = iloc - jl;
        const float dec = dd >= 0 ? __builtin_amdgcn_exp2f(lgf2 * (float)dd) : __builtin_amdgcn_exp2f(lgb2 * (float)(-dd)); v[e] = a[r + e] * dec; }
      const unsigned pk = cvt_pk_bf16(v[0], v[1]);
      if (r < 8) p0[r >> 1] = pk; else p1[(r - 8) >> 1] = pk;
    }
    pf[jt][0] = (bf16x8)p0; pf[jt][1] = (bf16x8)p1;
  }
  f32x16 acc[4];
#pragma unroll
  for (int i = 0; i < 4; ++i) acc[i] = (f32x16){};
  const unsigned cofs = (unsigned)(eh * 128 + 16 * G1 + 4 * p4) * 2u;
#pragma unroll
  for (int jt = 0; jt < 4; ++jt)
#pragma unroll
    for (int s = 0; s < 2; ++s) {
      const unsigned r = (unsigned)(jt * 32 + 16 * s + 4 * h + q4);
#pragma unroll
      for (int et = 0; et < 4; ++et) acc[et] = mfma32(tr_frag(lds, r * VS + et * 64 + cofs, (r + 8) * VS + et * 64 + cofs), pf[jt][s], acc[et]);
    }
#pragma unroll
  for (int dir = 0; dir < 2; ++dir) {
    const float xi = dir ? __builtin_amdgcn_exp2f(lgb2 * (float)(128 - iloc)) : __builtin_amdgcn_exp2f(lgf2 * (float)(iloc + 1));
    const bf16_t* sp = (dir ? STb : STf) + ((size_t)(cidx * 4 + head) * 256 + eh * 128 + il) * 128 + 8 * h;
#pragma unroll
    for (int kp = 0; kp < 4; ++kp) {
      bf16x8 sf[2][4];
#pragma unroll
      for (int k2 = 0; k2 < 2; ++k2)
#pragma unroll
        for (int et = 0; et < 4; ++et) sf[k2][et] = *(const bf16x8*)(sp + (size_t)et * 32 * 128 + 16 * (2 * kp + k2));
#pragma unroll
      for (int k2 = 0; k2 < 2; ++k2) {
        const bf16x8 sq = scale_frag(qf[2 * kp + k2], xi);
#pragma unroll
        for (int et = 0; et < 4; ++et) acc[et] = mfma32(sf[k2][et], sq, acc[et]);
      }
    }
  }
  float ss = 0.f;
#pragma unroll
  for (int et = 0; et < 4; ++et)
#pragma unroll
    for (int r = 0; r < 16; ++r) ss += acc[et][r] * acc[et][r];
  ss += __shfl_xor(ss, 32);
  LAS float* red = (LAS float*)(lds + ORED);
  if (h == 0) red[eh * 128 + iloc] = ss;
  __syncthreads();
  const float rn = rsqrtf((red[iloc] + red[128 + iloc]) * (1.f / 256.f) + 1e-6f);
  bf16_t* op = Vb + (size_t)(row0 + iloc) * 1024 + head * 256 + eh * 128 + 4 * h;
#pragma unroll
  for (int et = 0; et < 4; ++et)
#pragma unroll
    for (int g = 0; g < 4; ++g)
      *(u32x2*)(op + et * 32 + 8 * g) = pack4(acc[et][4 * g] * rn, acc[et][4 * g + 1] * rn, acc[et][4 * g + 2] * rn, acc[et][4 * g + 3] * rn);
  __syncthreads();
}

__device__ void attn_item(const bf16_t* __restrict__ QX, const bf16_t* __restrict__ KV, bf16_t* __restrict__ O, int tt, int head, LAS unsigned char* lds) {
  const int tid = opaque_tid(), w = tid >> 6, l = tid & 63; const int row0 = tt * 256; const int b = tt < 64 ? (tt >> 3) : 8; const int mrow0 = b * 256;
  constexpr unsigned KS = 528, VS = 576;
#pragma unroll 4
  for (int it = 0; it < 16; ++it) { const int q = tid + it * 512, m = q >> 5, c = q & 31;
    *(LAS u32x4*)(lds + m * KS + c * 16) = *(const u32x4*)(KV + (size_t)(mrow0 + m) * 2048 + head * 256 + c * 8); }
  __syncthreads();
  const int il = l & 31, h = l >> 5, i16 = l & 15, q4 = i16 >> 2, p4 = i16 & 3, G1 = (l >> 4) & 1;
  const int row = row0 + w * 32 + il;
  bf16x8 pf[8][2];
  float mxp = -3.0e38f, sum = 0.f;
  const bf16_t* qp = QX + (size_t)row * 1024 + head * 256 + 8 * h;
#pragma unroll
  for (int hf = 0; hf < 2; ++hf) {
    f32x16 sc[4];
#pragma unroll
    for (int i = 0; i < 4; ++i) sc[i] = (f32x16){};
#pragma unroll 4
    for (int ks = 0; ks < 16; ++ks) {
      const bf16x8 B = *(const bf16x8*)(qp + 16 * ks);
#pragma unroll
      for (int mt = 0; mt < 4; ++mt) sc[mt] = mfma32(*(const LAS bf16x8*)(lds + ((hf * 4 + mt) * 32 + il) * KS + (16 * ks + 8 * h) * 2), B, sc[mt]);
    }
    float mx = mxp;
#pragma unroll
    for (int mt = 0; mt < 4; ++mt)
#pragma unroll
      for (int r = 0; r < 16; ++r) mx = fmaxf(mx, sc[mt][r]);
    mx = fmaxf(mx, __shfl_xor(mx, 32));
    if (hf == 1) { const float f = __builtin_amdgcn_exp2f((mxp - mx) * 1.4426950408889634f); sum *= f;
#pragma unroll
      for (int mt = 0; mt < 4; ++mt) { pf[mt][0] = scale_frag(pf[mt][0], f); pf[mt][1] = scale_frag(pf[mt][1], f); } }
#pragma unroll
    for (int mt = 0; mt < 4; ++mt) {
      u32x4 p0, p1;
#pragma unroll
      for (int r = 0; r < 16; r += 2) {
        const float e0 = __builtin_amdgcn_exp2f((sc[mt][r] - mx) * 1.4426950408889634f), e1 = __builtin_amdgcn_exp2f((sc[mt][r + 1] - mx) * 1.4426950408889634f);
        sum += e0 + e1; const unsigned pk = cvt_pk_bf16(e0, e1);
        if (r < 8) p0[r >> 1] = pk; else p1[(r - 8) >> 1] = pk;
      }
      pf[hf * 4 + mt][0] = (bf16x8)p0; pf[hf * 4 + mt][1] = (bf16x8)p1;
    }
    mxp = mx;
  }
  sum += __shfl_xor(sum, 32);
  const float inv = __builtin_amdgcn_rcpf(sum);
  __builtin_amdgcn_sched_barrier(0);
  __syncthreads();
  __builtin_amdgcn_sched_barrier(0);
#pragma unroll 4
  for (int it = 0; it < 16; ++it) { const int q = tid + it * 512, m = q >> 5, c = q & 31;
    *(LAS u32x4*)(lds + m * VS + c * 16) = *(const u32x4*)(KV + (size_t)(mrow0 + m) * 2048 + 1024 + head * 256 + c * 8); }
  __syncthreads();
  __builtin_amdgcn_sched_barrier(0);
#pragma unroll 1
  for (int half = 0; half < 2; ++half) {
    f32x16 acc[4];
#pragma unroll
    for (int i = 0; i < 4; ++i) acc[i] = (f32x16){};
    const unsigned cofs = (unsigned)(half * 128 + 16 * G1 + 4 * p4) * 2u;
#pragma unroll
    for (int mt = 0; mt < 8; ++mt)
#pragma unroll
      for (int s = 0; s < 2; ++s) {
        const unsigned r = (unsigned)(mt * 32 + 16 * s + 4 * h + q4);
#pragma unroll
        for (int et = 0; et < 4; ++et) acc[et] = mfma32(tr_frag(lds, r * VS + et * 64 + cofs, (r + 8) * VS + et * 64 + cofs), pf[mt][s], acc[et]);
      }
    bf16_t* op = O + (size_t)row * 1024 + head * 256 + half * 128 + 4 * h;
#pragma unroll
    for (int et = 0; et < 4; ++et)
#pragma unroll
      for (int g = 0; g < 4; ++g)
        *(u32x2*)(op + et * 32 + 8 * g) = pack4(acc[et][4 * g] * inv, acc[et][4 * g + 1] * inv, acc[et][4 * g + 2] * inv, acc[et][4 * g + 3] * inv);
  }
  __syncthreads();
}

__device__ __forceinline__ float sel4(const float (&a)[4], int i) { return i == 0 ? a[0] : i == 1 ? a[1] : i == 2 ? a[2] : a[3]; }


#define XB_TMO      128
#define XB_XCNT(j)  (256  + 64 * (j))
#define XB_XSUB(j)  (1280 + 64 * (j))
#define XB_XGEN(j)  (2304 + 64 * (j))
#define XB_TOP      3328
#define XB_TOPGEN   3392
#define XCD_BAR_WORDS 3456
#define XB_SPIN_CAP (1u << 20)
__device__ __forceinline__ unsigned xb_ld(unsigned* p)              { return __hip_atomic_load(p, __ATOMIC_RELAXED, __HIP_MEMORY_SCOPE_AGENT); }
__device__ __forceinline__ unsigned xb_add(unsigned* p, unsigned v) { return __hip_atomic_fetch_add(p, v, __ATOMIC_RELAXED, __HIP_MEMORY_SCOPE_AGENT); }
__device__ __forceinline__ unsigned xb_xcc_id() { return (unsigned)__builtin_amdgcn_s_getreg((3 << 11) | 20) & 0xFu; }
#define XB_SPIN(cond, bar) do { unsigned _sp = 0; while (cond) { __builtin_amdgcn_s_sleep(1); \
    if ((++_sp & 255u) == 0u) { if (xb_ld(&(bar)[XB_TMO])) break; if (_sp > XB_SPIN_CAP) { atomicAdd(&(bar)[XB_TMO], 1u); break; } } } } while (0)
struct XcdBarrier { unsigned* bar; unsigned x; volatile LAS unsigned* st; };
__device__ __forceinline__ XcdBarrier xcd_barrier_post(unsigned* bar, volatile LAS unsigned* st) {
  XcdBarrier b; b.bar = bar; b.x = xb_xcc_id(); b.st = st;
  if (threadIdx.x == 0) (void)xb_add(&bar[XB_XCNT(b.x)], 1u);
  return b;
}
__device__ __forceinline__ void xcd_barrier_complete(unsigned* bar, unsigned x, unsigned& nloc, unsigned& nx) {
  const unsigned G = gridDim.x * gridDim.y * gridDim.z;
  unsigned sum, cnt, mine, sp = 0u;
  for (;;) {
    sum = 0u; cnt = 0u; mine = 0u;
#pragma unroll
    for (unsigned j = 0; j < 16; ++j) { const unsigned c = xb_ld(&bar[XB_XCNT(j)]); sum += c; cnt += (c > 0u) ? 1u : 0u; mine = (j == x) ? c : mine; }
    if (sum == G) break;
    __builtin_amdgcn_s_sleep(1);
    if ((++sp & 255u) == 0u) { if (xb_ld(&bar[XB_TMO])) break; if (sp > XB_SPIN_CAP) { atomicAdd(&bar[XB_TMO], 1u); break; } }
  }
  nloc = mine > 0u ? mine : 1u; nx = cnt > 0u ? cnt : 1u;
}
__device__ __forceinline__ void xcd_barrier(const XcdBarrier& b) {
  asm volatile("s_waitcnt vmcnt(0)" ::: "memory");
  __syncthreads();
  if (opaque_tid() == 0) {
    unsigned* bar = b.bar;
    __builtin_amdgcn_s_waitcnt(0);
    unsigned nloc = b.st[0], nx = b.st[1];
    if (nloc == 0u) { xcd_barrier_complete(bar, b.x, nloc, nx); b.st[0] = nloc; b.st[1] = nx; }
    const unsigned old = xb_add(&bar[XB_XSUB(b.x)], 1u);
    const unsigned gen = old / nloc;
    if (old + 1u == (gen + 1u) * nloc) {
      __builtin_amdgcn_fence(__ATOMIC_RELEASE, "agent");
      asm volatile("s_waitcnt vmcnt(0)" ::: "memory");
      const unsigned og = xb_add(&bar[XB_TOP], 1u);
      const unsigned tg = og / nx;
      if (og + 1u == (tg + 1u) * nx) xb_add(&bar[XB_TOPGEN], 1u);
      else XB_SPIN(xb_ld(&bar[XB_TOPGEN]) == tg, bar);
      __builtin_amdgcn_fence(__ATOMIC_ACQUIRE, "agent");
      xb_add(&bar[XB_XGEN(b.x)], 1u);
      asm volatile("s_waitcnt vmcnt(0)" ::: "memory");
    } else {
      XB_SPIN(xb_ld(&bar[XB_XGEN(b.x)]) == gen, bar);
      __builtin_amdgcn_fence(__ATOMIC_ACQUIRE, "agent");
      asm volatile("s_waitcnt vmcnt(0)" ::: "memory");
    }
  }
  __syncthreads();
}

__global__ void __launch_bounds__(512, 2) mega(Params p) {
  cg::grid_group grid = cg::this_grid();
  extern __shared__ __attribute__((aligned(16))) unsigned char smem_raw[];
  LAS unsigned char* lds = (LAS unsigned char*)smem_raw;
  float* ltf = (float*)smem_raw;
  const int tid = opaque_tid(), G = gridDim.x, wv = tid >> 6, lane = tid & 63;
  unsigned char* ws = p.ws;
  float2* TAB = (float2*)(ws + OFF_TAB); bf16_t* DT = (bf16_t*)(ws + OFF_DFT); bf16_t* MEMB = (bf16_t*)(ws + OFF_MEMB);
  float* RSS = (float*)(ws + OFF_RSS); bf16_t* XB = (bf16_t*)(ws + OFF_XB); bf16_t* WB = (bf16_t*)(ws + OFF_WB);
  bf16_t* RA = (bf16_t*)(ws + OFF_A); bf16_t* RS = (bf16_t*)(ws + OFF_S); bf16_t* RB = (bf16_t*)(ws + OFF_B);
  bf16_t* Zb = RA; bf16_t* Y1 = RA + 32 * MiB; bf16_t* GATES = RA; bf16_t* HID = RA; bf16_t* QX = RA; bf16_t* Ob = RA + 32 * MiB;
  bf16_t* STf = RS; bf16_t* STb = RS + 32 * MiB;
  bf16_t* Qb = RB; bf16_t* Kb = RB + 16 * MiB; bf16_t* Vb = RB + 32 * MiB; bf16_t* Fb = RB + 64 * MiB; bf16_t* Ub = RB; bf16_t* KVb = RB + 32 * MiB;
  float* X = p.X;
  bf16_t* XL = (bf16_t*)p.X;
  const LAS float* RSL = (const LAS float*)(lds + 131072);
  volatile LAS unsigned* xst = (volatile LAS unsigned*)(lds + 163824);
  if (threadIdx.x < 4) xst[threadIdx.x] = 0u;
  __syncthreads();
  const XcdBarrier xb = xcd_barrier_post((unsigned*)(ws + WS_NEED), xst);

  if (p.ws == nullptr) grid.sync();
  for (int r = blockIdx.x * 8 + wv; r < T_TOK; r += G * 8) {
    const float* src = r < 16384 ? p.in[0] + (size_t)r * DM : p.in[1] + (size_t)(r - 16384) * DM;
    float ss = 0.f;
#pragma unroll
    for (int k = 0; k < 4; ++k) { const f32x4 v = *(const f32x4*)(src + k * 256 + lane * 4);
      const u32x2 hi = pack4(v[0], v[1], v[2], v[3]);
      *(u32x2*)(XB + (size_t)r * DM + k * 256 + lane * 4) = hi;
      *(u32x2*)(XL + (size_t)r * DM + k * 256 + lane * 4) = pack4(v[0] - bf_lo(hi[0]), v[1] - bf_hi(hi[0]), v[2] - bf_lo(hi[1]), v[3] - bf_hi(hi[1]));
      ss += v[0] * v[0] + v[1] * v[1] + v[2] * v[2] + v[3] * v[3]; }
#pragma unroll
    for (int o = 32; o; o >>= 1) ss += __shfl_xor(ss, o);
    if (lane < 16) RSS[(size_t)r * 16 + lane] = lane == 0 ? ss : 0.f;
  }
  for (int r = blockIdx.x * 8 + wv; r < NMEMROWS; r += G * 8) {
    const float* src = r < 2048 ? p.in[2] + (size_t)r * DM : p.in[3] + (size_t)(r - 2048) * DM;
    f32x4 v0 = *(const f32x4*)(src + lane * 4), v1 = *(const f32x4*)(src + 256 + lane * 4), v2 = *(const f32x4*)(src + 512 + lane * 4), v3 = *(const f32x4*)(src + 768 + lane * 4);
    float ss = 0.f;
#pragma unroll
    for (int i = 0; i < 4; ++i) ss += v0[i] * v0[i] + v1[i] * v1[i] + v2[i] * v2[i] + v3[i] * v3[i];
#pragma unroll
    for (int o = 32; o; o >>= 1) ss += __shfl_xor(ss, o);
    const float rs = rsqrtf(ss * (1.f / 1024.f) + 1e-6f);
    bf16_t* mp = MEMB + (size_t)r * DM + lane * 4;
    *(u32x2*)(mp) = pack4(v0[0] * rs, v0[1] * rs, v0[2] * rs, v0[3] * rs); *(u32x2*)(mp + 256) = pack4(v1[0] * rs, v1[1] * rs, v1[2] * rs, v1[3] * rs);
    *(u32x2*)(mp + 512) = pack4(v2[0] * rs, v2[1] * rs, v2[2] * rs, v2[3] * rs); *(u32x2*)(mp + 768) = pack4(v3[0] * rs, v3[1] * rs, v3[2] * rs, v3[3] * rs);
  }
  for (int i = blockIdx.x * 512 + tid; i < 16384 * 64; i += G * 512) {
    const int s = i >> 6, d = i & 63;
    const float e = (float)d * 2.0f / 128.0f; const float inv = 1.0f / powf(10000.0f, e); const float ang = (float)s * inv;
    const double a = (double)ang * 0.15915494309189535; const double fr = a - rint(a);
    const float f = (float)fr;
    TAB[i] = make_float2(__builtin_amdgcn_cosf(f), __builtin_amdgcn_sinf(f));
  }
  for (int i = blockIdx.x * 512 + tid; i < 16384 + 4096 + 1024; i += G * 512) {
    int N, k, n, oc, os;
    if (i < 16384) { N = 128; k = i >> 7; n = i & 127; oc = DT_C128 + i; os = DT_S128 + i; }
    else if (i < 20480) { const int q = i - 16384; N = 64; k = q >> 6; n = q & 63; oc = DT_C64 + q; os = DT_S64 + q; }
    else { const int q = i - 20480; N = 32; k = q >> 5; n = q & 31; oc = DT_C32 + q; os = DT_S32 + q; }
    const float fr = (float)((k * n) & (N - 1)) / (float)N; const float sc = rsqrtf((float)N);
    const unsigned pk = cvt_pk_bf16(__builtin_amdgcn_cosf(fr) * sc, __builtin_amdgcn_sinf(fr) * sc);
    DT[oc] = (bf16_t)(pk & 0xffffu); DT[os] = (bf16_t)(pk >> 16);
  }

  for (int layer = 0; layer < 4; ++layer) {
    {
      int tb = 0;
      const float* g1 = p.in[4] + layer * DM; const float* gm = p.in[7] + layer * DM; const float* gx = p.in[14] + layer * DM;
      const float* gmem = p.in[15] + layer * DM; const float* g2 = p.in[19] + layer * DM;
      const float* wmix = p.in[8] + (size_t)layer * 1024 * 5632;
      prep_tiles(p.in[5] + (size_t)layer * 1024 * 5632, 5632, WB + W_1I, 1024, 5632, g1, 1.f, 1, 0, tb, ltf);
      prep_tiles(p.in[6] + (size_t)layer * DFF * 1024, 1024, WB + W_1O, DFF, 1024, nullptr, 1.f, 0, 0, tb, ltf);
      prep_zfold(wmix, gm, WB + W_M1, tb, ltf);
      prep_tiles(wmix, 5632, WB + W_M1 + (size_t)1024 * 1024, 1024, 512, gm, 1.f, 2, 512, tb, ltf);
      prep_tiles(wmix, 5632, WB + W_M1 + (size_t)1536 * 1024, 1024, 512, gm, 0.08838834764831845f, 2, 1024, tb, ltf);
      prep_tiles(wmix, 5632, WB + W_M1 + (size_t)2048 * 1024, 1024, 1024, gm, 1.f, 0, 1536, tb, ltf);
      prep_tiles(wmix, 5632, WB + W_M2, 1024, 3072, gm, 1.f, 0, 2560, tb, ltf);
      prep_tiles(p.in[9] + (size_t)layer * 512 * 1024, 1024, WB + W_F, 512, 1024, nullptr, 1.f, 0, 0, tb, ltf);
      prep_tiles(p.in[12] + (size_t)layer * 1024 * 1024, 1024, WB + W_R, 1024, 1024, nullptr, 1.f, 0, 0, tb, ltf);
      prep_tiles(p.in[13] + (size_t)layer * 1024 * 1024, 1024, WB + W_MO, 1024, 1024, nullptr, 1.f, 0, 0, tb, ltf);
      prep_tiles(p.in[16] + (size_t)layer * 1024 * 1024, 1024, WB + W_Q, 1024, 1024, gx, 1.f, 0, 0, tb, ltf);
      prep_tiles(p.in[17] + (size_t)layer * 1024 * 2048, 2048, WB + W_KV, 1024, 2048, gmem, 1.f, 0, 0, tb, ltf);
      prep_tiles(p.in[18] + (size_t)layer * 1024 * 1024, 1024, WB + W_O, 1024, 1024, nullptr, 1.f, 0, 0, tb, ltf);
      prep_tiles(p.in[20] + (size_t)layer * 1024 * 5632, 5632, WB + W_2I, 1024, 5632, g2, 1.f, 1, 0, tb, ltf);
      prep_tiles(p.in[21] + (size_t)layer * DFF * 1024, 1024, WB + W_2O, DFF, 1024, nullptr, 1.f, 0, 0, tb, ltf);
    }
    xcd_barrier(xb);
    run_gemm(lds, XB, WB + W_1I, T_TOK, 5632, 1024, EpiFfnIn{RSL, HID}, RSS);
    xcd_barrier(xb);
    run_gemm(lds, HID, WB + W_1O, T_TOK, 1024, DFF, EpiRes{XB, XL, XL, RSS, 0.5f});
    xcd_barrier(xb);
    run_gemm(lds, XB, WB + W_M1, T_TOK, 3072, 1024, EpiM1{RSL, TAB, Zb, Qb, Kb, Vb}, RSS);
    xcd_barrier(xb);
    float lgf2[4], lgb2[4], lgf[4], lgb[4];
#pragma unroll
    for (int hh = 0; hh < 4; ++hh) { lgf[hh] = log_sigmoid(p.in[10][layer * 4 + hh]); lgb[hh] = log_sigmoid(p.in[11][layer * 4 + hh]);
      lgf2[hh] = lgf[hh] * 1.4426950408889634f; lgb2[hh] = lgb[hh] * 1.4426950408889634f; }
    dft_phase<1>(Zb, Y1, DT, lds);
    for (int it = blockIdx.x; it < 1024; it += G) { const int hh = it & 3; ret_state_item(Kb, Vb, STf, STb, it >> 2, hh, sel4(lgf2, hh), sel4(lgb2, hh), lds); }
    xcd_barrier(xb);
    dft_phase<2>(Y1, Fb, DT, lds);
    for (int it = blockIdx.x; it < 256; it += G) {
      if (it < 128) { const int dir = it >> 6, sub = it & 63, hh = sub >> 4; ret_scan_seq(dir ? STb : STf, 128, 128, sub, dir ? sel4(lgb, hh) : sel4(lgf, hh), dir); }
      else for (int k = 0; k < 8; ++k) { const int r = (it - 128) * 8 + k, b = r >> 7, dir = (r >> 6) & 1, sub = r & 63, hh = sub >> 4;
        ret_scan_seq(dir ? STb : STf, b * 16, 16, sub, dir ? sel4(lgb, hh) : sel4(lgf, hh), dir); }
    }
    xcd_barrier(xb);
    for (int it = blockIdx.x; it < 1024; it += G) { const int hh = it & 3; ret_out_item(Qb, Kb, Vb, STf, STb, it >> 2, hh, sel4(lgf2, hh), sel4(lgb2, hh), lds); }
    xcd_barrier(xb);
    run_gemm(lds, XB, WB + W_M2, T_TOK, 3072, 1024, EpiM2{RSL, Vb, GATES}, RSS);
    xcd_barrier(xb);
    run_gemm(lds, Fb, WB + W_F, T_TOK, 1024, 512, EpiComb<0>{GATES, Ub});
    run_gemm(lds, Vb, WB + W_R, T_TOK, 1024, 1024, EpiComb<1>{GATES, Ub});
    xcd_barrier(xb);
    run_gemm(lds, Ub, WB + W_MO, T_TOK, 1024, 1024, EpiRes{XB, XL, XL, RSS, 1.0f});
    run_gemm(lds, MEMB, WB + W_KV, NMEMROWS, 2048, 1024, EpiPlain<false>{RSL, KVb, 2048, 1.0f});
    xcd_barrier(xb);
    run_gemm(lds, XB, WB + W_Q, T_TOK, 1024, 1024, EpiPlain<true>{RSL, QX, 1024, 0.0625f}, RSS);
    { pg8::StaticOrder S; S.init(T_TOK, 1024, G, blockIdx.x); Unit u; for (int i = 0; S.next(i, u); ++i) attn_item(QX, KVb, Ob, u.pm, u.pn, lds); }
    xcd_barrier(xb);
    run_gemm(lds, Ob, WB + W_O, T_TOK, 1024, 1024, EpiRes{XB, XL, XL, RSS, 1.0f});
    xcd_barrier(xb);
    run_gemm(lds, XB, WB + W_2I, T_TOK, 5632, 1024, EpiFfnIn{RSL, HID}, RSS);
    xcd_barrier(xb);
    run_gemm(lds, HID, WB + W_2O, T_TOK, 1024, DFF, EpiRes{XB, XL, layer == 3 ? RB : XL, RSS, 0.5f});
    xcd_barrier(xb);
  }
  const int tidf = opaque_tid(), wvf = tidf >> 6, lanef = tidf & 63;
  for (int r = blockIdx.x * 8 + wvf; r < T_TOK; r += G * 8) {
    const float rs = row_rstd(RSS, r);
#pragma unroll
    for (int k = 0; k < 4; ++k) { const size_t o = (size_t)r * DM + k * 256 + lanef * 4; const f32x4 g = *(const f32x4*)(p.in[22] + k * 256 + lanef * 4);
      const u32x2 hi = *(const u32x2*)(XB + o), lo = *(const u32x2*)(RB + o);
      f32x4 v = {bf_lo(hi[0]) + bf_lo(lo[0]), bf_hi(hi[0]) + bf_hi(lo[0]), bf_lo(hi[1]) + bf_lo(lo[1]), bf_hi(hi[1]) + bf_hi(lo[1])};
      *(f32x4*)(X + o) = v * rs * g; }
  }
}

extern "C" void kernel_launch(void* const* d_in, const int* in_sizes, int n_in, void* d_out, int out_size, void* d_ws, size_t ws_size, hipStream_t stream) {
  constexpr size_t kDynLds = 163840;
  static int grid_blocks = 0;
  if (!grid_blocks) {
    (void)hipFuncSetAttribute((const void*)mega, hipFuncAttributeMaxDynamicSharedMemorySize, (int)kDynLds);
    int dev = 0, cus = 0, per_cu = 0;
    (void)hipGetDevice(&dev);
    (void)hipDeviceGetAttribute(&cus, hipDeviceAttributeMultiprocessorCount, dev);
    (void)hipOccupancyMaxActiveBlocksPerMultiprocessor(&per_cu, mega, 512, kDynLds);
    grid_blocks = cus > 0 ? cus : 256;
    if (per_cu < 1) fprintf(stderr, "occupancy query returned %d\n", per_cu);
  }
  if (ws_size < WS_NEED + 16384) { fprintf(stderr, "workspace too small: %zu < %zu\n", ws_size, (size_t)WS_NEED); return; }
  (void)hipMemsetAsync((unsigned char*)d_ws + WS_NEED, 0, XCD_BAR_WORDS * 4, stream);
  Params p{};
  for (int i = 0; i < 23; ++i) p.in[i] = (const float*)d_in[i];
  p.X = (float*)d_out; p.ws = (unsigned char*)d_ws;
  void* args[] = {&p};
  hipError_t e = hipLaunchCooperativeKernel((void*)mega, dim3(grid_blocks), dim3(512), args, kDynLds, stream);
  if (e != hipSuccess) fprintf(stderr, "cooperative launch failed: %s (grid %d)\n", hipGetErrorString(e), grid_blocks);
}
```

```cpp
#include <hip/hip_runtime.h>
#include <hip/hip_cooperative_groups.h>
#include <cstdio>
namespace cg = cooperative_groups;

#define LAS __attribute__((address_space(3)))
typedef unsigned short bf16_t;
typedef short bf16x8 __attribute__((ext_vector_type(8)));
typedef short s16x4 __attribute__((ext_vector_type(4)));
typedef float f32x4 __attribute__((ext_vector_type(4)));
typedef float f32x16 __attribute__((ext_vector_type(16)));
typedef unsigned u32x4 __attribute__((ext_vector_type(4)));
typedef unsigned u32x2 __attribute__((ext_vector_type(2)));

constexpr int T_TOK = 32768, DM = 1024, DFF = 2816, NMEMROWS = 2304;
constexpr size_t MiB = 1048576;
constexpr size_t OFF_TAB = 0;
constexpr size_t OFF_DFT = 8 * MiB;
constexpr size_t OFF_MEMB = OFF_DFT + 256 * 1024;
constexpr size_t OFF_RSS = OFF_MEMB + 4718592;
constexpr size_t OFF_XB = OFF_RSS + 2 * MiB;
constexpr size_t OFF_WB = OFF_XB + 64 * MiB;
constexpr size_t OFF_A = OFF_WB + 58 * MiB;
constexpr size_t OFF_S = OFF_A + 128 * MiB;
constexpr size_t OFF_B = OFF_S + 128 * MiB;
constexpr size_t WS_NEED = OFF_B + 160 * MiB;
constexpr size_t W_1I = 0, W_1O = 5767168, W_M1 = 8650752, W_M2 = 11796480, W_F = 14942208, W_R = 15466496, W_MO = 16515072,
                 W_Q = 17563648, W_KV = 18612224, W_O = 20709376, W_2I = 21757952, W_2O = 27525120;
constexpr int DT_C128 = 0, DT_S128 = 16384, DT_C64 = 32768, DT_S64 = 36864, DT_C32 = 40960, DT_S32 = 41984;

struct Params {
  const float* in[23];
  float* X;
  unsigned char* ws;
};

__device__ __forceinline__ int opaque_tid() { int t = threadIdx.x; asm volatile("" : "+v"(t)); return t; }
typedef __bf16 bf16x2_t __attribute__((ext_vector_type(2)));
typedef float f32x2 __attribute__((ext_vector_type(2)));
__device__ __forceinline__ unsigned cvt_pk_bf16(float lo, float hi) { f32x2 v = {lo, hi}; bf16x2_t b = __builtin_convertvector(v, bf16x2_t); return __builtin_bit_cast(unsigned, b); }
__device__ __forceinline__ float bf_lo(unsigned u) { return __uint_as_float(u << 16); }
__device__ __forceinline__ float bf_hi(unsigned u) { return __uint_as_float(u & 0xffff0000u); }
__device__ __forceinline__ u32x4 pack8(f32x4 a, f32x4 b) { u32x4 o; o[0] = cvt_pk_bf16(a[0], a[1]); o[1] = cvt_pk_bf16(a[2], a[3]); o[2] = cvt_pk_bf16(b[0], b[1]); o[3] = cvt_pk_bf16(b[2], b[3]); return o; }
__device__ __forceinline__ u32x2 pack4(float a, float b, float c, float d) { u32x2 o; o[0] = cvt_pk_bf16(a, b); o[1] = cvt_pk_bf16(c, d); return o; }
__device__ __forceinline__ unsigned pack_u8x4(float a, float b, float c, float d) {
  return (unsigned)(a * 255.f + 0.5f) | ((unsigned)(b * 255.f + 0.5f) << 8) | ((unsigned)(c * 255.f + 0.5f) << 16) | ((unsigned)(d * 255.f + 0.5f) << 24); }
__device__ __forceinline__ float u8f(unsigned w, int k) { return (float)((w >> (8 * k)) & 0xffu) * (1.f / 255.f); }
__device__ __forceinline__ float fsigmoid(float x) { return __builtin_amdgcn_rcpf(1.f + __expf(-x)); }
__device__ __forceinline__ float fsilu(float x) { return x * fsigmoid(x); }
__device__ __forceinline__ f32x4 swiglu4(f32x4 g, f32x4 u, float c1  , float rs2  ) {
  f32x4 t = g * c1, d, r;
#pragma unroll
  for (int i = 0; i < 4; ++i) d[i] = __builtin_amdgcn_exp2f(t[i]);
  d = d + 1.0f;
#pragma unroll
  for (int i = 0; i < 4; ++i) r[i] = __builtin_amdgcn_rcpf(d[i]);
  return (g * u) * (r * rs2);
}
__device__ __forceinline__ f32x4 sigmoid4(f32x4 a, float c1) {
  f32x4 t = a * c1, d, r;
#pragma unroll
  for (int i = 0; i < 4; ++i) d[i] = __builtin_amdgcn_exp2f(t[i]);
  d = d + 1.0f;
#pragma unroll
  for (int i = 0; i < 4; ++i) r[i] = __builtin_amdgcn_rcpf(d[i]);
  return r;
}
__device__ __forceinline__ float row_rstd(const float* RSS, int row) {
  const f32x4* p = (const f32x4*)(RSS + (size_t)row * 16); f32x4 a = p[0], b = p[1], c = p[2], d = p[3];
  float s = ((a[0] + a[1]) + (a[2] + a[3])) + ((b[0] + b[1]) + (b[2] + b[3])) + ((c[0] + c[1]) + (c[2] + c[3])) + ((d[0] + d[1]) + (d[2] + d[3]));
  return rsqrtf(s * (1.f / 1024.f) + 1e-6f);
}
__device__ __forceinline__ bf16x8 tr_frag(const LAS unsigned char* lds, unsigned off_lo, unsigned off_hi) {
  s16x4 a = __builtin_amdgcn_ds_read_tr16_b64_v4i16((LAS s16x4*)(lds + off_lo));
  s16x4 b = __builtin_amdgcn_ds_read_tr16_b64_v4i16((LAS s16x4*)(lds + off_hi));
  return __builtin_shufflevector(a, b, 0, 1, 2, 3, 4, 5, 6, 7);
}
__device__ __forceinline__ void store_tile16(bf16_t* p, const f32x16& a, float sc, int h) {
#pragma unroll
  for (int gp = 0; gp < 2; ++gp) {
    u32x2 A = pack4(a[8 * gp] * sc, a[8 * gp + 1] * sc, a[8 * gp + 2] * sc, a[8 * gp + 3] * sc), B = pack4(a[8 * gp + 4] * sc, a[8 * gp + 5] * sc, a[8 * gp + 6] * sc, a[8 * gp + 7] * sc);
    const auto r0 = __builtin_amdgcn_permlane32_swap(A[0], B[0], false, false), r1 = __builtin_amdgcn_permlane32_swap(A[1], B[1], false, false);
    u32x4 o = {r0[0], r1[0], r0[1], r1[1]};
    *(u32x4*)(p + 16 * gp + 8 * h) = o;
  }
}
__device__ __forceinline__ f32x16 mfma32(bf16x8 a, bf16x8 b, f32x16 c) { return __builtin_amdgcn_mfma_f32_32x32x16_bf16(a, b, c, 0, 0, 0); }
__device__ __forceinline__ float log_sigmoid(float x) { return fminf(x, 0.f) - log1pf(expf(-fabsf(x))); }
__device__ __forceinline__ bf16x8 scale_frag(bf16x8 q, float s) {
  u32x4 u = (u32x4)q; u32x4 o;
#pragma unroll
  for (int i = 0; i < 4; ++i) o[i] = cvt_pk_bf16(bf_lo(u[i]) * s, bf_hi(u[i]) * s);
  return (bf16x8)o;
}

namespace pg8 {
constexpr int BM = 256, BK = 64, HALF = 128, HTB = HALF * BK * 2, STAGE_BYTES = 8 * HTB, NXCD = 8, WGM = 8;
__device__ __forceinline__ int lds_byte(int r, int c) { const int st = (r >> 4) * 2 + (c >> 5), rr = r & 15, cc = c & 31, ob = rr * 64 + cc * 2; return st * 1024 + (ob ^ (((ob >> 9) & 1) << 5)); }
__device__ __forceinline__ void stage_rc(int b, int& R, int& C) { const int st = b / 1024, sb = b % 1024, swz = sb ^ (((sb >> 9) & 1) << 5); R = (st >> 1) * 16 + swz / 64; C = (st & 1) * 32 + (swz % 64) / 2; }
__device__ __forceinline__ int perm32(int rho) { const int n = rho >> 4, i = rho & 15; return 8 * (i >> 2) + 4 * n + (i & 3); }
struct Unit { int pm, pn; };
struct Gemm { const bf16_t* A; const bf16_t* Bt; int M, N, K; };
struct StaticOrder {
  int nM, nN, nwg, G, c;
  __device__ void init(int M, int N, int G_, int c_) { nM = M / BM; nN = N / BM; nwg = nM * nN; G = G_; c = c_; }
  __device__ bool next(int i, Unit& u) const {
    const long L = (long)i * G + c; if (L >= nwg) return false;
    int wgid = (int)L; { const int q = nwg / NXCD, r = nwg % NXCD, xcd = wgid % NXCD, off = wgid / NXCD; wgid = (xcd < r ? xcd * (q + 1) : r * (q + 1) + (xcd - r) * q) + off; }
    const int nig = WGM * nN, gid = wgid / nig, fm = gid * WGM, gsz = (nM - fm) < WGM ? (nM - fm) : WGM;
    u.pm = fm + ((wgid % nig) % gsz); u.pn = (wgid % nig) / gsz; return true;
  }
  __device__ __forceinline__ void a_ready(const Unit&) const {}
  __device__ __forceinline__ void done(const Unit&) const {}
};

template <class Epi, class Sched>
__device__ __forceinline__ void gemm_phase(LAS unsigned char* lds, const Gemm g, const Sched& S, const Epi& E) {
  const int tid = opaque_tid(), wid = __builtin_amdgcn_readfirstlane(tid >> 6), lane = tid & 63, wr = wid >> 2, wc = wid & 3, fr = lane & 15, fq = lane >> 4;
  const int K = g.K, nt = K / BK;
  unsigned voffA[2], voffB[2];
#pragma unroll
  for (int i = 0; i < 2; ++i) { int R, C; stage_rc(tid * 16 + i * 8192, R, C); const int Rb = Epi::PERM ? ((R & ~31) + perm32(R & 31)) : R;
    voffA[i] = (unsigned)(R * K + C) * 2u; voffB[i] = (unsigned)(Rb * K + C) * 2u; }
  const size_t kstep = (size_t)(BK * 2);
  const size_t hstep = (size_t)HALF * K * 2;
  const size_t tstep = 2 * hstep;
  const unsigned ldsw = (unsigned)wid * 1024u;
  const int aoff = lds_byte(wr * 64 + fr, fq * 8), boff = lds_byte(wc * 32 + fr, fq * 8);
#define PG8_SA(b, h) (((b) * 2 + (h)) * HTB)
#define PG8_SB(b, h) ((4 + (b) * 2 + (h)) * HTB)
#define PG8_STAGE(bufoff, gbase, voff) do { _Pragma("unroll") for (int _i = 0; _i < 2; ++_i) \
    __builtin_amdgcn_global_load_lds((const unsigned*)((const char*)(gbase) + (voff)[_i]), (LAS unsigned*)(lds + (bufoff) + ldsw + _i * 8192), 16, 0, 0); } while (0)
#define PG8_LDA(dst, b, h) do { _Pragma("unroll") for (int m = 0; m < 4; ++m) _Pragma("unroll") for (int k = 0; k < 2; ++k) dst[m][k] = *(const LAS bf16x8*)(lds + PG8_SA(b, h) + aoff + m * 2048 + k * 1024); } while (0)
#define PG8_LDB(dst, b, h) do { _Pragma("unroll") for (int n = 0; n < 2; ++n) _Pragma("unroll") for (int k = 0; k < 2; ++k) dst[n][k] = *(const LAS bf16x8*)(lds + PG8_SB(b, h) + boff + n * 2048 + k * 1024); } while (0)
#define PG8_MMA(ai, bj, At, Bt) do { __builtin_amdgcn_s_setprio(1); _Pragma("unroll") for (int m = 0; m < 4; ++m) _Pragma("unroll") for (int n = 0; n < 2; ++n) _Pragma("unroll") for (int k = 0; k < 2; ++k) \
    acc[ai][bj][m][n] = __builtin_amdgcn_mfma_f32_16x16x32_bf16(Bt[n][k], At[m][k], acc[ai][bj][m][n], 0, 0, 0); __builtin_amdgcn_s_setprio(0); } while (0)
#define PG8_WAIT_V(n) asm volatile("s_waitcnt vmcnt(" #n ")" ::: "memory")
#define PG8_WAIT_L(n) asm volatile("s_waitcnt lgkmcnt(" #n ")" ::: "memory")
#define PG8_BAR __builtin_amdgcn_s_barrier()
#define PG8_SCHED __builtin_amdgcn_sched_barrier(0)
  Unit cur, nxt; int ui = 0;
  if (!S.next(0, cur)) return;
  f32x4 acc[2][2][4][2];
#pragma unroll
  for (int a = 0; a < 2; ++a)
#pragma unroll
    for (int b = 0; b < 2; ++b)
#pragma unroll
      for (int m = 0; m < 4; ++m)
#pragma unroll
        for (int n = 0; n < 2; ++n) acc[a][b][m][n] = (f32x4){0.f, 0.f, 0.f, 0.f};
  bf16x8 At[4][2], B0[2][2], B1[2][2];
  const char* cA = (const char*)g.A + (size_t)cur.pm * tstep; const char* cB = (const char*)g.Bt + (size_t)cur.pn * tstep;
  S.a_ready(cur);
  PG8_STAGE(PG8_SB(0, 0), cB, voffB); PG8_STAGE(PG8_SA(0, 0), cA, voffA); PG8_STAGE(PG8_SB(0, 1), cB + hstep, voffB); PG8_STAGE(PG8_SA(0, 1), cA + hstep, voffA);
  if (wr == 1) PG8_BAR;
  PG8_WAIT_V(4); PG8_BAR;
  PG8_STAGE(PG8_SB(1, 0), cB + kstep, voffB); PG8_STAGE(PG8_SA(1, 0), cA + kstep, voffA); PG8_STAGE(PG8_SB(1, 1), cB + hstep + kstep, voffB);
  PG8_WAIT_V(6); PG8_BAR;
  for (;;) {
    const bool has_next = S.next(ui + 1, nxt);
    const char* nA = has_next ? (const char*)g.A + (size_t)nxt.pm * tstep : cA; const char* nB = has_next ? (const char*)g.Bt + (size_t)nxt.pn * tstep : cB;
    for (int t = 0; t < nt; t += 2) {
      const bool last = (t == nt - 2);
      const char* a1 = cA + (size_t)(t + 1) * kstep;
      const char* a2 = last ? nA : cA + (size_t)(t + 2) * kstep; const char* b2 = last ? nB : cB + (size_t)(t + 2) * kstep;
      const char* a3 = a2 + kstep; const char* b3 = b2 + kstep;
      if (last && has_next) S.a_ready(nxt);
      PG8_LDB(B0, 0, 0); PG8_SCHED; PG8_LDA(At, 0, 0); PG8_STAGE(PG8_SA(1, 1), a1 + hstep, voffA);
      PG8_WAIT_L(8); PG8_BAR; PG8_WAIT_L(0); PG8_MMA(0, 0, At, B0); PG8_BAR; PG8_SCHED;
      PG8_LDB(B1, 0, 1); PG8_STAGE(PG8_SB(0, 0), b2, voffB);
      PG8_BAR; PG8_WAIT_L(0); PG8_MMA(0, 1, At, B1); PG8_BAR;
      PG8_LDA(At, 0, 1); PG8_STAGE(PG8_SA(0, 0), a2, voffA);
      PG8_BAR; PG8_WAIT_L(0); PG8_MMA(1, 0, At, B0); PG8_BAR; PG8_SCHED;
      PG8_STAGE(PG8_SB(0, 1), b2 + hstep, voffB);
      PG8_WAIT_V(6); PG8_BAR; PG8_MMA(1, 1, At, B1); PG8_BAR;
      PG8_LDB(B0, 1, 0); PG8_SCHED; PG8_LDA(At, 1, 0); PG8_STAGE(PG8_SA(0, 1), a2 + hstep, voffA);
      PG8_WAIT_L(8); PG8_BAR; PG8_WAIT_L(0); PG8_MMA(0, 0, At, B0); PG8_BAR; PG8_SCHED;
      PG8_LDB(B1, 1, 1); PG8_STAGE(PG8_SB(1, 0), b3, voffB);
      PG8_BAR; PG8_WAIT_L(0); PG8_MMA(0, 1, At, B1); PG8_BAR;
      PG8_LDA(At, 1, 1); PG8_STAGE(PG8_SA(1, 0), a3, voffA);
      PG8_BAR; PG8_WAIT_L(0); PG8_MMA(1, 0, At, B0); PG8_BAR; PG8_SCHED;
      PG8_STAGE(PG8_SB(1, 1), b3 + hstep, voffB);
      PG8_WAIT_V(6); PG8_BAR; PG8_MMA(1, 1, At, B1); PG8_BAR;
    }
    E(acc, cur, ui, wr, wc, fr, fq); S.done(cur);
    if (!has_next) break;
#pragma unroll
    for (int a = 0; a < 2; ++a)
#pragma unroll
      for (int b = 0; b < 2; ++b)
#pragma unroll
        for (int m = 0; m < 4; ++m)
#pragma unroll
          for (int n = 0; n < 2; ++n) acc[a][b][m][n] = (f32x4){0.f, 0.f, 0.f, 0.f};
    cur = nxt; cA = nA; cB = nB; ++ui;
  }
  PG8_WAIT_V(0);
  if (wr == 0) PG8_BAR;
  PG8_BAR;
#undef PG8_SA
#undef PG8_SB
#undef PG8_STAGE
#undef PG8_LDA
#undef PG8_LDB
#undef PG8_MMA
#undef PG8_WAIT_V
#undef PG8_WAIT_L
#undef PG8_BAR
#undef PG8_SCHED
}
}
using pg8::Unit;
typedef f32x4 AccT[2][2][4][2];

struct EpiFfnIn {
  static constexpr bool PERM = true;
  const LAS float* RSL; bf16_t* H;
  __device__ __forceinline__ void operator()(const AccT& acc, const Unit& u, int ui, int wr, int wc, int fr, int fq) const {
#pragma unroll
    for (int ai = 0; ai < 2; ++ai)
#pragma unroll
      for (int m = 0; m < 4; ++m) {
        const int row = u.pm * 256 + ai * 128 + wr * 64 + m * 16 + fr; const float rs = RSL[ui * 256 + ai * 128 + wr * 64 + m * 16 + fr];
        const float c1 = rs * -1.4426950408889634f, rs2 = rs * rs;
        const f32x4 h0 = swiglu4(acc[ai][0][m][0], acc[ai][1][m][0], c1, rs2), h1 = swiglu4(acc[ai][0][m][1], acc[ai][1][m][1], c1, rs2);
        *(u32x4*)(H + (size_t)row * DFF + u.pn * 128 + wc * 32 + fq * 8) = pack8(h0, h1);
      }
  }
};
struct EpiRes {
  static constexpr bool PERM = true;
  bf16_t* XB; const bf16_t* XLi; bf16_t* XLo; float* RSS; float s;
  __device__ __forceinline__ void operator()(const AccT& acc, const Unit& u, int ui, int wr, int wc, int fr, int fq) const {
#pragma unroll
    for (int aim = 0; aim < 4; ++aim) {
      const int ai = aim >> 1, m0 = (aim & 1) * 2;
      u32x4 xh[4][2], xl[4][2];
#pragma unroll
      for (int m = m0; m < m0 + 2; ++m)
#pragma unroll
        for (int bj = 0; bj < 2; ++bj) {
          const size_t o = (size_t)(u.pm * 256 + ai * 128 + wr * 64 + m * 16 + fr) * DM + u.pn * 256 + bj * 128 + wc * 32 + fq * 8;
          xh[m][bj] = *(const u32x4*)(XB + o); xl[m][bj] = *(const u32x4*)(XLi + o);
        }
#pragma unroll
      for (int m = m0; m < m0 + 2; ++m) {
        const int row = u.pm * 256 + ai * 128 + wr * 64 + m * 16 + fr; float ss = 0.f;
#pragma unroll
        for (int bj = 0; bj < 2; ++bj) {
          const size_t o = (size_t)row * DM + u.pn * 256 + bj * 128 + wc * 32 + fq * 8;
          const u32x4 h4 = xh[m][bj], l4 = xl[m][bj];
          f32x4 y0, y1;
#pragma unroll
          for (int i = 0; i < 2; ++i) { y0[2 * i] = bf_lo(h4[i]) + bf_lo(l4[i]); y0[2 * i + 1] = bf_hi(h4[i]) + bf_hi(l4[i]); y1[2 * i] = bf_lo(h4[2 + i]) + bf_lo(l4[2 + i]); y1[2 * i + 1] = bf_hi(h4[2 + i]) + bf_hi(l4[2 + i]); }
          y0 += acc[ai][bj][m][0] * s; y1 += acc[ai][bj][m][1] * s;
          const u32x4 nh = pack8(y0, y1);
          f32x4 r0, r1;
#pragma unroll
          for (int i = 0; i < 2; ++i) { r0[2 * i] = y0[2 * i] - bf_lo(nh[i]); r0[2 * i + 1] = y0[2 * i + 1] - bf_hi(nh[i]); r1[2 * i] = y1[2 * i] - bf_lo(nh[2 + i]); r1[2 * i + 1] = y1[2 * i + 1] - bf_hi(nh[2 + i]); }
          *(u32x4*)(XB + o) = nh; *(u32x4*)(XLo + o) = pack8(r0, r1);
#pragma unroll
          for (int i = 0; i < 4; ++i) ss += y0[i] * y0[i] + y1[i] * y1[i];
        }
        ss += __shfl_xor(ss, 16); ss += __shfl_xor(ss, 32);
        if (fq == 0) RSS[(size_t)row * 16 + u.pn * 4 + wc] = ss;
      }
    }
  }
};
struct EpiM1 {
  static constexpr bool PERM = true;
  const LAS float* RSL; const float2* TAB; bf16_t* Z; bf16_t* Q; bf16_t* Kb; bf16_t* V;
  __device__ __forceinline__ void operator()(const AccT& acc, const Unit& u, int ui, int wr, int wc, int fr, int fq) const {
    const int pn = u.pn;
    if (pn < 4 || pn >= 8) {
      bf16_t* dst = pn < 4 ? Z : V; const int cb = (pn < 4 ? pn : pn - 8) * 256;
#pragma unroll
      for (int ai = 0; ai < 2; ++ai)
#pragma unroll
        for (int m = 0; m < 4; ++m) {
          const int row = u.pm * 256 + ai * 128 + wr * 64 + m * 16 + fr; const float rs = RSL[ui * 256 + ai * 128 + wr * 64 + m * 16 + fr];
#pragma unroll
          for (int bj = 0; bj < 2; ++bj)
            *(u32x4*)(dst + (size_t)row * 1024 + cb + bj * 128 + wc * 32 + fq * 8) = pack8(acc[ai][bj][m][0] * rs, acc[ai][bj][m][1] * rs);
        }
    } else {
      bf16_t* dst = pn < 6 ? Q : Kb; const int head = 2 * (pn < 6 ? pn - 4 : pn - 6) + (wc >> 1); const int d0 = 32 * (wc & 1) + 8 * fq;
#pragma unroll
      for (int aim = 0; aim < 4; ++aim) {
        const int ai = aim >> 1, m0 = (aim & 1) * 2;
        f32x4 tt[4][4];
#pragma unroll
        for (int m = m0; m < m0 + 2; ++m) {
          const int row = u.pm * 256 + ai * 128 + wr * 64 + m * 16 + fr; const int spos = row < 16384 ? (row & 2047) : row - 16384;
          const f32x4* tp = (const f32x4*)(TAB + (size_t)spos * 64 + d0);
          tt[m][0] = tp[0]; tt[m][1] = tp[1]; tt[m][2] = tp[2]; tt[m][3] = tp[3];
        }
#pragma unroll
        for (int m = m0; m < m0 + 2; ++m) {
          const int row = u.pm * 256 + ai * 128 + wr * 64 + m * 16 + fr; const float rs = RSL[ui * 256 + ai * 128 + wr * 64 + m * 16 + fr];
          const f32x4 t0 = tt[m][0], t1 = tt[m][1], t2 = tt[m][2], t3 = tt[m][3];
          f32x4 x1a = acc[ai][0][m][0] * rs, x1b = acc[ai][0][m][1] * rs, x2a = acc[ai][1][m][0] * rs, x2b = acc[ai][1][m][1] * rs;
          f32x4 ca = {t0[0], t0[2], t1[0], t1[2]}, sa = {t0[1], t0[3], t1[1], t1[3]}, cb2 = {t2[0], t2[2], t3[0], t3[2]}, sb = {t2[1], t2[3], t3[1], t3[3]};
          f32x4 o1a = x1a * ca - x2a * sa, o1b = x1b * cb2 - x2b * sb, o2a = x2a * ca + x1a * sa, o2b = x2b * cb2 + x1b * sb;
          bf16_t* op = dst + (size_t)row * 512 + head * 128 + d0;
          *(u32x4*)op = pack8(o1a, o1b); *(u32x4*)(op + 64) = pack8(o2a, o2b);
        }
      }
    }
  }
};
struct EpiM2 {
  static constexpr bool PERM = true;
  const LAS float* RSL; bf16_t* YN; bf16_t* GATES;
  __device__ __forceinline__ void operator()(const AccT& acc, const Unit& u, int ui, int wr, int wc, int fr, int fq) const {
    const int pn = u.pn;
    if (pn < 4) {
#pragma unroll
      for (int ai = 0; ai < 2; ++ai) {
        u32x4 yy[4][2];
#pragma unroll
        for (int m = 0; m < 4; ++m)
#pragma unroll
          for (int bj = 0; bj < 2; ++bj) yy[m][bj] = *(const u32x4*)(YN + (size_t)(u.pm * 256 + ai * 128 + wr * 64 + m * 16 + fr) * 1024 + pn * 256 + bj * 128 + wc * 32 + fq * 8);
#pragma unroll
        for (int m = 0; m < 4; ++m) {
          const int row = u.pm * 256 + ai * 128 + wr * 64 + m * 16 + fr; const float rs = RSL[ui * 256 + ai * 128 + wr * 64 + m * 16 + fr];
#pragma unroll
          for (int bj = 0; bj < 2; ++bj) {
            f32x4 a = acc[ai][bj][m][0] * rs, b = acc[ai][bj][m][1] * rs; const u32x4 y = yy[m][bj];
#pragma unroll
            for (int i = 0; i < 2; ++i) { a[2 * i] = fsilu(a[2 * i]) * bf_lo(y[i]); a[2 * i + 1] = fsilu(a[2 * i + 1]) * bf_hi(y[i]); b[2 * i] = fsilu(b[2 * i]) * bf_lo(y[2 + i]); b[2 * i + 1] = fsilu(b[2 * i + 1]) * bf_hi(y[2 + i]); }
            *(u32x4*)(YN + (size_t)row * 1024 + pn * 256 + bj * 128 + wc * 32 + fq * 8) = pack8(a, b);
          }
        }
      }
    } else {
#pragma unroll
      for (int ai = 0; ai < 2; ++ai)
#pragma unroll
        for (int m = 0; m < 4; ++m) {
          const int row = u.pm * 256 + ai * 128 + wr * 64 + m * 16 + fr; const float rs = RSL[ui * 256 + ai * 128 + wr * 64 + m * 16 + fr];
#pragma unroll
          for (int bj = 0; bj < 2; ++bj) {
            const float c1 = rs * -1.4426950408889634f;
            const f32x4 a = sigmoid4(acc[ai][bj][m][0], c1), b = sigmoid4(acc[ai][bj][m][1], c1);
            u32x2 g8; g8[0] = pack_u8x4(a[0], a[1], a[2], a[3]); g8[1] = pack_u8x4(b[0], b[1], b[2], b[3]);
            *(u32x2*)((unsigned char*)GATES + (size_t)row * 2048 + (pn - 4) * 256 + bj * 128 + wc * 32 + fq * 8) = g8;
          }
        }
    }
  }
};
template <int MODE> struct EpiComb {
  static constexpr bool PERM = true;
  const bf16_t* GATES; bf16_t* U;
  __device__ __forceinline__ void operator()(const AccT& acc, const Unit& u, int ui, int wr, int wc, int fr, int fq) const {
#pragma unroll
    for (int aim = 0; aim < 4; ++aim) {
      const int ai = aim >> 1, m0 = (aim & 1) * 2;
      u32x2 gv[4][2]; u32x4 yv[4][2];
#pragma unroll
      for (int m = m0; m < m0 + 2; ++m)
#pragma unroll
        for (int bj = 0; bj < 2; ++bj) {
          const size_t row = (size_t)(u.pm * 256 + ai * 128 + wr * 64 + m * 16 + fr); const int col = u.pn * 256 + bj * 128 + wc * 32 + fq * 8;
          gv[m][bj] = *(const u32x2*)((const unsigned char*)GATES + row * 2048 + MODE * 1024 + col);
          if (MODE == 1) yv[m][bj] = *(const u32x4*)(U + row * 1024 + col);
        }
#pragma unroll
      for (int m = m0; m < m0 + 2; ++m)
#pragma unroll
        for (int bj = 0; bj < 2; ++bj) {
          const size_t row = (size_t)(u.pm * 256 + ai * 128 + wr * 64 + m * 16 + fr); const int col = u.pn * 256 + bj * 128 + wc * 32 + fq * 8;
          const u32x2 gg = gv[m][bj];
          f32x4 a = acc[ai][bj][m][0], b = acc[ai][bj][m][1];
#pragma unroll
          for (int i = 0; i < 4; ++i) { a[i] *= u8f(gg[0], i); b[i] *= u8f(gg[1], i); }
          if (MODE == 1) { const u32x4 y = yv[m][bj];
#pragma unroll
            for (int i = 0; i < 2; ++i) { a[2 * i] += bf_lo(y[i]); a[2 * i + 1] += bf_hi(y[i]); b[2 * i] += bf_lo(y[2 + i]); b[2 * i + 1] += bf_hi(y[2 + i]); } }
          *(u32x4*)(U + row * 1024 + col) = pack8(a, b);
        }
    }
  }
};
template <bool USE_RS> struct EpiPlain {
  static constexpr bool PERM = true;
  const LAS float* RSL; bf16_t* O; int ldo; float s;
  __device__ __forceinline__ void operator()(const AccT& acc, const Unit& u, int ui, int wr, int wc, int fr, int fq) const {
#pragma unroll
    for (int ai = 0; ai < 2; ++ai)
#pragma unroll
      for (int m = 0; m < 4; ++m) {
        const int row = u.pm * 256 + ai * 128 + wr * 64 + m * 16 + fr; const float rs = USE_RS ? RSL[ui * 256 + ai * 128 + wr * 64 + m * 16 + fr] * s : s;
#pragma unroll
        for (int bj = 0; bj < 2; ++bj)
          *(u32x4*)(O + (size_t)row * ldo + u.pn * 256 + bj * 128 + wc * 32 + fq * 8) = pack8(acc[ai][bj][m][0] * rs, acc[ai][bj][m][1] * rs);
      }
  }
};

template <class Epi> __device__ __forceinline__ void run_gemm(LAS unsigned char* lds, const bf16_t* A, const bf16_t* Bt, int M, int N, int K, const Epi& E, const float* RSS = nullptr) {
  pg8::Gemm g{A, Bt, M, N, K}; pg8::StaticOrder S; S.init(M, N, gridDim.x, blockIdx.x);
  if (RSS) {
    LAS float* rsl = (LAS float*)(lds + 131072); const int tid = opaque_tid(); Unit u;
    for (int i = 0; S.next(i, u); ++i) if (tid < 256) rsl[i * 256 + tid] = row_rstd(RSS, u.pm * 256 + tid);
    __syncthreads();
  }
  pg8::gemm_phase<Epi, pg8::StaticOrder>(lds, g, S, E);
  __syncthreads();
}

__device__ void prep_tiles(const float* __restrict__ src, int ld, bf16_t* __restrict__ dst, int K, int Ndst, const float* __restrict__ gain, float scale,
                           int maptype, int mapbase, int& tbase, float* lt) {
  const int tid = opaque_tid(), G = gridDim.x;
  const int nkt = K >> 6, ntiles = (Ndst >> 6) * nkt;
  int start = (int)blockIdx.x - (tbase % G); if (start < 0) start += G;
  for (int t = start; t < ntiles; t += G) {
    const int nt = t / nkt, kt = t - nt * nkt, n0 = nt << 6, k0 = kt << 6;
    int sc0;
    if (maptype == 0) sc0 = mapbase + n0;
    else if (maptype == 1) { const int pn = n0 >> 8, h = (n0 >> 7) & 1, j = n0 & 127; sc0 = h * DFF + pn * 128 + j; }
    else { const int tt = n0 >> 8, c = n0 & 255, bj = c >> 7, cc = c & 127; sc0 = mapbase + (2 * tt + (cc >> 6)) * 128 + bj * 64 + (cc & 63); }
#pragma unroll
    for (int it = 0; it < 2; ++it) {
      const int idx = tid + it * 512, k = idx >> 4, n4 = idx & 15;
      const f32x4 v = *(const f32x4*)(src + (size_t)(k0 + k) * ld + sc0 + n4 * 4);
      const float g = scale * (gain ? gain[k0 + k] : 1.f);
      float* p = lt + k * 65 + n4 * 4; p[0] = v[0] * g; p[1] = v[1] * g; p[2] = v[2] * g; p[3] = v[3] * g;
    }
    __syncthreads();
    { const int n = tid >> 3, kc = (tid & 7) << 3; f32x4 a, b;
#pragma unroll
      for (int j = 0; j < 4; ++j) { a[j] = lt[(kc + j) * 65 + n]; b[j] = lt[(kc + 4 + j) * 65 + n]; }
      *(u32x4*)(dst + (size_t)(n0 + n) * K + k0 + kc) = pack8(a, b); }
    __syncthreads();
  }
  tbase += ntiles;
}
__device__ void prep_zfold(const float* __restrict__ wmix  , const float* __restrict__ gain, bf16_t* __restrict__ WM1, int& tbase, float* lt) {
  const int tid = opaque_tid(), G = gridDim.x;
  float* cosT = lt + 16 * 129; float* sinT = cosT + 128;
  int start = (int)blockIdx.x - (tbase % G); if (start < 0) start += G;
  for (int t = start; t < 256; t += G) {
    const int grp = t >> 6, k0 = (t & 63) << 4;
    { const int k = tid >> 5, c4 = tid & 31; const f32x4 v = *(const f32x4*)(wmix + (size_t)(k0 + k) * 5632 + grp * 128 + c4 * 4);
      float* p = lt + k * 129 + c4 * 4; p[0] = v[0]; p[1] = v[1]; p[2] = v[2]; p[3] = v[3]; }
    if (tid < 128) { cosT[tid] = __builtin_amdgcn_cosf((float)tid * (1.f / 128.f)); sinT[tid] = __builtin_amdgcn_sinf((float)tid * (1.f / 128.f)); }
    __syncthreads();
    { const int nl = tid >> 1, ri = nl >> 7, cc = nl & 127, kh = (tid & 1) << 3;
      float a0 = 0.f, a1 = 0.f, a2 = 0.f, a3 = 0.f, a4 = 0.f, a5 = 0.f, a6 = 0.f, a7 = 0.f;
      const float* lp = lt + kh * 129;
      for (int c = 0; c < 128; ++c) {
        const int idx = (c * cc) & 127; const float w = ri ? -sinT[idx] : cosT[idx];
        a0 += lp[c] * w; a1 += lp[129 + c] * w; a2 += lp[2 * 129 + c] * w; a3 += lp[3 * 129 + c] * w;
        a4 += lp[4 * 129 + c] * w; a5 += lp[5 * 129 + c] * w; a6 += lp[6 * 129 + c] * w; a7 += lp[7 * 129 + c] * w;
      }
      const float sc = 0.08838834764831845f; const float* gp = gain + k0 + kh;
      f32x4 o0 = {a0 * sc * gp[0], a1 * sc * gp[1], a2 * sc * gp[2], a3 * sc * gp[3]}, o1 = {a4 * sc * gp[4], a5 * sc * gp[5], a6 * sc * gp[6], a7 * sc * gp[7]};
      *(u32x4*)(WM1 + (size_t)(ri * 512 + grp * 128 + cc) * 1024 + k0 + kh) = pack8(o0, o1); }
    __syncthreads();
  }
  tbase += 256;
}

template <int STAGE>
__device__ void dft_item(const bf16_t* __restrict__ src, bf16_t* __restrict__ dst, const bf16_t* __restrict__ Ct, const bf16_t* __restrict__ St,
                         int N, int lgN, int rowbase, int j, int chblk, int S, int N1, int N2, LAS unsigned char* lds) {
  const int tid = opaque_tid(), w = tid >> 6, l = tid & 63;
  const int CB = 8192 >> lgN, stride = CB * 4 + 64;
  const int lgcpr = 11 - lgN, cpr = 1 << lgcpr;
#pragma unroll
  for (int it = 0; it < 4; ++it) {
    const int q = tid + it * 512, n = q >> lgcpr, cq = q & (cpr - 1), part = cq >> (lgcpr - 1), cc = cq & ((cpr >> 1) - 1);
    const int irow = STAGE == 1 ? rowbase + N2 * n + j : rowbase + j * N2 + n;
    const u32x4 v = *(const u32x4*)(src + (size_t)irow * 1024 + part * 512 + chblk * CB + cc * 8);
    *(LAS u32x4*)(lds + n * stride + (part * CB + cc * 8) * 2) = v;
  }
  __syncthreads();
  const int kts = N >> 5, kt = w & (kts - 1), chsub = w >> (lgN - 5);
  const int i16 = l & 15, q4 = i16 >> 2, p4 = i16 & 3, G1 = (l >> 4) & 1, h = l >> 5;
  const unsigned colre = (unsigned)(chsub * 32 + 16 * G1 + 4 * p4) * 2u, colim = colre + (unsigned)CB * 2u;
  const int kout = kt * 32 + (l & 31);
  f32x16 a0 = {}, a1 = {}, a2 = {};
  const int nks = N >> 4;
  bf16x8 Bc[8], Bs[8];
#pragma unroll
  for (int ks = 0; ks < 8; ++ks) if (ks < nks) { Bc[ks] = *(const bf16x8*)(Ct + kout * N + 16 * ks + 8 * h); Bs[ks] = *(const bf16x8*)(St + kout * N + 16 * ks + 8 * h); }
#pragma unroll
  for (int ks = 0; ks < 8; ++ks) if (ks < nks) {
    const unsigned rlo = (unsigned)(16 * ks + 8 * h + q4) * stride, rhi = rlo + 4u * stride;
    const bf16x8 Ar = tr_frag(lds, rlo + colre, rhi + colre), Ai = tr_frag(lds, rlo + colim, rhi + colim);
    a0 = mfma32(Ar, Bc[ks], a0); a0 = mfma32(Ai, Bs[ks], a0);
    if (STAGE == 1) { a1 = mfma32(Ai, Bc[ks], a1); a2 = mfma32(Ar, Bs[ks], a2); }
  }
  const int chb = chblk * CB + chsub * 32;
  if (STAGE == 1) {
    const int mm = (j * kout) & (S - 1); const float fr = (float)mm / (float)S;
    const float c = __builtin_amdgcn_cosf(fr), s = __builtin_amdgcn_sinf(fr);
    const size_t orow = (size_t)(rowbase + kout * N2 + j) * 1024;
    f32x16 re, im;
#pragma unroll
    for (int i = 0; i < 16; ++i) { const float yr = a0[i], yi = a1[i] - a2[i]; re[i] = yr * c + yi * s; im[i] = yi * c - yr * s; }
    store_tile16(dst + orow + chb, re, 1.f, h); store_tile16(dst + orow + 512 + chb, im, 1.f, h);
  } else {
    const size_t orow = (size_t)(rowbase + j + N1 * kout) * 512;
    store_tile16(dst + orow + chb, a0, 1.f, h);
  }
  __syncthreads();
}
template <int STAGE>
__device__ void dft_phase(const bf16_t* src, bf16_t* dst, const bf16_t* DT, LAS unsigned char* lds) {
  for (int it = blockIdx.x; it < 2048; it += gridDim.x) {
    if (it < 1024) dft_item<STAGE>(src, dst, DT + DT_C128, DT + DT_S128, 128, 7, 16384, it >> 3, it & 7, 16384, 128, 128, lds);
    else {
      const int r = it - 1024, b = r >> 7, rr = r & 127;
      if (STAGE == 1) dft_item<STAGE>(src, dst, DT + DT_C32, DT + DT_S32, 32, 5, b * 2048, rr >> 1, rr & 1, 2048, 32, 64, lds);
      else dft_item<STAGE>(src, dst, DT + DT_C64, DT + DT_S64, 64, 6, b * 2048, rr >> 2, rr & 3, 2048, 32, 64, lds);
    }
  }
}

__device__ void ret_state_item(const bf16_t* __restrict__ Kb, const bf16_t* __restrict__ Vb, bf16_t* __restrict__ STf, bf16_t* __restrict__ STb,
                               int cidx, int head, float lgf2, float lgb2, LAS unsigned char* lds) {
  const int tid = opaque_tid(), w = tid >> 6, l = tid & 63; const int row0 = cidx * 128;
  constexpr unsigned VS = 576, KS = 320, OKF = 73728, OKB = 114688;
#pragma unroll
  for (int it = 0; it < 8; ++it) { const int q = tid + it * 512, j = q >> 5, c = q & 31;
    *(LAS u32x4*)(lds + j * VS + c * 16) = *(const u32x4*)(Vb + (size_t)(row0 + j) * 1024 + head * 256 + c * 8); }
#pragma unroll
  for (int it = 0; it < 4; ++it) { const int q = tid + it * 512, j = q >> 4, c = q & 15;
    const u32x4 v = *(const u32x4*)(Kb + (size_t)(row0 + j) * 512 + head * 128 + c * 8);
    const float zf = __builtin_amdgcn_exp2f(lgf2 * (float)(127 - j)), zb = __builtin_amdgcn_exp2f(lgb2 * (float)j);
    u32x4 of, ob;
#pragma unroll
    for (int i = 0; i < 4; ++i) { const float a = bf_lo(v[i]), b = bf_hi(v[i]); of[i] = cvt_pk_bf16(a * zf, b * zf); ob[i] = cvt_pk_bf16(a * zb, b * zb); }
    *(LAS u32x4*)(lds + OKF + j * KS + c * 16) = of; *(LAS u32x4*)(lds + OKB + j * KS + c * 16) = ob; }
  __syncthreads();
  const int i16 = l & 15, q4 = i16 >> 2, p4 = i16 & 3, G1 = (l >> 4) & 1, h = l >> 5;
  const unsigned cofs = (unsigned)(16 * G1 + 4 * p4) * 2u;
  f32x16 af[4], ab[4];
#pragma unroll
  for (int i = 0; i < 4; ++i) { af[i] = (f32x16){}; ab[i] = (f32x16){}; }
  for (int ks = 0; ks < 8; ++ks) {
    const unsigned r = (unsigned)(16 * ks + 8 * h + q4);
    const bf16x8 Bv = tr_frag(lds, r * VS + w * 64 + cofs, (r + 4) * VS + w * 64 + cofs);
#pragma unroll
    for (int dt = 0; dt < 4; ++dt) {
      const bf16x8 Af = tr_frag(lds, OKF + r * KS + dt * 64 + cofs, OKF + (r + 4) * KS + dt * 64 + cofs);
      const bf16x8 Ab = tr_frag(lds, OKB + r * KS + dt * 64 + cofs, OKB + (r + 4) * KS + dt * 64 + cofs);
      af[dt] = mfma32(Af, Bv, af[dt]); ab[dt] = mfma32(Ab, Bv, ab[dt]);
    }
  }
  const size_t ob = ((size_t)(cidx * 4 + head) * 256 + w * 32 + (l & 31)) * 128;
#pragma unroll
  for (int dt = 0; dt < 4; ++dt) { store_tile16(STf + ob + dt * 32, af[dt], 1.f, h); store_tile16(STb + ob + dt * 32, ab[dt], 1.f, h); }
  __syncthreads();
}
__device__ void ret_scan_seq(bf16_t* __restrict__ ST, int c0, int nch, int sub  , float lg, bool bwd) {
  const float g = expf(lg * 128.f);
  bf16_t* base = ST + (size_t)c0 * 131072 + (size_t)sub * 2048 + opaque_tid() * 4;
  float s0 = 0.f, s1 = 0.f, s2 = 0.f, s3 = 0.f;
  for (int cb = 0; cb < nch; cb += 8) {
    u32x2 u[8];
#pragma unroll
    for (int i = 0; i < 8; ++i) { const int c = bwd ? nch - 1 - (cb + i) : cb + i; u[i] = *(const u32x2*)(base + (size_t)c * 131072); }
#pragma unroll
    for (int i = 0; i < 8; ++i) { const int c = bwd ? nch - 1 - (cb + i) : cb + i;
      *(u32x2*)(base + (size_t)c * 131072) = pack4(s0, s1, s2, s3);
      s0 = g * s0 + bf_lo(u[i][0]); s1 = g * s1 + bf_hi(u[i][0]); s2 = g * s2 + bf_lo(u[i][1]); s3 = g * s3 + bf_hi(u[i][1]); }
  }
}
__device__ void ret_out_item(const bf16_t* __restrict__ Qb, const bf16_t* __restrict__ Kb, bf16_t* Vb, const bf16_t* __restrict__ STf, const bf16_t* __restrict__ STb,
                             int cidx, int head, float lgf2, float lgb2, LAS unsigned char* lds) {
  const int tid = opaque_tid(), w = tid >> 6, l = tid & 63; const int row0 = cidx * 128;
  constexpr unsigned VS = 576, ORED = 73728, QS = 272, OQ = 74752, OK = 74752 + 34816;
#pragma unroll
  for (int it = 0; it < 8; ++it) { const int q = tid + it * 512, j = q >> 5, c = q & 31;
    *(LAS u32x4*)(lds + j * VS + c * 16) = *(const u32x4*)(Vb + (size_t)(row0 + j) * 1024 + head * 256 + c * 8); }
#pragma unroll
  for (int it = 0; it < 4; ++it) { const int q = tid + it * 512, j = q >> 4, c = q & 15;
    *(LAS u32x4*)(lds + OQ + j * QS + c * 16) = *(const u32x4*)(Qb + (size_t)(row0 + j) * 512 + head * 128 + c * 8);
    *(LAS u32x4*)(lds + OK + j * QS + c * 16) = *(const u32x4*)(Kb + (size_t)(row0 + j) * 512 + head * 128 + c * 8); }
  __syncthreads();
  const int ib = w & 3, eh = w >> 2, il = l & 31, h = l >> 5;
  const int i16 = l & 15, q4 = i16 >> 2, p4 = i16 & 3, G1 = (l >> 4) & 1;
  const int iloc = ib * 32 + il;
  bf16x8 qf[8];
#pragma unroll
  for (int ks = 0; ks < 8; ++ks) qf[ks] = *(const LAS bf16x8*)(lds + OQ + iloc * QS + (16 * ks + 8 * h) * 2);
  bf16x8 pf[4][2];
#pragma unroll
  for (int jt = 0; jt < 4; ++jt) {
    f32x16 a = {};
#pragma unroll
    for (int ks = 0; ks < 8; ++ks) a = mfma32(*(const LAS bf16x8*)(lds + OK + (jt * 32 + il) * QS + (16 * ks + 8 * h) * 2), qf[ks], a);
    u32x4 p0, p1;
#pragma unroll
    for (int r = 0; r < 16; r += 2) {
      float v[2];
#pragma unroll
      for (int e = 0; e < 2; ++e) { const int jl = jt * 32 + ((r + e) & 3) + 8 * ((r + e) >> 2) + 4 * h; const int dd = iloc - jl;
        const float dec = dd >= 0 ? __builtin_amdgcn_exp2f(lgf2 * (float)dd) : __builtin_amdgcn_exp2f(lgb2 * (float)(-dd)); v[e] = a[r + e] * dec; }
      const unsigned pk = cvt_pk_bf16(v[0], v[1]);
      if (r < 8) p0[r >> 1] = pk; else p1[(r - 8) >> 1] = pk;
    }
    pf[jt][0] = (bf16x8)p0; pf[jt][1] = (bf16x8)p1;
  }
  f32x16 acc[4];
#pragma unroll
  for (int i = 0; i < 4; ++i) acc[i] = (f32x16){};
  const unsigned cofs = (unsigned)(eh * 128 + 16 * G1 + 4 * p4) * 2u;
#pragma unroll
  for (int jt = 0; jt < 4; ++jt)
#pragma unroll
    for (int s = 0; s < 2; ++s) {
      const unsigned r = (unsigned)(jt * 32 + 16 * s + 4 * h + q4);
#pragma unroll
      for (int et = 0; et < 4; ++et) acc[et] = mfma32(tr_frag(lds, r * VS + et * 64 + cofs, (r + 8) * VS + et * 64 + cofs), pf[jt][s], acc[et]);
    }
#pragma unroll
  for (int dir = 0; dir < 2; ++dir) {
    const float xi = dir ? __builtin_amdgcn_exp2f(lgb2 * (float)(128 - iloc)) : __builtin_amdgcn_exp2f(lgf2 * (float)(iloc + 1));
    const bf16_t* sp = (dir ? STb : STf) + ((size_t)(cidx * 4 + head) * 256 + eh * 128 + il) * 128 + 8 * h;
#pragma unroll
    for (int kp = 0; kp < 4; ++kp) {
      bf16x8 sf[2][4];
#pragma unroll
      for (int k2 = 0; k2 < 2; ++k2)
#pragma unroll
        for (int et = 0; et < 4; ++et) sf[k2][et] = *(const bf16x8*)(sp + (size_t)et * 32 * 128 + 16 * (2 * kp + k2));
#pragma unroll
      for (int k2 = 0; k2 < 2; ++k2) {
        const bf16x8 sq = scale_frag(qf[2 * kp + k2], xi);
#pragma unroll
        for (int et = 0; et < 4; ++et) acc[et] = mfma32(sf[k2][et], sq, acc[et]);
      }
    }
  }
  float ss = 0.f;
#pragma unroll
  for (int et = 0; et < 4; ++et)
#pragma unroll
    for (int r = 0; r < 16; ++r) ss += acc[et][r] * acc[et][r];
  ss += __shfl_xor(ss, 32);
  LAS float* red = (LAS float*)(lds + ORED);
  if (h == 0) red[eh * 128 + iloc] = ss;
  __syncthreads();
  const float rn = rsqrtf((red[iloc] + red[128 + iloc]) * (1.f / 256.f) + 1e-6f);
  bf16_t* op = Vb + (size_t)(row0 + iloc) * 1024 + head * 256 + eh * 128;
#pragma unroll
  for (int et = 0; et < 4; ++et) store_tile16(op + et * 32, acc[et], rn, h);
  __syncthreads();
}

__device__ void attn_item(const bf16_t* __restrict__ QX, const bf16_t* __restrict__ KV, bf16_t* __restrict__ O, int tt, int head, LAS unsigned char* lds) {
  const int tid = opaque_tid(), w = tid >> 6, l = tid & 63; const int row0 = tt * 256; const int b = tt < 64 ? (tt >> 3) : 8; const int mrow0 = b * 256;
  constexpr unsigned KS = 528, VS = 576;
#pragma unroll 4
  for (int it = 0; it < 16; ++it) { const int q = tid + it * 512, m = q >> 5, c = q & 31;
    *(LAS u32x4*)(lds + m * KS + c * 16) = *(const u32x4*)(KV + (size_t)(mrow0 + m) * 2048 + head * 256 + c * 8); }
  __syncthreads();
  const int il = l & 31, h = l >> 5, i16 = l & 15, q4 = i16 >> 2, p4 = i16 & 3, G1 = (l >> 4) & 1;
  const int row = row0 + w * 32 + il;
  bf16x8 pf[8][2];
  float mxp = -3.0e38f, sum = 0.f;
  const bf16_t* qp = QX + (size_t)row * 1024 + head * 256 + 8 * h;
#pragma unroll
  for (int hf = 0; hf < 2; ++hf) {
    f32x16 sc[4];
#pragma unroll
    for (int i = 0; i < 4; ++i) sc[i] = (f32x16){};
#pragma unroll 4
    for (int ks = 0; ks < 16; ++ks) {
      const bf16x8 B = *(const bf16x8*)(qp + 16 * ks);
#pragma unroll
      for (int mt = 0; mt < 4; ++mt) sc[mt] = mfma32(*(const LAS bf16x8*)(lds + ((hf * 4 + mt) * 32 + il) * KS + (16 * ks + 8 * h) * 2), B, sc[mt]);
    }
    float mx = mxp;
#pragma unroll
    for (int mt = 0; mt < 4; ++mt)
#pragma unroll
      for (int r = 0; r < 16; ++r) mx = fmaxf(mx, sc[mt][r]);
    mx = fmaxf(mx, __shfl_xor(mx, 32));
    if (hf == 1) { const float f = __builtin_amdgcn_exp2f((mxp - mx) * 1.4426950408889634f); sum *= f;
#pragma unroll
      for (int mt = 0; mt < 4; ++mt) { pf[mt][0] = scale_frag(pf[mt][0], f); pf[mt][1] = scale_frag(pf[mt][1], f); } }
#pragma unroll
    for (int mt = 0; mt < 4; ++mt) {
      u32x4 p0, p1;
#pragma unroll
      for (int r = 0; r < 16; r += 2) {
        const float e0 = __builtin_amdgcn_exp2f((sc[mt][r] - mx) * 1.4426950408889634f), e1 = __builtin_amdgcn_exp2f((sc[mt][r + 1] - mx) * 1.4426950408889634f);
        sum += e0 + e1; const unsigned pk = cvt_pk_bf16(e0, e1);
        if (r < 8) p0[r >> 1] = pk; else p1[(r - 8) >> 1] = pk;
      }
      pf[hf * 4 + mt][0] = (bf16x8)p0; pf[hf * 4 + mt][1] = (bf16x8)p1;
    }
    mxp = mx;
  }
  sum += __shfl_xor(sum, 32);
  const float inv = __builtin_amdgcn_rcpf(sum);
  __builtin_amdgcn_sched_barrier(0);
  __syncthreads();
  __builtin_amdgcn_sched_barrier(0);
#pragma unroll 4
  for (int it = 0; it < 16; ++it) { const int q = tid + it * 512, m = q >> 5, c = q & 31;
    *(LAS u32x4*)(lds + m * VS + c * 16) = *(const u32x4*)(KV + (size_t)(mrow0 + m) * 2048 + 1024 + head * 256 + c * 8); }
  __syncthreads();
  __builtin_amdgcn_sched_barrier(0);
#pragma unroll 1
  for (int half = 0; half < 2; ++half) {
    f32x16 acc[4];
#pragma unroll
    for (int i = 0; i < 4; ++i) acc[i] = (f32x16){};
    const unsigned cofs = (unsigned)(half * 128 + 16 * G1 + 4 * p4) * 2u;
#pragma unroll
    for (int mt = 0; mt < 8; ++mt)
#pragma unroll
      for (int s = 0; s < 2; ++s) {
        const unsigned r = (unsigned)(mt * 32 + 16 * s + 4 * h + q4);
#pragma unroll
        for (int et = 0; et < 4; ++et) acc[et] = mfma32(tr_frag(lds, r * VS + et * 64 + cofs, (r + 8) * VS + et * 64 + cofs), pf[mt][s], acc[et]);
      }
    bf16_t* op = O + (size_t)row * 1024 + head * 256 + half * 128;
#pragma unroll
    for (int et = 0; et < 4; ++et) store_tile16(op + et * 32, acc[et], inv, h);
  }
  __syncthreads();
}

__device__ __forceinline__ float sel4(const float (&a)[4], int i) { return i == 0 ? a[0] : i == 1 ? a[1] : i == 2 ? a[2] : a[3]; }


#define XB_TMO      128
#define XB_XCNT(j)  (256  + 64 * (j))
#define XB_XSUB(j)  (1280 + 64 * (j))
#define XB_XGEN(j)  (2304 + 64 * (j))
#define XB_TOP      3328
#define XB_TOPGEN   3392
#define XCD_BAR_WORDS 3456
#define XB_SPIN_CAP (1u << 20)
__device__ __forceinline__ unsigned xb_ld(unsigned* p)              { return __hip_atomic_load(p, __ATOMIC_RELAXED, __HIP_MEMORY_SCOPE_AGENT); }
__device__ __forceinline__ unsigned xb_add(unsigned* p, unsigned v) { return __hip_atomic_fetch_add(p, v, __ATOMIC_RELAXED, __HIP_MEMORY_SCOPE_AGENT); }
__device__ __forceinline__ unsigned xb_xcc_id() { return (unsigned)__builtin_amdgcn_s_getreg((3 << 11) | 20) & 0xFu; }
#define XB_SPIN(cond, bar) do { unsigned _sp = 0; while (cond) { __builtin_amdgcn_s_sleep(1); \
    if ((++_sp & 255u) == 0u) { if (xb_ld(&(bar)[XB_TMO])) break; if (_sp > XB_SPIN_CAP) { atomicAdd(&(bar)[XB_TMO], 1u); break; } } } } while (0)
struct XcdBarrier { unsigned* bar; unsigned x; volatile LAS unsigned* st; };
__device__ __forceinline__ XcdBarrier xcd_barrier_post(unsigned* bar, volatile LAS unsigned* st) {
  XcdBarrier b; b.bar = bar; b.x = xb_xcc_id(); b.st = st;
  if (threadIdx.x == 0) (void)xb_add(&bar[XB_XCNT(b.x)], 1u);
  return b;
}
__device__ __forceinline__ void xcd_barrier_complete(unsigned* bar, unsigned x, unsigned& nloc, unsigned& nx) {
  const unsigned G = gridDim.x * gridDim.y * gridDim.z;
  unsigned sum, cnt, mine, sp = 0u;
  for (;;) {
    sum = 0u; cnt = 0u; mine = 0u;
#pragma unroll
    for (unsigned j = 0; j < 16; ++j) { const unsigned c = xb_ld(&bar[XB_XCNT(j)]); sum += c; cnt += (c > 0u) ? 1u : 0u; mine = (j == x) ? c : mine; }
    if (sum == G) break;
    __builtin_amdgcn_s_sleep(1);
    if ((++sp & 255u) == 0u) { if (xb_ld(&bar[XB_TMO])) break; if (sp > XB_SPIN_CAP) { atomicAdd(&bar[XB_TMO], 1u); break; } }
  }
  nloc = mine > 0u ? mine : 1u; nx = cnt > 0u ? cnt : 1u;
}
__device__ __forceinline__ void xcd_barrier(const XcdBarrier& b) {
  asm volatile("s_waitcnt vmcnt(0)" ::: "memory");
  __syncthreads();
  if (opaque_tid() == 0) {
    unsigned* bar = b.bar;
    __builtin_amdgcn_s_waitcnt(0);
    unsigned nloc = b.st[0], nx = b.st[1];
    if (nloc == 0u) { xcd_barrier_complete(bar, b.x, nloc, nx); b.st[0] = nloc; b.st[1] = nx; }
    const unsigned old = xb_add(&bar[XB_XSUB(b.x)], 1u);
    const unsigned gen = old / nloc;
    if (old + 1u == (gen + 1u) * nloc) {
      __builtin_amdgcn_fence(__ATOMIC_RELEASE, "agent");
      asm volatile("s_waitcnt vmcnt(0)" ::: "memory");
      const unsigned og = xb_add(&bar[XB_TOP], 1u);
      const unsigned tg = og / nx;
      if (og + 1u == (tg + 1u) * nx) xb_add(&bar[XB_TOPGEN], 1u);
      else XB_SPIN(xb_ld(&bar[XB_TOPGEN]) == tg, bar);
      __builtin_amdgcn_fence(__ATOMIC_ACQUIRE, "agent");
      xb_add(&bar[XB_XGEN(b.x)], 1u);
      asm volatile("s_waitcnt vmcnt(0)" ::: "memory");
    } else {
      XB_SPIN(xb_ld(&bar[XB_XGEN(b.x)]) == gen, bar);
      __builtin_amdgcn_fence(__ATOMIC_ACQUIRE, "agent");
      asm volatile("s_waitcnt vmcnt(0)" ::: "memory");
    }
  }
  __syncthreads();
}

__global__ void __launch_bounds__(512, 2) mega(Params p) {
  cg::grid_group grid = cg::this_grid();
  extern __shared__ __attribute__((aligned(16))) unsigned char smem_raw[];
  LAS unsigned char* lds = (LAS unsigned char*)smem_raw;
  float* ltf = (float*)smem_raw;
  const int tid = opaque_tid(), G = gridDim.x, wv = tid >> 6, lane = tid & 63;
  unsigned char* ws = p.ws;
  float2* TAB = (float2*)(ws + OFF_TAB); bf16_t* DT = (bf16_t*)(ws + OFF_DFT); bf16_t* MEMB = (bf16_t*)(ws + OFF_MEMB);
  float* RSS = (float*)(ws + OFF_RSS); bf16_t* XB = (bf16_t*)(ws + OFF_XB); bf16_t* WB = (bf16_t*)(ws + OFF_WB);
  bf16_t* RA = (bf16_t*)(ws + OFF_A); bf16_t* RS = (bf16_t*)(ws + OFF_S); bf16_t* RB = (bf16_t*)(ws + OFF_B);
  bf16_t* Zb = RA; bf16_t* Y1 = RA + 32 * MiB; bf16_t* GATES = RA; bf16_t* HID = RA; bf16_t* QX = RA; bf16_t* Ob = RA + 32 * MiB;
  bf16_t* STf = RS; bf16_t* STb = RS + 32 * MiB;
  bf16_t* Qb = RB; bf16_t* Kb = RB + 16 * MiB; bf16_t* Vb = RB + 32 * MiB; bf16_t* Fb = RB + 64 * MiB; bf16_t* Ub = RB; bf16_t* KVb = RB + 32 * MiB;
  float* X = p.X;
  bf16_t* XL = (bf16_t*)p.X;
  const LAS float* RSL = (const LAS float*)(lds + 131072);
  volatile LAS unsigned* xst = (volatile LAS unsigned*)(lds + 163824);
  if (threadIdx.x < 4) xst[threadIdx.x] = 0u;
  __syncthreads();
  const XcdBarrier xb = xcd_barrier_post((unsigned*)(ws + WS_NEED), xst);

  if (p.ws == nullptr) grid.sync();
  for (int r = blockIdx.x * 8 + wv; r < T_TOK; r += G * 8) {
    const float* src = r < 16384 ? p.in[0] + (size_t)r * DM : p.in[1] + (size_t)(r - 16384) * DM;
    float ss = 0.f;
#pragma unroll
    for (int k = 0; k < 4; ++k) { const f32x4 v = *(const f32x4*)(src + k * 256 + lane * 4);
      const u32x2 hi = pack4(v[0], v[1], v[2], v[3]);
      *(u32x2*)(XB + (size_t)r * DM + k * 256 + lane * 4) = hi;
      *(u32x2*)(XL + (size_t)r * DM + k * 256 + lane * 4) = pack4(v[0] - bf_lo(hi[0]), v[1] - bf_hi(hi[0]), v[2] - bf_lo(hi[1]), v[3] - bf_hi(hi[1]));
      ss += v[0] * v[0] + v[1] * v[1] + v[2] * v[2] + v[3] * v[3]; }
#pragma unroll
    for (int o = 32; o; o >>= 1) ss += __shfl_xor(ss, o);
    if (lane < 16) RSS[(size_t)r * 16 + lane] = lane == 0 ? ss : 0.f;
  }
  for (int r = blockIdx.x * 8 + wv; r < NMEMROWS; r += G * 8) {
    const float* src = r < 2048 ? p.in[2] + (size_t)r * DM : p.in[3] + (size_t)(r - 2048) * DM;
    f32x4 v0 = *(const f32x4*)(src + lane * 4), v1 = *(const f32x4*)(src + 256 + lane * 4), v2 = *(const f32x4*)(src + 512 + lane * 4), v3 = *(const f32x4*)(src + 768 + lane * 4);
    float ss = 0.f;
#pragma unroll
    for (int i = 0; i < 4; ++i) ss += v0[i] * v0[i] + v1[i] * v1[i] + v2[i] * v2[i] + v3[i] * v3[i];
#pragma unroll
    for (int o = 32; o; o >>= 1) ss += __shfl_xor(ss, o);
    const float rs = rsqrtf(ss * (1.f / 1024.f) + 1e-6f);
    bf16_t* mp = MEMB + (size_t)r * DM + lane * 4;
    *(u32x2*)(mp) = pack4(v0[0] * rs, v0[1] * rs, v0[2] * rs, v0[3] * rs); *(u32x2*)(mp + 256) = pack4(v1[0] * rs, v1[1] * rs, v1[2] * rs, v1[3] * rs);
    *(u32x2*)(mp + 512) = pack4(v2[0] * rs, v2[1] * rs, v2[2] * rs, v2[3] * rs); *(u32x2*)(mp + 768) = pack4(v3[0] * rs, v3[1] * rs, v3[2] * rs, v3[3] * rs);
  }
  for (int i = blockIdx.x * 512 + tid; i < 16384 * 64; i += G * 512) {
    const int s = i >> 6, d = i & 63;
    const float e = (float)d * 2.0f / 128.0f; const float inv = 1.0f / powf(10000.0f, e); const float ang = (float)s * inv;
    const double a = (double)ang * 0.15915494309189535; const double fr = a - rint(a);
    const float f = (float)fr;
    TAB[i] = make_float2(__builtin_amdgcn_cosf(f), __builtin_amdgcn_sinf(f));
  }
  for (int i = blockIdx.x * 512 + tid; i < 16384 + 4096 + 1024; i += G * 512) {
    int N, k, n, oc, os;
    if (i < 16384) { N = 128; k = i >> 7; n = i & 127; oc = DT_C128 + i; os = DT_S128 + i; }
    else if (i < 20480) { const int q = i - 16384; N = 64; k = q >> 6; n = q & 63; oc = DT_C64 + q; os = DT_S64 + q; }
    else { const int q = i - 20480; N = 32; k = q >> 5; n = q & 31; oc = DT_C32 + q; os = DT_S32 + q; }
    const float fr = (float)((k * n) & (N - 1)) / (float)N; const float sc = rsqrtf((float)N);
    const unsigned pk = cvt_pk_bf16(__builtin_amdgcn_cosf(fr) * sc, __builtin_amdgcn_sinf(fr) * sc);
    DT[oc] = (bf16_t)(pk & 0xffffu); DT[os] = (bf16_t)(pk >> 16);
  }

  for (int layer = 0; layer < 4; ++layer) {
    {
      int tb = 0;
      const float* g1 = p.in[4] + layer * DM; const float* gm = p.in[7] + layer * DM; const float* gx = p.in[14] + layer * DM;
      const float* gmem = p.in[15] + layer * DM; const float* g2 = p.in[19] + layer * DM;
      const float* wmix = p.in[8] + (size_t)layer * 1024 * 5632;
      prep_tiles(p.in[5] + (size_t)layer * 1024 * 5632, 5632, WB + W_1I, 1024, 5632, g1, 1.f, 1, 0, tb, ltf);
      prep_tiles(p.in[6] + (size_t)layer * DFF * 1024, 1024, WB + W_1O, DFF, 1024, nullptr, 1.f, 0, 0, tb, ltf);
      prep_zfold(wmix, gm, WB + W_M1, tb, ltf);
      prep_tiles(wmix, 5632, WB + W_M1 + (size_t)1024 * 1024, 1024, 512, gm, 1.f, 2, 512, tb, ltf);
      prep_tiles(wmix, 5632, WB + W_M1 + (size_t)1536 * 1024, 1024, 512, gm, 0.08838834764831845f, 2, 1024, tb, ltf);
      prep_tiles(wmix, 5632, WB + W_M1 + (size_t)2048 * 1024, 1024, 1024, gm, 1.f, 0, 1536, tb, ltf);
      prep_tiles(wmix, 5632, WB + W_M2, 1024, 3072, gm, 1.f, 0, 2560, tb, ltf);
      prep_tiles(p.in[9] + (size_t)layer * 512 * 1024, 1024, WB + W_F, 512, 1024, nullptr, 1.f, 0, 0, tb, ltf);
      prep_tiles(p.in[12] + (size_t)layer * 1024 * 1024, 1024, WB + W_R, 1024, 1024, nullptr, 1.f, 0, 0, tb, ltf);
      prep_tiles(p.in[13] + (size_t)layer * 1024 * 1024, 1024, WB + W_MO, 1024, 1024, nullptr, 1.f, 0, 0, tb, ltf);
      prep_tiles(p.in[16] + (size_t)layer * 1024 * 1024, 1024, WB + W_Q, 1024, 1024, gx, 1.f, 0, 0, tb, ltf);
      prep_tiles(p.in[17] + (size_t)layer * 1024 * 2048, 2048, WB + W_KV, 1024, 2048, gmem, 1.f, 0, 0, tb, ltf);
      prep_tiles(p.in[18] + (size_t)layer * 1024 * 1024, 1024, WB + W_O, 1024, 1024, nullptr, 1.f, 0, 0, tb, ltf);
      prep_tiles(p.in[20] + (size_t)layer * 1024 * 5632, 5632, WB + W_2I, 1024, 5632, g2, 1.f, 1, 0, tb, ltf);
      prep_tiles(p.in[21] + (size_t)layer * DFF * 1024, 1024, WB + W_2O, DFF, 1024, nullptr, 1.f, 0, 0, tb, ltf);
    }
    xcd_barrier(xb);
    run_gemm(lds, XB, WB + W_1I, T_TOK, 5632, 1024, EpiFfnIn{RSL, HID}, RSS);
    xcd_barrier(xb);
    run_gemm(lds, HID, WB + W_1O, T_TOK, 1024, DFF, EpiRes{XB, XL, XL, RSS, 0.5f});
    xcd_barrier(xb);
    run_gemm(lds, XB, WB + W_M1, T_TOK, 3072, 1024, EpiM1{RSL, TAB, Zb, Qb, Kb, Vb}, RSS);
    xcd_barrier(xb);
    float lgf2[4], lgb2[4], lgf[4], lgb[4];
#pragma unroll
    for (int hh = 0; hh < 4; ++hh) { lgf[hh] = log_sigmoid(p.in[10][layer * 4 + hh]); lgb[hh] = log_sigmoid(p.in[11][layer * 4 + hh]);
      lgf2[hh] = lgf[hh] * 1.4426950408889634f; lgb2[hh] = lgb[hh] * 1.4426950408889634f; }
    dft_phase<1>(Zb, Y1, DT, lds);
    for (int it = blockIdx.x; it < 1024; it += G) { const int hh = it & 3; ret_state_item(Kb, Vb, STf, STb, it >> 2, hh, sel4(lgf2, hh), sel4(lgb2, hh), lds); }
    xcd_barrier(xb);
    dft_phase<2>(Y1, Fb, DT, lds);
    for (int it = blockIdx.x; it < 256; it += G) {
      if (it < 128) { const int dir = it >> 6, sub = it & 63, hh = sub >> 4; ret_scan_seq(dir ? STb : STf, 128, 128, sub, dir ? sel4(lgb, hh) : sel4(lgf, hh), dir); }
      else for (int k = 0; k < 8; ++k) { const int r = (it - 128) * 8 + k, b = r >> 7, dir = (r >> 6) & 1, sub = r & 63, hh = sub >> 4;
        ret_scan_seq(dir ? STb : STf, b * 16, 16, sub, dir ? sel4(lgb, hh) : sel4(lgf, hh), dir); }
    }
    xcd_barrier(xb);
    for (int it = blockIdx.x; it < 1024; it += G) { const int hh = it & 3; ret_out_item(Qb, Kb, Vb, STf, STb, it >> 2, hh, sel4(lgf2, hh), sel4(lgb2, hh), lds); }
    xcd_barrier(xb);
    run_gemm(lds, XB, WB + W_M2, T_TOK, 3072, 1024, EpiM2{RSL, Vb, GATES}, RSS);
    xcd_barrier(xb);
    run_gemm(lds, Fb, WB + W_F, T_TOK, 1024, 512, EpiComb<0>{GATES, Ub});
    run_gemm(lds, Vb, WB + W_R, T_TOK, 1024, 1024, EpiComb<1>{GATES, Ub});
    xcd_barrier(xb);
    run_gemm(lds, Ub, WB + W_MO, T_TOK, 1024, 1024, EpiRes{XB, XL, XL, RSS, 1.0f});
    run_gemm(lds, MEMB, WB + W_KV, NMEMROWS, 2048, 1024, EpiPlain<false>{RSL, KVb, 2048, 1.0f});
    xcd_barrier(xb);
    run_gemm(lds, XB, WB + W_Q, T_TOK, 1024, 1024, EpiPlain<true>{RSL, QX, 1024, 0.0625f}, RSS);
    { pg8::StaticOrder S; S.init(T_TOK, 1024, G, blockIdx.x); Unit u; for (int i = 0; S.next(i, u); ++i) attn_item(QX, KVb, Ob, u.pm, u.pn, lds); }
    xcd_barrier(xb);
    run_gemm(lds, Ob, WB + W_O, T_TOK, 1024, 1024, EpiRes{XB, XL, XL, RSS, 1.0f});
    xcd_barrier(xb);
    run_gemm(lds, XB, WB + W_2I, T_TOK, 5632, 1024, EpiFfnIn{RSL, HID}, RSS);
    xcd_barrier(xb);
    run_gemm(lds, HID, WB + W_2O, T_TOK, 1024, DFF, EpiRes{XB, XL, layer == 3 ? RB : XL, RSS, 0.5f});
    xcd_barrier(xb);
  }
  const int tidf = opaque_tid(), wvf = tidf >> 6, lanef = tidf & 63;
  for (int r = blockIdx.x * 8 + wvf; r < T_TOK; r += G * 8) {
    const float rs = row_rstd(RSS, r);
#pragma unroll
    for (int k = 0; k < 4; ++k) { const size_t o = (size_t)r * DM + k * 256 + lanef * 4; const f32x4 g = *(const f32x4*)(p.in[22] + k * 256 + lanef * 4);
      const u32x2 hi = *(const u32x2*)(XB + o), lo = *(const u32x2*)(RB + o);
      f32x4 v = {bf_lo(hi[0]) + bf_lo(lo[0]), bf_hi(hi[0]) + bf_hi(lo[0]), bf_lo(hi[1]) + bf_lo(lo[1]), bf_hi(hi[1]) + bf_hi(lo[1])};
      *(f32x4*)(X + o) = v * rs * g; }
  }
}

extern "C" void kernel_launch(void* const* d_in, const int* in_sizes, int n_in, void* d_out, int out_size, void* d_ws, size_t ws_size, hipStream_t stream) {
  constexpr size_t kDynLds = 163840;
  static int grid_blocks = 0;
  if (!grid_blocks) {
    (void)hipFuncSetAttribute((const void*)mega, hipFuncAttributeMaxDynamicSharedMemorySize, (int)kDynLds);
    int dev = 0, cus = 0, per_cu = 0;
    (void)hipGetDevice(&dev);
    (void)hipDeviceGetAttribute(&cus, hipDeviceAttributeMultiprocessorCount, dev);
    (void)hipOccupancyMaxActiveBlocksPerMultiprocessor(&per_cu, mega, 512, kDynLds);
    grid_blocks = cus > 0 ? cus : 256;
    if (per_cu < 1) fprintf(stderr, "occupancy query returned %d\n", per_cu);
  }
  if (ws_size < WS_NEED + 16384) { fprintf(stderr, "workspace too small: %zu < %zu\n", ws_size, (size_t)WS_NEED); return; }
  (void)hipMemsetAsync((unsigned char*)d_ws + WS_NEED, 0, XCD_BAR_WORDS * 4, stream);
  Params p{};
  for (int i = 0; i < 23; ++i) p.in[i] = (const float*)d_in[i];
  p.X = (float*)d_out; p.ws = (unsigned char*)d_ws;
  void* args[] = {&p};
  hipError_t e = hipLaunchCooperativeKernel((void*)mega, dim3(grid_blocks), dim3(512), args, kDynLds, stream);
  if (e != hipSuccess) fprintf(stderr, "cooperative launch failed: %s (grid %d)\n", hipGetErrorString(e), grid_blocks);
}
```

```cpp
#include <hip/hip_runtime.h>
#include <hip/hip_cooperative_groups.h>
#include <cstdio>
namespace cg = cooperative_groups;

#define LAS __attribute__((address_space(3)))
typedef unsigned short bf16_t;
typedef short bf16x8 __attribute__((ext_vector_type(8)));
typedef short s16x4 __attribute__((ext_vector_type(4)));
typedef float f32x4 __attribute__((ext_vector_type(4)));
typedef float f32x16 __attribute__((ext_vector_type(16)));
typedef unsigned u32x4 __attribute__((ext_vector_type(4)));
typedef unsigned u32x2 __attribute__((ext_vector_type(2)));

constexpr int T_TOK = 32768, DM = 1024, DFF = 2816, NMEMROWS = 2304;
constexpr size_t MiB = 1048576;
constexpr size_t OFF_TAB = 0;
constexpr size_t OFF_DFT = 8 * MiB;
constexpr size_t OFF_MEMB = OFF_DFT + 256 * 1024;
constexpr size_t OFF_RSS = OFF_MEMB + 4718592;
constexpr size_t OFF_XB = OFF_RSS + 2 * MiB;
constexpr size_t OFF_WB = OFF_XB + 64 * MiB;
constexpr size_t OFF_A = OFF_WB + 58 * MiB;
constexpr size_t OFF_S = OFF_A + 128 * MiB;
constexpr size_t OFF_B = OFF_S + 128 * MiB;
constexpr size_t WS_NEED = OFF_B + 160 * MiB;
constexpr size_t W_1I = 0, W_1O = 5767168, W_M1 = 8650752, W_M2 = 11796480, W_F = 14942208, W_R = 15466496, W_MO = 16515072,
                 W_Q = 17563648, W_KV = 18612224, W_O = 20709376, W_2I = 21757952, W_2O = 27525120;
constexpr int DT_C128 = 0, DT_S128 = 16384, DT_C64 = 32768, DT_S64 = 36864, DT_C32 = 40960, DT_S32 = 41984;

struct Params {
  const float* in[23];
  float* X;
  unsigned char* ws;
};

__device__ __forceinline__ int opaque_tid() { int t = threadIdx.x; asm volatile("" : "+v"(t)); return t; }
typedef __bf16 bf16x2_t __attribute__((ext_vector_type(2)));
typedef float f32x2 __attribute__((ext_vector_type(2)));
__device__ __forceinline__ unsigned cvt_pk_bf16(float lo, float hi) { f32x2 v = {lo, hi}; bf16x2_t b = __builtin_convertvector(v, bf16x2_t); return __builtin_bit_cast(unsigned, b); }
__device__ __forceinline__ float bf_lo(unsigned u) { return __uint_as_float(u << 16); }
__device__ __forceinline__ float bf_hi(unsigned u) { return __uint_as_float(u & 0xffff0000u); }
__device__ __forceinline__ u32x4 pack8(f32x4 a, f32x4 b) { u32x4 o; o[0] = cvt_pk_bf16(a[0], a[1]); o[1] = cvt_pk_bf16(a[2], a[3]); o[2] = cvt_pk_bf16(b[0], b[1]); o[3] = cvt_pk_bf16(b[2], b[3]); return o; }
__device__ __forceinline__ u32x2 pack4(float a, float b, float c, float d) { u32x2 o; o[0] = cvt_pk_bf16(a, b); o[1] = cvt_pk_bf16(c, d); return o; }
__device__ __forceinline__ unsigned pack_u8x4(float a, float b, float c, float d) {
  return (unsigned)(a * 255.f + 0.5f) | ((unsigned)(b * 255.f + 0.5f) << 8) | ((unsigned)(c * 255.f + 0.5f) << 16) | ((unsigned)(d * 255.f + 0.5f) << 24); }
__device__ __forceinline__ float u8f(unsigned w, int k) { return (float)((w >> (8 * k)) & 0xffu) * (1.f / 255.f); }
__device__ __forceinline__ float fsigmoid(float x) { return __builtin_amdgcn_rcpf(1.f + __expf(-x)); }
__device__ __forceinline__ float fsilu(float x) { return x * fsigmoid(x); }
__device__ __forceinline__ f32x4 swiglu4(f32x4 g, f32x4 u, float c1  , float rs2  ) {
  f32x4 t = g * c1, d, r;
#pragma unroll
  for (int i = 0; i < 4; ++i) d[i] = __builtin_amdgcn_exp2f(t[i]);
  d = d + 1.0f;
#pragma unroll
  for (int i = 0; i < 4; ++i) r[i] = __builtin_amdgcn_rcpf(d[i]);
  return (g * u) * (r * rs2);
}
__device__ __forceinline__ f32x4 sigmoid4(f32x4 a, float c1) {
  f32x4 t = a * c1, d, r;
#pragma unroll
  for (int i = 0; i < 4; ++i) d[i] = __builtin_amdgcn_exp2f(t[i]);
  d = d + 1.0f;
#pragma unroll
  for (int i = 0; i < 4; ++i) r[i] = __builtin_amdgcn_rcpf(d[i]);
  return r;
}
__device__ __forceinline__ float row_rstd(const float* RSS, int row) {
  const f32x4* p = (const f32x4*)(RSS + (size_t)row * 16); f32x4 a = p[0], b = p[1], c = p[2], d = p[3];
  float s = ((a[0] + a[1]) + (a[2] + a[3])) + ((b[0] + b[1]) + (b[2] + b[3])) + ((c[0] + c[1]) + (c[2] + c[3])) + ((d[0] + d[1]) + (d[2] + d[3]));
  return rsqrtf(s * (1.f / 1024.f) + 1e-6f);
}
__device__ __forceinline__ bf16x8 tr_frag(const LAS unsigned char* lds, unsigned off_lo, unsigned off_hi) {
  s16x4 a = __builtin_amdgcn_ds_read_tr16_b64_v4i16((LAS s16x4*)(lds + off_lo));
  s16x4 b = __builtin_amdgcn_ds_read_tr16_b64_v4i16((LAS s16x4*)(lds + off_hi));
  return __builtin_shufflevector(a, b, 0, 1, 2, 3, 4, 5, 6, 7);
}
__device__ __forceinline__ void store_tile16(bf16_t* p, const f32x16& a, float sc, int h) {
#pragma unroll
  for (int gp = 0; gp < 2; ++gp) {
    u32x2 A = pack4(a[8 * gp] * sc, a[8 * gp + 1] * sc, a[8 * gp + 2] * sc, a[8 * gp + 3] * sc), B = pack4(a[8 * gp + 4] * sc, a[8 * gp + 5] * sc, a[8 * gp + 6] * sc, a[8 * gp + 7] * sc);
    const auto r0 = __builtin_amdgcn_permlane32_swap(A[0], B[0], false, false), r1 = __builtin_amdgcn_permlane32_swap(A[1], B[1], false, false);
    u32x4 o = {r0[0], r1[0], r0[1], r1[1]};
    *(u32x4*)(p + 16 * gp + 8 * h) = o;
  }
}
__device__ __forceinline__ f32x16 mfma32(bf16x8 a, bf16x8 b, f32x16 c) { return __builtin_amdgcn_mfma_f32_32x32x16_bf16(a, b, c, 0, 0, 0); }
__device__ __forceinline__ float log_sigmoid(float x) { return fminf(x, 0.f) - log1pf(expf(-fabsf(x))); }
__device__ __forceinline__ bf16x8 scale_frag(bf16x8 q, float s) {
  u32x4 u = (u32x4)q; u32x4 o;
#pragma unroll
  for (int i = 0; i < 4; ++i) o[i] = cvt_pk_bf16(bf_lo(u[i]) * s, bf_hi(u[i]) * s);
  return (bf16x8)o;
}

namespace pg8 {
constexpr int BM = 256, BK = 64, HALF = 128, HTB = HALF * BK * 2, STAGE_BYTES = 8 * HTB, NXCD = 8, WGM = 8;
__device__ __forceinline__ int lds_byte(int r, int c) { const int st = (r >> 4) * 2 + (c >> 5), rr = r & 15, cc = c & 31, ob = rr * 64 + cc * 2; return st * 1024 + (ob ^ (((ob >> 9) & 1) << 5)); }
__device__ __forceinline__ void stage_rc(int b, int& R, int& C) { const int st = b / 1024, sb = b % 1024, swz = sb ^ (((sb >> 9) & 1) << 5); R = (st >> 1) * 16 + swz / 64; C = (st & 1) * 32 + (swz % 64) / 2; }
__device__ __forceinline__ int perm32(int rho) { const int n = rho >> 4, i = rho & 15; return 8 * (i >> 2) + 4 * n + (i & 3); }
struct Unit { int pm, pn; };
struct Gemm { const bf16_t* A; const bf16_t* Bt; int M, N, K; };
struct StaticOrder {
  int nM, nN, nwg, G, c;
  __device__ void init(int M, int N, int G_, int c_) { nM = M / BM; nN = N / BM; nwg = nM * nN; G = G_; c = c_; }
  __device__ bool next(int i, Unit& u) const {
    const long L = (long)i * G + c; if (L >= nwg) return false;
    int wgid = (int)L; { const int q = nwg / NXCD, r = nwg % NXCD, xcd = wgid % NXCD, off = wgid / NXCD; wgid = (xcd < r ? xcd * (q + 1) : r * (q + 1) + (xcd - r) * q) + off; }
    const int nig = WGM * nN, gid = wgid / nig, fm = gid * WGM, gsz = (nM - fm) < WGM ? (nM - fm) : WGM;
    u.pm = fm + ((wgid % nig) % gsz); u.pn = (wgid % nig) / gsz; return true;
  }
  __device__ __forceinline__ void a_ready(const Unit&) const {}
  __device__ __forceinline__ void done(const Unit&) const {}
};

template <class Epi, class Sched>
__device__ __forceinline__ void gemm_phase(LAS unsigned char* lds, const Gemm g, const Sched& S, const Epi& E) {
  const int tid = opaque_tid(), wid = __builtin_amdgcn_readfirstlane(tid >> 6), lane = tid & 63, wr = wid >> 2, wc = wid & 3, fr = lane & 15, fq = lane >> 4;
  const int K = g.K, nt = K / BK;
  unsigned voffA[2], voffB[2];
#pragma unroll
  for (int i = 0; i < 2; ++i) { int R, C; stage_rc(tid * 16 + i * 8192, R, C); const int Rb = Epi::PERM ? ((R & ~31) + perm32(R & 31)) : R;
    voffA[i] = (unsigned)(R * K + C) * 2u; voffB[i] = (unsigned)(Rb * K + C) * 2u; }
  const size_t kstep = (size_t)(BK * 2);
  const size_t hstep = (size_t)HALF * K * 2;
  const size_t tstep = 2 * hstep;
  const unsigned ldsw = (unsigned)wid * 1024u;
  const int aoff = lds_byte(wr * 64 + fr, fq * 8), boff = lds_byte(wc * 32 + fr, fq * 8);
#define PG8_SA(b, h) (((b) * 2 + (h)) * HTB)
#define PG8_SB(b, h) ((4 + (b) * 2 + (h)) * HTB)
#define PG8_STAGE(bufoff, gbase, voff) do { _Pragma("unroll") for (int _i = 0; _i < 2; ++_i) \
    __builtin_amdgcn_global_load_lds((const unsigned*)((const char*)(gbase) + (voff)[_i]), (LAS unsigned*)(lds + (bufoff) + ldsw + _i * 8192), 16, 0, 0); } while (0)
#define PG8_LDA(dst, b, h) do { _Pragma("unroll") for (int m = 0; m < 4; ++m) _Pragma("unroll") for (int k = 0; k < 2; ++k) dst[m][k] = *(const LAS bf16x8*)(lds + PG8_SA(b, h) + aoff + m * 2048 + k * 1024); } while (0)
#define PG8_LDB(dst, b, h) do { _Pragma("unroll") for (int n = 0; n < 2; ++n) _Pragma("unroll") for (int k = 0; k < 2; ++k) dst[n][k] = *(const LAS bf16x8*)(lds + PG8_SB(b, h) + boff + n * 2048 + k * 1024); } while (0)
#define PG8_MMA(ai, bj, At, Bt) do { __builtin_amdgcn_s_setprio(1); _Pragma("unroll") for (int m = 0; m < 4; ++m) _Pragma("unroll") for (int n = 0; n < 2; ++n) _Pragma("unroll") for (int k = 0; k < 2; ++k) \
    acc[ai][bj][m][n] = __builtin_amdgcn_mfma_f32_16x16x32_bf16(Bt[n][k], At[m][k], acc[ai][bj][m][n], 0, 0, 0); __builtin_amdgcn_s_setprio(0); } while (0)
#define PG8_WAIT_V(n) asm volatile("s_waitcnt vmcnt(" #n ")" ::: "memory")
#define PG8_WAIT_L(n) asm volatile("s_waitcnt lgkmcnt(" #n ")" ::: "memory")
#define PG8_BAR __builtin_amdgcn_s_barrier()
#define PG8_SCHED __builtin_amdgcn_sched_barrier(0)
  Unit cur, nxt; int ui = 0;
  if (!S.next(0, cur)) return;
  f32x4 acc[2][2][4][2];
#pragma unroll
  for (int a = 0; a < 2; ++a)
#pragma unroll
    for (int b = 0; b < 2; ++b)
#pragma unroll
      for (int m = 0; m < 4; ++m)
#pragma unroll
        for (int n = 0; n < 2; ++n) acc[a][b][m][n] = (f32x4){0.f, 0.f, 0.f, 0.f};
  bf16x8 At[4][2], B0[2][2], B1[2][2];
  const char* cA = (const char*)g.A + (size_t)cur.pm * tstep; const char* cB = (const char*)g.Bt + (size_t)cur.pn * tstep;
  S.a_ready(cur);
  PG8_STAGE(PG8_SB(0, 0), cB, voffB); PG8_STAGE(PG8_SA(0, 0), cA, voffA); PG8_STAGE(PG8_SB(0, 1), cB + hstep, voffB); PG8_STAGE(PG8_SA(0, 1), cA + hstep, voffA);
  if (wr == 1) PG8_BAR;
  PG8_WAIT_V(4); PG8_BAR;
  PG8_STAGE(PG8_SB(1, 0), cB + kstep, voffB); PG8_STAGE(PG8_SA(1, 0), cA + kstep, voffA); PG8_STAGE(PG8_SB(1, 1), cB + hstep + kstep, voffB);
  PG8_WAIT_V(6); PG8_BAR;
  for (;;) {
    const bool has_next = S.next(ui + 1, nxt);
    const char* nA = has_next ? (const char*)g.A + (size_t)nxt.pm * tstep : cA; const char* nB = has_next ? (const char*)g.Bt + (size_t)nxt.pn * tstep : cB;
    for (int t = 0; t < nt; t += 2) {
      const bool last = (t == nt - 2);
      const char* a1 = cA + (size_t)(t + 1) * kstep;
      const char* a2 = last ? nA : cA + (size_t)(t + 2) * kstep; const char* b2 = last ? nB : cB + (size_t)(t + 2) * kstep;
      const char* a3 = a2 + kstep; const char* b3 = b2 + kstep;
      if (last && has_next) S.a_ready(nxt);
      PG8_LDB(B0, 0, 0); PG8_SCHED; PG8_LDA(At, 0, 0); PG8_STAGE(PG8_SA(1, 1), a1 + hstep, voffA);
      PG8_WAIT_L(8); PG8_BAR; PG8_WAIT_L(0); PG8_MMA(0, 0, At, B0); PG8_BAR; PG8_SCHED;
      PG8_LDB(B1, 0, 1); PG8_STAGE(PG8_SB(0, 0), b2, voffB);
      PG8_BAR; PG8_WAIT_L(0); PG8_MMA(0, 1, At, B1); PG8_BAR;
      PG8_LDA(At, 0, 1); PG8_STAGE(PG8_SA(0, 0), a2, voffA);
      PG8_BAR; PG8_WAIT_L(0); PG8_MMA(1, 0, At, B0); PG8_BAR; PG8_SCHED;
      PG8_STAGE(PG8_SB(0, 1), b2 + hstep, voffB);
      PG8_WAIT_V(6); PG8_BAR; PG8_MMA(1, 1, At, B1); PG8_BAR;
      PG8_LDB(B0, 1, 0); PG8_SCHED; PG8_LDA(At, 1, 0); PG8_STAGE(PG8_SA(0, 1), a2 + hstep, voffA);
      PG8_WAIT_L(8); PG8_BAR; PG8_WAIT_L(0); PG8_MMA(0, 0, At, B0); PG8_BAR; PG8_SCHED;
      PG8_LDB(B1, 1, 1); PG8_STAGE(PG8_SB(1, 0), b3, voffB);
      PG8_BAR; PG8_WAIT_L(0); PG8_MMA(0, 1, At, B1); PG8_BAR;
      PG8_LDA(At, 1, 1); PG8_STAGE(PG8_SA(1, 0), a3, voffA);
      PG8_BAR; PG8_WAIT_L(0); PG8_MMA(1, 0, At, B0); PG8_BAR; PG8_SCHED;
      PG8_STAGE(PG8_SB(1, 1), b3 + hstep, voffB);
      PG8_WAIT_V(6); PG8_BAR; PG8_MMA(1, 1, At, B1); PG8_BAR;
    }
    E(acc, cur, ui, wr, wc, fr, fq); S.done(cur);
    if (!has_next) break;
#pragma unroll
    for (int a = 0; a < 2; ++a)
#pragma unroll
      for (int b = 0; b < 2; ++b)
#pragma unroll
        for (int m = 0; m < 4; ++m)
#pragma unroll
          for (int n = 0; n < 2; ++n) acc[a][b][m][n] = (f32x4){0.f, 0.f, 0.f, 0.f};
    cur = nxt; cA = nA; cB = nB; ++ui;
  }
  PG8_WAIT_V(0);
  if (wr == 0) PG8_BAR;
  PG8_BAR;
#undef PG8_SA
#undef PG8_SB
#undef PG8_STAGE
#undef PG8_LDA
#undef PG8_LDB
#undef PG8_MMA
#undef PG8_WAIT_V
#undef PG8_WAIT_L
#undef PG8_BAR
#undef PG8_SCHED
}
}
using pg8::Unit;
typedef f32x4 AccT[2][2][4][2];

struct EpiFfnIn {
  static constexpr bool PERM = true;
  const LAS float* RSL; bf16_t* H;
  __device__ __forceinline__ void operator()(const AccT& acc, const Unit& u, int ui, int wr, int wc, int fr, int fq) const {
#pragma unroll
    for (int ai = 0; ai < 2; ++ai)
#pragma unroll
      for (int m = 0; m < 4; ++m) {
        const int row = u.pm * 256 + ai * 128 + wr * 64 + m * 16 + fr; const float rs = RSL[ui * 256 + ai * 128 + wr * 64 + m * 16 + fr];
        const float c1 = rs * -1.4426950408889634f, rs2 = rs * rs;
        const f32x4 h0 = swiglu4(acc[ai][0][m][0], acc[ai][1][m][0], c1, rs2), h1 = swiglu4(acc[ai][0][m][1], acc[ai][1][m][1], c1, rs2);
        *(u32x4*)(H + (size_t)row * DFF + u.pn * 128 + wc * 32 + fq * 8) = pack8(h0, h1);
      }
  }
};
struct EpiRes {
  static constexpr bool PERM = true;
  bf16_t* XB; const bf16_t* XLi; bf16_t* XLo; float* RSS; float s;
  __device__ __forceinline__ void operator()(const AccT& acc, const Unit& u, int ui, int wr, int wc, int fr, int fq) const {
#pragma unroll
    for (int aim = 0; aim < 4; ++aim) {
      const int ai = aim >> 1, m0 = (aim & 1) * 2;
      u32x4 xh[4][2], xl[4][2];
#pragma unroll
      for (int m = m0; m < m0 + 2; ++m)
#pragma unroll
        for (int bj = 0; bj < 2; ++bj) {
          const size_t o = (size_t)(u.pm * 256 + ai * 128 + wr * 64 + m * 16 + fr) * DM + u.pn * 256 + bj * 128 + wc * 32 + fq * 8;
          xh[m][bj] = *(const u32x4*)(XB + o); xl[m][bj] = *(const u32x4*)(XLi + o);
        }
#pragma unroll
      for (int m = m0; m < m0 + 2; ++m) {
        const int row = u.pm * 256 + ai * 128 + wr * 64 + m * 16 + fr; float ss = 0.f;
#pragma unroll
        for (int bj = 0; bj < 2; ++bj) {
          const size_t o = (size_t)row * DM + u.pn * 256 + bj * 128 + wc * 32 + fq * 8;
          const u32x4 h4 = xh[m][bj], l4 = xl[m][bj];
          f32x4 y0, y1;
#pragma unroll
          for (int i = 0; i < 2; ++i) { y0[2 * i] = bf_lo(h4[i]) + bf_lo(l4[i]); y0[2 * i + 1] = bf_hi(h4[i]) + bf_hi(l4[i]); y1[2 * i] = bf_lo(h4[2 + i]) + bf_lo(l4[2 + i]); y1[2 * i + 1] = bf_hi(h4[2 + i]) + bf_hi(l4[2 + i]); }
          y0 += acc[ai][bj][m][0] * s; y1 += acc[ai][bj][m][1] * s;
          const u32x4 nh = pack8(y0, y1);
          f32x4 r0, r1;
#pragma unroll
          for (int i = 0; i < 2; ++i) { r0[2 * i] = y0[2 * i] - bf_lo(nh[i]); r0[2 * i + 1] = y0[2 * i + 1] - bf_hi(nh[i]); r1[2 * i] = y1[2 * i] - bf_lo(nh[2 + i]); r1[2 * i + 1] = y1[2 * i + 1] - bf_hi(nh[2 + i]); }
          *(u32x4*)(XB + o) = nh; *(u32x4*)(XLo + o) = pack8(r0, r1);
#pragma unroll
          for (int i = 0; i < 4; ++i) ss += y0[i] * y0[i] + y1[i] * y1[i];
        }
        ss += __shfl_xor(ss, 16); ss += __shfl_xor(ss, 32);
        if (fq == 0) RSS[(size_t)row * 16 + u.pn * 4 + wc] = ss;
      }
    }
  }
};
struct EpiM1 {
  static constexpr bool PERM = true;
  const LAS float* RSL; const float2* TAB; bf16_t* Z; bf16_t* Q; bf16_t* Kb; bf16_t* V;
  __device__ __forceinline__ void operator()(const AccT& acc, const Unit& u, int ui, int wr, int wc, int fr, int fq) const {
    const int pn = u.pn;
    if (pn < 4 || pn >= 8) {
      bf16_t* dst = pn < 4 ? Z : V; const int cb = (pn < 4 ? pn : pn - 8) * 256;
#pragma unroll
      for (int ai = 0; ai < 2; ++ai)
#pragma unroll
        for (int m = 0; m < 4; ++m) {
          const int row = u.pm * 256 + ai * 128 + wr * 64 + m * 16 + fr; const float rs = RSL[ui * 256 + ai * 128 + wr * 64 + m * 16 + fr];
#pragma unroll
          for (int bj = 0; bj < 2; ++bj)
            *(u32x4*)(dst + (size_t)row * 1024 + cb + bj * 128 + wc * 32 + fq * 8) = pack8(acc[ai][bj][m][0] * rs, acc[ai][bj][m][1] * rs);
        }
    } else {
      bf16_t* dst = pn < 6 ? Q : Kb; const int head = 2 * (pn < 6 ? pn - 4 : pn - 6) + (wc >> 1); const int d0 = 32 * (wc & 1) + 8 * fq;
#pragma unroll
      for (int aim = 0; aim < 4; ++aim) {
        const int ai = aim >> 1, m0 = (aim & 1) * 2;
        f32x4 tt[4][4];
#pragma unroll
        for (int m = m0; m < m0 + 2; ++m) {
          const int row = u.pm * 256 + ai * 128 + wr * 64 + m * 16 + fr; const int spos = row < 16384 ? (row & 2047) : row - 16384;
          const f32x4* tp = (const f32x4*)(TAB + (size_t)spos * 64 + d0);
          tt[m][0] = tp[0]; tt[m][1] = tp[1]; tt[m][2] = tp[2]; tt[m][3] = tp[3];
        }
#pragma unroll
        for (int m = m0; m < m0 + 2; ++m) {
          const int row = u.pm * 256 + ai * 128 + wr * 64 + m * 16 + fr; const float rs = RSL[ui * 256 + ai * 128 + wr * 64 + m * 16 + fr];
          const f32x4 t0 = tt[m][0], t1 = tt[m][1], t2 = tt[m][2], t3 = tt[m][3];
          f32x4 x1a = acc[ai][0][m][0] * rs, x1b = acc[ai][0][m][1] * rs, x2a = acc[ai][1][m][0] * rs, x2b = acc[ai][1][m][1] * rs;
          f32x4 ca = {t0[0], t0[2], t1[0], t1[2]}, sa = {t0[1], t0[3], t1[1], t1[3]}, cb2 = {t2[0], t2[2], t3[0], t3[2]}, sb = {t2[1], t2[3], t3[1], t3[3]};
          f32x4 o1a = x1a * ca - x2a * sa, o1b = x1b * cb2 - x2b * sb, o2a = x2a * ca + x1a * sa, o2b = x2b * cb2 + x1b * sb;
          bf16_t* op = dst + (size_t)row * 512 + head * 128 + d0;
          *(u32x4*)op = pack8(o1a, o1b); *(u32x4*)(op + 64) = pack8(o2a, o2b);
        }
      }
    }
  }
};
struct EpiM2 {
  static constexpr bool PERM = true;
  const LAS float* RSL; bf16_t* YN; bf16_t* GATES;
  __device__ __forceinline__ void operator()(const AccT& acc, const Unit& u, int ui, int wr, int wc, int fr, int fq) const {
    const int pn = u.pn;
    if (pn < 4) {
#pragma unroll
      for (int ai = 0; ai < 2; ++ai) {
        u32x4 yy[4][2];
#pragma unroll
        for (int m = 0; m < 4; ++m)
#pragma unroll
          for (int bj = 0; bj < 2; ++bj) yy[m][bj] = *(const u32x4*)(YN + (size_t)(u.pm * 256 + ai * 128 + wr * 64 + m * 16 + fr) * 1024 + pn * 256 + bj * 128 + wc * 32 + fq * 8);
#pragma unroll
        for (int m = 0; m < 4; ++m) {
          const int row = u.pm * 256 + ai * 128 + wr * 64 + m * 16 + fr; const float rs = RSL[ui * 256 + ai * 128 + wr * 64 + m * 16 + fr];
#pragma unroll
          for (int bj = 0; bj < 2; ++bj) {
            f32x4 a = acc[ai][bj][m][0] * rs, b = acc[ai][bj][m][1] * rs; const u32x4 y = yy[m][bj];
#pragma unroll
            for (int i = 0; i < 2; ++i) { a[2 * i] = fsilu(a[2 * i]) * bf_lo(y[i]); a[2 * i + 1] = fsilu(a[2 * i + 1]) * bf_hi(y[i]); b[2 * i] = fsilu(b[2 * i]) * bf_lo(y[2 + i]); b[2 * i + 1] = fsilu(b[2 * i + 1]) * bf_hi(y[2 + i]); }
            *(u32x4*)(YN + (size_t)row * 1024 + pn * 256 + bj * 128 + wc * 32 + fq * 8) = pack8(a, b);
          }
        }
      }
    } else {
#pragma unroll
      for (int ai = 0; ai < 2; ++ai)
#pragma unroll
        for (int m = 0; m < 4; ++m) {
          const int row = u.pm * 256 + ai * 128 + wr * 64 + m * 16 + fr; const float rs = RSL[ui * 256 + ai * 128 + wr * 64 + m * 16 + fr];
#pragma unroll
          for (int bj = 0; bj < 2; ++bj) {
            const float c1 = rs * -1.4426950408889634f;
            const f32x4 a = sigmoid4(acc[ai][bj][m][0], c1), b = sigmoid4(acc[ai][bj][m][1], c1);
            u32x2 g8; g8[0] = pack_u8x4(a[0], a[1], a[2], a[3]); g8[1] = pack_u8x4(b[0], b[1], b[2], b[3]);
            *(u32x2*)((unsigned char*)GATES + (size_t)row * 2048 + (pn - 4) * 256 + bj * 128 + wc * 32 + fq * 8) = g8;
          }
        }
    }
  }
};
template <int MODE> struct EpiComb {
  static constexpr bool PERM = true;
  const bf16_t* GATES; bf16_t* U;
  __device__ __forceinline__ void operator()(const AccT& acc, const Unit& u, int ui, int wr, int wc, int fr, int fq) const {
#pragma unroll
    for (int aim = 0; aim < 4; ++aim) {
      const int ai = aim >> 1, m0 = (aim & 1) * 2;
      u32x2 gv[4][2]; u32x4 yv[4][2];
#pragma unroll
      for (int m = m0; m < m0 + 2; ++m)
#pragma unroll
        for (int bj = 0; bj < 2; ++bj) {
          const size_t row = (size_t)(u.pm * 256 + ai * 128 + wr * 64 + m * 16 + fr); const int col = u.pn * 256 + bj * 128 + wc * 32 + fq * 8;
          gv[m][bj] = *(const u32x2*)((const unsigned char*)GATES + row * 2048 + MODE * 1024 + col);
          if (MODE == 1) yv[m][bj] = *(const u32x4*)(U + row * 1024 + col);
        }
#pragma unroll
      for (int m = m0; m < m0 + 2; ++m)
#pragma unroll
        for (int bj = 0; bj < 2; ++bj) {
          const size_t row = (size_t)(u.pm * 256 + ai * 128 + wr * 64 + m * 16 + fr); const int col = u.pn * 256 + bj * 128 + wc * 32 + fq * 8;
          const u32x2 gg = gv[m][bj];
          f32x4 a = acc[ai][bj][m][0], b = acc[ai][bj][m][1];
#pragma unroll
          for (int i = 0; i < 4; ++i) { a[i] *= u8f(gg[0], i); b[i] *= u8f(gg[1], i); }
          if (MODE == 1) { const u32x4 y = yv[m][bj];
#pragma unroll
            for (int i = 0; i < 2; ++i) { a[2 * i] += bf_lo(y[i]); a[2 * i + 1] += bf_hi(y[i]); b[2 * i] += bf_lo(y[2 + i]); b[2 * i + 1] += bf_hi(y[2 + i]); } }
          *(u32x4*)(U + row * 1024 + col) = pack8(a, b);
        }
    }
  }
};
template <bool USE_RS> struct EpiPlain {
  static constexpr bool PERM = true;
  const LAS float* RSL; bf16_t* O; int ldo; float s;
  __device__ __forceinline__ void operator()(const AccT& acc, const Unit& u, int ui, int wr, int wc, int fr, int fq) const {
#pragma unroll
    for (int ai = 0; ai < 2; ++ai)
#pragma unroll
      for (int m = 0; m < 4; ++m) {
        const int row = u.pm * 256 + ai * 128 + wr * 64 + m * 16 + fr; const float rs = USE_RS ? RSL[ui * 256 + ai * 128 + wr * 64 + m * 16 + fr] * s : s;
#pragma unroll
        for (int bj = 0; bj < 2; ++bj)
          *(u32x4*)(O + (size_t)row * ldo + u.pn * 256 + bj * 128 + wc * 32 + fq * 8) = pack8(acc[ai][bj][m][0] * rs, acc[ai][bj][m][1] * rs);
      }
  }
};

template <class Epi> __device__ __forceinline__ void run_gemm(LAS unsigned char* lds, const bf16_t* A, const bf16_t* Bt, int M, int N, int K, const Epi& E, const float* RSS = nullptr) {
  pg8::Gemm g{A, Bt, M, N, K}; pg8::StaticOrder S; S.init(M, N, gridDim.x, blockIdx.x);
  if (RSS) {
    LAS float* rsl = (LAS float*)(lds + 131072); const int tid = opaque_tid(); Unit u;
    for (int i = 0; S.next(i, u); ++i) if (tid < 256) rsl[i * 256 + tid] = row_rstd(RSS, u.pm * 256 + tid);
    __syncthreads();
  }
  pg8::gemm_phase<Epi, pg8::StaticOrder>(lds, g, S, E);
  __syncthreads();
}

__device__ void prep_tiles(const float* __restrict__ src, int ld, bf16_t* __restrict__ dst, int K, int Ndst, const float* __restrict__ gain, float scale,
                           int maptype, int mapbase, int& tbase, float* lt) {
  const int tid = opaque_tid(), G = gridDim.x;
  const int nkt = K >> 6, ntiles = (Ndst >> 6) * nkt;
  int start = (int)blockIdx.x - (tbase % G); if (start < 0) start += G;
  for (int t = start; t < ntiles; t += G) {
    const int nt = t / nkt, kt = t - nt * nkt, n0 = nt << 6, k0 = kt << 6;
    int sc0;
    if (maptype == 0) sc0 = mapbase + n0;
    else if (maptype == 1) { const int pn = n0 >> 8, h = (n0 >> 7) & 1, j = n0 & 127; sc0 = h * DFF + pn * 128 + j; }
    else { const int tt = n0 >> 8, c = n0 & 255, bj = c >> 7, cc = c & 127; sc0 = mapbase + (2 * tt + (cc >> 6)) * 128 + bj * 64 + (cc & 63); }
#pragma unroll
    for (int it = 0; it < 2; ++it) {
      const int idx = tid + it * 512, k = idx >> 4, n4 = idx & 15;
      const f32x4 v = *(const f32x4*)(src + (size_t)(k0 + k) * ld + sc0 + n4 * 4);
      const float g = scale * (gain ? gain[k0 + k] : 1.f);
      float* p = lt + k * 65 + n4 * 4; p[0] = v[0] * g; p[1] = v[1] * g; p[2] = v[2] * g; p[3] = v[3] * g;
    }
    __syncthreads();
    { const int n = tid >> 3, kc = (tid & 7) << 3; f32x4 a, b;
#pragma unroll
      for (int j = 0; j < 4; ++j) { a[j] = lt[(kc + j) * 65 + n]; b[j] = lt[(kc + 4 + j) * 65 + n]; }
      *(u32x4*)(dst + (size_t)(n0 + n) * K + k0 + kc) = pack8(a, b); }
    __syncthreads();
  }
  tbase += ntiles;
}
__device__ void prep_zfold(const float* __restrict__ wmix  , const float* __restrict__ gain, bf16_t* __restrict__ WM1, int& tbase, float* lt) {
  const int tid = opaque_tid(), G = gridDim.x;
  float* cosT = lt + 16 * 129; float* sinT = cosT + 128;
  int start = (int)blockIdx.x - (tbase % G); if (start < 0) start += G;
  for (int t = start; t < 256; t += G) {
    const int grp = t >> 6, k0 = (t & 63) << 4;
    { const int k = tid >> 5, c4 = tid & 31; const f32x4 v = *(const f32x4*)(wmix + (size_t)(k0 + k) * 5632 + grp * 128 + c4 * 4);
      float* p = lt + k * 129 + c4 * 4; p[0] = v[0]; p[1] = v[1]; p[2] = v[2]; p[3] = v[3]; }
    if (tid < 128) { cosT[tid] = __builtin_amdgcn_cosf((float)tid * (1.f / 128.f)); sinT[tid] = __builtin_amdgcn_sinf((float)tid * (1.f / 128.f)); }
    __syncthreads();
    { const int nl = tid >> 1, ri = nl >> 7, cc = nl & 127, kh = (tid & 1) << 3;
      float a0 = 0.f, a1 = 0.f, a2 = 0.f, a3 = 0.f, a4 = 0.f, a5 = 0.f, a6 = 0.f, a7 = 0.f;
      const float* lp = lt + kh * 129;
      for (int c = 0; c < 128; ++c) {
        const int idx = (c * cc) & 127; const float w = ri ? -sinT[idx] : cosT[idx];
        a0 += lp[c] * w; a1 += lp[129 + c] * w; a2 += lp[2 * 129 + c] * w; a3 += lp[3 * 129 + c] * w;
        a4 += lp[4 * 129 + c] * w; a5 += lp[5 * 129 + c] * w; a6 += lp[6 * 129 + c] * w; a7 += lp[7 * 129 + c] * w;
      }
      const float sc = 0.08838834764831845f; const float* gp = gain + k0 + kh;
      f32x4 o0 = {a0 * sc * gp[0], a1 * sc * gp[1], a2 * sc * gp[2], a3 * sc * gp[3]}, o1 = {a4 * sc * gp[4], a5 * sc * gp[5], a6 * sc * gp[6], a7 * sc * gp[7]};
      *(u32x4*)(WM1 + (size_t)(ri * 512 + grp * 128 + cc) * 1024 + k0 + kh) = pack8(o0, o1); }
    __syncthreads();
  }
  tbase += 256;
}

template <int STAGE>
__device__ void dft_item(const bf16_t* __restrict__ src, bf16_t* __restrict__ dst, const bf16_t* __restrict__ Ct, const bf16_t* __restrict__ St,
                         int N, int lgN, int rowbase, int j, int chblk, int S, int N1, int N2, LAS unsigned char* lds) {
  const int tid = opaque_tid(), w = tid >> 6, l = tid & 63;
  const int CB = 8192 >> lgN, stride = CB * 4 + 64;
  const int lgcpr = 11 - lgN, cpr = 1 << lgcpr;
#pragma unroll
  for (int it = 0; it < 4; ++it) {
    const int q = tid + it * 512, n = q >> lgcpr, cq = q & (cpr - 1), part = cq >> (lgcpr - 1), cc = cq & ((cpr >> 1) - 1);
    const int irow = STAGE == 1 ? rowbase + N2 * n + j : rowbase + j * N2 + n;
    const u32x4 v = *(const u32x4*)(src + (size_t)irow * 1024 + part * 512 + chblk * CB + cc * 8);
    *(LAS u32x4*)(lds + n * stride + (part * CB + cc * 8) * 2) = v;
  }
  __syncthreads();
  const int kts = N >> 5, kt = w & (kts - 1), chsub = w >> (lgN - 5);
  const int i16 = l & 15, q4 = i16 >> 2, p4 = i16 & 3, G1 = (l >> 4) & 1, h = l >> 5;
  const unsigned colre = (unsigned)(chsub * 32 + 16 * G1 + 4 * p4) * 2u, colim = colre + (unsigned)CB * 2u;
  const int kout = kt * 32 + (l & 31);
  f32x16 a0 = {}, a1 = {}, a2 = {};
  const int nks = N >> 4;
  bf16x8 Bc[8], Bs[8];
#pragma unroll
  for (int ks = 0; ks < 8; ++ks) if (ks < nks) { Bc[ks] = *(const bf16x8*)(Ct + kout * N + 16 * ks + 8 * h); Bs[ks] = *(const bf16x8*)(St + kout * N + 16 * ks + 8 * h); }
#pragma unroll
  for (int ks = 0; ks < 8; ++ks) if (ks < nks) {
    const unsigned rlo = (unsigned)(16 * ks + 8 * h + q4) * stride, rhi = rlo + 4u * stride;
    const bf16x8 Ar = tr_frag(lds, rlo + colre, rhi + colre), Ai = tr_frag(lds, rlo + colim, rhi + colim);
    a0 = mfma32(Ar, Bc[ks], a0); a0 = mfma32(Ai, Bs[ks], a0);
    if (STAGE == 1) { a1 = mfma32(Ai, Bc[ks], a1); a2 = mfma32(Ar, Bs[ks], a2); }
  }
  const int chb = chblk * CB + chsub * 32;
  if (STAGE == 1) {
    const int mm = (j * kout) & (S - 1); const float fr = (float)mm / (float)S;
    const float c = __builtin_amdgcn_cosf(fr), s = __builtin_amdgcn_sinf(fr);
    const size_t orow = (size_t)(rowbase + kout * N2 + j) * 1024;
    f32x16 re, im;
#pragma unroll
    for (int i = 0; i < 16; ++i) { const float yr = a0[i], yi = a1[i] - a2[i]; re[i] = yr * c + yi * s; im[i] = yi * c - yr * s; }
    store_tile16(dst + orow + chb, re, 1.f, h); store_tile16(dst + orow + 512 + chb, im, 1.f, h);
  } else {
    const size_t orow = (size_t)(rowbase + j + N1 * kout) * 512;
    store_tile16(dst + orow + chb, a0, 1.f, h);
  }
  __syncthreads();
}
template <int STAGE>
__device__ void dft_phase(const bf16_t* src, bf16_t* dst, const bf16_t* DT, LAS unsigned char* lds) {
  for (int it = blockIdx.x; it < 2048; it += gridDim.x) {
    if (it < 1024) dft_item<STAGE>(src, dst, DT + DT_C128, DT + DT_S128, 128, 7, 16384, it >> 3, it & 7, 16384, 128, 128, lds);
    else {
      const int r = it - 1024, b = r >> 7, rr = r & 127;
      if (STAGE == 1) dft_item<STAGE>(src, dst, DT + DT_C32, DT + DT_S32, 32, 5, b * 2048, rr >> 1, rr & 1, 2048, 32, 64, lds);
      else dft_item<STAGE>(src, dst, DT + DT_C64, DT + DT_S64, 64, 6, b * 2048, rr >> 2, rr & 3, 2048, 32, 64, lds);
    }
  }
}

__device__ void ret_state_item(const bf16_t* __restrict__ Kb, const bf16_t* __restrict__ Vb, bf16_t* __restrict__ STf, bf16_t* __restrict__ STb,
                               int cidx, int head, float lgf2, float lgb2, LAS unsigned char* lds) {
  const int tid = opaque_tid(), w = tid >> 6, l = tid & 63; const int row0 = cidx * 128;
  constexpr unsigned VS = 576, KS = 320, OKF = 73728, OKB = 114688;
#pragma unroll
  for (int it = 0; it < 8; ++it) { const int q = tid + it * 512, j = q >> 5, c = q & 31;
    *(LAS u32x4*)(lds + j * VS + c * 16) = *(const u32x4*)(Vb + (size_t)(row0 + j) * 1024 + head * 256 + c * 8); }
#pragma unroll
  for (int it = 0; it < 4; ++it) { const int q = tid + it * 512, j = q >> 4, c = q & 15;
    const u32x4 v = *(const u32x4*)(Kb + (size_t)(row0 + j) * 512 + head * 128 + c * 8);
    const float zf = __builtin_amdgcn_exp2f(lgf2 * (float)(127 - j)), zb = __builtin_amdgcn_exp2f(lgb2 * (float)j);
    u32x4 of, ob;
#pragma unroll
    for (int i = 0; i < 4; ++i) { const float a = bf_lo(v[i]), b = bf_hi(v[i]); of[i] = cvt_pk_bf16(a * zf, b * zf); ob[i] = cvt_pk_bf16(a * zb, b * zb); }
    *(LAS u32x4*)(lds + OKF + j * KS + c * 16) = of; *(LAS u32x4*)(lds + OKB + j * KS + c * 16) = ob; }
  __syncthreads();
  const int i16 = l & 15, q4 = i16 >> 2, p4 = i16 & 3, G1 = (l >> 4) & 1, h = l >> 5;
  const unsigned cofs = (unsigned)(16 * G1 + 4 * p4) * 2u;
  f32x16 af[4], ab[4];
#pragma unroll
  for (int i = 0; i < 4; ++i) { af[i] = (f32x16){}; ab[i] = (f32x16){}; }
  for (int ks = 0; ks < 8; ++ks) {
    const unsigned r = (unsigned)(16 * ks + 8 * h + q4);
    const bf16x8 Bv = tr_frag(lds, r * VS + w * 64 + cofs, (r + 4) * VS + w * 64 + cofs);
#pragma unroll
    for (int dt = 0; dt < 4; ++dt) {
      const bf16x8 Af = tr_frag(lds, OKF + r * KS + dt * 64 + cofs, OKF + (r + 4) * KS + dt * 64 + cofs);
      const bf16x8 Ab = tr_frag(lds, OKB + r * KS + dt * 64 + cofs, OKB + (r + 4) * KS + dt * 64 + cofs);
      af[dt] = mfma32(Af, Bv, af[dt]); ab[dt] = mfma32(Ab, Bv, ab[dt]);
    }
  }
  const size_t ob = ((size_t)(cidx * 4 + head) * 256 + w * 32 + (l & 31)) * 128;
#pragma unroll
  for (int dt = 0; dt < 4; ++dt) { store_tile16(STf + ob + dt * 32, af[dt], 1.f, h); store_tile16(STb + ob + dt * 32, ab[dt], 1.f, h); }
  __syncthreads();
}
__device__ void ret_scan_seq(bf16_t* __restrict__ ST, int c0, int nch, int sub  , float lg, bool bwd) {
  const float g = expf(lg * 128.f);
  bf16_t* base = ST + (size_t)c0 * 131072 + (size_t)sub * 2048 + opaque_tid() * 4;
  const long cstep = bwd ? -131072 : 131072;
  bf16_t* pc = base + (bwd ? (size_t)(nch - 1) * 131072 : 0);
  float s0 = 0.f, s1 = 0.f, s2 = 0.f, s3 = 0.f;
  u32x2 u[8], un[8];
#pragma unroll
  for (int i = 0; i < 8; ++i) u[i] = *(const u32x2*)(pc + i * cstep);
  for (int cb = 0; cb < nch; cb += 8) {
    const bool more = cb + 8 < nch;
    if (more) {
#pragma unroll
      for (int i = 0; i < 8; ++i) un[i] = *(const u32x2*)(pc + (8 + i) * cstep);
    }
#pragma unroll
    for (int i = 0; i < 8; ++i) {
      *(u32x2*)(pc + i * cstep) = pack4(s0, s1, s2, s3);
      s0 = g * s0 + bf_lo(u[i][0]); s1 = g * s1 + bf_hi(u[i][0]); s2 = g * s2 + bf_lo(u[i][1]); s3 = g * s3 + bf_hi(u[i][1]); }
    if (more) {
#pragma unroll
      for (int i = 0; i < 8; ++i) u[i] = un[i];
    }
    pc += 8 * cstep;
  }
}
__device__ void ret_out_item(const bf16_t* __restrict__ Qb, const bf16_t* __restrict__ Kb, bf16_t* Vb, const bf16_t* __restrict__ STf, const bf16_t* __restrict__ STb,
                             int cidx, int head, float lgf2, float lgb2, LAS unsigned char* lds) {
  const int tid = opaque_tid(), w = tid >> 6, l = tid & 63; const int row0 = cidx * 128;
  constexpr unsigned VS = 576, ORED = 73728, QS = 272, OQ = 74752, OK = 74752 + 34816;
#pragma unroll
  for (int it = 0; it < 8; ++it) { const int q = tid + it * 512, j = q >> 5, c = q & 31;
    *(LAS u32x4*)(lds + j * VS + c * 16) = *(const u32x4*)(Vb + (size_t)(row0 + j) * 1024 + head * 256 + c * 8); }
#pragma unroll
  for (int it = 0; it < 4; ++it) { const int q = tid + it * 512, j = q >> 4, c = q & 15;
    *(LAS u32x4*)(lds + OQ + j * QS + c * 16) = *(const u32x4*)(Qb + (size_t)(row0 + j) * 512 + head * 128 + c * 8);
    *(LAS u32x4*)(lds + OK + j * QS + c * 16) = *(const u32x4*)(Kb + (size_t)(row0 + j) * 512 + head * 128 + c * 8); }
  __syncthreads();
  const int ib = w & 3, eh = w >> 2, il = l & 31, h = l >> 5;
  const int i16 = l & 15, q4 = i16 >> 2, p4 = i16 & 3, G1 = (l >> 4) & 1;
  const int iloc = ib * 32 + il;
  bf16x8 qf[8];
#pragma unroll
  for (int ks = 0; ks < 8; ++ks) qf[ks] = *(const LAS bf16x8*)(lds + OQ + iloc * QS + (16 * ks + 8 * h) * 2);
  bf16x8 pf[4][2];
#pragma unroll
  for (int jt = 0; jt < 4; ++jt) {
    f32x16 a = {};
#pragma unroll
    for (int ks = 0; ks < 8; ++ks) a = mfma32(*(const LAS bf16x8*)(lds + OK + (jt * 32 + il) * QS + (16 * ks + 8 * h) * 2), qf[ks], a);
    u32x4 p0, p1;
#pragma unroll
    for (int r = 0; r < 16; r += 2) {
      float v[2];
#pragma unroll
      for (int e = 0; e < 2; ++e) { const int jl = jt * 32 + ((r + e) & 3) + 8 * ((r + e) >> 2) + 4 * h; const int dd = iloc - jl;
        const float dec = dd >= 0 ? __builtin_amdgcn_exp2f(lgf2 * (float)dd) : __builtin_amdgcn_exp2f(lgb2 * (float)(-dd)); v[e] = a[r + e] * dec; }
      const unsigned pk = cvt_pk_bf16(v[0], v[1]);
      if (r < 8) p0[r >> 1] = pk; else p1[(r - 8) >> 1] = pk;
    }
    pf[jt][0] = (bf16x8)p0; pf[jt][1] = (bf16x8)p1;
  }
  f32x16 acc[4];
#pragma unroll
  for (int i = 0; i < 4; ++i) acc[i] = (f32x16){};
  const unsigned cofs = (unsigned)(eh * 128 + 16 * G1 + 4 * p4) * 2u;
#pragma unroll
  for (int jt = 0; jt < 4; ++jt)
#pragma unroll
    for (int s = 0; s < 2; ++s) {
      const unsigned r = (unsigned)(jt * 32 + 16 * s + 4 * h + q4);
#pragma unroll
      for (int et = 0; et < 4; ++et) acc[et] = mfma32(tr_frag(lds, r * VS + et * 64 + cofs, (r + 8) * VS + et * 64 + cofs), pf[jt][s], acc[et]);
    }
#pragma unroll
  for (int dir = 0; dir < 2; ++dir) {
    const float xi = dir ? __builtin_amdgcn_exp2f(lgb2 * (float)(128 - iloc)) : __builtin_amdgcn_exp2f(lgf2 * (float)(iloc + 1));
    const bf16_t* sp = (dir ? STb : STf) + ((size_t)(cidx * 4 + head) * 256 + eh * 128 + il) * 128 + 8 * h;
#pragma unroll
    for (int kp = 0; kp < 4; ++kp) {
      bf16x8 sf[2][4];
#pragma unroll
      for (int k2 = 0; k2 < 2; ++k2)
#pragma unroll
        for (int et = 0; et < 4; ++et) sf[k2][et] = *(const bf16x8*)(sp + (size_t)et * 32 * 128 + 16 * (2 * kp + k2));
#pragma unroll
      for (int k2 = 0; k2 < 2; ++k2) {
        const bf16x8 sq = scale_frag(qf[2 * kp + k2], xi);
#pragma unroll
        for (int et = 0; et < 4; ++et) acc[et] = mfma32(sf[k2][et], sq, acc[et]);
      }
    }
  }
  float ss = 0.f;
#pragma unroll
  for (int et = 0; et < 4; ++et)
#pragma unroll
    for (int r = 0; r < 16; ++r) ss += acc[et][r] * acc[et][r];
  ss += __shfl_xor(ss, 32);
  LAS float* red = (LAS float*)(lds + ORED);
  if (h == 0) red[eh * 128 + iloc] = ss;
  __syncthreads();
  const float rn = rsqrtf((red[iloc] + red[128 + iloc]) * (1.f / 256.f) + 1e-6f);
  bf16_t* op = Vb + (size_t)(row0 + iloc) * 1024 + head * 256 + eh * 128;
#pragma unroll
  for (int et = 0; et < 4; ++et) store_tile16(op + et * 32, acc[et], rn, h);
  __syncthreads();
}

__device__ void attn_item(const bf16_t* __restrict__ QX, const bf16_t* __restrict__ KV, bf16_t* __restrict__ O, int tt, int head, LAS unsigned char* lds) {
  const int tid = opaque_tid(), w = tid >> 6, l = tid & 63; const int row0 = tt * 256; const int b = tt < 64 ? (tt >> 3) : 8; const int mrow0 = b * 256;
  constexpr unsigned KS = 528, VS = 576;
#pragma unroll 4
  for (int it = 0; it < 16; ++it) { const int q = tid + it * 512, m = q >> 5, c = q & 31;
    *(LAS u32x4*)(lds + m * KS + c * 16) = *(const u32x4*)(KV + (size_t)(mrow0 + m) * 2048 + head * 256 + c * 8); }
  __syncthreads();
  const int il = l & 31, h = l >> 5, i16 = l & 15, q4 = i16 >> 2, p4 = i16 & 3, G1 = (l >> 4) & 1;
  const int row = row0 + w * 32 + il;
  bf16x8 pf[8][2];
  float mxp = -3.0e38f, sum = 0.f;
  const bf16_t* qp = QX + (size_t)row * 1024 + head * 256 + 8 * h;
#pragma unroll
  for (int hf = 0; hf < 2; ++hf) {
    f32x16 sc[4];
#pragma unroll
    for (int i = 0; i < 4; ++i) sc[i] = (f32x16){};
#pragma unroll 4
    for (int ks = 0; ks < 16; ++ks) {
      const bf16x8 B = *(const bf16x8*)(qp + 16 * ks);
#pragma unroll
      for (int mt = 0; mt < 4; ++mt) sc[mt] = mfma32(*(const LAS bf16x8*)(lds + ((hf * 4 + mt) * 32 + il) * KS + (16 * ks + 8 * h) * 2), B, sc[mt]);
    }
    float mx = mxp;
#pragma unroll
    for (int mt = 0; mt < 4; ++mt)
#pragma unroll
      for (int r = 0; r < 16; ++r) mx = fmaxf(mx, sc[mt][r]);
    mx = fmaxf(mx, __shfl_xor(mx, 32));
    if (hf == 1) { const float f = __builtin_amdgcn_exp2f((mxp - mx) * 1.4426950408889634f); sum *= f;
#pragma unroll
      for (int mt = 0; mt < 4; ++mt) { pf[mt][0] = scale_frag(pf[mt][0], f); pf[mt][1] = scale_frag(pf[mt][1], f); } }
#pragma unroll
    for (int mt = 0; mt < 4; ++mt) {
      u32x4 p0, p1;
#pragma unroll
      for (int r = 0; r < 16; r += 2) {
        const float e0 = __builtin_amdgcn_exp2f((sc[mt][r] - mx) * 1.4426950408889634f), e1 = __builtin_amdgcn_exp2f((sc[mt][r + 1] - mx) * 1.4426950408889634f);
        sum += e0 + e1; const unsigned pk = cvt_pk_bf16(e0, e1);
        if (r < 8) p0[r >> 1] = pk; else p1[(r - 8) >> 1] = pk;
      }
      pf[hf * 4 + mt][0] = (bf16x8)p0; pf[hf * 4 + mt][1] = (bf16x8)p1;
    }
    mxp = mx;
  }
  sum += __shfl_xor(sum, 32);
  const float inv = __builtin_amdgcn_rcpf(sum);
  __builtin_amdgcn_sched_barrier(0);
  __syncthreads();
  __builtin_amdgcn_sched_barrier(0);
#pragma unroll 4
  for (int it = 0; it < 16; ++it) { const int q = tid + it * 512, m = q >> 5, c = q & 31;
    *(LAS u32x4*)(lds + m * VS + c * 16) = *(const u32x4*)(KV + (size_t)(mrow0 + m) * 2048 + 1024 + head * 256 + c * 8); }
  __syncthreads();
  __builtin_amdgcn_sched_barrier(0);
#pragma unroll 1
  for (int half = 0; half < 2; ++half) {
    f32x16 acc[4];
#pragma unroll
    for (int i = 0; i < 4; ++i) acc[i] = (f32x16){};
    const unsigned cofs = (unsigned)(half * 128 + 16 * G1 + 4 * p4) * 2u;
#pragma unroll
    for (int mt = 0; mt < 8; ++mt)
#pragma unroll
      for (int s = 0; s < 2; ++s) {
        const unsigned r = (unsigned)(mt * 32 + 16 * s + 4 * h + q4);
#pragma unroll
        for (int et = 0; et < 4; ++et) acc[et] = mfma32(tr_frag(lds, r * VS + et * 64 + cofs, (r + 8) * VS + et * 64 + cofs), pf[mt][s], acc[et]);
      }
    bf16_t* op = O + (size_t)row * 1024 + head * 256 + half * 128;
#pragma unroll
    for (int et = 0; et < 4; ++et) store_tile16(op + et * 32, acc[et], inv, h);
  }
  __syncthreads();
}

__device__ __forceinline__ float sel4(const float (&a)[4], int i) { return i == 0 ? a[0] : i == 1 ? a[1] : i == 2 ? a[2] : a[3]; }


#define XB_TMO      128
#define XB_XCNT(j)  (256  + 64 * (j))
#define XB_XSUB(j)  (1280 + 64 * (j))
#define XB_XGEN(j)  (2304 + 64 * (j))
#define XB_TOP      3328
#define XB_TOPGEN   3392
#define XCD_BAR_WORDS 3456
#define XB_SPIN_CAP (1u << 20)
__device__ __forceinline__ unsigned xb_ld(unsigned* p)              { return __hip_atomic_load(p, __ATOMIC_RELAXED, __HIP_MEMORY_SCOPE_AGENT); }
__device__ __forceinline__ unsigned xb_add(unsigned* p, unsigned v) { return __hip_atomic_fetch_add(p, v, __ATOMIC_RELAXED, __HIP_MEMORY_SCOPE_AGENT); }
__device__ __forceinline__ unsigned xb_xcc_id() { return (unsigned)__builtin_amdgcn_s_getreg((3 << 11) | 20) & 0xFu; }
#define XB_SPIN(cond, bar) do { unsigned _sp = 0; while (cond) { __builtin_amdgcn_s_sleep(1); \
    if ((++_sp & 255u) == 0u) { if (xb_ld(&(bar)[XB_TMO])) break; if (_sp > XB_SPIN_CAP) { atomicAdd(&(bar)[XB_TMO], 1u); break; } } } } while (0)
struct XcdBarrier { unsigned* bar; unsigned x; volatile LAS unsigned* st; };
__device__ __forceinline__ XcdBarrier xcd_barrier_post(unsigned* bar, volatile LAS unsigned* st) {
  XcdBarrier b; b.bar = bar; b.x = xb_xcc_id(); b.st = st;
  if (threadIdx.x == 0) (void)xb_add(&bar[XB_XCNT(b.x)], 1u);
  return b;
}
__device__ __forceinline__ void xcd_barrier_complete(unsigned* bar, unsigned x, unsigned& nloc, unsigned& nx) {
  const unsigned G = gridDim.x * gridDim.y * gridDim.z;
  unsigned sum, cnt, mine, sp = 0u;
  for (;;) {
    sum = 0u; cnt = 0u; mine = 0u;
#pragma unroll
    for (unsigned j = 0; j < 16; ++j) { const unsigned c = xb_ld(&bar[XB_XCNT(j)]); sum += c; cnt += (c > 0u) ? 1u : 0u; mine = (j == x) ? c : mine; }
    if (sum == G) break;
    __builtin_amdgcn_s_sleep(1);
    if ((++sp & 255u) == 0u) { if (xb_ld(&bar[XB_TMO])) break; if (sp > XB_SPIN_CAP) { atomicAdd(&bar[XB_TMO], 1u); break; } }
  }
  nloc = mine > 0u ? mine : 1u; nx = cnt > 0u ? cnt : 1u;
}
__device__ __forceinline__ void xcd_barrier(const XcdBarrier& b) {
  asm volatile("s_waitcnt vmcnt(0)" ::: "memory");
  __syncthreads();
  if (opaque_tid() == 0) {
    unsigned* bar = b.bar;
    __builtin_amdgcn_s_waitcnt(0);
    unsigned nloc = b.st[0], nx = b.st[1];
    if (nloc == 0u) { xcd_barrier_complete(bar, b.x, nloc, nx); b.st[0] = nloc; b.st[1] = nx; }
    const unsigned old = xb_add(&bar[XB_XSUB(b.x)], 1u);
    const unsigned gen = old / nloc;
    if (old + 1u == (gen + 1u) * nloc) {
      __builtin_amdgcn_fence(__ATOMIC_RELEASE, "agent");
      asm volatile("s_waitcnt vmcnt(0)" ::: "memory");
      const unsigned og = xb_add(&bar[XB_TOP], 1u);
      const unsigned tg = og / nx;
      if (og + 1u == (tg + 1u) * nx) xb_add(&bar[XB_TOPGEN], 1u);
      else XB_SPIN(xb_ld(&bar[XB_TOPGEN]) == tg, bar);
      __builtin_amdgcn_fence(__ATOMIC_ACQUIRE, "agent");
      xb_add(&bar[XB_XGEN(b.x)], 1u);
      asm volatile("s_waitcnt vmcnt(0)" ::: "memory");
    } else {
      XB_SPIN(xb_ld(&bar[XB_XGEN(b.x)]) == gen, bar);
      __builtin_amdgcn_fence(__ATOMIC_ACQUIRE, "agent");
      asm volatile("s_waitcnt vmcnt(0)" ::: "memory");
    }
  }
  __syncthreads();
}

__global__ void __launch_bounds__(512, 2) mega(Params p) {
  cg::grid_group grid = cg::this_grid();
  extern __shared__ __attribute__((aligned(16))) unsigned char smem_raw[];
  LAS unsigned char* lds = (LAS unsigned char*)smem_raw;
  float* ltf = (float*)smem_raw;
  const int tid = opaque_tid(), G = gridDim.x, wv = tid >> 6, lane = tid & 63;
  unsigned char* ws = p.ws;
  float2* TAB = (float2*)(ws + OFF_TAB); bf16_t* DT = (bf16_t*)(ws + OFF_DFT); bf16_t* MEMB = (bf16_t*)(ws + OFF_MEMB);
  float* RSS = (float*)(ws + OFF_RSS); bf16_t* XB = (bf16_t*)(ws + OFF_XB); bf16_t* WB = (bf16_t*)(ws + OFF_WB);
  bf16_t* RA = (bf16_t*)(ws + OFF_A); bf16_t* RS = (bf16_t*)(ws + OFF_S); bf16_t* RB = (bf16_t*)(ws + OFF_B);
  bf16_t* Zb = RA; bf16_t* Y1 = RA + 32 * MiB; bf16_t* GATES = RA; bf16_t* HID = RA; bf16_t* QX = RA; bf16_t* Ob = RA + 32 * MiB;
  bf16_t* STf = RS; bf16_t* STb = RS + 32 * MiB;
  bf16_t* Qb = RB; bf16_t* Kb = RB + 16 * MiB; bf16_t* Vb = RB + 32 * MiB; bf16_t* Fb = RB + 64 * MiB; bf16_t* Ub = RB; bf16_t* KVb = RB + 32 * MiB;
  float* X = p.X;
  bf16_t* XL = (bf16_t*)p.X;
  const LAS float* RSL = (const LAS float*)(lds + 131072);
  volatile LAS unsigned* xst = (volatile LAS unsigned*)(lds + 163824);
  if (threadIdx.x < 4) xst[threadIdx.x] = 0u;
  __syncthreads();
  const XcdBarrier xb = xcd_barrier_post((unsigned*)(ws + WS_NEED), xst);

  if (p.ws == nullptr) grid.sync();
  for (int r = blockIdx.x * 8 + wv; r < T_TOK; r += G * 8) {
    const float* src = r < 16384 ? p.in[0] + (size_t)r * DM : p.in[1] + (size_t)(r - 16384) * DM;
    float ss = 0.f;
#pragma unroll
    for (int k = 0; k < 4; ++k) { const f32x4 v = *(const f32x4*)(src + k * 256 + lane * 4);
      const u32x2 hi = pack4(v[0], v[1], v[2], v[3]);
      *(u32x2*)(XB + (size_t)r * DM + k * 256 + lane * 4) = hi;
      *(u32x2*)(XL + (size_t)r * DM + k * 256 + lane * 4) = pack4(v[0] - bf_lo(hi[0]), v[1] - bf_hi(hi[0]), v[2] - bf_lo(hi[1]), v[3] - bf_hi(hi[1]));
      ss += v[0] * v[0] + v[1] * v[1] + v[2] * v[2] + v[3] * v[3]; }
#pragma unroll
    for (int o = 32; o; o >>= 1) ss += __shfl_xor(ss, o);
    if (lane < 16) RSS[(size_t)r * 16 + lane] = lane == 0 ? ss : 0.f;
  }
  for (int r = blockIdx.x * 8 + wv; r < NMEMROWS; r += G * 8) {
    const float* src = r < 2048 ? p.in[2] + (size_t)r * DM : p.in[3] + (size_t)(r - 2048) * DM;
    f32x4 v0 = *(const f32x4*)(src + lane * 4), v1 = *(const f32x4*)(src + 256 + lane * 4), v2 = *(const f32x4*)(src + 512 + lane * 4), v3 = *(const f32x4*)(src + 768 + lane * 4);
    float ss = 0.f;
#pragma unroll
    for (int i = 0; i < 4; ++i) ss += v0[i] * v0[i] + v1[i] * v1[i] + v2[i] * v2[i] + v3[i] * v3[i];
#pragma unroll
    for (int o = 32; o; o >>= 1) ss += __shfl_xor(ss, o);
    const float rs = rsqrtf(ss * (1.f / 1024.f) + 1e-6f);
    bf16_t* mp = MEMB + (size_t)r * DM + lane * 4;
    *(u32x2*)(mp) = pack4(v0[0] * rs, v0[1] * rs, v0[2] * rs, v0[3] * rs); *(u32x2*)(mp + 256) = pack4(v1[0] * rs, v1[1] * rs, v1[2] * rs, v1[3] * rs);
    *(u32x2*)(mp + 512) = pack4(v2[0] * rs, v2[1] * rs, v2[2] * rs, v2[3] * rs); *(u32x2*)(mp + 768) = pack4(v3[0] * rs, v3[1] * rs, v3[2] * rs, v3[3] * rs);
  }
  for (int i = blockIdx.x * 512 + tid; i < 16384 * 64; i += G * 512) {
    const int s = i >> 6, d = i & 63;
    const float e = (float)d * 2.0f / 128.0f; const float inv = 1.0f / powf(10000.0f, e); const float ang = (float)s * inv;
    const double a = (double)ang * 0.15915494309189535; const double fr = a - rint(a);
    const float f = (float)fr;
    TAB[i] = make_float2(__builtin_amdgcn_cosf(f), __builtin_amdgcn_sinf(f));
  }
  for (int i = blockIdx.x * 512 + tid; i < 16384 + 4096 + 1024; i += G * 512) {
    int N, k, n, oc, os;
    if (i < 16384) { N = 128; k = i >> 7; n = i & 127; oc = DT_C128 + i; os = DT_S128 + i; }
    else if (i < 20480) { const int q = i - 16384; N = 64; k = q >> 6; n = q & 63; oc = DT_C64 + q; os = DT_S64 + q; }
    else { const int q = i - 20480; N = 32; k = q >> 5; n = q & 31; oc = DT_C32 + q; os = DT_S32 + q; }
    const float fr = (float)((k * n) & (N - 1)) / (float)N; const float sc = rsqrtf((float)N);
    const unsigned pk = cvt_pk_bf16(__builtin_amdgcn_cosf(fr) * sc, __builtin_amdgcn_sinf(fr) * sc);
    DT[oc] = (bf16_t)(pk & 0xffffu); DT[os] = (bf16_t)(pk >> 16);
  }

  for (int layer = 0; layer < 4; ++layer) {
    {
      int tb = 0;
      const float* g1 = p.in[4] + layer * DM; const float* gm = p.in[7] + layer * DM; const float* gx = p.in[14] + layer * DM;
      const float* gmem = p.in[15] + layer * DM; const float* g2 = p.in[19] + layer * DM;
      const float* wmix = p.in[8] + (size_t)layer * 1024 * 5632;
      prep_tiles(p.in[5] + (size_t)layer * 1024 * 5632, 5632, WB + W_1I, 1024, 5632, g1, 1.f, 1, 0, tb, ltf);
      prep_tiles(p.in[6] + (size_t)layer * DFF * 1024, 1024, WB + W_1O, DFF, 1024, nullptr, 1.f, 0, 0, tb, ltf);
      prep_zfold(wmix, gm, WB + W_M1, tb, ltf);
      prep_tiles(wmix, 5632, WB + W_M1 + (size_t)1024 * 1024, 1024, 512, gm, 1.f, 2, 512, tb, ltf);
      prep_tiles(wmix, 5632, WB + W_M1 + (size_t)1536 * 1024, 1024, 512, gm, 0.08838834764831845f, 2, 1024, tb, ltf);
      prep_tiles(wmix, 5632, WB + W_M1 + (size_t)2048 * 1024, 1024, 1024, gm, 1.f, 0, 1536, tb, ltf);
      prep_tiles(wmix, 5632, WB + W_M2, 1024, 3072, gm, 1.f, 0, 2560, tb, ltf);
      prep_tiles(p.in[9] + (size_t)layer * 512 * 1024, 1024, WB + W_F, 512, 1024, nullptr, 1.f, 0, 0, tb, ltf);
      prep_tiles(p.in[12] + (size_t)layer * 1024 * 1024, 1024, WB + W_R, 1024, 1024, nullptr, 1.f, 0, 0, tb, ltf);
      prep_tiles(p.in[13] + (size_t)layer * 1024 * 1024, 1024, WB + W_MO, 1024, 1024, nullptr, 1.f, 0, 0, tb, ltf);
      prep_tiles(p.in[16] + (size_t)layer * 1024 * 1024, 1024, WB + W_Q, 1024, 1024, gx, 1.f, 0, 0, tb, ltf);
      prep_tiles(p.in[17] + (size_t)layer * 1024 * 2048, 2048, WB + W_KV, 1024, 2048, gmem, 1.f, 0, 0, tb, ltf);
      prep_tiles(p.in[18] + (size_t)layer * 1024 * 1024, 1024, WB + W_O, 1024, 1024, nullptr, 1.f, 0, 0, tb, ltf);
      prep_tiles(p.in[20] + (size_t)layer * 1024 * 5632, 5632, WB + W_2I, 1024, 5632, g2, 1.f, 1, 0, tb, ltf);
      prep_tiles(p.in[21] + (size_t)layer * DFF * 1024, 1024, WB + W_2O, DFF, 1024, nullptr, 1.f, 0, 0, tb, ltf);
    }
    xcd_barrier(xb);
    run_gemm(lds, XB, WB + W_1I, T_TOK, 5632, 1024, EpiFfnIn{RSL, HID}, RSS);
    xcd_barrier(xb);
    run_gemm(lds, HID, WB + W_1O, T_TOK, 1024, DFF, EpiRes{XB, XL, XL, RSS, 0.5f});
    xcd_barrier(xb);
    run_gemm(lds, XB, WB + W_M1, T_TOK, 3072, 1024, EpiM1{RSL, TAB, Zb, Qb, Kb, Vb}, RSS);
    xcd_barrier(xb);
    float lgf2[4], lgb2[4], lgf[4], lgb[4];
#pragma unroll
    for (int hh = 0; hh < 4; ++hh) { lgf[hh] = log_sigmoid(p.in[10][layer * 4 + hh]); lgb[hh] = log_sigmoid(p.in[11][layer * 4 + hh]);
      lgf2[hh] = lgf[hh] * 1.4426950408889634f; lgb2[hh] = lgb[hh] * 1.4426950408889634f; }
    dft_phase<1>(Zb, Y1, DT, lds);
    for (int it = blockIdx.x; it < 1024; it += G) { const int hh = it & 3; ret_state_item(Kb, Vb, STf, STb, it >> 2, hh, sel4(lgf2, hh), sel4(lgb2, hh), lds); }
    xcd_barrier(xb);
    dft_phase<2>(Y1, Fb, DT, lds);
    for (int it = blockIdx.x; it < 256; it += G) {
      if (it < 128) { const int dir = it >> 6, sub = it & 63, hh = sub >> 4; ret_scan_seq(dir ? STb : STf, 128, 128, sub, dir ? sel4(lgb, hh) : sel4(lgf, hh), dir); }
      else for (int k = 0; k < 8; ++k) { const int r = (it - 128) * 8 + k, b = r >> 7, dir = (r >> 6) & 1, sub = r & 63, hh = sub >> 4;
        ret_scan_seq(dir ? STb : STf, b * 16, 16, sub, dir ? sel4(lgb, hh) : sel4(lgf, hh), dir); }
    }
    xcd_barrier(xb);
    for (int it = blockIdx.x; it < 1024; it += G) { const int hh = it & 3; ret_out_item(Qb, Kb, Vb, STf, STb, it >> 2, hh, sel4(lgf2, hh), sel4(lgb2, hh), lds); }
    xcd_barrier(xb);
    run_gemm(lds, XB, WB + W_M2, T_TOK, 3072, 1024, EpiM2{RSL, Vb, GATES}, RSS);
    xcd_barrier(xb);
    run_gemm(lds, Fb, WB + W_F, T_TOK, 1024, 512, EpiComb<0>{GATES, Ub});
    run_gemm(lds, Vb, WB + W_R, T_TOK, 1024, 1024, EpiComb<1>{GATES, Ub});
    xcd_barrier(xb);
    run_gemm(lds, Ub, WB + W_MO, T_TOK, 1024, 1024, EpiRes{XB, XL, XL, RSS, 1.0f});
    run_gemm(lds, MEMB, WB + W_KV, NMEMROWS, 2048, 1024, EpiPlain<false>{RSL, KVb, 2048, 1.0f});
    xcd_barrier(xb);
    run_gemm(lds, XB, WB + W_Q, T_TOK, 1024, 1024, EpiPlain<true>{RSL, QX, 1024, 0.0625f}, RSS);
    { pg8::StaticOrder S; S.init(T_TOK, 1024, G, blockIdx.x); Unit u; for (int i = 0; S.next(i, u); ++i) attn_item(QX, KVb, Ob, u.pm, u.pn, lds); }
    xcd_barrier(xb);
    run_gemm(lds, Ob, WB + W_O, T_TOK, 1024, 1024, EpiRes{XB, XL, XL, RSS, 1.0f});
    xcd_barrier(xb);
    run_gemm(lds, XB, WB + W_2I, T_TOK, 5632, 1024, EpiFfnIn{RSL, HID}, RSS);
    xcd_barrier(xb);
    run_gemm(lds, HID, WB + W_2O, T_TOK, 1024, DFF, EpiRes{XB, XL, layer == 3 ? RB : XL, RSS, 0.5f});
    xcd_barrier(xb);
  }
  const int tidf = opaque_tid(), wvf = tidf >> 6, lanef = tidf & 63;
  for (int r = blockIdx.x * 8 + wvf; r < T_TOK; r += G * 8) {
    const float rs = row_rstd(RSS, r);
#pragma unroll
    for (int k = 0; k < 4; ++k) { const size_t o = (size_t)r * DM + k * 256 + lanef * 4; const f32x4 g = *(const f32x4*)(p.in[22] + k * 256 + lanef * 4);
      const u32x2 hi = *(const u32x2*)(XB + o), lo = *(const u32x2*)(RB + o);
      f32x4 v = {bf_lo(hi[0]) + bf_lo(lo[0]), bf_hi(hi[0]) + bf_hi(lo[0]), bf_lo(hi[1]) + bf_lo(lo[1]), bf_hi(hi[1]) + bf_hi(lo[1])};
      *(f32x4*)(X + o) = v * rs * g; }
  }
}

extern "C" void kernel_launch(void* const* d_in, const int* in_sizes, int n_in, void* d_out, int out_size, void* d_ws, size_t ws_size, hipStream_t stream) {
  constexpr size_t kDynLds = 163840;
  static int grid_blocks = 0;
  if (!grid_blocks) {
    (void)hipFuncSetAttribute((const void*)mega, hipFuncAttributeMaxDynamicSharedMemorySize, (int)kDynLds);
    int dev = 0, cus = 0, per_cu = 0;
    (void)hipGetDevice(&dev);
    (void)hipDeviceGetAttribute(&cus, hipDeviceAttributeMultiprocessorCount, dev);
    (void)hipOccupancyMaxActiveBlocksPerMultiprocessor(&per_cu, mega, 512, kDynLds);
    grid_blocks = cus > 0 ? cus : 256;
    if (per_cu < 1) fprintf(stderr, "occupancy query returned %d\n", per_cu);
  }
  if (ws_size < WS_NEED + 16384) { fprintf(stderr, "workspace too small: %zu < %zu\n", ws_size, (size_t)WS_NEED); return; }
  (void)hipMemsetAsync((unsigned char*)d_ws + WS_NEED, 0, XCD_BAR_WORDS * 4, stream);
  Params p{};
  for (int i = 0; i < 23; ++i) p.in[i] = (const float*)d_in[i];
  p.X = (float*)d_out; p.ws = (unsigned char*)d_ws;
  void* args[] = {&p};
  hipError_t e = hipLaunchCooperativeKernel((void*)mega, dim3(grid_blocks), dim3(512), args, kDynLds, stream);
  if (e != hipSuccess) fprintf(stderr, "cooperative launch failed: %s (grid %d)\n", hipGetErrorString(e), grid_blocks);
}
```

```cpp
#include <hip/hip_runtime.h>
#include <hip/hip_cooperative_groups.h>
#include <cstdio>
namespace cg = cooperative_groups;

#define LAS __attribute__((address_space(3)))
typedef unsigned short bf16_t;
typedef short bf16x8 __attribute__((ext_vector_type(8)));
typedef short s16x4 __attribute__((ext_vector_type(4)));
typedef float f32x4 __attribute__((ext_vector_type(4)));
typedef float f32x16 __attribute__((ext_vector_type(16)));
typedef unsigned u32x4 __attribute__((ext_vector_type(4)));
typedef unsigned u32x2 __attribute__((ext_vector_type(2)));

constexpr int T_TOK = 32768, DM = 1024, DFF = 2816, NMEMROWS = 2304;
constexpr size_t MiB = 1048576;
constexpr size_t OFF_TAB = 0;
constexpr size_t OFF_DFT = 8 * MiB;
constexpr size_t OFF_MEMB = OFF_DFT + 256 * 1024;
constexpr size_t OFF_RSS = OFF_MEMB + 4718592;
constexpr size_t OFF_XB = OFF_RSS + 2 * MiB;
constexpr size_t OFF_WB = OFF_XB + 64 * MiB;
constexpr size_t OFF_A = OFF_WB + 58 * MiB;
constexpr size_t OFF_S = OFF_A + 128 * MiB;
constexpr size_t OFF_B = OFF_S + 128 * MiB;
constexpr size_t WS_NEED = OFF_B + 160 * MiB;
constexpr size_t W_1I = 0, W_1O = 5767168, W_M1 = 8650752, W_M2 = 11796480, W_F = 14942208, W_R = 15466496, W_MO = 16515072,
                 W_Q = 17563648, W_KV = 18612224, W_O = 20709376, W_2I = 21757952, W_2O = 27525120;
constexpr int DT_C128 = 0, DT_S128 = 16384, DT_C64 = 32768, DT_S64 = 36864, DT_C32 = 40960, DT_S32 = 41984;

struct Params {
  const float* in[23];
  float* X;
  unsigned char* ws;
};

__device__ __forceinline__ int opaque_tid() { int t = threadIdx.x; asm volatile("" : "+v"(t)); return t; }
typedef __bf16 bf16x2_t __attribute__((ext_vector_type(2)));
typedef float f32x2 __attribute__((ext_vector_type(2)));
__device__ __forceinline__ unsigned cvt_pk_bf16(float lo, float hi) { f32x2 v = {lo, hi}; bf16x2_t b = __builtin_convertvector(v, bf16x2_t); return __builtin_bit_cast(unsigned, b); }
__device__ __forceinline__ float bf_lo(unsigned u) { return __uint_as_float(u << 16); }
__device__ __forceinline__ float bf_hi(unsigned u) { return __uint_as_float(u & 0xffff0000u); }
__device__ __forceinline__ u32x4 pack8(f32x4 a, f32x4 b) { u32x4 o; o[0] = cvt_pk_bf16(a[0], a[1]); o[1] = cvt_pk_bf16(a[2], a[3]); o[2] = cvt_pk_bf16(b[0], b[1]); o[3] = cvt_pk_bf16(b[2], b[3]); return o; }
__device__ __forceinline__ u32x2 pack4(float a, float b, float c, float d) { u32x2 o; o[0] = cvt_pk_bf16(a, b); o[1] = cvt_pk_bf16(c, d); return o; }
__device__ __forceinline__ unsigned pack_u8x4(float a, float b, float c, float d) {
  return (unsigned)(a * 255.f + 0.5f) | ((unsigned)(b * 255.f + 0.5f) << 8) | ((unsigned)(c * 255.f + 0.5f) << 16) | ((unsigned)(d * 255.f + 0.5f) << 24); }
__device__ __forceinline__ float u8f(unsigned w, int k) { return (float)((w >> (8 * k)) & 0xffu) * (1.f / 255.f); }
__device__ __forceinline__ float fsigmoid(float x) { return __builtin_amdgcn_rcpf(1.f + __expf(-x)); }
__device__ __forceinline__ float fsilu(float x) { return x * fsigmoid(x); }
__device__ __forceinline__ f32x4 swiglu4(f32x4 g, f32x4 u, float c1  , float rs2  ) {
  f32x4 t = g * c1, d, r;
#pragma unroll
  for (int i = 0; i < 4; ++i) d[i] = __builtin_amdgcn_exp2f(t[i]);
  d = d + 1.0f;
#pragma unroll
  for (int i = 0; i < 4; ++i) r[i] = __builtin_amdgcn_rcpf(d[i]);
  return (g * u) * (r * rs2);
}
__device__ __forceinline__ f32x4 sigmoid4(f32x4 a, float c1) {
  f32x4 t = a * c1, d, r;
#pragma unroll
  for (int i = 0; i < 4; ++i) d[i] = __builtin_amdgcn_exp2f(t[i]);
  d = d + 1.0f;
#pragma unroll
  for (int i = 0; i < 4; ++i) r[i] = __builtin_amdgcn_rcpf(d[i]);
  return r;
}
__device__ __forceinline__ float row_rstd(const float* RSS, int row) {
  const f32x4* p = (const f32x4*)(RSS + (size_t)row * 16); f32x4 a = p[0], b = p[1], c = p[2], d = p[3];
  float s = ((a[0] + a[1]) + (a[2] + a[3])) + ((b[0] + b[1]) + (b[2] + b[3])) + ((c[0] + c[1]) + (c[2] + c[3])) + ((d[0] + d[1]) + (d[2] + d[3]));
  return rsqrtf(s * (1.f / 1024.f) + 1e-6f);
}
__device__ __forceinline__ bf16x8 tr_frag(const LAS unsigned char* lds, unsigned off_lo, unsigned off_hi) {
  s16x4 a = __builtin_amdgcn_ds_read_tr16_b64_v4i16((LAS s16x4*)(lds + off_lo));
  s16x4 b = __builtin_amdgcn_ds_read_tr16_b64_v4i16((LAS s16x4*)(lds + off_hi));
  return __builtin_shufflevector(a, b, 0, 1, 2, 3, 4, 5, 6, 7);
}
__device__ __forceinline__ void store_tile16(bf16_t* p, const f32x16& a, float sc, int h) {
#pragma unroll
  for (int gp = 0; gp < 2; ++gp) {
    u32x2 A = pack4(a[8 * gp] * sc, a[8 * gp + 1] * sc, a[8 * gp + 2] * sc, a[8 * gp + 3] * sc), B = pack4(a[8 * gp + 4] * sc, a[8 * gp + 5] * sc, a[8 * gp + 6] * sc, a[8 * gp + 7] * sc);
    const auto r0 = __builtin_amdgcn_permlane32_swap(A[0], B[0], false, false), r1 = __builtin_amdgcn_permlane32_swap(A[1], B[1], false, false);
    u32x4 o = {r0[0], r1[0], r0[1], r1[1]};
    *(u32x4*)(p + 16 * gp + 8 * h) = o;
  }
}
__device__ __forceinline__ f32x16 mfma32(bf16x8 a, bf16x8 b, f32x16 c) { return __builtin_amdgcn_mfma_f32_32x32x16_bf16(a, b, c, 0, 0, 0); }
__device__ __forceinline__ float log_sigmoid(float x) { return fminf(x, 0.f) - log1pf(expf(-fabsf(x))); }
__device__ __forceinline__ bf16x8 scale_frag(bf16x8 q, float s) {
  u32x4 u = (u32x4)q; u32x4 o;
#pragma unroll
  for (int i = 0; i < 4; ++i) o[i] = cvt_pk_bf16(bf_lo(u[i]) * s, bf_hi(u[i]) * s);
  return (bf16x8)o;
}

namespace pg8 {
constexpr int BM = 256, BK = 64, HALF = 128, HTB = HALF * BK * 2, STAGE_BYTES = 8 * HTB, NXCD = 8, WGM = 8;
__device__ __forceinline__ int lds_byte(int r, int c) { const int st = (r >> 4) * 2 + (c >> 5), rr = r & 15, cc = c & 31, ob = rr * 64 + cc * 2; return st * 1024 + (ob ^ (((ob >> 9) & 1) << 5)); }
__device__ __forceinline__ void stage_rc(int b, int& R, int& C) { const int st = b / 1024, sb = b % 1024, swz = sb ^ (((sb >> 9) & 1) << 5); R = (st >> 1) * 16 + swz / 64; C = (st & 1) * 32 + (swz % 64) / 2; }
__device__ __forceinline__ int perm32(int rho) { const int n = rho >> 4, i = rho & 15; return 8 * (i >> 2) + 4 * n + (i & 3); }
struct Unit { int pm, pn; };
struct Gemm { const bf16_t* A; const bf16_t* Bt; int M, N, K; };
struct StaticOrder {
  int nM, nN, nwg, G, c;
  __device__ void init(int M, int N, int G_, int c_) { nM = M / BM; nN = N / BM; nwg = nM * nN; G = G_; c = c_; }
  __device__ bool next(int i, Unit& u) const {
    const long L = (long)i * G + c; if (L >= nwg) return false;
    int wgid = (int)L; { const int q = nwg / NXCD, r = nwg % NXCD, xcd = wgid % NXCD, off = wgid / NXCD; wgid = (xcd < r ? xcd * (q + 1) : r * (q + 1) + (xcd - r) * q) + off; }
    const int nig = WGM * nN, gid = wgid / nig, fm = gid * WGM, gsz = (nM - fm) < WGM ? (nM - fm) : WGM;
    u.pm = fm + ((wgid % nig) % gsz); u.pn = (wgid % nig) / gsz; return true;
  }
  __device__ __forceinline__ void a_ready(const Unit&) const {}
  __device__ __forceinline__ void done(const Unit&) const {}
};

template <class Epi, class Sched>
__device__ __forceinline__ void gemm_phase(LAS unsigned char* lds, const Gemm g, const Sched& S, const Epi& E) {
  const int tid = opaque_tid(), wid = __builtin_amdgcn_readfirstlane(tid >> 6), lane = tid & 63, wr = wid >> 2, wc = wid & 3, fr = lane & 15, fq = lane >> 4;
  const int K = g.K, nt = K / BK;
  unsigned voffA[2], voffB[2];
#pragma unroll
  for (int i = 0; i < 2; ++i) { int R, C; stage_rc(tid * 16 + i * 8192, R, C); const int Rb = Epi::PERM ? ((R & ~31) + perm32(R & 31)) : R;
    voffA[i] = (unsigned)(R * K + C) * 2u; voffB[i] = (unsigned)(Rb * K + C) * 2u; }
  const size_t kstep = (size_t)(BK * 2);
  const size_t hstep = (size_t)HALF * K * 2;
  const size_t tstep = 2 * hstep;
  const unsigned ldsw = (unsigned)wid * 1024u;
  const int aoff = lds_byte(wr * 64 + fr, fq * 8), boff = lds_byte(wc * 32 + fr, fq * 8);
#define PG8_SA(b, h) (((b) * 2 + (h)) * HTB)
#define PG8_SB(b, h) ((4 + (b) * 2 + (h)) * HTB)
#define PG8_STAGE(bufoff, gbase, voff) do { _Pragma("unroll") for (int _i = 0; _i < 2; ++_i) \
    __builtin_amdgcn_global_load_lds((const unsigned*)((const char*)(gbase) + (voff)[_i]), (LAS unsigned*)(lds + (bufoff) + ldsw + _i * 8192), 16, 0, 0); } while (0)
#define PG8_LDA(dst, b, h) do { _Pragma("unroll") for (int m = 0; m < 4; ++m) _Pragma("unroll") for (int k = 0; k < 2; ++k) dst[m][k] = *(const LAS bf16x8*)(lds + PG8_SA(b, h) + aoff + m * 2048 + k * 1024); } while (0)
#define PG8_LDB(dst, b, h) do { _Pragma("unroll") for (int n = 0; n < 2; ++n) _Pragma("unroll") for (int k = 0; k < 2; ++k) dst[n][k] = *(const LAS bf16x8*)(lds + PG8_SB(b, h) + boff + n * 2048 + k * 1024); } while (0)
#define PG8_MMA(ai, bj, At, Bt) do { __builtin_amdgcn_s_setprio(1); _Pragma("unroll") for (int m = 0; m < 4; ++m) _Pragma("unroll") for (int n = 0; n < 2; ++n) _Pragma("unroll") for (int k = 0; k < 2; ++k) \
    acc[ai][bj][m][n] = __builtin_amdgcn_mfma_f32_16x16x32_bf16(Bt[n][k], At[m][k], acc[ai][bj][m][n], 0, 0, 0); __builtin_amdgcn_s_setprio(0); } while (0)
#define PG8_WAIT_V(n) asm volatile("s_waitcnt vmcnt(" #n ")" ::: "memory")
#define PG8_WAIT_L(n) asm volatile("s_waitcnt lgkmcnt(" #n ")" ::: "memory")
#define PG8_BAR __builtin_amdgcn_s_barrier()
#define PG8_SCHED __builtin_amdgcn_sched_barrier(0)
  Unit cur, nxt; int ui = 0;
  if (!S.next(0, cur)) return;
  f32x4 acc[2][2][4][2];
#pragma unroll
  for (int a = 0; a < 2; ++a)
#pragma unroll
    for (int b = 0; b < 2; ++b)
#pragma unroll
      for (int m = 0; m < 4; ++m)
#pragma unroll
        for (int n = 0; n < 2; ++n) acc[a][b][m][n] = (f32x4){0.f, 0.f, 0.f, 0.f};
  bf16x8 At[4][2], B0[2][2], B1[2][2];
  const char* cA = (const char*)g.A + (size_t)cur.pm * tstep; const char* cB = (const char*)g.Bt + (size_t)cur.pn * tstep;
  S.a_ready(cur);
  PG8_STAGE(PG8_SB(0, 0), cB, voffB); PG8_STAGE(PG8_SA(0, 0), cA, voffA); PG8_STAGE(PG8_SB(0, 1), cB + hstep, voffB); PG8_STAGE(PG8_SA(0, 1), cA + hstep, voffA);
  if (wr == 1) PG8_BAR;
  PG8_WAIT_V(4); PG8_BAR;
  PG8_STAGE(PG8_SB(1, 0), cB + kstep, voffB); PG8_STAGE(PG8_SA(1, 0), cA + kstep, voffA); PG8_STAGE(PG8_SB(1, 1), cB + hstep + kstep, voffB);
  PG8_WAIT_V(6); PG8_BAR;
  for (;;) {
    const bool has_next = S.next(ui + 1, nxt);
    const char* nA = has_next ? (const char*)g.A + (size_t)nxt.pm * tstep : cA; const char* nB = has_next ? (const char*)g.Bt + (size_t)nxt.pn * tstep : cB;
    for (int t = 0; t < nt; t += 2) {
      const bool last = (t == nt - 2);
      const char* a1 = cA + (size_t)(t + 1) * kstep;
      const char* a2 = last ? nA : cA + (size_t)(t + 2) * kstep; const char* b2 = last ? nB : cB + (size_t)(t + 2) * kstep;
      const char* a3 = a2 + kstep; const char* b3 = b2 + kstep;
      if (last && has_next) S.a_ready(nxt);
      PG8_LDB(B0, 0, 0); PG8_SCHED; PG8_LDA(At, 0, 0); PG8_STAGE(PG8_SA(1, 1), a1 + hstep, voffA);
      PG8_WAIT_L(8); PG8_BAR; PG8_WAIT_L(0); PG8_MMA(0, 0, At, B0); PG8_BAR; PG8_SCHED;
      PG8_LDB(B1, 0, 1); PG8_STAGE(PG8_SB(0, 0), b2, voffB);
      PG8_BAR; PG8_WAIT_L(0); PG8_MMA(0, 1, At, B1); PG8_BAR;
      PG8_LDA(At, 0, 1); PG8_STAGE(PG8_SA(0, 0), a2, voffA);
      PG8_BAR; PG8_WAIT_L(0); PG8_MMA(1, 0, At, B0); PG8_BAR; PG8_SCHED;
      PG8_STAGE(PG8_SB(0, 1), b2 + hstep, voffB);
      PG8_WAIT_V(6); PG8_BAR; PG8_MMA(1, 1, At, B1); PG8_BAR;
      PG8_LDB(B0, 1, 0); PG8_SCHED; PG8_LDA(At, 1, 0); PG8_STAGE(PG8_SA(0, 1), a2 + hstep, voffA);
      PG8_WAIT_L(8); PG8_BAR; PG8_WAIT_L(0); PG8_MMA(0, 0, At, B0); PG8_BAR; PG8_SCHED;
      PG8_LDB(B1, 1, 1); PG8_STAGE(PG8_SB(1, 0), b3, voffB);
      PG8_BAR; PG8_WAIT_L(0); PG8_MMA(0, 1, At, B1); PG8_BAR;
      PG8_LDA(At, 1, 1); PG8_STAGE(PG8_SA(1, 0), a3, voffA);
      PG8_BAR; PG8_WAIT_L(0); PG8_MMA(1, 0, At, B0); PG8_BAR; PG8_SCHED;
      PG8_STAGE(PG8_SB(1, 1), b3 + hstep, voffB);
      PG8_WAIT_V(6); PG8_BAR; PG8_MMA(1, 1, At, B1); PG8_BAR;
    }
    E(acc, cur, ui, wr, wc, fr, fq); S.done(cur);
    if (!has_next) break;
#pragma unroll
    for (int a = 0; a < 2; ++a)
#pragma unroll
      for (int b = 0; b < 2; ++b)
#pragma unroll
        for (int m = 0; m < 4; ++m)
#pragma unroll
          for (int n = 0; n < 2; ++n) acc[a][b][m][n] = (f32x4){0.f, 0.f, 0.f, 0.f};
    cur = nxt; cA = nA; cB = nB; ++ui;
  }
  PG8_WAIT_V(0);
  if (wr == 0) PG8_BAR;
  PG8_BAR;
#undef PG8_SA
#undef PG8_SB
#undef PG8_STAGE
#undef PG8_LDA
#undef PG8_LDB
#undef PG8_MMA
#undef PG8_WAIT_V
#undef PG8_WAIT_L
#undef PG8_BAR
#undef PG8_SCHED
}
}
using pg8::Unit;
typedef f32x4 AccT[2][2][4][2];

struct EpiFfnIn {
  static constexpr bool PERM = true;
  const LAS float* RSL; bf16_t* H;
  __device__ __forceinline__ void operator()(const AccT& acc, const Unit& u, int ui, int wr, int wc, int fr, int fq) const {
#pragma unroll
    for (int ai = 0; ai < 2; ++ai)
#pragma unroll
      for (int m = 0; m < 4; ++m) {
        const int row = u.pm * 256 + ai * 128 + wr * 64 + m * 16 + fr; const float rs = RSL[ui * 256 + ai * 128 + wr * 64 + m * 16 + fr];
        const float c1 = rs * -1.4426950408889634f, rs2 = rs * rs;
        const f32x4 h0 = swiglu4(acc[ai][0][m][0], acc[ai][1][m][0], c1, rs2), h1 = swiglu4(acc[ai][0][m][1], acc[ai][1][m][1], c1, rs2);
        *(u32x4*)(H + (size_t)row * DFF + u.pn * 128 + wc * 32 + fq * 8) = pack8(h0, h1);
      }
  }
};
struct EpiRes {
  static constexpr bool PERM = true;
  bf16_t* XB; float* RSS; float s;
  __device__ __forceinline__ void operator()(const AccT& acc, const Unit& u, int ui, int wr, int wc, int fr, int fq) const {
#pragma unroll
    for (int ai = 0; ai < 2; ++ai) {
      u32x4 xh[4][2];
#pragma unroll
      for (int m = 0; m < 4; ++m)
#pragma unroll
        for (int bj = 0; bj < 2; ++bj)
          xh[m][bj] = *(const u32x4*)(XB + (size_t)(u.pm * 256 + ai * 128 + wr * 64 + m * 16 + fr) * DM + u.pn * 256 + bj * 128 + wc * 32 + fq * 8);
#pragma unroll
      for (int m = 0; m < 4; ++m) {
        const int row = u.pm * 256 + ai * 128 + wr * 64 + m * 16 + fr; float ss = 0.f;
#pragma unroll
        for (int bj = 0; bj < 2; ++bj) {
          const size_t o = (size_t)row * DM + u.pn * 256 + bj * 128 + wc * 32 + fq * 8;
          const u32x4 h4 = xh[m][bj];
          f32x4 y0 = {bf_lo(h4[0]), bf_hi(h4[0]), bf_lo(h4[1]), bf_hi(h4[1])}, y1 = {bf_lo(h4[2]), bf_hi(h4[2]), bf_lo(h4[3]), bf_hi(h4[3])};
          y0 += acc[ai][bj][m][0] * s; y1 += acc[ai][bj][m][1] * s;
          *(u32x4*)(XB + o) = pack8(y0, y1);
#pragma unroll
          for (int i = 0; i < 4; ++i) ss += y0[i] * y0[i] + y1[i] * y1[i];
        }
        ss += __shfl_xor(ss, 16); ss += __shfl_xor(ss, 32);
        if (fq == 0) RSS[(size_t)row * 16 + u.pn * 4 + wc] = ss;
      }
    }
  }
};
struct EpiM1 {
  static constexpr bool PERM = true;
  const LAS float* RSL; const float2* TAB; bf16_t* Z; bf16_t* Q; bf16_t* Kb; bf16_t* V;
  __device__ __forceinline__ void operator()(const AccT& acc, const Unit& u, int ui, int wr, int wc, int fr, int fq) const {
    const int pn = u.pn;
    if (pn < 4 || pn >= 8) {
      bf16_t* dst = pn < 4 ? Z : V; const int cb = (pn < 4 ? pn : pn - 8) * 256;
#pragma unroll
      for (int ai = 0; ai < 2; ++ai)
#pragma unroll
        for (int m = 0; m < 4; ++m) {
          const int row = u.pm * 256 + ai * 128 + wr * 64 + m * 16 + fr; const float rs = RSL[ui * 256 + ai * 128 + wr * 64 + m * 16 + fr];
#pragma unroll
          for (int bj = 0; bj < 2; ++bj)
            *(u32x4*)(dst + (size_t)row * 1024 + cb + bj * 128 + wc * 32 + fq * 8) = pack8(acc[ai][bj][m][0] * rs, acc[ai][bj][m][1] * rs);
        }
    } else {
      bf16_t* dst = pn < 6 ? Q : Kb; const int head = 2 * (pn < 6 ? pn - 4 : pn - 6) + (wc >> 1); const int d0 = 32 * (wc & 1) + 8 * fq;
#pragma unroll
      for (int aim = 0; aim < 4; ++aim) {
        const int ai = aim >> 1, m0 = (aim & 1) * 2;
        f32x4 tt[4][4];
#pragma unroll
        for (int m = m0; m < m0 + 2; ++m) {
          const int row = u.pm * 256 + ai * 128 + wr * 64 + m * 16 + fr; const int spos = row < 16384 ? (row & 2047) : row - 16384;
          const f32x4* tp = (const f32x4*)(TAB + (size_t)spos * 64 + d0);
          tt[m][0] = tp[0]; tt[m][1] = tp[1]; tt[m][2] = tp[2]; tt[m][3] = tp[3];
        }
#pragma unroll
        for (int m = m0; m < m0 + 2; ++m) {
          const int row = u.pm * 256 + ai * 128 + wr * 64 + m * 16 + fr; const float rs = RSL[ui * 256 + ai * 128 + wr * 64 + m * 16 + fr];
          const f32x4 t0 = tt[m][0], t1 = tt[m][1], t2 = tt[m][2], t3 = tt[m][3];
          f32x4 x1a = acc[ai][0][m][0] * rs, x1b = acc[ai][0][m][1] * rs, x2a = acc[ai][1][m][0] * rs, x2b = acc[ai][1][m][1] * rs;
          f32x4 ca = {t0[0], t0[2], t1[0], t1[2]}, sa = {t0[1], t0[3], t1[1], t1[3]}, cb2 = {t2[0], t2[2], t3[0], t3[2]}, sb = {t2[1], t2[3], t3[1], t3[3]};
          f32x4 o1a = x1a * ca - x2a * sa, o1b = x1b * cb2 - x2b * sb, o2a = x2a * ca + x1a * sa, o2b = x2b * cb2 + x1b * sb;
          bf16_t* op = dst + (size_t)row * 512 + head * 128 + d0;
          *(u32x4*)op = pack8(o1a, o1b); *(u32x4*)(op + 64) = pack8(o2a, o2b);
        }
      }
    }
  }
};
struct EpiM2 {
  static constexpr bool PERM = true;
  const LAS float* RSL; bf16_t* YN; bf16_t* GATES;
  __device__ __forceinline__ void operator()(const AccT& acc, const Unit& u, int ui, int wr, int wc, int fr, int fq) const {
    const int pn = u.pn;
    if (pn < 4) {
#pragma unroll
      for (int ai = 0; ai < 2; ++ai) {
        u32x4 yy[4][2];
#pragma unroll
        for (int m = 0; m < 4; ++m)
#pragma unroll
          for (int bj = 0; bj < 2; ++bj) yy[m][bj] = *(const u32x4*)(YN + (size_t)(u.pm * 256 + ai * 128 + wr * 64 + m * 16 + fr) * 1024 + pn * 256 + bj * 128 + wc * 32 + fq * 8);
#pragma unroll
        for (int m = 0; m < 4; ++m) {
          const int row = u.pm * 256 + ai * 128 + wr * 64 + m * 16 + fr; const float rs = RSL[ui * 256 + ai * 128 + wr * 64 + m * 16 + fr];
#pragma unroll
          for (int bj = 0; bj < 2; ++bj) {
            f32x4 a = acc[ai][bj][m][0] * rs, b = acc[ai][bj][m][1] * rs; const u32x4 y = yy[m][bj];
#pragma unroll
            for (int i = 0; i < 2; ++i) { a[2 * i] = fsilu(a[2 * i]) * bf_lo(y[i]); a[2 * i + 1] = fsilu(a[2 * i + 1]) * bf_hi(y[i]); b[2 * i] = fsilu(b[2 * i]) * bf_lo(y[2 + i]); b[2 * i + 1] = fsilu(b[2 * i + 1]) * bf_hi(y[2 + i]); }
            *(u32x4*)(YN + (size_t)row * 1024 + pn * 256 + bj * 128 + wc * 32 + fq * 8) = pack8(a, b);
          }
        }
      }
    } else {
#pragma unroll
      for (int ai = 0; ai < 2; ++ai)
#pragma unroll
        for (int m = 0; m < 4; ++m) {
          const int row = u.pm * 256 + ai * 128 + wr * 64 + m * 16 + fr; const float rs = RSL[ui * 256 + ai * 128 + wr * 64 + m * 16 + fr];
#pragma unroll
          for (int bj = 0; bj < 2; ++bj) {
            const float c1 = rs * -1.4426950408889634f;
            const f32x4 a = sigmoid4(acc[ai][bj][m][0], c1), b = sigmoid4(acc[ai][bj][m][1], c1);
            u32x2 g8; g8[0] = pack_u8x4(a[0], a[1], a[2], a[3]); g8[1] = pack_u8x4(b[0], b[1], b[2], b[3]);
            *(u32x2*)((unsigned char*)GATES + (size_t)row * 2048 + (pn - 4) * 256 + bj * 128 + wc * 32 + fq * 8) = g8;
          }
        }
    }
  }
};
template <int MODE> struct EpiComb {
  static constexpr bool PERM = true;
  const bf16_t* GATES; bf16_t* U;
  __device__ __forceinline__ void operator()(const AccT& acc, const Unit& u, int ui, int wr, int wc, int fr, int fq) const {
#pragma unroll
    for (int aim = 0; aim < 4; ++aim) {
      const int ai = aim >> 1, m0 = (aim & 1) * 2;
      u32x2 gv[4][2]; u32x4 yv[4][2];
#pragma unroll
      for (int m = m0; m < m0 + 2; ++m)
#pragma unroll
        for (int bj = 0; bj < 2; ++bj) {
          const size_t row = (size_t)(u.pm * 256 + ai * 128 + wr * 64 + m * 16 + fr); const int col = u.pn * 256 + bj * 128 + wc * 32 + fq * 8;
          gv[m][bj] = *(const u32x2*)((const unsigned char*)GATES + row * 2048 + MODE * 1024 + col);
          if (MODE == 1) yv[m][bj] = *(const u32x4*)(U + row * 1024 + col);
        }
#pragma unroll
      for (int m = m0; m < m0 + 2; ++m)
#pragma unroll
        for (int bj = 0; bj < 2; ++bj) {
          const size_t row = (size_t)(u.pm * 256 + ai * 128 + wr * 64 + m * 16 + fr); const int col = u.pn * 256 + bj * 128 + wc * 32 + fq * 8;
          const u32x2 gg = gv[m][bj];
          f32x4 a = acc[ai][bj][m][0], b = acc[ai][bj][m][1];
#pragma unroll
          for (int i = 0; i < 4; ++i) { a[i] *= u8f(gg[0], i); b[i] *= u8f(gg[1], i); }
          if (MODE == 1) { const u32x4 y = yv[m][bj];
#pragma unroll
            for (int i = 0; i < 2; ++i) { a[2 * i] += bf_lo(y[i]); a[2 * i + 1] += bf_hi(y[i]); b[2 * i] += bf_lo(y[2 + i]); b[2 * i + 1] += bf_hi(y[2 + i]); } }
          *(u32x4*)(U + row * 1024 + col) = pack8(a, b);
        }
    }
  }
};
template <bool USE_RS> struct EpiPlain {
  static constexpr bool PERM = true;
  const LAS float* RSL; bf16_t* O; int ldo; float s;
  __device__ __forceinline__ void operator()(const AccT& acc, const Unit& u, int ui, int wr, int wc, int fr, int fq) const {
#pragma unroll
    for (int ai = 0; ai < 2; ++ai)
#pragma unroll
      for (int m = 0; m < 4; ++m) {
        const int row = u.pm * 256 + ai * 128 + wr * 64 + m * 16 + fr; const float rs = USE_RS ? RSL[ui * 256 + ai * 128 + wr * 64 + m * 16 + fr] * s : s;
#pragma unroll
        for (int bj = 0; bj < 2; ++bj)
          *(u32x4*)(O + (size_t)row * ldo + u.pn * 256 + bj * 128 + wc * 32 + fq * 8) = pack8(acc[ai][bj][m][0] * rs, acc[ai][bj][m][1] * rs);
      }
  }
};

template <class Epi> __device__ __forceinline__ void run_gemm(LAS unsigned char* lds, const bf16_t* A, const bf16_t* Bt, int M, int N, int K, const Epi& E, const float* RSS = nullptr) {
  pg8::Gemm g{A, Bt, M, N, K}; pg8::StaticOrder S; S.init(M, N, gridDim.x, blockIdx.x);
  if (RSS) {
    LAS float* rsl = (LAS float*)(lds + 131072); const int tid = opaque_tid(); Unit u;
    for (int i = 0; S.next(i, u); ++i) if (tid < 256) rsl[i * 256 + tid] = row_rstd(RSS, u.pm * 256 + tid);
    __syncthreads();
  }
  pg8::gemm_phase<Epi, pg8::StaticOrder>(lds, g, S, E);
  __syncthreads();
}

__device__ void prep_tiles(const float* __restrict__ src, int ld, bf16_t* __restrict__ dst, int K, int Ndst, const float* __restrict__ gain, float scale,
                           int maptype, int mapbase, int& tbase, float* lt) {
  const int tid = opaque_tid(), G = gridDim.x;
  const int nkt = K >> 6, ntiles = (Ndst >> 6) * nkt;
  int start = (int)blockIdx.x - (tbase % G); if (start < 0) start += G;
  for (int t = start; t < ntiles; t += G) {
    const int nt = t / nkt, kt = t - nt * nkt, n0 = nt << 6, k0 = kt << 6;
    int sc0;
    if (maptype == 0) sc0 = mapbase + n0;
    else if (maptype == 1) { const int pn = n0 >> 8, h = (n0 >> 7) & 1, j = n0 & 127; sc0 = h * DFF + pn * 128 + j; }
    else { const int tt = n0 >> 8, c = n0 & 255, bj = c >> 7, cc = c & 127; sc0 = mapbase + (2 * tt + (cc >> 6)) * 128 + bj * 64 + (cc & 63); }
#pragma unroll
    for (int it = 0; it < 2; ++it) {
      const int idx = tid + it * 512, k = idx >> 4, n4 = idx & 15;
      const f32x4 v = *(const f32x4*)(src + (size_t)(k0 + k) * ld + sc0 + n4 * 4);
      const float g = scale * (gain ? gain[k0 + k] : 1.f);
      float* p = lt + k * 65 + n4 * 4; p[0] = v[0] * g; p[1] = v[1] * g; p[2] = v[2] * g; p[3] = v[3] * g;
    }
    __syncthreads();
    { const int n = tid >> 3, kc = (tid & 7) << 3; f32x4 a, b;
#pragma unroll
      for (int j = 0; j < 4; ++j) { a[j] = lt[(kc + j) * 65 + n]; b[j] = lt[(kc + 4 + j) * 65 + n]; }
      *(u32x4*)(dst + (size_t)(n0 + n) * K + k0 + kc) = pack8(a, b); }
    __syncthreads();
  }
  tbase += ntiles;
}
__device__ void prep_zfold(const float* __restrict__ wmix  , const float* __restrict__ gain, bf16_t* __restrict__ WM1, int& tbase, float* lt) {
  const int tid = opaque_tid(), G = gridDim.x;
  float* cosT = lt + 16 * 129; float* sinT = cosT + 128;
  int start = (int)blockIdx.x - (tbase % G); if (start < 0) start += G;
  for (int t = start; t < 256; t += G) {
    const int grp = t >> 6, k0 = (t & 63) << 4;
    { const int k = tid >> 5, c4 = tid & 31; const f32x4 v = *(const f32x4*)(wmix + (size_t)(k0 + k) * 5632 + grp * 128 + c4 * 4);
      float* p = lt + k * 129 + c4 * 4; p[0] = v[0]; p[1] = v[1]; p[2] = v[2]; p[3] = v[3]; }
    if (tid < 128) { cosT[tid] = __builtin_amdgcn_cosf((float)tid * (1.f / 128.f)); sinT[tid] = __builtin_amdgcn_sinf((float)tid * (1.f / 128.f)); }
    __syncthreads();
    { const int nl = tid >> 1, ri = nl >> 7, cc = nl & 127, kh = (tid & 1) << 3;
      float a0 = 0.f, a1 = 0.f, a2 = 0.f, a3 = 0.f, a4 = 0.f, a5 = 0.f, a6 = 0.f, a7 = 0.f;
      const float* lp = lt + kh * 129;
      for (int c = 0; c < 128; ++c) {
        const int idx = (c * cc) & 127; const float w = ri ? -sinT[idx] : cosT[idx];
        a0 += lp[c] * w; a1 += lp[129 + c] * w; a2 += lp[2 * 129 + c] * w; a3 += lp[3 * 129 + c] * w;
        a4 += lp[4 * 129 + c] * w; a5 += lp[5 * 129 + c] * w; a6 += lp[6 * 129 + c] * w; a7 += lp[7 * 129 + c] * w;
      }
      const float sc = 0.08838834764831845f; const float* gp = gain + k0 + kh;
      f32x4 o0 = {a0 * sc * gp[0], a1 * sc * gp[1], a2 * sc * gp[2], a3 * sc * gp[3]}, o1 = {a4 * sc * gp[4], a5 * sc * gp[5], a6 * sc * gp[6], a7 * sc * gp[7]};
      *(u32x4*)(WM1 + (size_t)(ri * 512 + grp * 128 + cc) * 1024 + k0 + kh) = pack8(o0, o1); }
    __syncthreads();
  }
  tbase += 256;
}

template <int STAGE>
__device__ void dft_item(const bf16_t* __restrict__ src, bf16_t* __restrict__ dst, const bf16_t* __restrict__ Ct, const bf16_t* __restrict__ St,
                         int N, int lgN, int rowbase, int j, int chblk, int S, int N1, int N2, LAS unsigned char* lds) {
  const int tid = opaque_tid(), w = tid >> 6, l = tid & 63;
  const int CB = 8192 >> lgN, stride = CB * 4 + 64;
  const int lgcpr = 11 - lgN, cpr = 1 << lgcpr;
#pragma unroll
  for (int it = 0; it < 4; ++it) {
    const int q = tid + it * 512, n = q >> lgcpr, cq = q & (cpr - 1), part = cq >> (lgcpr - 1), cc = cq & ((cpr >> 1) - 1);
    const int irow = STAGE == 1 ? rowbase + N2 * n + j : rowbase + j * N2 + n;
    const u32x4 v = *(const u32x4*)(src + (size_t)irow * 1024 + part * 512 + chblk * CB + cc * 8);
    *(LAS u32x4*)(lds + n * stride + (part * CB + cc * 8) * 2) = v;
  }
  __syncthreads();
  const int kts = N >> 5, kt = w & (kts - 1), chsub = w >> (lgN - 5);
  const int i16 = l & 15, q4 = i16 >> 2, p4 = i16 & 3, G1 = (l >> 4) & 1, h = l >> 5;
  const unsigned colre = (unsigned)(chsub * 32 + 16 * G1 + 4 * p4) * 2u, colim = colre + (unsigned)CB * 2u;
  const int kout = kt * 32 + (l & 31);
  f32x16 a0 = {}, a1 = {}, a2 = {};
  const int nks = N >> 4;
  bf16x8 Bc[8], Bs[8];
#pragma unroll
  for (int ks = 0; ks < 8; ++ks) if (ks < nks) { Bc[ks] = *(const bf16x8*)(Ct + kout * N + 16 * ks + 8 * h); Bs[ks] = *(const bf16x8*)(St + kout * N + 16 * ks + 8 * h); }
#pragma unroll
  for (int ks = 0; ks < 8; ++ks) if (ks < nks) {
    const unsigned rlo = (unsigned)(16 * ks + 8 * h + q4) * stride, rhi = rlo + 4u * stride;
    const bf16x8 Ar = tr_frag(lds, rlo + colre, rhi + colre), Ai = tr_frag(lds, rlo + colim, rhi + colim);
    a0 = mfma32(Ar, Bc[ks], a0); a0 = mfma32(Ai, Bs[ks], a0);
    if (STAGE == 1) { a1 = mfma32(Ai, Bc[ks], a1); a2 = mfma32(Ar, Bs[ks], a2); }
  }
  const int chb = chblk * CB + chsub * 32;
  if (STAGE == 1) {
    const int mm = (j * kout) & (S - 1); const float fr = (float)mm / (float)S;
    const float c = __builtin_amdgcn_cosf(fr), s = __builtin_amdgcn_sinf(fr);
    const size_t orow = (size_t)(rowbase + kout * N2 + j) * 1024;
    f32x16 re, im;
#pragma unroll
    for (int i = 0; i < 16; ++i) { const float yr = a0[i], yi = a1[i] - a2[i]; re[i] = yr * c + yi * s; im[i] = yi * c - yr * s; }
    store_tile16(dst + orow + chb, re, 1.f, h); store_tile16(dst + orow + 512 + chb, im, 1.f, h);
  } else {
    const size_t orow = (size_t)(rowbase + j + N1 * kout) * 512;
    store_tile16(dst + orow + chb, a0, 1.f, h);
  }
  __syncthreads();
}
template <int STAGE>
__device__ void dft_phase(const bf16_t* src, bf16_t* dst, const bf16_t* DT, LAS unsigned char* lds) {
  for (int it = blockIdx.x; it < 2048; it += gridDim.x) {
    if (it < 1024) dft_item<STAGE>(src, dst, DT + DT_C128, DT + DT_S128, 128, 7, 16384, it >> 3, it & 7, 16384, 128, 128, lds);
    else {
      const int r = it - 1024, b = r >> 7, rr = r & 127;
      if (STAGE == 1) dft_item<STAGE>(src, dst, DT + DT_C32, DT + DT_S32, 32, 5, b * 2048, rr >> 1, rr & 1, 2048, 32, 64, lds);
      else dft_item<STAGE>(src, dst, DT + DT_C64, DT + DT_S64, 64, 6, b * 2048, rr >> 2, rr & 3, 2048, 32, 64, lds);
    }
  }
}

__device__ void ret_state_item(const bf16_t* __restrict__ Kb, const bf16_t* __restrict__ Vb, bf16_t* __restrict__ STf, bf16_t* __restrict__ STb,
                               int cidx, int head, float lgf2, float lgb2, LAS unsigned char* lds) {
  const int tid = opaque_tid(), w = tid >> 6, l = tid & 63; const int row0 = cidx * 128;
  constexpr unsigned VS = 576, KS = 320, OKF = 73728, OKB = 114688;
#pragma unroll
  for (int it = 0; it < 8; ++it) { const int q = tid + it * 512, j = q >> 5, c = q & 31;
    *(LAS u32x4*)(lds + j * VS + c * 16) = *(const u32x4*)(Vb + (size_t)(row0 + j) * 1024 + head * 256 + c * 8); }
#pragma unroll
  for (int it = 0; it < 4; ++it) { const int q = tid + it * 512, j = q >> 4, c = q & 15;
    const u32x4 v = *(const u32x4*)(Kb + (size_t)(row0 + j) * 512 + head * 128 + c * 8);
    const float zf = __builtin_amdgcn_exp2f(lgf2 * (float)(127 - j)), zb = __builtin_amdgcn_exp2f(lgb2 * (float)j);
    u32x4 of, ob;
#pragma unroll
    for (int i = 0; i < 4; ++i) { const float a = bf_lo(v[i]), b = bf_hi(v[i]); of[i] = cvt_pk_bf16(a * zf, b * zf); ob[i] = cvt_pk_bf16(a * zb, b * zb); }
    *(LAS u32x4*)(lds + OKF + j * KS + c * 16) = of; *(LAS u32x4*)(lds + OKB + j * KS + c * 16) = ob; }
  __syncthreads();
  const int i16 = l & 15, q4 = i16 >> 2, p4 = i16 & 3, G1 = (l >> 4) & 1, h = l >> 5;
  const unsigned cofs = (unsigned)(16 * G1 + 4 * p4) * 2u;
  f32x16 af[4], ab[4];
#pragma unroll
  for (int i = 0; i < 4; ++i) { af[i] = (f32x16){}; ab[i] = (f32x16){}; }
  for (int ks = 0; ks < 8; ++ks) {
    const unsigned r = (unsigned)(16 * ks + 8 * h + q4);
    const bf16x8 Bv = tr_frag(lds, r * VS + w * 64 + cofs, (r + 4) * VS + w * 64 + cofs);
#pragma unroll
    for (int dt = 0; dt < 4; ++dt) {
      const bf16x8 Af = tr_frag(lds, OKF + r * KS + dt * 64 + cofs, OKF + (r + 4) * KS + dt * 64 + cofs);
      const bf16x8 Ab = tr_frag(lds, OKB + r * KS + dt * 64 + cofs, OKB + (r + 4) * KS + dt * 64 + cofs);
      af[dt] = mfma32(Af, Bv, af[dt]); ab[dt] = mfma32(Ab, Bv, ab[dt]);
    }
  }
  const size_t ob = ((size_t)(cidx * 4 + head) * 256 + w * 32 + (l & 31)) * 128;
#pragma unroll
  for (int dt = 0; dt < 4; ++dt) { store_tile16(STf + ob + dt * 32, af[dt], 1.f, h); store_tile16(STb + ob + dt * 32, ab[dt], 1.f, h); }
  __syncthreads();
}
__device__ void ret_scan_seq(bf16_t* __restrict__ ST, int c0, int nch, int sub  , float lg, bool bwd) {
  const float g = expf(lg * 128.f);
  bf16_t* base = ST + (size_t)c0 * 131072 + (size_t)sub * 2048 + opaque_tid() * 4;
  const long cstep = bwd ? -131072 : 131072;
  bf16_t* pc = base + (bwd ? (size_t)(nch - 1) * 131072 : 0);
  float s0 = 0.f, s1 = 0.f, s2 = 0.f, s3 = 0.f;
  u32x2 u[8], un[8];
#pragma unroll
  for (int i = 0; i < 8; ++i) u[i] = *(const u32x2*)(pc + i * cstep);
  for (int cb = 0; cb < nch; cb += 8) {
    const bool more = cb + 8 < nch;
    if (more) {
#pragma unroll
      for (int i = 0; i < 8; ++i) un[i] = *(const u32x2*)(pc + (8 + i) * cstep);
    }
#pragma unroll
    for (int i = 0; i < 8; ++i) {
      *(u32x2*)(pc + i * cstep) = pack4(s0, s1, s2, s3);
      s0 = g * s0 + bf_lo(u[i][0]); s1 = g * s1 + bf_hi(u[i][0]); s2 = g * s2 + bf_lo(u[i][1]); s3 = g * s3 + bf_hi(u[i][1]); }
    if (more) {
#pragma unroll
      for (int i = 0; i < 8; ++i) u[i] = un[i];
    }
    pc += 8 * cstep;
  }
}
__device__ void ret_out_item(const bf16_t* __restrict__ Qb, const bf16_t* __restrict__ Kb, bf16_t* Vb, const bf16_t* __restrict__ STf, const bf16_t* __restrict__ STb,
                             int cidx, int head, float lgf2, float lgb2, LAS unsigned char* lds) {
  const int tid = opaque_tid(), w = tid >> 6, l = tid & 63; const int row0 = cidx * 128;
  constexpr unsigned VS = 576, ORED = 73728, QS = 272, OQ = 74752, OK = 74752 + 34816;
#pragma unroll
  for (int it = 0; it < 8; ++it) { const int q = tid + it * 512, j = q >> 5, c = q & 31;
    *(LAS u32x4*)(lds + j * VS + c * 16) = *(const u32x4*)(Vb + (size_t)(row0 + j) * 1024 + head * 256 + c * 8); }
#pragma unroll
  for (int it = 0; it < 4; ++it) { const int q = tid + it * 512, j = q >> 4, c = q & 15;
    *(LAS u32x4*)(lds + OQ + j * QS + c * 16) = *(const u32x4*)(Qb + (size_t)(row0 + j) * 512 + head * 128 + c * 8);
    *(LAS u32x4*)(lds + OK + j * QS + c * 16) = *(const u32x4*)(Kb + (size_t)(row0 + j) * 512 + head * 128 + c * 8); }
  __syncthreads();
  const int ib = w & 3, eh = w >> 2, il = l & 31, h = l >> 5;
  const int i16 = l & 15, q4 = i16 >> 2, p4 = i16 & 3, G1 = (l >> 4) & 1;
  const int iloc = ib * 32 + il;
  bf16x8 qf[8];
#pragma unroll
  for (int ks = 0; ks < 8; ++ks) qf[ks] = *(const LAS bf16x8*)(lds + OQ + iloc * QS + (16 * ks + 8 * h) * 2);
  bf16x8 pf[4][2];
#pragma unroll
  for (int jt = 0; jt < 4; ++jt) {
    f32x16 a = {};
#pragma unroll
    for (int ks = 0; ks < 8; ++ks) a = mfma32(*(const LAS bf16x8*)(lds + OK + (jt * 32 + il) * QS + (16 * ks + 8 * h) * 2), qf[ks], a);
    u32x4 p0, p1;
#pragma unroll
    for (int r = 0; r < 16; r += 2) {
      float v[2];
#pragma unroll
      for (int e = 0; e < 2; ++e) { const int jl = jt * 32 + ((r + e) & 3) + 8 * ((r + e) >> 2) + 4 * h; const int dd = iloc - jl;
        const float dec = dd >= 0 ? __builtin_amdgcn_exp2f(lgf2 * (float)dd) : __builtin_amdgcn_exp2f(lgb2 * (float)(-dd)); v[e] = a[r + e] * dec; }
      const unsigned pk = cvt_pk_bf16(v[0], v[1]);
      if (r < 8) p0[r >> 1] = pk; else p1[(r - 8) >> 1] = pk;
    }
    pf[jt][0] = (bf16x8)p0; pf[jt][1] = (bf16x8)p1;
  }
  f32x16 acc[4];
#pragma unroll
  for (int i = 0; i < 4; ++i) acc[i] = (f32x16){};
  const unsigned cofs = (unsigned)(eh * 128 + 16 * G1 + 4 * p4) * 2u;
#pragma unroll
  for (int jt = 0; jt < 4; ++jt)
#pragma unroll
    for (int s = 0; s < 2; ++s) {
      const unsigned r = (unsigned)(jt * 32 + 16 * s + 4 * h + q4);
#pragma unroll
      for (int et = 0; et < 4; ++et) acc[et] = mfma32(tr_frag(lds, r * VS + et * 64 + cofs, (r + 8) * VS + et * 64 + cofs), pf[jt][s], acc[et]);
    }
#pragma unroll
  for (int dir = 0; dir < 2; ++dir) {
    const float xi = dir ? __builtin_amdgcn_exp2f(lgb2 * (float)(128 - iloc)) : __builtin_amdgcn_exp2f(lgf2 * (float)(iloc + 1));
    const bf16_t* sp = (dir ? STb : STf) + ((size_t)(cidx * 4 + head) * 256 + eh * 128 + il) * 128 + 8 * h;
#pragma unroll
    for (int kp = 0; kp < 4; ++kp) {
      bf16x8 sf[2][4];
#pragma unroll
      for (int k2 = 0; k2 < 2; ++k2)
#pragma unroll
        for (int et = 0; et < 4; ++et) sf[k2][et] = *(const bf16x8*)(sp + (size_t)et * 32 * 128 + 16 * (2 * kp + k2));
#pragma unroll
      for (int k2 = 0; k2 < 2; ++k2) {
        const bf16x8 sq = scale_frag(qf[2 * kp + k2], xi);
#pragma unroll
        for (int et = 0; et < 4; ++et) acc[et] = mfma32(sf[k2][et], sq, acc[et]);
      }
    }
  }
  float ss = 0.f;
#pragma unroll
  for (int et = 0; et < 4; ++et)
#pragma unroll
    for (int r = 0; r < 16; ++r) ss += acc[et][r] * acc[et][r];
  ss += __shfl_xor(ss, 32);
  LAS float* red = (LAS float*)(lds + ORED);
  if (h == 0) red[eh * 128 + iloc] = ss;
  __syncthreads();
  const float rn = rsqrtf((red[iloc] + red[128 + iloc]) * (1.f / 256.f) + 1e-6f);
  bf16_t* op = Vb + (size_t)(row0 + iloc) * 1024 + head * 256 + eh * 128;
#pragma unroll
  for (int et = 0; et < 4; ++et) store_tile16(op + et * 32, acc[et], rn, h);
  __syncthreads();
}

__device__ void attn_item(const bf16_t* __restrict__ QX, const bf16_t* __restrict__ KV, bf16_t* __restrict__ O, int tt, int head, LAS unsigned char* lds) {
  const int tid = opaque_tid(), w = tid >> 6, l = tid & 63; const int row0 = tt * 256; const int b = tt < 64 ? (tt >> 3) : 8; const int mrow0 = b * 256;
  constexpr unsigned KS = 528, VS = 576;
#pragma unroll 4
  for (int it = 0; it < 16; ++it) { const int q = tid + it * 512, m = q >> 5, c = q & 31;
    *(LAS u32x4*)(lds + m * KS + c * 16) = *(const u32x4*)(KV + (size_t)(mrow0 + m) * 2048 + head * 256 + c * 8); }
  __syncthreads();
  const int il = l & 31, h = l >> 5, i16 = l & 15, q4 = i16 >> 2, p4 = i16 & 3, G1 = (l >> 4) & 1;
  const int row = row0 + w * 32 + il;
  bf16x8 pf[8][2];
  float mxp = -3.0e38f, sum = 0.f;
  const bf16_t* qp = QX + (size_t)row * 1024 + head * 256 + 8 * h;
#pragma unroll
  for (int hf = 0; hf < 2; ++hf) {
    f32x16 sc[4];
#pragma unroll
    for (int i = 0; i < 4; ++i) sc[i] = (f32x16){};
#pragma unroll 4
    for (int ks = 0; ks < 16; ++ks) {
      const bf16x8 B = *(const bf16x8*)(qp + 16 * ks);
#pragma unroll
      for (int mt = 0; mt < 4; ++mt) sc[mt] = mfma32(*(const LAS bf16x8*)(lds + ((hf * 4 + mt) * 32 + il) * KS + (16 * ks + 8 * h) * 2), B, sc[mt]);
    }
    float mx = mxp;
#pragma unroll
    for (int mt = 0; mt < 4; ++mt)
#pragma unroll
      for (int r = 0; r < 16; ++r) mx = fmaxf(mx, sc[mt][r]);
    mx = fmaxf(mx, __shfl_xor(mx, 32));
    if (hf == 1) { const float f = __builtin_amdgcn_exp2f((mxp - mx) * 1.4426950408889634f); sum *= f;
#pragma unroll
      for (int mt = 0; mt < 4; ++mt) { pf[mt][0] = scale_frag(pf[mt][0], f); pf[mt][1] = scale_frag(pf[mt][1], f); } }
#pragma unroll
    for (int mt = 0; mt < 4; ++mt) {
      u32x4 p0, p1;
#pragma unroll
      for (int r = 0; r < 16; r += 2) {
        const float e0 = __builtin_amdgcn_exp2f((sc[mt][r] - mx) * 1.4426950408889634f), e1 = __builtin_amdgcn_exp2f((sc[mt][r + 1] - mx) * 1.4426950408889634f);
        sum += e0 + e1; const unsigned pk = cvt_pk_bf16(e0, e1);
        if (r < 8) p0[r >> 1] = pk; else p1[(r - 8) >> 1] = pk;
      }
      pf[hf * 4 + mt][0] = (bf16x8)p0; pf[hf * 4 + mt][1] = (bf16x8)p1;
    }
    mxp = mx;
  }
  sum += __shfl_xor(sum, 32);
  const float inv = __builtin_amdgcn_rcpf(sum);
  __builtin_amdgcn_sched_barrier(0);
  __syncthreads();
  __builtin_amdgcn_sched_barrier(0);
#pragma unroll 4
  for (int it = 0; it < 16; ++it) { const int q = tid + it * 512, m = q >> 5, c = q & 31;
    *(LAS u32x4*)(lds + m * VS + c * 16) = *(const u32x4*)(KV + (size_t)(mrow0 + m) * 2048 + 1024 + head * 256 + c * 8); }
  __syncthreads();
  __builtin_amdgcn_sched_barrier(0);
#pragma unroll 1
  for (int half = 0; half < 2; ++half) {
    f32x16 acc[4];
#pragma unroll
    for (int i = 0; i < 4; ++i) acc[i] = (f32x16){};
    const unsigned cofs = (unsigned)(half * 128 + 16 * G1 + 4 * p4) * 2u;
#pragma unroll
    for (int mt = 0; mt < 8; ++mt)
#pragma unroll
      for (int s = 0; s < 2; ++s) {
        const unsigned r = (unsigned)(mt * 32 + 16 * s + 4 * h + q4);
#pragma unroll
        for (int et = 0; et < 4; ++et) acc[et] = mfma32(tr_frag(lds, r * VS + et * 64 + cofs, (r + 8) * VS + et * 64 + cofs), pf[mt][s], acc[et]);
      }
    bf16_t* op = O + (size_t)row * 1024 + head * 256 + half * 128;
#pragma unroll
    for (int et = 0; et < 4; ++et) store_tile16(op + et * 32, acc[et], inv, h);
  }
  __syncthreads();
}

__device__ __forceinline__ float sel4(const float (&a)[4], int i) { return i == 0 ? a[0] : i == 1 ? a[1] : i == 2 ? a[2] : a[3]; }


#define XB_TMO      128
#define XB_XCNT(j)  (256  + 64 * (j))
#define XB_XSUB(j)  (1280 + 64 * (j))
#define XB_XGEN(j)  (2304 + 64 * (j))
#define XB_TOP      3328
#define XB_TOPGEN   3392
#define XCD_BAR_WORDS 3456
#define XB_SPIN_CAP (1u << 20)
__device__ __forceinline__ unsigned xb_ld(unsigned* p)              { return __hip_atomic_load(p, __ATOMIC_RELAXED, __HIP_MEMORY_SCOPE_AGENT); }
__device__ __forceinline__ unsigned xb_add(unsigned* p, unsigned v) { return __hip_atomic_fetch_add(p, v, __ATOMIC_RELAXED, __HIP_MEMORY_SCOPE_AGENT); }
__device__ __forceinline__ unsigned xb_xcc_id() { return (unsigned)__builtin_amdgcn_s_getreg((3 << 11) | 20) & 0xFu; }
#define XB_SPIN(cond, bar) do { unsigned _sp = 0; while (cond) { __builtin_amdgcn_s_sleep(1); \
    if ((++_sp & 255u) == 0u) { if (xb_ld(&(bar)[XB_TMO])) break; if (_sp > XB_SPIN_CAP) { atomicAdd(&(bar)[XB_TMO], 1u); break; } } } } while (0)
struct XcdBarrier { unsigned* bar; unsigned x; volatile LAS unsigned* st; };
__device__ __forceinline__ XcdBarrier xcd_barrier_post(unsigned* bar, volatile LAS unsigned* st) {
  XcdBarrier b; b.bar = bar; b.x = xb_xcc_id(); b.st = st;
  if (threadIdx.x == 0) (void)xb_add(&bar[XB_XCNT(b.x)], 1u);
  return b;
}
__device__ __forceinline__ void xcd_barrier_complete(unsigned* bar, unsigned x, unsigned& nloc, unsigned& nx) {
  const unsigned G = gridDim.x * gridDim.y * gridDim.z;
  unsigned sum, cnt, mine, sp = 0u;
  for (;;) {
    sum = 0u; cnt = 0u; mine = 0u;
#pragma unroll
    for (unsigned j = 0; j < 16; ++j) { const unsigned c = xb_ld(&bar[XB_XCNT(j)]); sum += c; cnt += (c > 0u) ? 1u : 0u; mine = (j == x) ? c : mine; }
    if (sum == G) break;
    __builtin_amdgcn_s_sleep(1);
    if ((++sp & 255u) == 0u) { if (xb_ld(&bar[XB_TMO])) break; if (sp > XB_SPIN_CAP) { atomicAdd(&bar[XB_TMO], 1u); break; } }
  }
  nloc = mine > 0u ? mine : 1u; nx = cnt > 0u ? cnt : 1u;
}
__device__ __forceinline__ void xcd_barrier(const XcdBarrier& b) {
  asm volatile("s_waitcnt vmcnt(0)" ::: "memory");
  __syncthreads();
  if (opaque_tid() == 0) {
    unsigned* bar = b.bar;
    __builtin_amdgcn_s_waitcnt(0);
    unsigned nloc = b.st[0], nx = b.st[1];
    if (nloc == 0u) { xcd_barrier_complete(bar, b.x, nloc, nx); b.st[0] = nloc; b.st[1] = nx; }
    const unsigned old = xb_add(&bar[XB_XSUB(b.x)], 1u);
    const unsigned gen = old / nloc;
    if (old + 1u == (gen + 1u) * nloc) {
      __builtin_amdgcn_fence(__ATOMIC_RELEASE, "agent");
      asm volatile("s_waitcnt vmcnt(0)" ::: "memory");
      const unsigned og = xb_add(&bar[XB_TOP], 1u);
      const unsigned tg = og / nx;
      if (og + 1u == (tg + 1u) * nx) xb_add(&bar[XB_TOPGEN], 1u);
      else XB_SPIN(xb_ld(&bar[XB_TOPGEN]) == tg, bar);
      __builtin_amdgcn_fence(__ATOMIC_ACQUIRE, "agent");
      xb_add(&bar[XB_XGEN(b.x)], 1u);
      asm volatile("s_waitcnt vmcnt(0)" ::: "memory");
    } else {
      XB_SPIN(xb_ld(&bar[XB_XGEN(b.x)]) == gen, bar);
      __builtin_amdgcn_fence(__ATOMIC_ACQUIRE, "agent");
      asm volatile("s_waitcnt vmcnt(0)" ::: "memory");
    }
  }
  __syncthreads();
}

__global__ void __launch_bounds__(512, 2) mega(Params p) {
  cg::grid_group grid = cg::this_grid();
  extern __shared__ __attribute__((aligned(16))) unsigned char smem_raw[];
  LAS unsigned char* lds = (LAS unsigned char*)smem_raw;
  float* ltf = (float*)smem_raw;
  const int tid = opaque_tid(), G = gridDim.x, wv = tid >> 6, lane = tid & 63;
  unsigned char* ws = p.ws;
  float2* TAB = (float2*)(ws + OFF_TAB); bf16_t* DT = (bf16_t*)(ws + OFF_DFT); bf16_t* MEMB = (bf16_t*)(ws + OFF_MEMB);
  float* RSS = (float*)(ws + OFF_RSS); bf16_t* XB = (bf16_t*)(ws + OFF_XB); bf16_t* WB = (bf16_t*)(ws + OFF_WB);
  bf16_t* RA = (bf16_t*)(ws + OFF_A); bf16_t* RS = (bf16_t*)(ws + OFF_S); bf16_t* RB = (bf16_t*)(ws + OFF_B);
  bf16_t* Zb = RA; bf16_t* Y1 = RA + 32 * MiB; bf16_t* GATES = RA; bf16_t* HID = RA; bf16_t* QX = RA; bf16_t* Ob = RA + 32 * MiB;
  bf16_t* STf = RS; bf16_t* STb = RS + 32 * MiB;
  bf16_t* Qb = RB; bf16_t* Kb = RB + 16 * MiB; bf16_t* Vb = RB + 32 * MiB; bf16_t* Fb = RB + 64 * MiB; bf16_t* Ub = RB; bf16_t* KVb = RB + 32 * MiB;
  float* X = p.X;
  bf16_t* XL = (bf16_t*)p.X;
  const LAS float* RSL = (const LAS float*)(lds + 131072);
  volatile LAS unsigned* xst = (volatile LAS unsigned*)(lds + 163824);
  if (threadIdx.x < 4) xst[threadIdx.x] = 0u;
  __syncthreads();
  const XcdBarrier xb = xcd_barrier_post((unsigned*)(ws + WS_NEED), xst);

  if (p.ws == nullptr) grid.sync();
  for (int r = blockIdx.x * 8 + wv; r < T_TOK; r += G * 8) {
    const float* src = r < 16384 ? p.in[0] + (size_t)r * DM : p.in[1] + (size_t)(r - 16384) * DM;
    float ss = 0.f;
#pragma unroll
    for (int k = 0; k < 4; ++k) { const f32x4 v = *(const f32x4*)(src + k * 256 + lane * 4);
      const u32x2 hi = pack4(v[0], v[1], v[2], v[3]);
      *(u32x2*)(XB + (size_t)r * DM + k * 256 + lane * 4) = hi;
      ss += v[0] * v[0] + v[1] * v[1] + v[2] * v[2] + v[3] * v[3]; }
#pragma unroll
    for (int o = 32; o; o >>= 1) ss += __shfl_xor(ss, o);
    if (lane < 16) RSS[(size_t)r * 16 + lane] = lane == 0 ? ss : 0.f;
  }
  for (int r = blockIdx.x * 8 + wv; r < NMEMROWS; r += G * 8) {
    const float* src = r < 2048 ? p.in[2] + (size_t)r * DM : p.in[3] + (size_t)(r - 2048) * DM;
    f32x4 v0 = *(const f32x4*)(src + lane * 4), v1 = *(const f32x4*)(src + 256 + lane * 4), v2 = *(const f32x4*)(src + 512 + lane * 4), v3 = *(const f32x4*)(src + 768 + lane * 4);
    float ss = 0.f;
#pragma unroll
    for (int i = 0; i < 4; ++i) ss += v0[i] * v0[i] + v1[i] * v1[i] + v2[i] * v2[i] + v3[i] * v3[i];
#pragma unroll
    for (int o = 32; o; o >>= 1) ss += __shfl_xor(ss, o);
    const float rs = rsqrtf(ss * (1.f / 1024.f) + 1e-6f);
    bf16_t* mp = MEMB + (size_t)r * DM + lane * 4;
    *(u32x2*)(mp) = pack4(v0[0] * rs, v0[1] * rs, v0[2] * rs, v0[3] * rs); *(u32x2*)(mp + 256) = pack4(v1[0] * rs, v1[1] * rs, v1[2] * rs, v1[3] * rs);
    *(u32x2*)(mp + 512) = pack4(v2[0] * rs, v2[1] * rs, v2[2] * rs, v2[3] * rs); *(u32x2*)(mp + 768) = pack4(v3[0] * rs, v3[1] * rs, v3[2] * rs, v3[3] * rs);
  }
  for (int i = blockIdx.x * 512 + tid; i < 16384 * 64; i += G * 512) {
    const int s = i >> 6, d = i & 63;
    const float e = (float)d * 2.0f / 128.0f; const float inv = 1.0f / powf(10000.0f, e); const float ang = (float)s * inv;
    const double a = (double)ang * 0.15915494309189535; const double fr = a - rint(a);
    const float f = (float)fr;
    TAB[i] = make_float2(__builtin_amdgcn_cosf(f), __builtin_amdgcn_sinf(f));
  }
  for (int i = blockIdx.x * 512 + tid; i < 16384 + 4096 + 1024; i += G * 512) {
    int N, k, n, oc, os;
    if (i < 16384) { N = 128; k = i >> 7; n = i & 127; oc = DT_C128 + i; os = DT_S128 + i; }
    else if (i < 20480) { const int q = i - 16384; N = 64; k = q >> 6; n = q & 63; oc = DT_C64 + q; os = DT_S64 + q; }
    else { const int q = i - 20480; N = 32; k = q >> 5; n = q & 31; oc = DT_C32 + q; os = DT_S32 + q; }
    const float fr = (float)((k * n) & (N - 1)) / (float)N; const float sc = rsqrtf((float)N);
    const unsigned pk = cvt_pk_bf16(__builtin_amdgcn_cosf(fr) * sc, __builtin_amdgcn_sinf(fr) * sc);
    DT[oc] = (bf16_t)(pk & 0xffffu); DT[os] = (bf16_t)(pk >> 16);
  }

  for (int layer = 0; layer < 4; ++layer) {
    {
      int tb = 0;
      const float* g1 = p.in[4] + layer * DM; const float* gm = p.in[7] + layer * DM; const float* gx = p.in[14] + layer * DM;
      const float* gmem = p.in[15] + layer * DM; const float* g2 = p.in[19] + layer * DM;
      const float* wmix = p.in[8] + (size_t)layer * 1024 * 5632;
      prep_tiles(p.in[5] + (size_t)layer * 1024 * 5632, 5632, WB + W_1I, 1024, 5632, g1, 1.f, 1, 0, tb, ltf);
      prep_tiles(p.in[6] + (size_t)layer * DFF * 1024, 1024, WB + W_1O, DFF, 1024, nullptr, 1.f, 0, 0, tb, ltf);
      prep_zfold(wmix, gm, WB + W_M1, tb, ltf);
      prep_tiles(wmix, 5632, WB + W_M1 + (size_t)1024 * 1024, 1024, 512, gm, 1.f, 2, 512, tb, ltf);
      prep_tiles(wmix, 5632, WB + W_M1 + (size_t)1536 * 1024, 1024, 512, gm, 0.08838834764831845f, 2, 1024, tb, ltf);
      prep_tiles(wmix, 5632, WB + W_M1 + (size_t)2048 * 1024, 1024, 1024, gm, 1.f, 0, 1536, tb, ltf);
      prep_tiles(wmix, 5632, WB + W_M2, 1024, 3072, gm, 1.f, 0, 2560, tb, ltf);
      prep_tiles(p.in[9] + (size_t)layer * 512 * 1024, 1024, WB + W_F, 512, 1024, nullptr, 1.f, 0, 0, tb, ltf);
      prep_tiles(p.in[12] + (size_t)layer * 1024 * 1024, 1024, WB + W_R, 1024, 1024, nullptr, 1.f, 0, 0, tb, ltf);
      prep_tiles(p.in[13] + (size_t)layer * 1024 * 1024, 1024, WB + W_MO, 1024, 1024, nullptr, 1.f, 0, 0, tb, ltf);
      prep_tiles(p.in[16] + (size_t)layer * 1024 * 1024, 1024, WB + W_Q, 1024, 1024, gx, 1.f, 0, 0, tb, ltf);
      prep_tiles(p.in[17] + (size_t)layer * 1024 * 2048, 2048, WB + W_KV, 1024, 2048, gmem, 1.f, 0, 0, tb, ltf);
      prep_tiles(p.in[18] + (size_t)layer * 1024 * 1024, 1024, WB + W_O, 1024, 1024, nullptr, 1.f, 0, 0, tb, ltf);
      prep_tiles(p.in[20] + (size_t)layer * 1024 * 5632, 5632, WB + W_2I, 1024, 5632, g2, 1.f, 1, 0, tb, ltf);
      prep_tiles(p.in[21] + (size_t)layer * DFF * 1024, 1024, WB + W_2O, DFF, 1024, nullptr, 1.f, 0, 0, tb, ltf);
    }
    xcd_barrier(xb);
    run_gemm(lds, XB, WB + W_1I, T_TOK, 5632, 1024, EpiFfnIn{RSL, HID}, RSS);
    xcd_barrier(xb);
    run_gemm(lds, HID, WB + W_1O, T_TOK, 1024, DFF, EpiRes{XB, RSS, 0.5f});
    xcd_barrier(xb);
    run_gemm(lds, XB, WB + W_M1, T_TOK, 3072, 1024, EpiM1{RSL, TAB, Zb, Qb, Kb, Vb}, RSS);
    xcd_barrier(xb);
    float lgf2[4], lgb2[4], lgf[4], lgb[4];
#pragma unroll
    for (int hh = 0; hh < 4; ++hh) { lgf[hh] = log_sigmoid(p.in[10][layer * 4 + hh]); lgb[hh] = log_sigmoid(p.in[11][layer * 4 + hh]);
      lgf2[hh] = lgf[hh] * 1.4426950408889634f; lgb2[hh] = lgb[hh] * 1.4426950408889634f; }
    dft_phase<1>(Zb, Y1, DT, lds);
    for (int it = blockIdx.x; it < 1024; it += G) { const int hh = it & 3; ret_state_item(Kb, Vb, STf, STb, it >> 2, hh, sel4(lgf2, hh), sel4(lgb2, hh), lds); }
    xcd_barrier(xb);
    dft_phase<2>(Y1, Fb, DT, lds);
    for (int it = blockIdx.x; it < 256; it += G) {
      if (it < 128) { const int dir = it >> 6, sub = it & 63, hh = sub >> 4; ret_scan_seq(dir ? STb : STf, 128, 128, sub, dir ? sel4(lgb, hh) : sel4(lgf, hh), dir); }
      else for (int k = 0; k < 8; ++k) { const int r = (it - 128) * 8 + k, b = r >> 7, dir = (r >> 6) & 1, sub = r & 63, hh = sub >> 4;
        ret_scan_seq(dir ? STb : STf, b * 16, 16, sub, dir ? sel4(lgb, hh) : sel4(lgf, hh), dir); }
    }
    xcd_barrier(xb);
    for (int it = blockIdx.x; it < 1024; it += G) { const int hh = it & 3; ret_out_item(Qb, Kb, Vb, STf, STb, it >> 2, hh, sel4(lgf2, hh), sel4(lgb2, hh), lds); }
    xcd_barrier(xb);
    run_gemm(lds, XB, WB + W_M2, T_TOK, 3072, 1024, EpiM2{RSL, Vb, GATES}, RSS);
    xcd_barrier(xb);
    run_gemm(lds, Fb, WB + W_F, T_TOK, 1024, 512, EpiComb<0>{GATES, Ub});
    run_gemm(lds, Vb, WB + W_R, T_TOK, 1024, 1024, EpiComb<1>{GATES, Ub});
    xcd_barrier(xb);
    run_gemm(lds, Ub, WB + W_MO, T_TOK, 1024, 1024, EpiRes{XB, RSS, 1.0f});
    run_gemm(lds, MEMB, WB + W_KV, NMEMROWS, 2048, 1024, EpiPlain<false>{RSL, KVb, 2048, 1.0f});
    xcd_barrier(xb);
    run_gemm(lds, XB, WB + W_Q, T_TOK, 1024, 1024, EpiPlain<true>{RSL, QX, 1024, 0.0625f}, RSS);
    { pg8::StaticOrder S; S.init(T_TOK, 1024, G, blockIdx.x); Unit u; for (int i = 0; S.next(i, u); ++i) attn_item(QX, KVb, Ob, u.pm, u.pn, lds); }
    xcd_barrier(xb);
    run_gemm(lds, Ob, WB + W_O, T_TOK, 1024, 1024, EpiRes{XB, RSS, 1.0f});
    xcd_barrier(xb);
    run_gemm(lds, XB, WB + W_2I, T_TOK, 5632, 1024, EpiFfnIn{RSL, HID}, RSS);
    xcd_barrier(xb);
    run_gemm(lds, HID, WB + W_2O, T_TOK, 1024, DFF, EpiRes{XB, RSS, 0.5f});
    xcd_barrier(xb);
  }
  const int tidf = opaque_tid(), wvf = tidf >> 6, lanef = tidf & 63;
  for (int r = blockIdx.x * 8 + wvf; r < T_TOK; r += G * 8) {
    const float rs = row_rstd(RSS, r);
#pragma unroll
    for (int k = 0; k < 4; ++k) { const size_t o = (size_t)r * DM + k * 256 + lanef * 4; const f32x4 g = *(const f32x4*)(p.in[22] + k * 256 + lanef * 4);
      const u32x2 hi = *(const u32x2*)(XB + o);
      f32x4 v = {bf_lo(hi[0]), bf_hi(hi[0]), bf_lo(hi[1]), bf_hi(hi[1])};
      *(f32x4*)(X + o) = v * rs * g; }
  }
}

extern "C" void kernel_launch(void* const* d_in, const int* in_sizes, int n_in, void* d_out, int out_size, void* d_ws, size_t ws_size, hipStream_t stream) {
  constexpr size_t kDynLds = 163840;
  static int grid_blocks = 0;
  if (!grid_blocks) {
    (void)hipFuncSetAttribute((const void*)mega, hipFuncAttributeMaxDynamicSharedMemorySize, (int)kDynLds);
    int dev = 0, cus = 0, per_cu = 0;
    (void)hipGetDevice(&dev);
    (void)hipDeviceGetAttribute(&cus, hipDeviceAttributeMultiprocessorCount, dev);
    (void)hipOccupancyMaxActiveBlocksPerMultiprocessor(&per_cu, mega, 512, kDynLds);
    grid_blocks = cus > 0 ? cus : 256;
    if (per_cu < 1) fprintf(stderr, "occupancy query returned %d\n", per_cu);
  }
  if (ws_size < WS_NEED + 16384) { fprintf(stderr, "workspace too small: %zu < %zu\n", ws_size, (size_t)WS_NEED); return; }
  (void)hipMemsetAsync((unsigned char*)d_ws + WS_NEED, 0, XCD_BAR_WORDS * 4, stream);
  Params p{};
  for (int i = 0; i < 23; ++i) p.in[i] = (const float*)d_in[i];
  p.X = (float*)d_out; p.ws = (unsigned char*)d_ws;
  void* args[] = {&p};
  hipError_t e = hipLaunchCooperativeKernel((void*)mega, dim3(grid_blocks), dim3(512), args, kDynLds, stream);
  if (e != hipSuccess) fprintf(stderr, "cooperative launch failed: %s (grid %d)\n", hipGetErrorString(e), grid_blocks);
}
```
